# Optimizing an MI355X kernel written in HIP

```python
import math
import jax, jax.numpy as jnp
from jax import lax
import numpy as np

D_MODEL = 2048
BATCH = 2
SEQ = 4096
DEPTH = 1

HEAD_DIM = 128
N_HEADS_A = 8
WIDTH_A = N_HEADS_A * HEAD_DIM
DILATED_PATTERNS = ((128, 1), (512, 4), (2048, 16))
N_HEADS_B = 4
DIFF_HEAD_DIM = 128
WIDTH_B = N_HEADS_B * 2 * DIFF_HEAD_DIM
IN_SPLITS = (WIDTH_A, WIDTH_A, WIDTH_A, WIDTH_B, WIDTH_B, WIDTH_B, D_MODEL, D_MODEL)
IN_WIDTH = sum(IN_SPLITS)
N_EXPERTS = 32
TOP_K = 4
D_FF = D_MODEL
SWIGLU_LIMIT = 7.0
SWIGLU_ALPHA = 1.702
MOE_BLOCK = 128
Q_BLOCK = 128
N_MOD = 6
EPS = 1e-5
NEG = -1e30

kernel_name = "hybrid_dilated_diffattn_moe_encoder"


def _alibi_slopes(n):
    return np.array([2.0 ** (-8.0 * (i + 1) / n) for i in range(n)], dtype=np.float32)


def rmsnorm(x, g):
    xf = x.astype(jnp.float32)
    y = xf * lax.rsqrt(jnp.mean(xf * xf, axis=-1, keepdims=True) + EPS)
    return (y * g.astype(jnp.float32)).astype(x.dtype)


def _dilated_pattern(q, k, v, window, dilation, slopes):
    B, S, H, Dh = q.shape
    d = dilation
    R = window // (2 * d)
    L = S // d
    nb = -(-L // R)
    Lp = nb * R

    def to_sub(t):
        t = t.reshape(B, L, d, H, Dh).transpose(0, 2, 1, 3, 4)
        t = jnp.pad(t, ((0, 0), (0, 0), (0, Lp - L), (0, 0), (0, 0)))
        return t.reshape(B, d, nb, R, H, Dh)

    def band(t):
        tp = jnp.pad(t, ((0, 0), (0, 0), (1, 1), (0, 0), (0, 0), (0, 0)))
        return jnp.concatenate([tp[:, :, :-2], tp[:, :, 1:-1], tp[:, :, 2:]], axis=3)

    qs = to_sub(q)
    kw = band(to_sub(k))
    vw = band(to_sub(v))
    qi = np.arange(nb)[:, None, None] * R + np.arange(R)[None, :, None]
    kj = (np.arange(nb)[:, None, None] - 1) * R + np.arange(3 * R)[None, None, :]
    rel = kj - qi
    valid = (np.abs(rel) <= R) & (kj >= 0) & (kj < L)
    dist = (np.abs(rel) * d).astype(np.float32)
    bias = -slopes[None, :, None, None] * dist[:, None]
    s = jnp.einsum('brnqhe,brnkhe->brnhqk', qs, kw).astype(jnp.float32) * (Dh ** -0.5) + bias
    s = jnp.where(valid[:, None], s, NEG)
    lse = jax.nn.logsumexp(s, axis=-1)
    p = jnp.exp(s - lse[..., None])
    o = jnp.einsum('brnhqk,brnkhe->brnqhe', p.astype(v.dtype), vw)
    o = o.reshape(B, d, Lp, H, Dh)[:, :, :L].transpose(0, 2, 1, 3, 4).reshape(B, S, H, Dh)
    lse = lse.transpose(0, 1, 2, 4, 3).reshape(B, d, Lp, H)[:, :, :L]
    lse = lse.transpose(0, 2, 1, 3).reshape(B, S, H)
    return o, lse


def dilated_attention(q, k, v, slopes):
    outs, lses = [], []
    for window, dilation in DILATED_PATTERNS:
        o, l = _dilated_pattern(q, k, v, window, dilation, slopes)
        outs.append(o)
        lses.append(l)
    o = jnp.stack(outs, axis=0)
    w = jax.nn.softmax(jnp.stack(lses, axis=0), axis=0)
    return jnp.einsum('pbsh,pbshe->bshe', w.astype(o.dtype), o)


def diff_attention(q, k, v, lam_q1, lam_k1, lam_q2, lam_k2, subln_g, slopes, lambda_init):
    B, S, H, _, Dh = q.shape
    f32 = jnp.float32
    lam = (jnp.exp(jnp.sum(lam_q1.astype(f32) * lam_k1.astype(f32)))
           - jnp.exp(jnp.sum(lam_q2.astype(f32) * lam_k2.astype(f32))) + lambda_init)
    nblk = S // Q_BLOCK
    kpos = jnp.arange(S)
    qb = q.reshape(B, nblk, Q_BLOCK, H, 2, Dh).transpose(1, 0, 2, 3, 4, 5)

    def block(args):
        i, qblk = args
        qpos = i * Q_BLOCK + jnp.arange(Q_BLOCK)
        dist = jnp.abs(qpos[:, None] - kpos[None, :]).astype(f32)
        bias = -slopes[:, None, None] * dist[None]
        s = jnp.einsum('bqhcd,bkhcd->bchqk', qblk, k).astype(f32) * (Dh ** -0.5) + bias[None, None]
        p = jax.nn.softmax(s, axis=-1)
        a = p[:, 0] - lam * p[:, 1]
        return jnp.einsum('bhqk,bkhe->bqhe', a.astype(v.dtype), v)

    o = lax.map(block, (jnp.arange(nblk), qb))
    o = o.transpose(1, 0, 2, 3, 4).reshape(B, S, H, 2 * Dh)
    return rmsnorm(o, subln_g) * (1.0 - lambda_init)


def moe(h, w_router, b_router, w_gate, b_gate, w_up, b_up, w_down, b_down):
    B, S, D = h.shape
    T = B * S
    TK = T * TOP_K
    xt = h.reshape(T, D)
    logits = (xt @ w_router + b_router).astype(jnp.float32)
    top_vals, top_idx = lax.top_k(logits, TOP_K)
    probs = jax.nn.softmax(top_vals, axis=-1)
    flat_e = top_idx.reshape(-1)
    flat_tok = jnp.repeat(jnp.arange(T, dtype=jnp.int32), TOP_K)
    order = jnp.argsort(flat_e)
    se = flat_e[order]
    stok = flat_tok[order]
    counts = jnp.bincount(flat_e, length=N_EXPERTS)
    starts = jnp.cumsum(counts) - counts
    padded = (counts + MOE_BLOCK - 1) // MOE_BLOCK * MOE_BLOCK
    pends = jnp.cumsum(padded)
    pstarts = pends - padded
    dest = pstarts[se] + (jnp.arange(TK) - starts[se])
    nblk = -(-TK // MOE_BLOCK) + N_EXPERTS
    buf_tok = jnp.full((nblk * MOE_BLOCK,), T, dtype=jnp.int32).at[dest].set(stok)
    block_expert = jnp.clip(jnp.searchsorted(pends, jnp.arange(nblk) * MOE_BLOCK, side='right'),
                            0, N_EXPERTS - 1)
    x_pad = jnp.concatenate([xt, jnp.zeros((1, D), xt.dtype)], axis=0)

    def block(args):
        e, toks = args
        xb = x_pad[toks]
        g = jnp.minimum(xb @ w_gate[e] + b_gate[e], SWIGLU_LIMIT)
        u = jnp.clip(xb @ w_up[e] + b_up[e], -SWIGLU_LIMIT, SWIGLU_LIMIT)
        y = (u + 1.0) * (g * jax.nn.sigmoid(SWIGLU_ALPHA * g))
        return y @ w_down[e] + b_down[e]

    ybuf = lax.map(block, (block_expert, buf_tok.reshape(nblk, MOE_BLOCK))).reshape(-1, D)
    y_sorted = ybuf[dest]
    y_slots = jnp.zeros_like(y_sorted).at[order].set(y_sorted).reshape(T, TOP_K, D)
    out = jnp.einsum('tk,tkd->td', probs.astype(y_slots.dtype), y_slots)
    return out.reshape(B, S, D).astype(h.dtype)


def setup_inputs(seed: int = 0) -> dict:
    key = jax.random.key(seed)
    ks = jax.random.split(key, 24)

    def nrm(k, shape, scale):
        return jax.random.normal(k, shape, jnp.float32) * scale

    L = DEPTH
    return {
        "x": nrm(ks[0], (BATCH, SEQ, D_MODEL), 1.0),
        "c": nrm(ks[1], (BATCH, D_MODEL), 1.0),
        "w_ada": nrm(ks[2], (L, D_MODEL, N_MOD * D_MODEL), 0.5 * D_MODEL ** -0.5),
        "b_ada": nrm(ks[3], (L, N_MOD * D_MODEL), 0.02),
        "norm1_g": 1.0 + nrm(ks[4], (L, D_MODEL), 0.02),
        "w_in": nrm(ks[5], (L, D_MODEL, IN_WIDTH), D_MODEL ** -0.5),
        "lam_q1": nrm(ks[6], (L, DIFF_HEAD_DIM), 0.1),
        "lam_k1": nrm(ks[7], (L, DIFF_HEAD_DIM), 0.1),
        "lam_q2": nrm(ks[8], (L, DIFF_HEAD_DIM), 0.1),
        "lam_k2": nrm(ks[9], (L, DIFF_HEAD_DIM), 0.1),
        "subln_g": 1.0 + nrm(ks[10], (L, 2 * DIFF_HEAD_DIM), 0.02),
        "w_out_a": nrm(ks[11], (L, WIDTH_A, D_MODEL), WIDTH_A ** -0.5),
        "w_out_b": nrm(ks[12], (L, WIDTH_B, D_MODEL), WIDTH_B ** -0.5),
        "w_o": nrm(ks[13], (L, D_MODEL, D_MODEL), D_MODEL ** -0.5),
        "norm2_g": 1.0 + nrm(ks[14], (L, D_MODEL), 0.02),
        "w_router": nrm(ks[15], (L, D_MODEL, N_EXPERTS), D_MODEL ** -0.5),
        "b_router": nrm(ks[16], (L, N_EXPERTS), 0.01),
        "w_gate": nrm(ks[17], (L, N_EXPERTS, D_MODEL, D_FF), D_MODEL ** -0.5),
        "b_gate": nrm(ks[18], (L, N_EXPERTS, D_FF), 0.01),
        "w_up": nrm(ks[19], (L, N_EXPERTS, D_MODEL, D_FF), D_MODEL ** -0.5),
        "b_up": nrm(ks[20], (L, N_EXPERTS, D_FF), 0.01),
        "w_down": nrm(ks[21], (L, N_EXPERTS, D_FF, D_MODEL), D_FF ** -0.5),
        "b_down": nrm(ks[22], (L, N_EXPERTS, D_MODEL), 0.01),
        "final_g": 1.0 + nrm(ks[23], (D_MODEL,), 0.02),
    }


def reference(x, c, w_ada, b_ada, norm1_g, w_in, lam_q1, lam_k1, lam_q2, lam_k2, subln_g,
              w_out_a, w_out_b, w_o, norm2_g, w_router, b_router, w_gate, b_gate, w_up, b_up,
              w_down, b_down, final_g):
    B, S, D = x.shape
    slopes = _alibi_slopes(N_HEADS_A + N_HEADS_B)
    slopes_a = jnp.asarray(slopes[:N_HEADS_A])
    slopes_b = jnp.asarray(slopes[N_HEADS_A:])
    split_points = np.cumsum(IN_SPLITS)[:-1].tolist()
    h = x
    for l in range(DEPTH):
        lambda_init = 0.8 - 0.6 * math.exp(-0.3 * l)
        mod = (jax.nn.silu(c) @ w_ada[l] + b_ada[l]).reshape(B, N_MOD, 1, D)
        sh1, sc1, g1, sh2, sc2, g2 = (mod[:, i] for i in range(N_MOD))

        u = rmsnorm(h, norm1_g[l]) * (1.0 + sc1) + sh1
        q_a, k_a, v_a, q_b, k_b, v_b, gate_a, gate_b = jnp.split(u @ w_in[l], split_points, axis=-1)
        y_a = dilated_attention(q_a.reshape(B, S, N_HEADS_A, HEAD_DIM),
                                k_a.reshape(B, S, N_HEADS_A, HEAD_DIM),
                                v_a.reshape(B, S, N_HEADS_A, HEAD_DIM), slopes_a)
        y_b = diff_attention(q_b.reshape(B, S, N_HEADS_B, 2, DIFF_HEAD_DIM),
                             k_b.reshape(B, S, N_HEADS_B, 2, DIFF_HEAD_DIM),
                             v_b.reshape(B, S, N_HEADS_B, 2 * DIFF_HEAD_DIM),
                             lam_q1[l], lam_k1[l], lam_q2[l], lam_k2[l], subln_g[l],
                             slopes_b, lambda_init)
        merged = (jax.nn.sigmoid(gate_a) * (y_a.reshape(B, S, WIDTH_A) @ w_out_a[l])
                  + jax.nn.sigmoid(gate_b) * (y_b.reshape(B, S, WIDTH_B) @ w_out_b[l]))
        h = h + g1 * (merged @ w_o[l])

        u2 = rmsnorm(h, norm2_g[l]) * (1.0 + sc2) + sh2
        h = h + g2 * moe(u2, w_router[l], b_router[l], w_gate[l], b_gate[l], w_up[l], b_up[l],
                         w_down[l], b_down[l])
    return rmsnorm(h, final_g)
```

```cpp
#include <hip/hip_runtime.h>
#include <cstdio>
#include <cstdint>
#include <cstring>
#include <cmath>
namespace pg8 {
#define PG8_LAS __attribute__((address_space(3)))
typedef unsigned short bf16_t;
typedef short bf16x8 __attribute__((ext_vector_type(8)));
typedef float f32x4 __attribute__((ext_vector_type(4)));
typedef unsigned u32x4 __attribute__((ext_vector_type(4)));
constexpr int BM = 256, BK = 64, HALF = 128, HTB = HALF * BK * 2  , STAGE_BYTES = 8 * HTB, NXCD = 8, WGM = 8;

__host__ __device__ __forceinline__ int lds_byte(int r, int c) { const int st = (r >> 4) * 2 + (c >> 5), rr = r & 15, cc = c & 31, ob = rr * 64 + cc * 2; return st * 1024 + (ob ^ (((ob >> 9) & 1) << 5)); }
__host__ __device__ __forceinline__ void stage_rc(int b, int& R, int& C) { const int st = b / 1024, sb = b % 1024, swz = sb ^ (((sb >> 9) & 1) << 5); R = (st >> 1) * 16 + swz / 64; C = (st & 1) * 32 + (swz % 64) / 2; }
__host__ __device__ __forceinline__ int perm32(int rho) { const int n = rho >> 4, i = rho & 15; return 8 * (i >> 2) + 4 * n + (i & 3); }

struct Unit { int pm, pn; };
struct Gemm { const bf16_t* A; const bf16_t* Bt; int M, N, K; };

struct StaticOrder {
    int nM, nN, nwg, G, c;
    __host__ __device__ void init(int M, int N, int G_, int c_) { nM = M / BM; nN = N / BM; nwg = nM * nN; G = G_; c = c_; }
    __host__ __device__ bool next(int i, Unit& u) const {
        const long L = (long)i * G + c; if (L >= nwg) return false;
        int wgid = (int)L; { const int q = nwg / NXCD, r = nwg % NXCD, xcd = wgid % NXCD, off = wgid / NXCD; wgid = (xcd < r ? xcd * (q + 1) : r * (q + 1) + (xcd - r) * q) + off; }
        const int nig = WGM * nN, gid = wgid / nig, fm = gid * WGM, gsz = (nM - fm) < WGM ? (nM - fm) : WGM;
        u.pm = fm + ((wgid % nig) % gsz); u.pn = (wgid % nig) / gsz; return true;
    }
    __device__ __forceinline__ void a_ready(const Unit&) const {}
    __device__ __forceinline__ void done(const Unit&) const {}
};

__device__ __forceinline__ unsigned cvt_pk_bf16(float lo, float hi) { unsigned r; asm volatile("v_cvt_pk_bf16_f32 %0, %1, %2" : "=v"(r) : "v"(lo), "v"(hi)); return r; }

template <class Epi, class Sched, bool ALIGN_EPI = false, bool SP2 = false>
__device__ __forceinline__ void gemm_phase(PG8_LAS unsigned char* lds, const Gemm g, const Sched& S, const Epi& E) {
    const int tid = threadIdx.x, wid = __builtin_amdgcn_readfirstlane(tid >> 6), lane = tid & 63, wr = wid >> 2, wc = wid & 3, fr = lane & 15, fq = lane >> 4;
    const int K = g.K, nt = K / BK;
    unsigned voffA[2], voffB[2];
#pragma unroll
    for (int i = 0; i < 2; ++i) { int R, C; stage_rc(tid * 16 + i * 8192, R, C); const int Rb = Epi::PERM ? ((R & ~31) + perm32(R & 31)) : R;
        voffA[i] = (unsigned)(R * K + C) * 2u; voffB[i] = (unsigned)(Rb * K + C) * 2u; }
    const size_t kstep = (size_t)(BK * 2);
    const size_t hstep = (size_t)HALF * K * 2;
    const size_t tstep = 2 * hstep;
    const unsigned ldsw = (unsigned)wid * 1024u;
    const int aoff = lds_byte(wr * 64 + fr, fq * 8), boff = lds_byte(wc * 32 + fr, fq * 8);
#define PG8_SA(b, h) (((b) * 2 + (h)) * HTB)
#define PG8_SB(b, h) ((4 + (b) * 2 + (h)) * HTB)
#define PG8_STAGE(bufoff, gbase, voff) do { _Pragma("unroll") for (int _i = 0; _i < 2; ++_i) \
        __builtin_amdgcn_global_load_lds((const unsigned*)((const char*)(gbase) + (voff)[_i]), (PG8_LAS unsigned*)(lds + (bufoff) + ldsw + _i * 8192), 16, 0, 0); } while (0)
#define PG8_LDA(dst, b, h) do { _Pragma("unroll") for (int m = 0; m < 4; ++m) _Pragma("unroll") for (int k = 0; k < 2; ++k) dst[m][k] = *(const PG8_LAS bf16x8*)(lds + PG8_SA(b, h) + aoff + m * 2048 + k * 1024); } while (0)
#define PG8_LDB(dst, b, h) do { _Pragma("unroll") for (int n = 0; n < 2; ++n) _Pragma("unroll") for (int k = 0; k < 2; ++k) dst[n][k] = *(const PG8_LAS bf16x8*)(lds + PG8_SB(b, h) + boff + n * 2048 + k * 1024); } while (0)
#define PG8_MMA(ai, bj, At, Bt) do { __builtin_amdgcn_s_setprio(1); _Pragma("unroll") for (int m = 0; m < 4; ++m) _Pragma("unroll") for (int n = 0; n < 2; ++n) _Pragma("unroll") for (int k = 0; k < 2; ++k) \
        acc[ai][bj][m][n] = __builtin_amdgcn_mfma_f32_16x16x32_bf16(Bt[n][k], At[m][k], acc[ai][bj][m][n], 0, 0, 0); __builtin_amdgcn_s_setprio(0); } while (0)
#define PG8_WAIT_V(n) asm volatile("s_waitcnt vmcnt(" #n ")" ::: "memory")
#define PG8_WAIT_L(n) asm volatile("s_waitcnt lgkmcnt(" #n ")" ::: "memory")
#define PG8_BAR __builtin_amdgcn_s_barrier()
#define PG8_SCHED __builtin_amdgcn_sched_barrier(0)
    Unit cur, nxt; int ui = 0;
    if (!S.next(0, cur)) return;
    f32x4 acc[2][2][4][2];
#pragma unroll
    for (int a = 0; a < 2; ++a)
#pragma unroll
        for (int b = 0; b < 2; ++b)
#pragma unroll
            for (int m = 0; m < 4; ++m)
#pragma unroll
                for (int n = 0; n < 2; ++n) acc[a][b][m][n] = (f32x4){0.f, 0.f, 0.f, 0.f};
    bf16x8 At[4][2], B0[2][2], B1[2][2];
    const char* cA = (const char*)g.A + (size_t)cur.pm * tstep; const char* cB = (const char*)g.Bt + (size_t)cur.pn * tstep;
    S.a_ready(cur);
    if constexpr (SP2) {
        PG8_STAGE(PG8_SB(0, 0), cB, voffB); PG8_STAGE(PG8_SB(0, 1), cB + hstep, voffB); PG8_STAGE(PG8_SA(0, 0), cA, voffA); PG8_STAGE(PG8_SA(0, 1), cA + hstep, voffA);
        if (wr == 1) PG8_BAR;
        PG8_WAIT_V(2); PG8_BAR;
        PG8_STAGE(PG8_SB(1, 0), cB + kstep, voffB); PG8_STAGE(PG8_SA(1, 0), cA + kstep, voffA); PG8_STAGE(PG8_SB(1, 1), cB + hstep + kstep, voffB);
        PG8_WAIT_V(6); PG8_BAR;
    } else {
        PG8_STAGE(PG8_SB(0, 0), cB, voffB); PG8_STAGE(PG8_SA(0, 0), cA, voffA); PG8_STAGE(PG8_SB(0, 1), cB + hstep, voffB); PG8_STAGE(PG8_SA(0, 1), cA + hstep, voffA);
        if (wr == 1) PG8_BAR;
        PG8_WAIT_V(4); PG8_BAR;
        PG8_STAGE(PG8_SB(1, 0), cB + kstep, voffB); PG8_STAGE(PG8_SA(1, 0), cA + kstep, voffA); PG8_STAGE(PG8_SB(1, 1), cB + hstep + kstep, voffB);
        PG8_WAIT_V(6); PG8_BAR;
    }
    for (;;) {
        const bool has_next = S.next(ui + 1, nxt);
        const char* nA = has_next ? (const char*)g.A + (size_t)nxt.pm * tstep : cA; const char* nB = has_next ? (const char*)g.Bt + (size_t)nxt.pn * tstep : cB;
        for (int t = 0; t < nt; t += 2) {
            const bool last = (t == nt - 2);
            const char* a1 = cA + (size_t)(t + 1) * kstep;
            const char* a2 = last ? nA : cA + (size_t)(t + 2) * kstep; const char* b2 = last ? nB : cB + (size_t)(t + 2) * kstep;
            const char* a3 = a2 + kstep; const char* b3 = b2 + kstep;
            if (last && has_next) S.a_ready(nxt);
            if constexpr (SP2) {
            PG8_LDB(B0, 0, 0); PG8_LDB(B1, 0, 1); PG8_SCHED; PG8_LDA(At, 0, 0); PG8_STAGE(PG8_SA(1, 1), a1 + hstep, voffA);
            PG8_WAIT_V(8); PG8_WAIT_L(0); PG8_BAR; PG8_MMA(0, 0, At, B0); PG8_MMA(0, 1, At, B1); PG8_BAR; PG8_SCHED;
            PG8_LDA(At, 0, 1); PG8_STAGE(PG8_SB(0, 0), b2, voffB); PG8_STAGE(PG8_SB(0, 1), b2 + hstep, voffB); PG8_STAGE(PG8_SA(0, 0), a2, voffA);
            PG8_WAIT_V(8); PG8_WAIT_L(0); PG8_BAR; PG8_MMA(1, 0, At, B0); PG8_MMA(1, 1, At, B1); PG8_BAR; PG8_SCHED;
            PG8_LDB(B0, 1, 0); PG8_LDB(B1, 1, 1); PG8_SCHED; PG8_LDA(At, 1, 0); PG8_STAGE(PG8_SA(0, 1), a2 + hstep, voffA);
            PG8_WAIT_V(8); PG8_WAIT_L(0); PG8_BAR; PG8_MMA(0, 0, At, B0); PG8_MMA(0, 1, At, B1); PG8_BAR; PG8_SCHED;
            PG8_LDA(At, 1, 1); PG8_STAGE(PG8_SB(1, 0), b3, voffB); PG8_STAGE(PG8_SB(1, 1), b3 + hstep, voffB); PG8_STAGE(PG8_SA(1, 0), a3, voffA);
            PG8_WAIT_V(8); PG8_WAIT_L(0); PG8_BAR; PG8_MMA(1, 0, At, B0); PG8_MMA(1, 1, At, B1); PG8_BAR; PG8_SCHED;
            } else {
            PG8_LDB(B0, 0, 0); PG8_SCHED; PG8_LDA(At, 0, 0); PG8_STAGE(PG8_SA(1, 1), a1 + hstep, voffA);
            PG8_WAIT_L(8); PG8_BAR; PG8_WAIT_L(0); PG8_MMA(0, 0, At, B0); PG8_BAR; PG8_SCHED;
            PG8_LDB(B1, 0, 1); PG8_STAGE(PG8_SB(0, 0), b2, voffB);
            PG8_BAR; PG8_WAIT_L(0); PG8_MMA(0, 1, At, B1); PG8_BAR;
            PG8_LDA(At, 0, 1); PG8_STAGE(PG8_SA(0, 0), a2, voffA);
            PG8_BAR; PG8_WAIT_L(0); PG8_MMA(1, 0, At, B0); PG8_BAR; PG8_SCHED;
            PG8_STAGE(PG8_SB(0, 1), b2 + hstep, voffB);
            PG8_WAIT_V(6); PG8_BAR; PG8_MMA(1, 1, At, B1); PG8_BAR;
            PG8_LDB(B0, 1, 0); PG8_SCHED; PG8_LDA(At, 1, 0); PG8_STAGE(PG8_SA(0, 1), a2 + hstep, voffA);
            PG8_WAIT_L(8); PG8_BAR; PG8_WAIT_L(0); PG8_MMA(0, 0, At, B0); PG8_BAR; PG8_SCHED;
            PG8_LDB(B1, 1, 1); PG8_STAGE(PG8_SB(1, 0), b3, voffB);
            PG8_BAR; PG8_WAIT_L(0); PG8_MMA(0, 1, At, B1); PG8_BAR;
            PG8_LDA(At, 1, 1); PG8_STAGE(PG8_SA(1, 0), a3, voffA);
            PG8_BAR; PG8_WAIT_L(0); PG8_MMA(1, 0, At, B0); PG8_BAR; PG8_SCHED;
            PG8_STAGE(PG8_SB(1, 1), b3 + hstep, voffB);
            PG8_WAIT_V(6); PG8_BAR; PG8_MMA(1, 1, At, B1); PG8_BAR;
            }
        }
        if constexpr (ALIGN_EPI) { if (wr == 0) PG8_BAR; }
        if constexpr (!Epi::AFTER_DRAIN) { E(acc, cur, wr, wc, fr, fq); S.done(cur); }
        if (!has_next) break;
#pragma unroll
        for (int a = 0; a < 2; ++a)
#pragma unroll
            for (int b = 0; b < 2; ++b)
#pragma unroll
                for (int m = 0; m < 4; ++m)
#pragma unroll
                    for (int n = 0; n < 2; ++n) acc[a][b][m][n] = (f32x4){0.f, 0.f, 0.f, 0.f};
        cur = nxt; cA = nA; cB = nB; ++ui;
        if constexpr (ALIGN_EPI) { if (wr == 1) PG8_BAR; }
    }
    PG8_WAIT_V(0);
    if constexpr (!ALIGN_EPI) { if (wr == 0) PG8_BAR; }
    PG8_BAR;
    if constexpr (Epi::AFTER_DRAIN) { E.fused(acc, cur, wr, wc, fr, fq, lds, wid, lane); S.done(cur); }
#undef PG8_SA
#undef PG8_SB
#undef PG8_STAGE
#undef PG8_LDA
#undef PG8_LDB
#undef PG8_MMA
#undef PG8_WAIT_V
#undef PG8_WAIT_L
#undef PG8_BAR
#undef PG8_SCHED
}
}
namespace pg8 {
typedef float f32x2e __attribute__((ext_vector_type(2)));
__device__ __forceinline__ float bf_lo(unsigned w) { return __uint_as_float(w << 16); }
__device__ __forceinline__ float bf_hi(unsigned w) { return __uint_as_float(w & 0xffff0000u); }
__device__ __forceinline__ float sigmoidf_fast(float x) { return __builtin_amdgcn_rcpf(1.0f + __expf(-x)); }

struct EpiBf16B {
    static constexpr bool PERM = true, AFTER_DRAIN = false;
    bf16_t* O; int ldc; const float* bias; int ntile_mod;
    __device__ __forceinline__ void operator()(const f32x4 (&acc)[2][2][4][2], const Unit& u, int wr, int wc, int fr, int fq) const {
        const int row0 = u.pm * BM + wr * 64 + fr; const int colt = (u.pn % ntile_mod) * BM;
        const int col0 = colt + wc * 32 + 8 * fq, bcol0 = u.pn * BM + wc * 32 + 8 * fq;
        f32x4 bv[2][2];
#pragma unroll
        for (int bj = 0; bj < 2; ++bj)
#pragma unroll
            for (int n = 0; n < 2; ++n) bv[bj][n] = bias ? *(const f32x4*)(bias + bcol0 + bj * HALF + 4 * n) : (f32x4){0.f, 0.f, 0.f, 0.f};
#pragma unroll
        for (int ai = 0; ai < 2; ++ai)
#pragma unroll
            for (int m = 0; m < 4; ++m) { bf16_t* rowp = O + (size_t)(row0 + ai * HALF + m * 16) * ldc + col0;
#pragma unroll
                for (int bj = 0; bj < 2; ++bj) { const f32x4 v0 = acc[ai][bj][m][0] + bv[bj][0], v1 = acc[ai][bj][m][1] + bv[bj][1];
                    u32x4 w; w.x = cvt_pk_bf16(v0[0], v0[1]); w.y = cvt_pk_bf16(v0[2], v0[3]); w.z = cvt_pk_bf16(v1[0], v1[1]); w.w = cvt_pk_bf16(v1[2], v1[3]);
                    *(u32x4*)(rowp + bj * HALF) = w; } }
    }
};
struct EpiQKV {
    static constexpr bool PERM = true, AFTER_DRAIN = false;
    bf16_t* O; int ldc; int sig_tile0;
    __device__ __forceinline__ void operator()(const f32x4 (&acc)[2][2][4][2], const Unit& u, int wr, int wc, int fr, int fq) const {
        const int row0 = u.pm * BM + wr * 64 + fr; const int col0 = u.pn * BM + wc * 32 + 8 * fq; const bool sg = u.pn >= sig_tile0;
#pragma unroll
        for (int ai = 0; ai < 2; ++ai)
#pragma unroll
            for (int m = 0; m < 4; ++m) { bf16_t* rowp = O + (size_t)(row0 + ai * HALF + m * 16) * ldc + col0;
#pragma unroll
                for (int bj = 0; bj < 2; ++bj) { f32x4 v0 = acc[ai][bj][m][0], v1 = acc[ai][bj][m][1];
                    if (sg) {
#pragma unroll
                        for (int i = 0; i < 4; ++i) { v0[i] = sigmoidf_fast(v0[i]); v1[i] = sigmoidf_fast(v1[i]); } }
                    u32x4 w; w.x = cvt_pk_bf16(v0[0], v0[1]); w.y = cvt_pk_bf16(v0[2], v0[3]); w.z = cvt_pk_bf16(v1[0], v1[1]); w.w = cvt_pk_bf16(v1[2], v1[3]);
                    *(u32x4*)(rowp + bj * HALF) = w; } }
    }
};
struct EpiM1 {
    static constexpr bool PERM = true, AFTER_DRAIN = false;
    float* M1; const bf16_t* G; int ldg;
    __device__ __forceinline__ void operator()(const f32x4 (&acc)[2][2][4][2], const Unit& u, int wr, int wc, int fr, int fq) const {
        const int row0 = u.pm * BM + wr * 64 + fr; const int col0 = u.pn * BM + wc * 32 + 8 * fq;
#pragma unroll
        for (int ai = 0; ai < 2; ++ai)
#pragma unroll
            for (int m = 0; m < 4; ++m) { const size_t row = (size_t)(row0 + ai * HALF + m * 16);
#pragma unroll
                for (int bj = 0; bj < 2; ++bj) { const int col = col0 + bj * HALF; const u32x4 g = *(const u32x4*)(G + row * ldg + col);
                    const f32x4 a0 = acc[ai][bj][m][0], a1 = acc[ai][bj][m][1];
                    const f32x4 o0 = {a0[0] * bf_lo(g.x), a0[1] * bf_hi(g.x), a0[2] * bf_lo(g.y), a0[3] * bf_hi(g.y)};
                    const f32x4 o1 = {a1[0] * bf_lo(g.z), a1[1] * bf_hi(g.z), a1[2] * bf_lo(g.w), a1[3] * bf_hi(g.w)};
                    float* p = M1 + row * 2048 + col; *(f32x4*)p = o0; *(f32x4*)(p + 4) = o1; } }
    }
};
struct EpiMerged {
    static constexpr bool PERM = true, AFTER_DRAIN = false;
    const float* M1; const bf16_t* G; int ldg; bf16_t* MG;
    __device__ __forceinline__ void operator()(const f32x4 (&acc)[2][2][4][2], const Unit& u, int wr, int wc, int fr, int fq) const {
        const int row0 = u.pm * BM + wr * 64 + fr; const int col0 = u.pn * BM + wc * 32 + 8 * fq;
#pragma unroll
        for (int ai = 0; ai < 2; ++ai)
#pragma unroll
            for (int m = 0; m < 4; ++m) { const size_t row = (size_t)(row0 + ai * HALF + m * 16);
#pragma unroll
                for (int bj = 0; bj < 2; ++bj) { const int col = col0 + bj * HALF; const u32x4 g = *(const u32x4*)(G + row * ldg + col);
                    const float* p = M1 + row * 2048 + col; const f32x4 m0 = *(const f32x4*)p, m1 = *(const f32x4*)(p + 4);
                    const f32x4 a0 = acc[ai][bj][m][0], a1 = acc[ai][bj][m][1];
                    const f32x4 o0 = {m0[0] + a0[0] * bf_lo(g.x), m0[1] + a0[1] * bf_hi(g.x), m0[2] + a0[2] * bf_lo(g.y), m0[3] + a0[3] * bf_hi(g.y)};
                    const f32x4 o1 = {m1[0] + a1[0] * bf_lo(g.z), m1[1] + a1[1] * bf_hi(g.z), m1[2] + a1[2] * bf_lo(g.w), m1[3] + a1[3] * bf_hi(g.w)};
                    u32x4 w; w.x = cvt_pk_bf16(o0[0], o0[1]); w.y = cvt_pk_bf16(o0[2], o0[3]); w.z = cvt_pk_bf16(o1[0], o1[1]); w.w = cvt_pk_bf16(o1[2], o1[3]);
                    *(u32x4*)(MG + row * 2048 + col) = w; } }
    }
};
struct EpiH1 {
    static constexpr bool PERM = false, AFTER_DRAIN = false;
    const float* X; float* H1; const float* g1; int g1_stride; int tiles_per_batch;
    __device__ __forceinline__ void operator()(const f32x4 (&acc)[2][2][4][2], const Unit& u, int wr, int wc, int fr, int fq) const {
        const int row0 = u.pm * BM + wr * 64 + fr; const int col0 = u.pn * BM + wc * 32 + 4 * fq; const float* gb = g1 + (size_t)(u.pm / tiles_per_batch) * g1_stride;
        f32x4 gv[2][2];
#pragma unroll
        for (int bj = 0; bj < 2; ++bj)
#pragma unroll
            for (int n = 0; n < 2; ++n) gv[bj][n] = *(const f32x4*)(gb + col0 + bj * HALF + n * 16);
#pragma unroll
        for (int ai = 0; ai < 2; ++ai)
#pragma unroll
            for (int m = 0; m < 4; ++m) { const size_t off = (size_t)(row0 + ai * HALF + m * 16) * 2048 + col0;
#pragma unroll
                for (int bj = 0; bj < 2; ++bj)
#pragma unroll
                    for (int n = 0; n < 2; ++n) { const f32x4 xv = *(const f32x4*)(X + off + bj * HALF + n * 16);
                        *(f32x4*)(H1 + off + bj * HALF + n * 16) = xv + gv[bj][n] * acc[ai][bj][m][n]; } }
    }
};
struct EpiSwiGLU {
    static constexpr bool PERM = true, AFTER_DRAIN = false;
    bf16_t* Y; const float* bg; const float* bu;
    __device__ __forceinline__ void operator()(const f32x4 (&acc)[2][2][4][2], const Unit& u, int wr, int wc, int fr, int fq) const {
        const int e = u.pn >> 4, pnl = u.pn & 15; const int row0 = u.pm * BM + wr * 64 + fr; const int col0 = pnl * HALF + wc * 32 + 8 * fq;
        f32x4 bgv[2], buv[2];
#pragma unroll
        for (int n = 0; n < 2; ++n) { bgv[n] = *(const f32x4*)(bg + (size_t)e * 2048 + col0 + 4 * n); buv[n] = *(const f32x4*)(bu + (size_t)e * 2048 + col0 + 4 * n); }
#pragma unroll
        for (int ai = 0; ai < 2; ++ai)
#pragma unroll
            for (int m = 0; m < 4; ++m) { bf16_t* rowp = Y + (size_t)(row0 + ai * HALF + m * 16) * 2048 + col0; f32x4 y[2];
#pragma unroll
                for (int n = 0; n < 2; ++n) { const f32x4 g4 = acc[ai][0][m][n] + bgv[n], u4 = acc[ai][1][m][n] + buv[n];
#pragma unroll
                    for (int i = 0; i < 4; ++i) { const float g = fminf(g4[i], 7.0f), uu = fminf(fmaxf(u4[i], -7.0f), 7.0f); y[n][i] = (uu + 1.0f) * (g * sigmoidf_fast(1.702f * g)); } }
                u32x4 w; w.x = cvt_pk_bf16(y[0][0], y[0][1]); w.y = cvt_pk_bf16(y[0][2], y[0][3]); w.z = cvt_pk_bf16(y[1][0], y[1][1]); w.w = cvt_pk_bf16(y[1][2], y[1][3]);
                *(u32x4*)rowp = w; }
    }
};
struct MoeOrder {
    const PG8_LAS int* tstart; int npn, lo, hi, rank, W;
    __device__ __forceinline__ void init(const PG8_LAS int* ts, int npn_, int G, int c) { tstart = ts; npn = npn_; const int U = ts[32] * npn_; const int x = c % NXCD; rank = c / NXCD; W = G / NXCD;
        lo = (int)(((long)U * x) / NXCD); hi = (int)(((long)U * (x + 1)) / NXCD); }
    __device__ __forceinline__ bool next(int i, Unit& u) const {
        const int q = lo + rank + W * i; if (q >= hi) return false;
        int e = 0;
#pragma unroll 1
        for (int k = 1; k < 32; ++k) if (tstart[k] * npn <= q) e = k;
        const int ts = tstart[e], te = tstart[e + 1] - ts, qq = q - ts * npn;
        u.pm = ts + qq % te; u.pn = e * npn + qq / te; return true;
    }
    __device__ __forceinline__ void a_ready(const Unit&) const {}
    __device__ __forceinline__ void done(const Unit&) const {}
};
}
namespace att {
using bf16x8 = __attribute__((ext_vector_type(8))) short;
using s16x4  = __attribute__((ext_vector_type(4))) short;
using f32x16 = __attribute__((ext_vector_type(16))) float;
using u32x4  = __attribute__((ext_vector_type(4))) unsigned;
typedef unsigned short bf16;
constexpr int   D = 128, NW = 8, QBLK = 32, KVBLK = 64;
constexpr float SCALE = 0.088388347648318440f;
constexpr float THR = 8.f;
constexpr size_t SHM_V = KVBLK * D * 2, SHM_K = KVBLK * D * 2, SHM_ATTN = 2 * SHM_V + 2 * SHM_K + NW * 64 * 4;
#define KSWZ(row, colB) ((row) * 256 + ((colB) ^ (((row) & 7) << 4)))
#define SBAR() __builtin_amdgcn_sched_barrier(0)
__device__ __forceinline__ int crow(int r, int hi) { return (r & 3) + 8 * (r >> 2) + 4 * hi; }
__device__ __forceinline__ unsigned cvtpk(float lo, float hi) { unsigned r; asm volatile("v_cvt_pk_bf16_f32 %0, %1, %2" : "=v"(r) : "v"(lo), "v"(hi)); return r; }

template <int MODE>
__device__ __forceinline__ void partialSM(f32x16& p0, f32x16& p1, float& m_reg, float& mn, float& alpha, float relb, float kk, bool valid) {
  constexpr float C = SCALE * 1.4426950408889634f;
#pragma unroll
  for (int r = 0; r < 16; ++r) {
    const float d0 = relb - (float)((r & 3) + 8 * (r >> 2)), a0 = __builtin_fabsf(d0), a1 = __builtin_fabsf(d0 - 32.f);
    p0[r] = fmaf(a0, -kk, p0[r]); p1[r] = fmaf(a1, -kk, p1[r]);
    if (MODE == 1) { if (!(valid && a0 <= 64.f)) p0[r] = -INFINITY; if (!(valid && a1 <= 64.f)) p1[r] = -INFINITY; }
  }
  float pmax = p0[0];
#pragma unroll
  for (int r = 1; r < 16; ++r) pmax = fmaxf(pmax, p0[r]);
#pragma unroll
  for (int r = 0; r < 16; ++r) pmax = fmaxf(pmax, p1[r]);
  { auto rr = __builtin_amdgcn_permlane32_swap(__float_as_uint(pmax), __float_as_uint(pmax), false, false);
    pmax = fmaxf(__uint_as_float(rr[0]), __uint_as_float(rr[1])); }
  if (__builtin_expect(__all(pmax - m_reg <= THR / SCALE), 1)) { mn = m_reg; alpha = 1.f; }
  else { mn = fmaxf(m_reg, pmax); alpha = __builtin_amdgcn_exp2f((m_reg - mn) * C); m_reg = mn; }
  const float mnC = -mn * C;
#pragma unroll
  for (int r = 0; r < 16; ++r) p0[r] = fmaf(p0[r], C, mnC);
#pragma unroll
  for (int r = 0; r < 16; ++r) p1[r] = fmaf(p1[r], C, mnC);
#pragma unroll
  for (int r = 0; r < 16; ++r) p0[r] = __builtin_amdgcn_exp2f(p0[r]);
}
__device__ __forceinline__ void finishSM(f32x16& p0, f32x16& p1, float alpha, float& l_reg, bf16x8& pa0, bf16x8& pa1, bf16x8& pa2, bf16x8& pa3) {
#pragma unroll
  for (int r = 0; r < 16; ++r) p1[r] = __builtin_amdgcn_exp2f(p1[r]);
  float ps = 0;
#pragma unroll
  for (int r = 0; r < 16; ++r) ps += p0[r];
#pragma unroll
  for (int r = 0; r < 16; ++r) ps += p1[r];
  { auto rr = __builtin_amdgcn_permlane32_swap(__float_as_uint(ps), __float_as_uint(ps), false, false);
    ps = __uint_as_float(rr[0]) + __uint_as_float(rr[1]); }
  l_reg = l_reg * alpha + ps;
#define PK4(P, BASE, OUT) do { unsigned a0 = cvtpk(P[BASE + 0], P[BASE + 1]), a1 = cvtpk(P[BASE + 2], P[BASE + 3]);   \
    unsigned b0 = cvtpk(P[BASE + 4], P[BASE + 5]), b1 = cvtpk(P[BASE + 6], P[BASE + 7]);                              \
    auto r0 = __builtin_amdgcn_permlane32_swap(a0, b0, false, false); auto r1 = __builtin_amdgcn_permlane32_swap(a1, b1, false, false); \
    u32x4 w = {r0[0], r1[0], r0[1], r1[1]}; OUT = *reinterpret_cast<bf16x8*>(&w); } while (0)
  PK4(p0, 0, pa0); PK4(p0, 8, pa1); PK4(p1, 0, pa2); PK4(p1, 8, pa3);
#undef PK4
}
__device__ __forceinline__ void qkt(f32x16& p0, f32x16& p1, const bf16* Ks, const bf16x8* qr, int r32, int hi) {
  p0 = f32x16{}; p1 = f32x16{};
#pragma unroll
  for (int d0 = 0; d0 < 8; ++d0) { const int cb = (d0 * 16 + hi * 8) * 2;
    bf16x8 b0 = *reinterpret_cast<const bf16x8*>((const char*)Ks + KSWZ(r32, cb));
    bf16x8 b1 = *reinterpret_cast<const bf16x8*>((const char*)Ks + KSWZ(32 + r32, cb));
    p0 = __builtin_amdgcn_mfma_f32_32x32x16_bf16(b0, qr[d0], p0, 0, 0, 0);
    p1 = __builtin_amdgcn_mfma_f32_32x32x16_bf16(b1, qr[d0], p1, 0, 0, 0); }
}
__device__ __forceinline__ int v_st(int k, int c) { const int kk = (k & ~0xC) | ((k & 4) << 1) | ((k & 8) >> 1); return ((kk >> 3) * 4 + (c >> 5)) * 512 + ((kk & 7) * 32 + (c & 31)) * 2; }
__device__ __forceinline__ int v_rd_base(int lane) { return ((lane & 3) << 3) | (((lane >> 2) & 3) << 6) | (((lane >> 4) & 1) << 5) | (((lane >> 5) & 1) << 8); }
constexpr int v_rd_off(int d0, int ks, int half) { return d0 * 512 + ks * 4096 + half * 2048; }
template <int OFF> __device__ __forceinline__ s16x4 tr_read(int vb) {
  s16x4 r; asm volatile("ds_read_b64_tr_b16 %0, %1 offset:%2" : "=&v"(r) : "v"(vb), "i"(OFF) : "memory"); return r;
}
template <int D0> __device__ __forceinline__ void pv_one(f32x16& od, int vb, bf16x8 pa0, bf16x8 pa1, bf16x8 pa2, bf16x8 pa3) {
  const s16x4 l0 = tr_read<v_rd_off(D0, 0, 0)>(vb), h0 = tr_read<v_rd_off(D0, 0, 1)>(vb), l1 = tr_read<v_rd_off(D0, 1, 0)>(vb), h1 = tr_read<v_rd_off(D0, 1, 1)>(vb);
  const s16x4 l2 = tr_read<v_rd_off(D0, 2, 0)>(vb), h2 = tr_read<v_rd_off(D0, 2, 1)>(vb), l3 = tr_read<v_rd_off(D0, 3, 0)>(vb), h3 = tr_read<v_rd_off(D0, 3, 1)>(vb);
  asm volatile("s_waitcnt lgkmcnt(0)" ::: "memory"); SBAR();
#define PK(L, H) (bf16x8){L[0], L[1], L[2], L[3], H[0], H[1], H[2], H[3]}
  od = __builtin_amdgcn_mfma_f32_32x32x16_bf16(pa0, PK(l0, h0), od, 0, 0, 0);
  od = __builtin_amdgcn_mfma_f32_32x32x16_bf16(pa1, PK(l1, h1), od, 0, 0, 0);
  od = __builtin_amdgcn_mfma_f32_32x32x16_bf16(pa2, PK(l2, h2), od, 0, 0, 0);
  od = __builtin_amdgcn_mfma_f32_32x32x16_bf16(pa3, PK(l3, h3), od, 0, 0, 0);
#undef PK
}
__device__ __forceinline__ void pv_d0(f32x16* o, int vb, bf16x8 pa0, bf16x8 pa1, bf16x8 pa2, bf16x8 pa3) {
  pv_one<0>(o[0], vb, pa0, pa1, pa2, pa3); pv_one<1>(o[1], vb, pa0, pa1, pa2, pa3); pv_one<2>(o[2], vb, pa0, pa1, pa2, pa3); pv_one<3>(o[3], vb, pa0, pa1, pa2, pa3);
}

template <int MODE>
__device__ __forceinline__ void attn_body(const bf16* __restrict__ Qb, long ldq, const bf16* __restrict__ Kh, const bf16* __restrict__ Vh, long ldk,
                                          int t0, int NT, int ntmax, int qpos0, float kk, float* __restrict__ Ob, long ldo, float* __restrict__ Lb, long ldl, char* lds) {
  const int tid = threadIdx.x, wid = tid >> 6, lane = tid & 63, r32 = lane & 31, hi = lane >> 5;
  bf16* V_lds = (bf16*)lds; bf16* K_lds = (bf16*)(lds + 2 * SHM_V);
  float* ws = (float*)(lds + 2 * SHM_V + 2 * SHM_K) + wid * 64; float* li_l = ws; float* al_l = ws + 32;
  float m_reg = -1e30f, l_reg = 0; f32x16 o[4] = {}; bf16x8 qr[8];
  const bf16* Qw = Qb + (long)(wid * QBLK + r32) * ldq + hi * 8;
#pragma unroll
  for (int d0 = 0; d0 < 8; ++d0) qr[d0] = *reinterpret_cast<const bf16x8*>(Qw + d0 * 16);
  const int sr = tid >> 4, sc = (tid & 15) * 8, vst0 = v_st(sr, sc), vst1 = v_st(32 + sr, sc);
  const int vb0 = (int)(uintptr_t)V_lds + v_rd_base(lane);
  const unsigned so0 = (unsigned)(sr * (int)ldk + sc), so1 = so0 + 32u * (unsigned)ldk;
  const float qposf = (float)(qpos0 + wid * QBLK + r32 - 4 * hi);
  struct { bf16x8 vs0, vs1, ks0, ks1; } sr_[2];
#define TCL(jt) ({ int _t = t0 + (jt); _t = _t < 0 ? 0 : (_t >= ntmax ? ntmax - 1 : _t); _t * KVBLK; })
#define TVALID(jt) ((t0 + (jt)) >= 0 && (t0 + (jt)) < ntmax)
#define RELB(jt) (qposf - (float)((t0 + (jt)) * KVBLK))
#define SLOAD(i, jt) do { const long _k0 = (long)TCL(jt) * ldk; const bf16* _vp = Vh + _k0; const bf16* _kp = Kh + _k0; \
    sr_[i].vs0 = *reinterpret_cast<const bf16x8*>(_vp + so0); sr_[i].vs1 = *reinterpret_cast<const bf16x8*>(_vp + so1); \
    sr_[i].ks0 = *reinterpret_cast<const bf16x8*>(_kp + so0); sr_[i].ks1 = *reinterpret_cast<const bf16x8*>(_kp + so1); } while (0)
#define SWRITE(b, i) do { *(bf16x8*)((char*)V_lds + (b) * SHM_V + vst0) = sr_[i].vs0;          \
    *(bf16x8*)((char*)V_lds + (b) * SHM_V + vst1) = sr_[i].vs1; const int kc = sc * 2;               \
    *(bf16x8*)((char*)K_lds + (b) * SHM_K + KSWZ(sr, kc)) = sr_[i].ks0;                       \
    *(bf16x8*)((char*)K_lds + (b) * SHM_K + KSWZ(32 + sr, kc)) = sr_[i].ks1; } while (0)
#define SWAIT() asm volatile("s_waitcnt vmcnt(4)" ::: "memory")
#define RESC(a) do { if (__any((a) < 1.f)) { if (hi == 0) al_l[r32] = (a); asm volatile("s_waitcnt lgkmcnt(0)" ::: "memory"); \
    _Pragma("unroll") for (int d = 0; d < 4; ++d) _Pragma("unroll") for (int r = 0; r < 16; ++r) o[d][r] *= al_l[crow(r, hi)]; } } while (0)
  f32x16 pA0, pA1, pB0, pB1; float mnA, mnB, alA, alB; bf16x8 pa0, pa1, pa2, pa3;
  constexpr int SE = 0, SO = 1;
  SLOAD(SE, 0); asm volatile("s_waitcnt vmcnt(0)" ::: "memory"); SWRITE(0, SE); __syncthreads();
  qkt(pA0, pA1, K_lds, qr, r32, hi); partialSM<MODE>(pA0, pA1, m_reg, mnA, alA, RELB(0), kk, TVALID(0));
  SLOAD(SO, 1); if (2 < NT) SLOAD(SE, 2);
  SWAIT(); SWRITE(1, SO); __syncthreads();
  for (int j = 1; j + 1 < NT; j += 2) {
    SBAR(); qkt(pB0, pB1, (bf16*)((char*)K_lds + SHM_K), qr, r32, hi);
    finishSM(pA0, pA1, alA, l_reg, pa0, pa1, pa2, pa3); SBAR();
    SLOAD(SO, j + 2); SBAR();
    pv_d0(o, vb0, pa0, pa1, pa2, pa3); partialSM<MODE>(pB0, pB1, m_reg, mnB, alB, RELB(j), kk, TVALID(j));
    __syncthreads(); SWAIT(); SWRITE(0, SE);
    RESC(alB); __syncthreads();
    SBAR(); qkt(pA0, pA1, K_lds, qr, r32, hi);
    finishSM(pB0, pB1, alB, l_reg, pa0, pa1, pa2, pa3); SBAR();
    if (j + 3 < NT) SLOAD(SE, j + 3); SBAR();
    pv_d0(o, vb0 + (int)SHM_V, pa0, pa1, pa2, pa3); partialSM<MODE>(pA0, pA1, m_reg, mnA, alA, RELB(j + 1), kk, TVALID(j + 1));
    __syncthreads(); SWAIT(); SWRITE(1, SO);
    RESC(alA); __syncthreads();
  }
  SBAR(); qkt(pB0, pB1, (bf16*)((char*)K_lds + SHM_K), qr, r32, hi);
  finishSM(pA0, pA1, alA, l_reg, pa0, pa1, pa2, pa3); SBAR();
  pv_d0(o, vb0, pa0, pa1, pa2, pa3); partialSM<MODE>(pB0, pB1, m_reg, mnB, alB, RELB(NT - 1), kk, TVALID(NT - 1));
  __syncthreads(); RESC(alB);
  finishSM(pB0, pB1, alB, l_reg, pa0, pa1, pa2, pa3); SBAR();
  pv_d0(o, vb0 + (int)SHM_V, pa0, pa1, pa2, pa3);
  if (hi == 0) li_l[r32] = l_reg; asm volatile("s_waitcnt lgkmcnt(0)" ::: "memory");
  float rli[16];
#pragma unroll
  for (int r = 0; r < 16; ++r) rli[r] = __builtin_amdgcn_rcpf(li_l[crow(r, hi)]);
  int hie = hi; asm volatile("" : "+v"(hie));
  float* Ow = Ob + (long)(wid * QBLK + 4 * hie) * ldo + r32;
#pragma unroll
  for (int r = 0; r < 16; ++r) { float* Or = Ow + (long)((r & 3) + 8 * (r >> 2)) * ldo;
#pragma unroll
    for (int d0 = 0; d0 < 4; ++d0) Or[d0 * 32] = o[d0][r] * rli[r]; }
  if (Lb != nullptr && hi == 0) Lb[(long)(wid * QBLK + r32) * ldl] = m_reg * SCALE + __logf(l_reg);
  __syncthreads();
#undef TCL
#undef TVALID
#undef RELB
#undef SLOAD
#undef SWRITE
#undef SWAIT
#undef RESC
}
#undef KSWZ
#undef SBAR
}
constexpr int NWAVES = 8;
#ifndef MK_SPLIT
#define MK_SPLIT 0
#endif
#ifndef DBG_ORACLE
#define DBG_ORACLE 0
#endif
constexpr int N_PHASES = 12;

constexpr int DM = 2048, BATCH = 2, SEQ = 4096, T = BATCH * SEQ;
constexpr int NQKV = 10240;
constexpr int C_QA = 0, C_KA = 1024, C_VA = 2048, C_QB = 3072, C_KB = 4096, C_VB = 5120, C_GA = 6144, C_GB = 8192;
constexpr int NE = 32, TOPK = 4, TK = T * TOPK, TKPAD = TK + NE * 256;
constexpr float EPS = 1e-5f;
constexpr float LAMBDA_INIT = 0.2f;

constexpr size_t MiB = 1u << 20;
constexpr size_t WS_CTL = 0, CTL_ZERO_BYTES = 1 * MiB;
constexpr size_t WS_MOD = 1 * MiB;
constexpr size_t WS_RC = 1 * MiB + 512 * 1024;
constexpr size_t WS_TOPI = 2 * MiB;
constexpr size_t WS_TOPP = 2 * MiB + 256 * 1024;
constexpr size_t WS_POS = 2 * MiB + 512 * 1024;
constexpr size_t WS_ERR = 3 * MiB;
constexpr size_t WS_WINT = 4 * MiB;
constexpr size_t WS_WAT = 44 * MiB;
constexpr size_t WS_WBT = 48 * MiB;
constexpr size_t WS_WOT = 52 * MiB;
constexpr size_t WS_U = 64 * MiB;
constexpr size_t WS_QKV = 96 * MiB;
constexpr size_t WS_OA = 256 * MiB;
constexpr size_t WS_OB = 352 * MiB;
constexpr size_t WS_LSE = 416 * MiB;
constexpr size_t WS_YA = 418 * MiB;
constexpr size_t WS_YB = 434 * MiB;
constexpr size_t WS_M1 = 450 * MiB;
constexpr size_t WS_MG = 514 * MiB;
constexpr size_t WS_H1 = 546 * MiB;
constexpr size_t WS_XS = 610 * MiB;
constexpr size_t WS_YACT = 770 * MiB;
constexpr size_t WS_YSLOT = 930 * MiB;
constexpr size_t WS_WGU = 1090 * MiB;
constexpr size_t WS_WD = 1602 * MiB;
constexpr size_t WS_END = 1858 * MiB;
constexpr int CW_TMO = 0, CW_CODE = 1;
constexpr int CW_BAR = 4096;
constexpr int CW_CNT = 8192;

constexpr int RING_OFF = 0, RING_BYTES = 131072;
constexpr int LDSCTL_OFF = RING_BYTES, MISC_OFF = LDSCTL_OFF + 320;
constexpr int TST_OFF = LDSCTL_OFF + 1024;
constexpr int LDS_BYTES = 147456;

#define GAS __attribute__((address_space(1)))
#define LAS __attribute__((address_space(3)))
typedef unsigned short bf16;
typedef unsigned v4u __attribute__((ext_vector_type(4)));
typedef unsigned v2u __attribute__((ext_vector_type(2)));
typedef float f32x4 __attribute__((ext_vector_type(4)));
typedef GAS unsigned gu32;
#define RLX_AGENT __ATOMIC_RELAXED, __HIP_MEMORY_SCOPE_AGENT
#define LDS_WAIT() asm volatile("s_waitcnt lgkmcnt(0)" ::: "memory")
#define VM_WAIT() asm volatile("s_waitcnt vmcnt(0)" ::: "memory")
__device__ __forceinline__ unsigned f2bf(float f) { unsigned u = __builtin_bit_cast(unsigned, f); return (u + 0x7fffu + ((u >> 16) & 1u)) >> 16; }
__device__ __forceinline__ unsigned pk2(float lo, float hi) { return f2bf(lo) | (f2bf(hi) << 16); }
__device__ __forceinline__ float bf2f(unsigned short h) { return __uint_as_float(((unsigned)h) << 16); }
__device__ __forceinline__ float wave_sum(float v) {
#pragma unroll
    for (int o = 1; o < 64; o <<= 1) v += __shfl_xor(v, o);
    return v;
}
__device__ __forceinline__ float wave_max(float v) {
#pragma unroll
    for (int o = 1; o < 64; o <<= 1) v = fmaxf(v, __shfl_xor(v, o));
    return v;
}
__device__ __forceinline__ float siluf(float x) { return x / (1.0f + __expf(-x)); }
#define XB_TMO      128
#define XB_XCNT(j)  (256  + 64 * (j))
#define XB_XSUB(j)  (1280 + 64 * (j))
#define XB_XGEN(j)  (2304 + 64 * (j))
#define XB_TOP      3328
#define XB_TOPGEN   3392
#define XCD_BAR_WORDS 3456
#define XB_SPIN_CAP (1u << 18)

__device__ __forceinline__ unsigned xb_ld(unsigned* p)              { return __hip_atomic_load(p, __ATOMIC_RELAXED, __HIP_MEMORY_SCOPE_AGENT); }
__device__ __forceinline__ unsigned xb_add(unsigned* p, unsigned v) { return __hip_atomic_fetch_add(p, v, __ATOMIC_RELAXED, __HIP_MEMORY_SCOPE_AGENT); }
__device__ __forceinline__ unsigned xb_xcc_id() { return (unsigned)__builtin_amdgcn_s_getreg((3 << 11) | 20) & 0xFu; }
#define XB_SPIN(cond, bar) do { unsigned _sp = 0; while (cond) { __builtin_amdgcn_s_sleep(1); \
    if ((++_sp & 255u) == 0u) { if (xb_ld(&(bar)[XB_TMO])) break; if (_sp > XB_SPIN_CAP) { atomicAdd(&(bar)[XB_TMO], 1u); break; } } } } while (0)

struct XcdBarrier {
    unsigned* bar; unsigned x;
    volatile LAS unsigned* st;
};

__device__ __forceinline__ XcdBarrier xcd_barrier_post(unsigned* bar, volatile LAS unsigned* st) {
    XcdBarrier b; b.bar = bar; b.x = xb_xcc_id(); b.st = st;
    if (threadIdx.x == 0) (void)xb_add(&bar[XB_XCNT(b.x)], 1u);
    return b;
}
__device__ __forceinline__ void xcd_barrier_complete(unsigned* bar, unsigned x, unsigned& nloc, unsigned& nx) {
    const unsigned G = gridDim.x * gridDim.y * gridDim.z;
    unsigned sum, cnt, mine, sp = 0u;
    for (;;) {
        sum = 0u; cnt = 0u; mine = 0u;
#pragma unroll
        for (unsigned j = 0; j < 16; ++j) { const unsigned c = xb_ld(&bar[XB_XCNT(j)]); sum += c; cnt += (c > 0u) ? 1u : 0u; mine = (j == x) ? c : mine; }
        if (sum == G) break;
        __builtin_amdgcn_s_sleep(1);
        if ((++sp & 255u) == 0u) { if (xb_ld(&bar[XB_TMO])) break; if (sp > XB_SPIN_CAP) { atomicAdd(&bar[XB_TMO], 1u); break; } }
    }
    nloc = mine > 0u ? mine : 1u; nx = cnt > 0u ? cnt : 1u;
}

__device__ __forceinline__ void xcd_barrier(const XcdBarrier& b) {
    asm volatile("s_waitcnt vmcnt(0)" ::: "memory");
    __syncthreads();
    if (threadIdx.x == 0) {
        unsigned* bar = b.bar;
        __builtin_amdgcn_s_waitcnt(0);
        unsigned nloc = b.st[0], nx = b.st[1];
        if (nloc == 0u) { xcd_barrier_complete(bar, b.x, nloc, nx); b.st[0] = nloc; b.st[1] = nx; }
        const unsigned old = xb_add(&bar[XB_XSUB(b.x)], 1u);
        const unsigned gen = old / nloc;
        if (old + 1u == (gen + 1u) * nloc) {
            __builtin_amdgcn_fence(__ATOMIC_RELEASE, "agent");
            asm volatile("s_waitcnt vmcnt(0)" ::: "memory");
            const unsigned og = xb_add(&bar[XB_TOP], 1u);
            const unsigned tg = og / nx;
            if (og + 1u == (tg + 1u) * nx) xb_add(&bar[XB_TOPGEN], 1u);
            else XB_SPIN(xb_ld(&bar[XB_TOPGEN]) == tg, bar);
            __builtin_amdgcn_fence(__ATOMIC_ACQUIRE, "agent");
            xb_add(&bar[XB_XGEN(b.x)], 1u);
            asm volatile("s_waitcnt vmcnt(0)" ::: "memory");
        } else {
            XB_SPIN(xb_ld(&bar[XB_XGEN(b.x)]) == gen, bar);
            __builtin_amdgcn_fence(__ATOMIC_ACQUIRE, "agent");
            asm volatile("s_waitcnt vmcnt(0)" ::: "memory");
        }
    }
    __syncthreads();
}
struct Args { const float* in[24]; float* out; unsigned char* ws; int ph_lo, ph_hi; };
enum { I_X = 0, I_C, I_WADA, I_BADA, I_N1G, I_WIN, I_LQ1, I_LK1, I_LQ2, I_LK2, I_SUBG, I_WOA, I_WOB, I_WO, I_N2G, I_WR, I_BR, I_WG, I_BG, I_WU, I_BU, I_WDN, I_BDN, I_FG };
struct Frame {
    LAS unsigned char* lds; char* ldsg;
    volatile LAS unsigned* MISC;
    gu32* ctl;
    int tid, lane, wave, vcu, G;
    unsigned char* ws;
};
#define WSP(T_, off) ((T_*)(F.ws + (off)))

__device__ __forceinline__ void cvt_item(const float* __restrict__ W, int N, int K, bf16* __restrict__ WT, int k0, int n0, long dst_row0, LAS float* scr, int lane) {
    f32x4 v[8];
    const int lr = lane >> 3, lc = 4 * (lane & 7);
#pragma unroll
    for (int i = 0; i < 8; ++i) v[i] = *(const f32x4*)(W + (size_t)(k0 + lr + 8 * i) * N + n0 + lc);
#pragma unroll
    for (int i = 0; i < 8; ++i) { LAS float* s = scr + (lr + 8 * i) * 33 + lc; s[0] = v[i].x; s[1] = v[i].y; s[2] = v[i].z; s[3] = v[i].w; }
    LDS_WAIT(); asm volatile("" ::: "memory");
    const int c = lane & 7;
#pragma unroll
    for (int j = 0; j < 4; ++j) { const int n = (lane >> 3) + 8 * j; const LAS float* s = scr + (8 * c) * 33 + n;
        v4u o; o.x = pk2(s[0 * 33], s[1 * 33]); o.y = pk2(s[2 * 33], s[3 * 33]); o.z = pk2(s[4 * 33], s[5 * 33]); o.w = pk2(s[6 * 33], s[7 * 33]);
        *(v4u*)(WT + (size_t)(dst_row0 + n) * K + k0 + 8 * c) = o; }
    LDS_WAIT(); asm volatile("" ::: "memory");
}
__device__ __forceinline__ void p0_prologue(Frame& F, const Args& A) {
    LAS float* red = (LAS float*)F.lds;
    if (F.vcu < 192) {
        const int col = F.vcu * 64 + F.lane, k0 = F.wave * 256;
        const float* wp = A.in[I_WADA] + (size_t)k0 * 12288 + col; const float* cp = A.in[I_C];
        float a0 = 0.f, a1 = 0.f;
#pragma unroll 8
        for (int k = 0; k < 256; ++k) { const float wv = wp[(size_t)k * 12288]; a0 = fmaf(siluf(cp[k0 + k]), wv, a0); a1 = fmaf(siluf(cp[2048 + k0 + k]), wv, a1); }
        red[(F.wave * 2 + 0) * 64 + F.lane] = a0; red[(F.wave * 2 + 1) * 64 + F.lane] = a1;
    }
    __syncthreads();
    if (F.vcu < 192 && F.tid < 128) { const int b = F.tid >> 6, l = F.tid & 63; float s = 0.f;
#pragma unroll
        for (int w = 0; w < 8; ++w) s += red[(w * 2 + b) * 64 + l];
        const int col = F.vcu * 64 + l; WSP(float, WS_MOD)[b * 12288 + col] = s + A.in[I_BADA][col]; }
    __syncthreads();
    LAS float* scr = (LAS float*)(F.lds + F.wave * 16384);
    const int gw = F.vcu * NWAVES + F.wave, NGW = F.G * NWAVES;
    constexpr int I_IN = 32 * 320, I_A = 16 * 64, I_B = 16 * 64, I_O = 32 * 64, I_E = 32 * 64, NITEMS = I_IN + I_A + I_B + I_O + 96 * I_E;
    for (int it = gw; it < NITEMS; it += NGW) {
        int r = it;
        if (r < I_IN) { cvt_item(A.in[I_WIN], NQKV, DM, WSP(bf16, WS_WINT), (r / 320) * 64, (r % 320) * 32, (r % 320) * 32, scr, F.lane); continue; } r -= I_IN;
        if (r < I_A) { cvt_item(A.in[I_WOA], DM, 1024, WSP(bf16, WS_WAT), (r / 64) * 64, (r % 64) * 32, (r % 64) * 32, scr, F.lane); continue; } r -= I_A;
        if (r < I_B) { cvt_item(A.in[I_WOB], DM, 1024, WSP(bf16, WS_WBT), (r / 64) * 64, (r % 64) * 32, (r % 64) * 32, scr, F.lane); continue; } r -= I_B;
        if (r < I_O) { cvt_item(A.in[I_WO], DM, DM, WSP(bf16, WS_WOT), (r / 64) * 64, (r % 64) * 32, (r % 64) * 32, scr, F.lane); continue; } r -= I_O;
        const int m = r / I_E, rr = r % I_E, e = m / 3, which = m % 3, k0 = (rr / 64) * 64, n0 = (rr % 64) * 32;
        const size_t wo = (size_t)e * DM * DM;
        if (which == 0) cvt_item(A.in[I_WG] + wo, DM, DM, WSP(bf16, WS_WGU), k0, n0, (long)e * 4096 + (n0 >> 7) * 256 + (n0 & 127), scr, F.lane);
        else if (which == 1) cvt_item(A.in[I_WU] + wo, DM, DM, WSP(bf16, WS_WGU), k0, n0, (long)e * 4096 + (n0 >> 7) * 256 + 128 + (n0 & 127), scr, F.lane);
        else cvt_item(A.in[I_WDN] + wo, DM, DM, WSP(bf16, WS_WD), k0, n0, (long)e * 2048 + n0, scr, F.lane);
    }
}
__device__ __forceinline__ void p1_modulate(Frame& F, const Args& A) {
    const int gw = F.vcu * NWAVES + F.wave, NGW = F.G * NWAVES; const float* MOD = WSP(float, WS_MOD);
    if (gw < 64) { const int b = gw >> 5, e = gw & 31; float s = 0.f;
        for (int k = F.lane; k < DM; k += 64) s = fmaf(MOD[b * 12288 + 3 * DM + k], A.in[I_WR][k * 32 + e], s);
        s = wave_sum(s); if (F.lane == 0) WSP(float, WS_RC)[b * 32 + e] = s + A.in[I_BR][e]; }
    for (int m = gw; m < T; m += NGW) {
        const int b = m / SEQ; const float* xr = A.in[I_X] + (size_t)m * DM + 4 * F.lane; f32x4 v[8]; float s = 0.f;
#pragma unroll
        for (int j = 0; j < 8; ++j) { v[j] = *(const f32x4*)(xr + 256 * j); s += (v[j].x * v[j].x + v[j].y * v[j].y) + (v[j].z * v[j].z + v[j].w * v[j].w); }
        const float rstd = 1.0f / sqrtf(wave_sum(s) * (1.0f / DM) + EPS);
        bf16* ur = WSP(bf16, WS_U) + (size_t)m * DM + 4 * F.lane;
#pragma unroll
        for (int j = 0; j < 8; ++j) { const int k = 4 * F.lane + 256 * j;
            const f32x4 g = *(const f32x4*)(A.in[I_N1G] + k), sc = *(const f32x4*)(MOD + b * 12288 + 1 * DM + k), sh = *(const f32x4*)(MOD + b * 12288 + k);
            const f32x4 u = v[j] * rstd * g * (sc + 1.0f) + sh; v2u o; o.x = pk2(u.x, u.y); o.y = pk2(u.z, u.w); *(v2u*)(ur + 256 * j) = o; }
    }
}
__device__ __forceinline__ void p3_attention(Frame& F, const Args& A) {
    const bf16* QKV = WSP(bf16, WS_QKV);
    for (int i = F.vcu; i < 1280; i += F.G) {
        if (i < 512) {
            const int c2 = i >> 5, b = c2 >> 3, h = (c2 >> 1) & 3, c = c2 & 1, vh = (i >> 4) & 1, qb = i & 15;
            const size_t rowb = (size_t)b * SEQ;
            const bf16* Qb = QKV + (rowb + qb * 256) * NQKV + C_QB + h * 256 + c * 128;
            const bf16* Kh = QKV + rowb * NQKV + C_KB + h * 256 + c * 128;
            const bf16* Vh = QKV + rowb * NQKV + C_VB + h * 256 + vh * 128;
            float* Ob = WSP(float, WS_OB) + ((size_t)c * T + rowb + qb * 256) * 1024 + h * 256 + vh * 128;
            const float slope = exp2f(-(float)(8 + h + 1) * (8.0f / 12.0f));
            att::attn_body<0>(Qb, NQKV, Kh, Vh, NQKV, 0, SEQ / 64, SEQ / 64, qb * 256, slope / att::SCALE, Ob, 1024, nullptr, 0, F.ldsg);
        } else {
            const int j = i - 512, p = j >> 8, r = j & 255, b = r >> 7, h = (r >> 4) & 7, uu = r & 15;
            const int dil = p == 0 ? 1 : (p == 1 ? 4 : 16), L = SEQ / dil, gpr = L / 256, res = uu / gpr, g = uu % gpr;
            const size_t rowb = (size_t)b * SEQ + res;
            const bf16* Qb = QKV + (rowb + (size_t)g * 256 * dil) * NQKV + C_QA + h * 128;
            const bf16* Kh = QKV + rowb * NQKV + C_KA + h * 128;
            const bf16* Vh = QKV + rowb * NQKV + C_VA + h * 128;
            float* Ob = WSP(float, WS_OA) + ((size_t)p * T + rowb + (size_t)g * 256 * dil) * 1024 + h * 128;
            float* Lb = WSP(float, WS_LSE) + ((size_t)p * T + rowb + (size_t)g * 256 * dil) * 8 + h;
            const float slope = exp2f(-(float)(h + 1) * (8.0f / 12.0f)) * (float)dil;
            att::attn_body<1>(Qb, (long)dil * NQKV, Kh, Vh, (long)dil * NQKV, 4 * g - 1, 6, L / 64, g * 256, slope / att::SCALE, Ob, (long)dil * 1024, Lb, (long)dil * 8, F.ldsg);
        }
    }
}
__device__ __forceinline__ void p4_finalize(Frame& F, const Args& A) {
    const int gw = F.vcu * NWAVES + F.wave, NGW = F.G * NWAVES;
    float s1 = A.in[I_LQ1][F.lane] * A.in[I_LK1][F.lane] + A.in[I_LQ1][F.lane + 64] * A.in[I_LK1][F.lane + 64];
    float s2 = A.in[I_LQ2][F.lane] * A.in[I_LK2][F.lane] + A.in[I_LQ2][F.lane + 64] * A.in[I_LK2][F.lane + 64];
    s1 = wave_sum(s1); s2 = wave_sum(s2);
    const float lam = expf(s1) - expf(s2) + LAMBDA_INIT;
    const float* OA = WSP(float, WS_OA); const float* OB = WSP(float, WS_OB); const float* LS = WSP(float, WS_LSE);
    for (int m = gw; m < T; m += NGW) {
        { const int h = F.lane >> 3; const float l0 = LS[((size_t)0 * T + m) * 8 + h], l1 = LS[((size_t)1 * T + m) * 8 + h], l2 = LS[((size_t)2 * T + m) * 8 + h];
          const float mx = fmaxf(l0, fmaxf(l1, l2)); float w0 = __expf(l0 - mx), w1 = __expf(l1 - mx), w2 = __expf(l2 - mx); const float inv = 1.0f / (w0 + w1 + w2); w0 *= inv; w1 *= inv; w2 *= inv;
          const size_t o = (size_t)m * 1024 + 16 * F.lane; unsigned pk[8];
#pragma unroll
          for (int q = 0; q < 4; ++q) { const f32x4 a0 = *(const f32x4*)(OA + o + 4 * q), a1 = *(const f32x4*)(OA + (size_t)T * 1024 + o + 4 * q), a2 = *(const f32x4*)(OA + (size_t)2 * T * 1024 + o + 4 * q);
              const f32x4 y = a0 * w0 + a1 * w1 + a2 * w2; pk[2 * q] = pk2(y.x, y.y); pk[2 * q + 1] = pk2(y.z, y.w); }
          bf16* ya = WSP(bf16, WS_YA) + o; *(v4u*)ya = (v4u){pk[0], pk[1], pk[2], pk[3]}; *(v4u*)(ya + 8) = (v4u){pk[4], pk[5], pk[6], pk[7]}; }
#pragma unroll
        for (int h = 0; h < 4; ++h) { const size_t o = (size_t)m * 1024 + h * 256 + 4 * F.lane;
            const f32x4 v = *(const f32x4*)(OB + o) - *(const f32x4*)(OB + (size_t)T * 1024 + o) * lam;
            const float ss = wave_sum((v.x * v.x + v.y * v.y) + (v.z * v.z + v.w * v.w)); const float rstd = 1.0f / sqrtf(ss * (1.0f / 256.0f) + EPS);
            const f32x4 g = *(const f32x4*)(A.in[I_SUBG] + 4 * F.lane); const f32x4 y = v * rstd * g * (1.0f - LAMBDA_INIT);
            v2u w; w.x = pk2(y.x, y.y); w.y = pk2(y.z, y.w); *(v2u*)(WSP(bf16, WS_YB) + o) = w; }
    }
}
__device__ __forceinline__ void p7_router(Frame& F, const Args& A) {
    LAS float* gainL = (LAS float*)F.lds;
    LAS float* shiftL = gainL + 2048;
    LAS float* part = shiftL + 2048;
    LAS float* ssp = part + 8 * 32 * 64;
    LAS float* logitL = ssp + 512;
    LAS float* rstdL = logitL + 64 * 33;
    LAS int* lcnt = (LAS int*)(rstdL + 64);
    LAS int* lbase = lcnt + 32;
    const float* H1 = WSP(float, WS_H1); const float* MODp = WSP(float, WS_MOD); const float* RC = WSP(float, WS_RC);
    for (int blk = F.vcu; blk < T / 64; blk += F.G) {
        const int t0 = blk * 64, bb = t0 / SEQ; const float* mod = MODp + bb * 12288;
        for (int k = F.tid; k < DM; k += 512) { gainL[k] = A.in[I_N2G][k] * (1.0f + mod[4 * DM + k]); shiftL[k] = mod[3 * DM + k]; }
        if (F.tid < 32) lcnt[F.tid] = 0;
        __syncthreads();
        {
            float acc[32]; float ss = 0.f;
#pragma unroll
            for (int e = 0; e < 32; ++e) acc[e] = 0.f;
            const float* hrow = H1 + (size_t)(t0 + F.lane) * DM + F.wave * 256;
            const float* wr = A.in[I_WR] + (size_t)(F.wave * 256) * 32;
            for (int kk = 0; kk < 256; kk += 4) {
                const f32x4 hv = *(const f32x4*)(hrow + kk); const f32x4 g4 = *(const LAS f32x4*)(gainL + F.wave * 256 + kk);
                ss += (hv.x * hv.x + hv.y * hv.y) + (hv.z * hv.z + hv.w * hv.w);
#pragma unroll
                for (int c = 0; c < 4; ++c) { const float a = hv[c] * g4[c];
#pragma unroll
                    for (int e = 0; e < 32; ++e) acc[e] = fmaf(a, wr[(kk + c) * 32 + e], acc[e]); }
            }
#pragma unroll
            for (int e = 0; e < 32; ++e) part[(F.wave * 32 + e) * 64 + F.lane] = acc[e];
            ssp[F.wave * 64 + F.lane] = ss;
        }
        __syncthreads();
        { const int token = F.tid & 63, eg = F.tid >> 6; float s2 = 0.f;
#pragma unroll
          for (int w = 0; w < 8; ++w) s2 += ssp[w * 64 + token];
          const float rstd = 1.0f / sqrtf(s2 * (1.0f / DM) + EPS);
#pragma unroll
          for (int q = 0; q < 4; ++q) { const int e = eg * 4 + q; float raw = 0.f;
#pragma unroll
              for (int w = 0; w < 8; ++w) raw += part[(w * 32 + e) * 64 + token];
              logitL[token * 33 + e] = rstd * raw + RC[bb * 32 + e]; }
          if (eg == 0) rstdL[token] = rstd; }
        __syncthreads();
        int se[4] = {0, 0, 0, 0}, lp[4] = {0, 0, 0, 0}; float pv[4] = {0.f, 0.f, 0.f, 0.f};
        if (F.tid < 64) {
            float sv[4];
#pragma unroll
            for (int k = 0; k < 4; ++k) { float best = -INFINITY; int bi = 0;
                for (int e = 0; e < 32; ++e) { const float v = logitL[F.tid * 33 + e]; if (v > best) { best = v; bi = e; } }
                sv[k] = best; se[k] = bi; logitL[F.tid * 33 + bi] = -INFINITY; }
            float sum = 0.f;
#pragma unroll
            for (int k = 0; k < 4; ++k) { pv[k] = expf(sv[k] - sv[0]); sum += pv[k]; }
            const float inv = 1.0f / sum;
#pragma unroll
            for (int k = 0; k < 4; ++k) { pv[k] *= inv; lp[k] = __hip_atomic_fetch_add(lcnt + se[k], 1, __ATOMIC_RELAXED, __HIP_MEMORY_SCOPE_WORKGROUP); }
        }
        __syncthreads();
        if (F.tid < 32) lbase[F.tid] = (int)__hip_atomic_fetch_add((unsigned*)(F.ctl + CW_CNT + 64 * F.tid), (unsigned)lcnt[F.tid], RLX_AGENT);
        __syncthreads();
        if (F.tid < 64) { const int m = t0 + F.tid;
#pragma unroll
            for (int k = 0; k < 4; ++k) { WSP(int, WS_TOPI)[m * 4 + k] = se[k]; WSP(float, WS_TOPP)[m * 4 + k] = pv[k]; WSP(int, WS_POS)[m * 4 + k] = lbase[se[k]] + lp[k]; } }
        for (int i = 0; i < 8; ++i) { const int token = F.wave * 8 + i, m = t0 + token; const float rstd = rstdL[token];
            const float* hr = H1 + (size_t)m * DM + 4 * F.lane; bf16* ur = WSP(bf16, WS_U) + (size_t)m * DM + 4 * F.lane;
#pragma unroll
            for (int j = 0; j < 8; ++j) { const f32x4 h = *(const f32x4*)(hr + 256 * j), g = *(const LAS f32x4*)(gainL + 4 * F.lane + 256 * j), s = *(const LAS f32x4*)(shiftL + 4 * F.lane + 256 * j);
                const f32x4 u = h * rstd * g + s; v2u o; o.x = pk2(u.x, u.y); o.y = pk2(u.z, u.w); *(v2u*)(ur + 256 * j) = o; } }
        __syncthreads();
    }
}
__device__ __forceinline__ void build_tile_table(Frame& F) {
    LAS int* ts = (LAS int*)(F.lds + TST_OFF);
    if (F.tid == 0) { int acc = 0;
        for (int e = 0; e < NE; ++e) { ts[e] = acc; acc += ((int)__hip_atomic_load((unsigned*)(F.ctl + CW_CNT + 64 * e), RLX_AGENT) + 255) >> 8; }
        ts[32] = acc; }
    __syncthreads();
}
__device__ __forceinline__ void p8_gather(Frame& F, const Args& A) {
    build_tile_table(F);
    const LAS int* ts = (const LAS int*)(F.lds + TST_OFF);
    const int gw = F.vcu * NWAVES + F.wave, NGW = F.G * NWAVES;
    for (int m = gw; m < T; m += NGW) {
        const v4u* src = (const v4u*)(WSP(bf16, WS_U) + (size_t)m * DM); v4u v[4];
#pragma unroll
        for (int q = 0; q < 4; ++q) v[q] = src[F.lane + 64 * q];
#pragma unroll
        for (int k = 0; k < 4; ++k) { const int e = WSP(int, WS_TOPI)[m * 4 + k], pos = WSP(int, WS_POS)[m * 4 + k]; const size_t row = (size_t)ts[e] * 256 + pos;
            v4u* dst = (v4u*)(WSP(bf16, WS_XS) + row * DM);
#pragma unroll
            for (int q = 0; q < 4; ++q) dst[F.lane + 64 * q] = v[q]; }
    }
}
__device__ __forceinline__ void p11_final(Frame& F, const Args& A) {
    build_tile_table(F);
    const LAS int* ts = (const LAS int*)(F.lds + TST_OFF);
    const int gw = F.vcu * NWAVES + F.wave, NGW = F.G * NWAVES; const float* MODp = WSP(float, WS_MOD);
    for (int m = gw; m < T; m += NGW) {
        const int bb = m / SEQ; const bf16* yr[4]; float p[4];
#pragma unroll
        for (int k = 0; k < 4; ++k) { const int e = WSP(int, WS_TOPI)[m * 4 + k], pos = WSP(int, WS_POS)[m * 4 + k]; p[k] = WSP(float, WS_TOPP)[m * 4 + k];
            yr[k] = WSP(bf16, WS_YSLOT) + ((size_t)ts[e] * 256 + pos) * DM + 4 * F.lane; }
        const float* hr = WSP(float, WS_H1) + (size_t)m * DM + 4 * F.lane; f32x4 v[8]; float s = 0.f;
#pragma unroll
        for (int j = 0; j < 8; ++j) { f32x4 a = {0.f, 0.f, 0.f, 0.f};
#pragma unroll
            for (int k = 0; k < 4; ++k) { const v2u w = *(const v2u*)(yr[k] + 256 * j); const f32x4 y = {__uint_as_float(w.x << 16), __uint_as_float(w.x & 0xffff0000u), __uint_as_float(w.y << 16), __uint_as_float(w.y & 0xffff0000u)}; a += y * p[k]; }
            const f32x4 g2 = *(const f32x4*)(MODp + bb * 12288 + 5 * DM + 4 * F.lane + 256 * j);
            v[j] = *(const f32x4*)(hr + 256 * j) + g2 * a; s += (v[j].x * v[j].x + v[j].y * v[j].y) + (v[j].z * v[j].z + v[j].w * v[j].w); }
        const float rstd = 1.0f / sqrtf(wave_sum(s) * (1.0f / DM) + EPS);
        float* orow = A.out + (size_t)m * DM + 4 * F.lane;
#pragma unroll
        for (int j = 0; j < 8; ++j) { const f32x4 g = *(const f32x4*)(A.in[I_FG] + 4 * F.lane + 256 * j); *(f32x4*)(orow + 256 * j) = v[j] * rstd * g; }
    }
}

__global__ void __launch_bounds__(NWAVES * 64, 2) fwd(Args args) {
    extern __shared__ __attribute__((aligned(16))) unsigned char lds[];
    Frame F;
    F.lds = (LAS unsigned char*)lds; F.ldsg = (char*)lds;
    F.MISC = (volatile LAS unsigned*)(F.lds + MISC_OFF);
    F.tid = threadIdx.x; F.lane = F.tid & 63; F.wave = __builtin_amdgcn_readfirstlane(F.tid >> 6);
    F.G = gridDim.x; { const int bx = blockIdx.x; F.vcu = (F.G % 8 == 0) ? (bx % 8) * (F.G / 8) + bx / 8 : bx; }
    F.ws = args.ws; F.ctl = (gu32*)(args.ws + WS_CTL);
    for (int u = F.tid; u < (LDS_BYTES - LDSCTL_OFF) / 4; u += NWAVES * 64) ((LAS unsigned*)(F.lds + LDSCTL_OFF))[u] = 0u;
    __syncthreads();
#if MK_SPLIT
#define GRID_BAR() do { } while (0)
#else
    XcdBarrier bar = xcd_barrier_post((unsigned*)(F.ctl + CW_BAR), F.MISC + 8);
#define GRID_BAR() xcd_barrier(bar)
#endif
    const int lo = args.ph_lo, hi = args.ph_hi;
#define IN(k) (lo <= (k) && (k) < hi)
#define SEAM(k) do { if (IN(k) && IN((k) + 1)) GRID_BAR(); } while (0)
    const Args& A = args;
    constexpr bool AL = true, SP = true;

    if (IN(0)) { p0_prologue(F, A); } SEAM(0);
    if (IN(1)) { p1_modulate(F, A); } SEAM(1);
    if (IN(2)) {
        pg8::Gemm g{WSP(bf16, WS_U), WSP(bf16, WS_WINT), T, NQKV, DM}; pg8::StaticOrder S; S.init(T, NQKV, F.G, (int)blockIdx.x);
        pg8::EpiQKV E{WSP(bf16, WS_QKV), NQKV, C_GA / 256};
        pg8::gemm_phase<pg8::EpiQKV, pg8::StaticOrder, AL, SP>(F.lds + RING_OFF, g, S, E);
    } SEAM(2);
    if (IN(3)) { p3_attention(F, A); } SEAM(3);
    if (IN(4)) { p4_finalize(F, A); } SEAM(4);
    if (IN(5)) {
        { pg8::Gemm g{WSP(bf16, WS_YA), WSP(bf16, WS_WAT), T, DM, 1024}; pg8::StaticOrder S; S.init(T, DM, F.G, (int)blockIdx.x);
          pg8::EpiM1 E{WSP(float, WS_M1), WSP(bf16, WS_QKV) + C_GA, NQKV};
          pg8::gemm_phase<pg8::EpiM1, pg8::StaticOrder, AL, SP>(F.lds + RING_OFF, g, S, E); }
        VM_WAIT(); __syncthreads();
        { pg8::Gemm g{WSP(bf16, WS_YB), WSP(bf16, WS_WBT), T, DM, 1024}; pg8::StaticOrder S; S.init(T, DM, F.G, (int)blockIdx.x);
          pg8::EpiMerged E{WSP(float, WS_M1), WSP(bf16, WS_QKV) + C_GB, NQKV, WSP(bf16, WS_MG)};
          pg8::gemm_phase<pg8::EpiMerged, pg8::StaticOrder, AL, SP>(F.lds + RING_OFF, g, S, E); }
    } SEAM(5);
    if (IN(6)) {
        pg8::Gemm g{WSP(bf16, WS_MG), WSP(bf16, WS_WOT), T, DM, DM}; pg8::StaticOrder S; S.init(T, DM, F.G, (int)blockIdx.x);
        pg8::EpiH1 E{A.in[I_X], WSP(float, WS_H1), WSP(float, WS_MOD) + 2 * DM, 12288, SEQ / 256};
        pg8::gemm_phase<pg8::EpiH1, pg8::StaticOrder, AL, SP>(F.lds + RING_OFF, g, S, E);
    } SEAM(6);
    if (IN(7)) { p7_router(F, A); } SEAM(7);
    if (IN(8)) { p8_gather(F, A); } SEAM(8);
    if (IN(9)) {
        build_tile_table(F);
        pg8::Gemm g{WSP(bf16, WS_XS), WSP(bf16, WS_WGU), TKPAD, NE * 4096, DM}; pg8::MoeOrder S; S.init((const LAS int*)(F.lds + TST_OFF), 16, F.G, (int)blockIdx.x);
        pg8::EpiSwiGLU E{WSP(bf16, WS_YACT), A.in[I_BG], A.in[I_BU]};
        pg8::gemm_phase<pg8::EpiSwiGLU, pg8::MoeOrder, AL, SP>(F.lds + RING_OFF, g, S, E);
    } SEAM(9);
    if (IN(10)) {
        build_tile_table(F);
        pg8::Gemm g{WSP(bf16, WS_YACT), WSP(bf16, WS_WD), TKPAD, NE * DM, DM}; pg8::MoeOrder S; S.init((const LAS int*)(F.lds + TST_OFF), 8, F.G, (int)blockIdx.x);
        pg8::EpiBf16B E{WSP(bf16, WS_YSLOT), DM, A.in[I_BDN], 8};
        pg8::gemm_phase<pg8::EpiBf16B, pg8::MoeOrder, AL, SP>(F.lds + RING_OFF, g, S, E);
    } SEAM(10);
    if (IN(11)) { p11_final(F, A); }
#undef IN
#undef SEAM
}
extern "C" void kernel_launch(void* const* d_in, const int* in_sizes, int n_in, void* d_out, int out_size, void* d_ws, size_t ws_size, hipStream_t stream) {
    static int grid = 0;
    if (grid == 0) {
        if (n_in != 24 || in_sizes[0] != T * DM || out_size != T * DM || ws_size < WS_END) { fprintf(stderr, "kernel_launch: shape mismatch (n_in %d, in0 %d, out %d, ws %zu < %zu); nothing launched\n", n_in, n_in > 0 ? in_sizes[0] : -1, out_size, ws_size, (size_t)WS_END); grid = -1; return; }
        int dev = 0, cus = 0, per_cu = 0;
        if (hipGetDevice(&dev) != hipSuccess || hipDeviceGetAttribute(&cus, hipDeviceAttributeMultiprocessorCount, dev) != hipSuccess) { grid = -1; return; }
        if (hipFuncSetAttribute((const void*)fwd, hipFuncAttributeMaxDynamicSharedMemorySize, LDS_BYTES) != hipSuccess) { fprintf(stderr, "kernel_launch: hipFuncSetAttribute failed\n"); grid = -1; return; }
        if (hipOccupancyMaxActiveBlocksPerMultiprocessor(&per_cu, (const void*)fwd, NWAVES * 64, LDS_BYTES) != hipSuccess || per_cu < 1)
            fprintf(stderr, "kernel_launch: note: occupancy query reports %d workgroups per CU\n", per_cu);
        (void)hipGetLastError();
        grid = cus;
    }
    if (grid < 0) return;
    if (hipMemsetAsync((char*)d_ws + WS_CTL, 0, CTL_ZERO_BYTES, stream) != hipSuccess) return;
    Args a; memset(&a, 0, sizeof(a));
    for (int i = 0; i < 24; ++i) a.in[i] = (const float*)d_in[i];
    a.out = (float*)d_out; a.ws = (unsigned char*)d_ws;
#if MK_SPLIT
    for (int ph = 0; ph < N_PHASES; ++ph) { a.ph_lo = ph; a.ph_hi = ph + 1; hipLaunchKernelGGL(fwd, dim3(grid), dim3(NWAVES * 64), LDS_BYTES, stream, a); }
#else
    a.ph_lo = 0; a.ph_hi = N_PHASES; hipLaunchKernelGGL(fwd, dim3(grid), dim3(NWAVES * 64), LDS_BYTES, stream, a);
#endif
    const hipError_t le = hipPeekAtLastError();
    if (le != hipSuccess) fprintf(stderr, "kernel_launch: launch failed: %s\n", hipGetErrorName(le));
#if DBG_ORACLE
    dbg_launch(a, stream);
#endif
}
```

```cpp
#include <hip/hip_runtime.h>
#include <cstdio>
#include <cstdint>
#include <cstring>
#include <cmath>
namespace pg8 {
#define PG8_LAS __attribute__((address_space(3)))
typedef unsigned short bf16_t;
typedef short bf16x8 __attribute__((ext_vector_type(8)));
typedef float f32x4 __attribute__((ext_vector_type(4)));
typedef unsigned u32x4 __attribute__((ext_vector_type(4)));
constexpr int BM = 256, BK = 64, HALF = 128, HTB = HALF * BK * 2  , STAGE_BYTES = 8 * HTB, NXCD = 8, WGM = 8;

__host__ __device__ __forceinline__ int lds_byte(int r, int c) { const int st = (r >> 4) * 2 + (c >> 5), rr = r & 15, cc = c & 31, ob = rr * 64 + cc * 2; return st * 1024 + (ob ^ (((ob >> 9) & 1) << 5)); }
__host__ __device__ __forceinline__ void stage_rc(int b, int& R, int& C) { const int st = b / 1024, sb = b % 1024, swz = sb ^ (((sb >> 9) & 1) << 5); R = (st >> 1) * 16 + swz / 64; C = (st & 1) * 32 + (swz % 64) / 2; }
__host__ __device__ __forceinline__ int perm32(int rho) { const int n = rho >> 4, i = rho & 15; return 8 * (i >> 2) + 4 * n + (i & 3); }

struct Unit { int pm, pn; };
struct Gemm { const bf16_t* A; const bf16_t* Bt; int M, N, K; };

struct StaticOrder {
    int nM, nN, nwg, G, c;
    __host__ __device__ void init(int M, int N, int G_, int c_) { nM = M / BM; nN = N / BM; nwg = nM * nN; G = G_; c = c_; }
    __host__ __device__ bool next(int i, Unit& u) const {
        const long L = (long)i * G + c; if (L >= nwg) return false;
        int wgid = (int)L; { const int q = nwg / NXCD, r = nwg % NXCD, xcd = wgid % NXCD, off = wgid / NXCD; wgid = (xcd < r ? xcd * (q + 1) : r * (q + 1) + (xcd - r) * q) + off; }
        const int nig = WGM * nN, gid = wgid / nig, fm = gid * WGM, gsz = (nM - fm) < WGM ? (nM - fm) : WGM;
        u.pm = fm + ((wgid % nig) % gsz); u.pn = (wgid % nig) / gsz; return true;
    }
    __device__ __forceinline__ void a_ready(const Unit&) const {}
    __device__ __forceinline__ void done(const Unit&) const {}
};

__device__ __forceinline__ unsigned cvt_pk_bf16(float lo, float hi) { unsigned r; asm volatile("v_cvt_pk_bf16_f32 %0, %1, %2" : "=v"(r) : "v"(lo), "v"(hi)); return r; }

typedef int v4i_t __attribute__((ext_vector_type(4)));
typedef int v8i_t __attribute__((ext_vector_type(8)));
template <class Epi, class Sched, bool ALIGN_EPI = false, bool SP2 = false, bool F8 = false>
__device__ __forceinline__ void gemm_phase(PG8_LAS unsigned char* lds, const Gemm g, const Sched& S, const Epi& E) {
    const int tid = threadIdx.x, wid = __builtin_amdgcn_readfirstlane(tid >> 6), lane = tid & 63, wr = wid >> 2, wc = wid & 3, fr = lane & 15, fq = lane >> 4;
    const int K = g.K, nt = K / BK;
    unsigned voffA[2], voffB[2];
#pragma unroll
    for (int i = 0; i < 2; ++i) { int R, C; stage_rc(tid * 16 + i * 8192, R, C); const int Rb = Epi::PERM ? ((R & ~31) + perm32(R & 31)) : R;
        voffA[i] = (unsigned)(R * K + C) * 2u; voffB[i] = (unsigned)(Rb * K + C) * 2u; }
    const size_t kstep = (size_t)(BK * 2);
    const size_t hstep = (size_t)HALF * K * 2;
    const size_t tstep = 2 * hstep;
    const unsigned ldsw = (unsigned)wid * 1024u;
    const int aoff = lds_byte(wr * 64 + fr, fq * 8), boff = lds_byte(wc * 32 + fr, fq * 8);
#define PG8_SA(b, h) (((b) * 2 + (h)) * HTB)
#define PG8_SB(b, h) ((4 + (b) * 2 + (h)) * HTB)
#define PG8_STAGE(bufoff, gbase, voff) do { _Pragma("unroll") for (int _i = 0; _i < 2; ++_i) \
        __builtin_amdgcn_global_load_lds((const unsigned*)((const char*)(gbase) + (voff)[_i]), (PG8_LAS unsigned*)(lds + (bufoff) + ldsw + _i * 8192), 16, 0, 0); } while (0)
#define PG8_LDA(dst, b, h) do { _Pragma("unroll") for (int m = 0; m < 4; ++m) _Pragma("unroll") for (int k = 0; k < 2; ++k) dst[m][k] = *(const PG8_LAS bf16x8*)(lds + PG8_SA(b, h) + aoff + m * 2048 + k * 1024); } while (0)
#define PG8_LDB(dst, b, h) do { _Pragma("unroll") for (int n = 0; n < 2; ++n) _Pragma("unroll") for (int k = 0; k < 2; ++k) dst[n][k] = *(const PG8_LAS bf16x8*)(lds + PG8_SB(b, h) + boff + n * 2048 + k * 1024); } while (0)
#define PG8_MMA(ai, bj, At, Bt) do { __builtin_amdgcn_s_setprio(1); _Pragma("unroll") for (int m = 0; m < 4; ++m) _Pragma("unroll") for (int n = 0; n < 2; ++n) { \
        if constexpr (F8) { const v8i_t _b = __builtin_shufflevector(__builtin_bit_cast(v4i_t, Bt[n][0]), __builtin_bit_cast(v4i_t, Bt[n][1]), 0, 1, 2, 3, 4, 5, 6, 7); \
            const v8i_t _a = __builtin_shufflevector(__builtin_bit_cast(v4i_t, At[m][0]), __builtin_bit_cast(v4i_t, At[m][1]), 0, 1, 2, 3, 4, 5, 6, 7); \
            asm volatile("v_mfma_scale_f32_16x16x128_f8f6f4 %0, %1, %2, %0, %3, %3 op_sel_hi:[0,0,0]" : "+v"(acc[ai][bj][m][n]) : "v"(_b), "v"(_a), "v"(f8scale)); } \
        else { _Pragma("unroll") for (int k = 0; k < 2; ++k) acc[ai][bj][m][n] = __builtin_amdgcn_mfma_f32_16x16x32_bf16(Bt[n][k], At[m][k], acc[ai][bj][m][n], 0, 0, 0); } } \
        __builtin_amdgcn_s_setprio(0); } while (0)
#define PG8_WAIT_V(n) asm volatile("s_waitcnt vmcnt(" #n ")" ::: "memory")
#define PG8_WAIT_L(n) asm volatile("s_waitcnt lgkmcnt(" #n ")" ::: "memory")
#define PG8_BAR __builtin_amdgcn_s_barrier()
#define PG8_SCHED __builtin_amdgcn_sched_barrier(0)
    Unit cur, nxt; int ui = 0;
    if (!S.next(0, cur)) return;
    const int f8scale = 0x7f7f7f7f;
    f32x4 acc[2][2][4][2];
#pragma unroll
    for (int a = 0; a < 2; ++a)
#pragma unroll
        for (int b = 0; b < 2; ++b)
#pragma unroll
            for (int m = 0; m < 4; ++m)
#pragma unroll
                for (int n = 0; n < 2; ++n) acc[a][b][m][n] = (f32x4){0.f, 0.f, 0.f, 0.f};
    bf16x8 At[4][2], B0[2][2], B1[2][2];
    const char* cA = (const char*)g.A + (size_t)cur.pm * tstep; const char* cB = (const char*)g.Bt + (size_t)cur.pn * tstep;
    S.a_ready(cur);
    if constexpr (SP2) {
        PG8_STAGE(PG8_SB(0, 0), cB, voffB); PG8_STAGE(PG8_SB(0, 1), cB + hstep, voffB); PG8_STAGE(PG8_SA(0, 0), cA, voffA); PG8_STAGE(PG8_SA(0, 1), cA + hstep, voffA);
        if (wr == 1) PG8_BAR;
        PG8_WAIT_V(2); PG8_BAR;
        PG8_STAGE(PG8_SB(1, 0), cB + kstep, voffB); PG8_STAGE(PG8_SA(1, 0), cA + kstep, voffA); PG8_STAGE(PG8_SB(1, 1), cB + hstep + kstep, voffB);
        PG8_WAIT_V(6); PG8_BAR;
    } else {
        PG8_STAGE(PG8_SB(0, 0), cB, voffB); PG8_STAGE(PG8_SA(0, 0), cA, voffA); PG8_STAGE(PG8_SB(0, 1), cB + hstep, voffB); PG8_STAGE(PG8_SA(0, 1), cA + hstep, voffA);
        if (wr == 1) PG8_BAR;
        PG8_WAIT_V(4); PG8_BAR;
        PG8_STAGE(PG8_SB(1, 0), cB + kstep, voffB); PG8_STAGE(PG8_SA(1, 0), cA + kstep, voffA); PG8_STAGE(PG8_SB(1, 1), cB + hstep + kstep, voffB);
        PG8_WAIT_V(6); PG8_BAR;
    }
    for (;;) {
        const bool has_next = S.next(ui + 1, nxt);
        const char* nA = has_next ? (const char*)g.A + (size_t)nxt.pm * tstep : cA; const char* nB = has_next ? (const char*)g.Bt + (size_t)nxt.pn * tstep : cB;
        for (int t = 0; t < nt; t += 2) {
            const bool last = (t == nt - 2);
            const char* a1 = cA + (size_t)(t + 1) * kstep;
            const char* a2 = last ? nA : cA + (size_t)(t + 2) * kstep; const char* b2 = last ? nB : cB + (size_t)(t + 2) * kstep;
            const char* a3 = a2 + kstep; const char* b3 = b2 + kstep;
            if (last && has_next) S.a_ready(nxt);
            if constexpr (SP2) {
            PG8_LDB(B0, 0, 0); PG8_LDB(B1, 0, 1); PG8_SCHED; PG8_LDA(At, 0, 0); PG8_STAGE(PG8_SA(1, 1), a1 + hstep, voffA);
            PG8_WAIT_V(8); PG8_WAIT_L(0); PG8_BAR; PG8_MMA(0, 0, At, B0); PG8_MMA(0, 1, At, B1); PG8_BAR; PG8_SCHED;
            PG8_LDA(At, 0, 1); PG8_STAGE(PG8_SB(0, 0), b2, voffB); PG8_STAGE(PG8_SB(0, 1), b2 + hstep, voffB); PG8_STAGE(PG8_SA(0, 0), a2, voffA);
            PG8_WAIT_V(8); PG8_WAIT_L(0); PG8_BAR; PG8_MMA(1, 0, At, B0); PG8_MMA(1, 1, At, B1); PG8_BAR; PG8_SCHED;
            PG8_LDB(B0, 1, 0); PG8_LDB(B1, 1, 1); PG8_SCHED; PG8_LDA(At, 1, 0); PG8_STAGE(PG8_SA(0, 1), a2 + hstep, voffA);
            PG8_WAIT_V(8); PG8_WAIT_L(0); PG8_BAR; PG8_MMA(0, 0, At, B0); PG8_MMA(0, 1, At, B1); PG8_BAR; PG8_SCHED;
            PG8_LDA(At, 1, 1); PG8_STAGE(PG8_SB(1, 0), b3, voffB); PG8_STAGE(PG8_SB(1, 1), b3 + hstep, voffB); PG8_STAGE(PG8_SA(1, 0), a3, voffA);
            PG8_WAIT_V(8); PG8_WAIT_L(0); PG8_BAR; PG8_MMA(1, 0, At, B0); PG8_MMA(1, 1, At, B1); PG8_BAR; PG8_SCHED;
            } else {
            PG8_LDB(B0, 0, 0); PG8_SCHED; PG8_LDA(At, 0, 0); PG8_STAGE(PG8_SA(1, 1), a1 + hstep, voffA);
            PG8_WAIT_L(8); PG8_BAR; PG8_WAIT_L(0); PG8_MMA(0, 0, At, B0); PG8_BAR; PG8_SCHED;
            PG8_LDB(B1, 0, 1); PG8_STAGE(PG8_SB(0, 0), b2, voffB);
            PG8_BAR; PG8_WAIT_L(0); PG8_MMA(0, 1, At, B1); PG8_BAR;
            PG8_LDA(At, 0, 1); PG8_STAGE(PG8_SA(0, 0), a2, voffA);
            PG8_BAR; PG8_WAIT_L(0); PG8_MMA(1, 0, At, B0); PG8_BAR; PG8_SCHED;
            PG8_STAGE(PG8_SB(0, 1), b2 + hstep, voffB);
            PG8_WAIT_V(6); PG8_BAR; PG8_MMA(1, 1, At, B1); PG8_BAR;
            PG8_LDB(B0, 1, 0); PG8_SCHED; PG8_LDA(At, 1, 0); PG8_STAGE(PG8_SA(0, 1), a2 + hstep, voffA);
            PG8_WAIT_L(8); PG8_BAR; PG8_WAIT_L(0); PG8_MMA(0, 0, At, B0); PG8_BAR; PG8_SCHED;
            PG8_LDB(B1, 1, 1); PG8_STAGE(PG8_SB(1, 0), b3, voffB);
            PG8_BAR; PG8_WAIT_L(0); PG8_MMA(0, 1, At, B1); PG8_BAR;
            PG8_LDA(At, 1, 1); PG8_STAGE(PG8_SA(1, 0), a3, voffA);
            PG8_BAR; PG8_WAIT_L(0); PG8_MMA(1, 0, At, B0); PG8_BAR; PG8_SCHED;
            PG8_STAGE(PG8_SB(1, 1), b3 + hstep, voffB);
            PG8_WAIT_V(6); PG8_BAR; PG8_MMA(1, 1, At, B1); PG8_BAR;
            }
        }
        if constexpr (F8) asm volatile("s_nop 15\n\ts_nop 7" ::: "memory");
        if constexpr (ALIGN_EPI) { if (wr == 0) PG8_BAR; }
        if constexpr (!Epi::AFTER_DRAIN) { E(acc, cur, wr, wc, fr, fq); S.done(cur); }
        if (!has_next) break;
#pragma unroll
        for (int a = 0; a < 2; ++a)
#pragma unroll
            for (int b = 0; b < 2; ++b)
#pragma unroll
                for (int m = 0; m < 4; ++m)
#pragma unroll
                    for (int n = 0; n < 2; ++n) acc[a][b][m][n] = (f32x4){0.f, 0.f, 0.f, 0.f};
        cur = nxt; cA = nA; cB = nB; ++ui;
        if constexpr (ALIGN_EPI) { if (wr == 1) PG8_BAR; }
    }
    PG8_WAIT_V(0);
    if constexpr (!ALIGN_EPI) { if (wr == 0) PG8_BAR; }
    PG8_BAR;
    if constexpr (Epi::AFTER_DRAIN) { E.fused(acc, cur, wr, wc, fr, fq, lds, wid, lane); S.done(cur); }
#undef PG8_SA
#undef PG8_SB
#undef PG8_STAGE
#undef PG8_LDA
#undef PG8_LDB
#undef PG8_MMA
#undef PG8_WAIT_V
#undef PG8_WAIT_L
#undef PG8_BAR
#undef PG8_SCHED
}
}
namespace pg8 {
typedef float f32x2e __attribute__((ext_vector_type(2)));
__device__ __forceinline__ float bf_lo(unsigned w) { return __uint_as_float(w << 16); }
__device__ __forceinline__ float bf_hi(unsigned w) { return __uint_as_float(w & 0xffff0000u); }
__device__ __forceinline__ float sigmoidf_fast(float x) { return __builtin_amdgcn_rcpf(1.0f + __expf(-x)); }

struct EpiBf16B {
    static constexpr bool PERM = true, AFTER_DRAIN = false;
    bf16_t* O; int ldc; const float* bias; int ntile_mod; float scale;
    __device__ __forceinline__ void operator()(const f32x4 (&acc)[2][2][4][2], const Unit& u, int wr, int wc, int fr, int fq) const {
        const int row0 = u.pm * BM + wr * 64 + fr; const int colt = (u.pn % ntile_mod) * BM;
        const int col0 = colt + wc * 32 + 8 * fq, bcol0 = u.pn * BM + wc * 32 + 8 * fq;
        f32x4 bv[2][2];
#pragma unroll
        for (int bj = 0; bj < 2; ++bj)
#pragma unroll
            for (int n = 0; n < 2; ++n) bv[bj][n] = bias ? *(const f32x4*)(bias + bcol0 + bj * HALF + 4 * n) : (f32x4){0.f, 0.f, 0.f, 0.f};
#pragma unroll
        for (int ai = 0; ai < 2; ++ai)
#pragma unroll
            for (int m = 0; m < 4; ++m) { bf16_t* rowp = O + (size_t)(row0 + ai * HALF + m * 16) * ldc + col0;
#pragma unroll
                for (int bj = 0; bj < 2; ++bj) { const f32x4 v0 = acc[ai][bj][m][0] * scale + bv[bj][0], v1 = acc[ai][bj][m][1] * scale + bv[bj][1];
                    u32x4 w; w.x = cvt_pk_bf16(v0[0], v0[1]); w.y = cvt_pk_bf16(v0[2], v0[3]); w.z = cvt_pk_bf16(v1[0], v1[1]); w.w = cvt_pk_bf16(v1[2], v1[3]);
                    *(u32x4*)(rowp + bj * HALF) = w; } }
    }
};
struct EpiQKV {
    static constexpr bool PERM = true, AFTER_DRAIN = false;
    bf16_t* O; int ldc; int sig_tile0;
    __device__ __forceinline__ void operator()(const f32x4 (&acc)[2][2][4][2], const Unit& u, int wr, int wc, int fr, int fq) const {
        const int row0 = u.pm * BM + wr * 64 + fr; const int col0 = u.pn * BM + wc * 32 + 8 * fq; const bool sg = u.pn >= sig_tile0;
#pragma unroll
        for (int ai = 0; ai < 2; ++ai)
#pragma unroll
            for (int m = 0; m < 4; ++m) { bf16_t* rowp = O + (size_t)(row0 + ai * HALF + m * 16) * ldc + col0;
#pragma unroll
                for (int bj = 0; bj < 2; ++bj) { f32x4 v0 = acc[ai][bj][m][0], v1 = acc[ai][bj][m][1];
                    if (sg) {
#pragma unroll
                        for (int i = 0; i < 4; ++i) { v0[i] = sigmoidf_fast(v0[i]); v1[i] = sigmoidf_fast(v1[i]); } }
                    u32x4 w; w.x = cvt_pk_bf16(v0[0], v0[1]); w.y = cvt_pk_bf16(v0[2], v0[3]); w.z = cvt_pk_bf16(v1[0], v1[1]); w.w = cvt_pk_bf16(v1[2], v1[3]);
                    *(u32x4*)(rowp + bj * HALF) = w; } }
    }
};
struct EpiM1 {
    static constexpr bool PERM = true, AFTER_DRAIN = false;
    float* M1; const bf16_t* G; int ldg;
    __device__ __forceinline__ void operator()(const f32x4 (&acc)[2][2][4][2], const Unit& u, int wr, int wc, int fr, int fq) const {
        const int row0 = u.pm * BM + wr * 64 + fr; const int col0 = u.pn * BM + wc * 32 + 8 * fq;
#pragma unroll
        for (int ai = 0; ai < 2; ++ai)
#pragma unroll
            for (int m = 0; m < 4; ++m) { const size_t row = (size_t)(row0 + ai * HALF + m * 16);
#pragma unroll
                for (int bj = 0; bj < 2; ++bj) { const int col = col0 + bj * HALF; const u32x4 g = *(const u32x4*)(G + row * ldg + col);
                    const f32x4 a0 = acc[ai][bj][m][0], a1 = acc[ai][bj][m][1];
                    const f32x4 o0 = {a0[0] * bf_lo(g.x), a0[1] * bf_hi(g.x), a0[2] * bf_lo(g.y), a0[3] * bf_hi(g.y)};
                    const f32x4 o1 = {a1[0] * bf_lo(g.z), a1[1] * bf_hi(g.z), a1[2] * bf_lo(g.w), a1[3] * bf_hi(g.w)};
                    float* p = M1 + row * 2048 + col; *(f32x4*)p = o0; *(f32x4*)(p + 4) = o1; } }
    }
};
struct EpiMerged {
    static constexpr bool PERM = true, AFTER_DRAIN = false;
    const float* M1; const bf16_t* G; int ldg; bf16_t* MG;
    __device__ __forceinline__ void operator()(const f32x4 (&acc)[2][2][4][2], const Unit& u, int wr, int wc, int fr, int fq) const {
        const int row0 = u.pm * BM + wr * 64 + fr; const int col0 = u.pn * BM + wc * 32 + 8 * fq;
#pragma unroll
        for (int ai = 0; ai < 2; ++ai)
#pragma unroll
            for (int m = 0; m < 4; ++m) { const size_t row = (size_t)(row0 + ai * HALF + m * 16);
#pragma unroll
                for (int bj = 0; bj < 2; ++bj) { const int col = col0 + bj * HALF; const u32x4 g = *(const u32x4*)(G + row * ldg + col);
                    const float* p = M1 + row * 2048 + col; const f32x4 m0 = *(const f32x4*)p, m1 = *(const f32x4*)(p + 4);
                    const f32x4 a0 = acc[ai][bj][m][0], a1 = acc[ai][bj][m][1];
                    const f32x4 o0 = {m0[0] + a0[0] * bf_lo(g.x), m0[1] + a0[1] * bf_hi(g.x), m0[2] + a0[2] * bf_lo(g.y), m0[3] + a0[3] * bf_hi(g.y)};
                    const f32x4 o1 = {m1[0] + a1[0] * bf_lo(g.z), m1[1] + a1[1] * bf_hi(g.z), m1[2] + a1[2] * bf_lo(g.w), m1[3] + a1[3] * bf_hi(g.w)};
                    u32x4 w; w.x = cvt_pk_bf16(o0[0], o0[1]); w.y = cvt_pk_bf16(o0[2], o0[3]); w.z = cvt_pk_bf16(o1[0], o1[1]); w.w = cvt_pk_bf16(o1[2], o1[3]);
                    *(u32x4*)(MG + row * 2048 + col) = w; } }
    }
};
struct EpiH1 {
    static constexpr bool PERM = false, AFTER_DRAIN = false;
    const float* X; float* H1; const float* g1; int g1_stride; int tiles_per_batch;
    __device__ __forceinline__ void operator()(const f32x4 (&acc)[2][2][4][2], const Unit& u, int wr, int wc, int fr, int fq) const {
        const int row0 = u.pm * BM + wr * 64 + fr; const int col0 = u.pn * BM + wc * 32 + 4 * fq; const float* gb = g1 + (size_t)(u.pm / tiles_per_batch) * g1_stride;
        f32x4 gv[2][2];
#pragma unroll
        for (int bj = 0; bj < 2; ++bj)
#pragma unroll
            for (int n = 0; n < 2; ++n) gv[bj][n] = *(const f32x4*)(gb + col0 + bj * HALF + n * 16);
#pragma unroll
        for (int ai = 0; ai < 2; ++ai)
#pragma unroll
            for (int m = 0; m < 4; ++m) { const size_t off = (size_t)(row0 + ai * HALF + m * 16) * 2048 + col0;
#pragma unroll
                for (int bj = 0; bj < 2; ++bj)
#pragma unroll
                    for (int n = 0; n < 2; ++n) { const f32x4 xv = *(const f32x4*)(X + off + bj * HALF + n * 16);
                        *(f32x4*)(H1 + off + bj * HALF + n * 16) = xv + gv[bj][n] * acc[ai][bj][m][n]; } }
    }
};
struct EpiSwiGLU {
    static constexpr bool PERM = true, AFTER_DRAIN = false;
    unsigned char* Y; const float* bg; const float* bu; float wscale;
    __device__ __forceinline__ void operator()(const f32x4 (&acc)[2][2][4][2], const Unit& u, int wr, int wc, int fr, int fq) const {
        const int e = u.pn >> 4, pnl = u.pn & 15; const int row0 = u.pm * BM + wr * 64 + fr; const int col0 = pnl * HALF + wc * 32 + 8 * fq;
        f32x4 bgv[2], buv[2];
#pragma unroll
        for (int n = 0; n < 2; ++n) { bgv[n] = *(const f32x4*)(bg + (size_t)e * 2048 + col0 + 4 * n); buv[n] = *(const f32x4*)(bu + (size_t)e * 2048 + col0 + 4 * n); }
#pragma unroll
        for (int ai = 0; ai < 2; ++ai)
#pragma unroll
            for (int m = 0; m < 4; ++m) { unsigned char* rowp = Y + (size_t)(row0 + ai * HALF + m * 16) * 2048 + col0; f32x4 y[2];
#pragma unroll
                for (int n = 0; n < 2; ++n) { const f32x4 g4 = acc[ai][0][m][n] * wscale + bgv[n], u4 = acc[ai][1][m][n] * wscale + buv[n];
#pragma unroll
                    for (int i = 0; i < 4; ++i) { const float g = fminf(g4[i], 7.0f), uu = fminf(fmaxf(u4[i], -7.0f), 7.0f); y[n][i] = (uu + 1.0f) * (g * sigmoidf_fast(1.702f * g)); } }
                int w0 = __builtin_amdgcn_cvt_pk_fp8_f32(y[0][0], y[0][1], 0, false); w0 = __builtin_amdgcn_cvt_pk_fp8_f32(y[0][2], y[0][3], w0, true);
                int w1 = __builtin_amdgcn_cvt_pk_fp8_f32(y[1][0], y[1][1], 0, false); w1 = __builtin_amdgcn_cvt_pk_fp8_f32(y[1][2], y[1][3], w1, true);
                typedef int v2i_t __attribute__((ext_vector_type(2))); *(v2i_t*)rowp = (v2i_t){w0, w1}; }
    }
};
struct MoeOrder {
    const PG8_LAS int* tstart; int npn, lo, hi, rank, W;
    __device__ __forceinline__ void init(const PG8_LAS int* ts, int npn_, int G, int c) { tstart = ts; npn = npn_; const int U = ts[32] * npn_; const int x = c % NXCD; rank = c / NXCD; W = G / NXCD;
        lo = (int)(((long)U * x) / NXCD); hi = (int)(((long)U * (x + 1)) / NXCD); }
    __device__ __forceinline__ bool next(int i, Unit& u) const {
        const int q = lo + rank + W * i; if (q >= hi) return false;
        int e = 0;
#pragma unroll 1
        for (int k = 1; k < 32; ++k) if (tstart[k] * npn <= q) e = k;
        const int ts = tstart[e], te = tstart[e + 1] - ts, qq = q - ts * npn;
        u.pm = ts + qq % te; u.pn = e * npn + qq / te; return true;
    }
    __device__ __forceinline__ void a_ready(const Unit&) const {}
    __device__ __forceinline__ void done(const Unit&) const {}
};
}
namespace att {
using bf16x8 = __attribute__((ext_vector_type(8))) short;
using s16x4  = __attribute__((ext_vector_type(4))) short;
using f32x16 = __attribute__((ext_vector_type(16))) float;
using u32x4  = __attribute__((ext_vector_type(4))) unsigned;
typedef unsigned short bf16;
constexpr int   D = 128, NW = 8, QBLK = 32, KVBLK = 64;
constexpr float SCALE = 0.088388347648318440f;
constexpr float THR = 8.f;
constexpr size_t SHM_V = KVBLK * D * 2, SHM_K = KVBLK * D * 2, SHM_ATTN = 2 * SHM_V + 2 * SHM_K + NW * 64 * 4;
#define KSWZ(row, colB) ((row) * 256 + ((colB) ^ (((row) & 7) << 4)))
#define SBAR() __builtin_amdgcn_sched_barrier(0)
__device__ __forceinline__ int crow(int r, int hi) { return (r & 3) + 8 * (r >> 2) + 4 * hi; }
__device__ __forceinline__ unsigned cvtpk(float lo, float hi) { unsigned r; asm volatile("v_cvt_pk_bf16_f32 %0, %1, %2" : "=v"(r) : "v"(lo), "v"(hi)); return r; }

template <int MODE>
__device__ __forceinline__ void partialSM(f32x16& p0, f32x16& p1, float& m_reg, float& mn, float& alpha, float relb, float kk, bool valid) {
  constexpr float C = SCALE * 1.4426950408889634f;
#pragma unroll
  for (int r = 0; r < 16; ++r) {
    const float d0 = relb - (float)((r & 3) + 8 * (r >> 2)), a0 = __builtin_fabsf(d0), a1 = __builtin_fabsf(d0 - 32.f);
    p0[r] = fmaf(a0, -kk, p0[r]); p1[r] = fmaf(a1, -kk, p1[r]);
    if (MODE == 1) { if (!(valid && a0 <= 64.f)) p0[r] = -INFINITY; if (!(valid && a1 <= 64.f)) p1[r] = -INFINITY; }
  }
  float pmax = p0[0];
#pragma unroll
  for (int r = 1; r < 16; ++r) pmax = fmaxf(pmax, p0[r]);
#pragma unroll
  for (int r = 0; r < 16; ++r) pmax = fmaxf(pmax, p1[r]);
  { auto rr = __builtin_amdgcn_permlane32_swap(__float_as_uint(pmax), __float_as_uint(pmax), false, false);
    pmax = fmaxf(__uint_as_float(rr[0]), __uint_as_float(rr[1])); }
  if (__builtin_expect(__all(pmax - m_reg <= THR / SCALE), 1)) { mn = m_reg; alpha = 1.f; }
  else { mn = fmaxf(m_reg, pmax); alpha = __builtin_amdgcn_exp2f((m_reg - mn) * C); m_reg = mn; }
  const float mnC = -mn * C;
#pragma unroll
  for (int r = 0; r < 16; ++r) p0[r] = fmaf(p0[r], C, mnC);
#pragma unroll
  for (int r = 0; r < 16; ++r) p1[r] = fmaf(p1[r], C, mnC);
#pragma unroll
  for (int r = 0; r < 16; ++r) p0[r] = __builtin_amdgcn_exp2f(p0[r]);
}
__device__ __forceinline__ void finishSM(f32x16& p0, f32x16& p1, float alpha, float& l_reg, bf16x8& pa0, bf16x8& pa1, bf16x8& pa2, bf16x8& pa3) {
#pragma unroll
  for (int r = 0; r < 16; ++r) p1[r] = __builtin_amdgcn_exp2f(p1[r]);
  float ps = 0;
#pragma unroll
  for (int r = 0; r < 16; ++r) ps += p0[r];
#pragma unroll
  for (int r = 0; r < 16; ++r) ps += p1[r];
  { auto rr = __builtin_amdgcn_permlane32_swap(__float_as_uint(ps), __float_as_uint(ps), false, false);
    ps = __uint_as_float(rr[0]) + __uint_as_float(rr[1]); }
  l_reg = l_reg * alpha + ps;
#define PK4(P, BASE, OUT) do { unsigned a0 = cvtpk(P[BASE + 0], P[BASE + 1]), a1 = cvtpk(P[BASE + 2], P[BASE + 3]);   \
    unsigned b0 = cvtpk(P[BASE + 4], P[BASE + 5]), b1 = cvtpk(P[BASE + 6], P[BASE + 7]);                              \
    auto r0 = __builtin_amdgcn_permlane32_swap(a0, b0, false, false); auto r1 = __builtin_amdgcn_permlane32_swap(a1, b1, false, false); \
    u32x4 w = {r0[0], r1[0], r0[1], r1[1]}; OUT = *reinterpret_cast<bf16x8*>(&w); } while (0)
  PK4(p0, 0, pa0); PK4(p0, 8, pa1); PK4(p1, 0, pa2); PK4(p1, 8, pa3);
#undef PK4
}
__device__ __forceinline__ void qkt(f32x16& p0, f32x16& p1, const bf16* Ks, const bf16x8* qr, int r32, int hi) {
  p0 = f32x16{}; p1 = f32x16{};
#pragma unroll
  for (int d0 = 0; d0 < 8; ++d0) { const int cb = (d0 * 16 + hi * 8) * 2;
    bf16x8 b0 = *reinterpret_cast<const bf16x8*>((const char*)Ks + KSWZ(r32, cb));
    bf16x8 b1 = *reinterpret_cast<const bf16x8*>((const char*)Ks + KSWZ(32 + r32, cb));
    p0 = __builtin_amdgcn_mfma_f32_32x32x16_bf16(b0, qr[d0], p0, 0, 0, 0);
    p1 = __builtin_amdgcn_mfma_f32_32x32x16_bf16(b1, qr[d0], p1, 0, 0, 0); }
}
__device__ __forceinline__ int v_st(int k, int c) { const int kk = (k & ~0xC) | ((k & 4) << 1) | ((k & 8) >> 1); return ((kk >> 3) * 4 + (c >> 5)) * 512 + ((kk & 7) * 32 + (c & 31)) * 2; }
__device__ __forceinline__ int v_rd_base(int lane) { return ((lane & 3) << 3) | (((lane >> 2) & 3) << 6) | (((lane >> 4) & 1) << 5) | (((lane >> 5) & 1) << 8); }
constexpr int v_rd_off(int d0, int ks, int half) { return d0 * 512 + ks * 4096 + half * 2048; }
template <int OFF> __device__ __forceinline__ s16x4 tr_read(int vb) {
  s16x4 r; asm volatile("ds_read_b64_tr_b16 %0, %1 offset:%2" : "=&v"(r) : "v"(vb), "i"(OFF) : "memory"); return r;
}
template <int D0> __device__ __forceinline__ void pv_one(f32x16& od, int vb, bf16x8 pa0, bf16x8 pa1, bf16x8 pa2, bf16x8 pa3) {
  const s16x4 l0 = tr_read<v_rd_off(D0, 0, 0)>(vb), h0 = tr_read<v_rd_off(D0, 0, 1)>(vb), l1 = tr_read<v_rd_off(D0, 1, 0)>(vb), h1 = tr_read<v_rd_off(D0, 1, 1)>(vb);
  const s16x4 l2 = tr_read<v_rd_off(D0, 2, 0)>(vb), h2 = tr_read<v_rd_off(D0, 2, 1)>(vb), l3 = tr_read<v_rd_off(D0, 3, 0)>(vb), h3 = tr_read<v_rd_off(D0, 3, 1)>(vb);
  asm volatile("s_waitcnt lgkmcnt(0)" ::: "memory"); SBAR();
#define PK(L, H) (bf16x8){L[0], L[1], L[2], L[3], H[0], H[1], H[2], H[3]}
  od = __builtin_amdgcn_mfma_f32_32x32x16_bf16(pa0, PK(l0, h0), od, 0, 0, 0);
  od = __builtin_amdgcn_mfma_f32_32x32x16_bf16(pa1, PK(l1, h1), od, 0, 0, 0);
  od = __builtin_amdgcn_mfma_f32_32x32x16_bf16(pa2, PK(l2, h2), od, 0, 0, 0);
  od = __builtin_amdgcn_mfma_f32_32x32x16_bf16(pa3, PK(l3, h3), od, 0, 0, 0);
#undef PK
}
__device__ __forceinline__ void pv_d0(f32x16* o, int vb, bf16x8 pa0, bf16x8 pa1, bf16x8 pa2, bf16x8 pa3) {
  pv_one<0>(o[0], vb, pa0, pa1, pa2, pa3); pv_one<1>(o[1], vb, pa0, pa1, pa2, pa3); pv_one<2>(o[2], vb, pa0, pa1, pa2, pa3); pv_one<3>(o[3], vb, pa0, pa1, pa2, pa3);
}

template <int MODE>
__device__ __forceinline__ void attn_body(const bf16* __restrict__ Qb, long ldq, const bf16* __restrict__ Kh, const bf16* __restrict__ Vh, long ldk,
                                          int t0, int NT, int ntmax, int qpos0, float kk, float* __restrict__ Ob, long ldo, float* __restrict__ Lb, long ldl, char* lds) {
  const int tid = threadIdx.x, wid = tid >> 6, lane = tid & 63, r32 = lane & 31, hi = lane >> 5;
  bf16* V_lds = (bf16*)lds; bf16* K_lds = (bf16*)(lds + 2 * SHM_V);
  float* ws = (float*)(lds + 2 * SHM_V + 2 * SHM_K) + wid * 64; float* li_l = ws; float* al_l = ws + 32;
  float m_reg = -1e30f, l_reg = 0; f32x16 o[4] = {}; bf16x8 qr[8];
  const bf16* Qw = Qb + (long)(wid * QBLK + r32) * ldq + hi * 8;
#pragma unroll
  for (int d0 = 0; d0 < 8; ++d0) qr[d0] = *reinterpret_cast<const bf16x8*>(Qw + d0 * 16);
  const int sr = tid >> 4, sc = (tid & 15) * 8, vst0 = v_st(sr, sc), vst1 = v_st(32 + sr, sc);
  const int vb0 = (int)(uintptr_t)V_lds + v_rd_base(lane);
  const unsigned so0 = (unsigned)(sr * (int)ldk + sc), so1 = so0 + 32u * (unsigned)ldk;
  const float qposf = (float)(qpos0 + wid * QBLK + r32 - 4 * hi);
  struct { bf16x8 vs0, vs1, ks0, ks1; } sr_[2];
#define TCL(jt) ({ int _t = t0 + (jt); _t = _t < 0 ? 0 : (_t >= ntmax ? ntmax - 1 : _t); _t * KVBLK; })
#define TVALID(jt) ((t0 + (jt)) >= 0 && (t0 + (jt)) < ntmax)
#define RELB(jt) (qposf - (float)((t0 + (jt)) * KVBLK))
#define SLOAD(i, jt) do { const long _k0 = (long)TCL(jt) * ldk; const bf16* _vp = Vh + _k0; const bf16* _kp = Kh + _k0; \
    sr_[i].vs0 = *reinterpret_cast<const bf16x8*>(_vp + so0); sr_[i].vs1 = *reinterpret_cast<const bf16x8*>(_vp + so1); \
    sr_[i].ks0 = *reinterpret_cast<const bf16x8*>(_kp + so0); sr_[i].ks1 = *reinterpret_cast<const bf16x8*>(_kp + so1); } while (0)
#define SWRITE(b, i) do { *(bf16x8*)((char*)V_lds + (b) * SHM_V + vst0) = sr_[i].vs0;          \
    *(bf16x8*)((char*)V_lds + (b) * SHM_V + vst1) = sr_[i].vs1; const int kc = sc * 2;               \
    *(bf16x8*)((char*)K_lds + (b) * SHM_K + KSWZ(sr, kc)) = sr_[i].ks0;                       \
    *(bf16x8*)((char*)K_lds + (b) * SHM_K + KSWZ(32 + sr, kc)) = sr_[i].ks1; } while (0)
#define SWAIT() asm volatile("s_waitcnt vmcnt(4)" ::: "memory")
#define RESC(a) do { if (__any((a) < 1.f)) { if (hi == 0) al_l[r32] = (a); asm volatile("s_waitcnt lgkmcnt(0)" ::: "memory"); \
    _Pragma("unroll") for (int d = 0; d < 4; ++d) _Pragma("unroll") for (int r = 0; r < 16; ++r) o[d][r] *= al_l[crow(r, hi)]; } } while (0)
  f32x16 pA0, pA1, pB0, pB1; float mnA, mnB, alA, alB; bf16x8 pa0, pa1, pa2, pa3;
  constexpr int SE = 0, SO = 1;
  SLOAD(SE, 0); asm volatile("s_waitcnt vmcnt(0)" ::: "memory"); SWRITE(0, SE); __syncthreads();
  qkt(pA0, pA1, K_lds, qr, r32, hi); partialSM<MODE>(pA0, pA1, m_reg, mnA, alA, RELB(0), kk, TVALID(0));
  SLOAD(SO, 1); if (2 < NT) SLOAD(SE, 2);
  SWAIT(); SWRITE(1, SO); __syncthreads();
  for (int j = 1; j + 1 < NT; j += 2) {
    SBAR(); qkt(pB0, pB1, (bf16*)((char*)K_lds + SHM_K), qr, r32, hi);
    finishSM(pA0, pA1, alA, l_reg, pa0, pa1, pa2, pa3); SBAR();
    SLOAD(SO, j + 2); SBAR();
    pv_d0(o, vb0, pa0, pa1, pa2, pa3); partialSM<MODE>(pB0, pB1, m_reg, mnB, alB, RELB(j), kk, TVALID(j));
    __syncthreads(); SWAIT(); SWRITE(0, SE);
    RESC(alB); __syncthreads();
    SBAR(); qkt(pA0, pA1, K_lds, qr, r32, hi);
    finishSM(pB0, pB1, alB, l_reg, pa0, pa1, pa2, pa3); SBAR();
    if (j + 3 < NT) SLOAD(SE, j + 3); SBAR();
    pv_d0(o, vb0 + (int)SHM_V, pa0, pa1, pa2, pa3); partialSM<MODE>(pA0, pA1, m_reg, mnA, alA, RELB(j + 1), kk, TVALID(j + 1));
    __syncthreads(); SWAIT(); SWRITE(1, SO);
    RESC(alA); __syncthreads();
  }
  SBAR(); qkt(pB0, pB1, (bf16*)((char*)K_lds + SHM_K), qr, r32, hi);
  finishSM(pA0, pA1, alA, l_reg, pa0, pa1, pa2, pa3); SBAR();
  pv_d0(o, vb0, pa0, pa1, pa2, pa3); partialSM<MODE>(pB0, pB1, m_reg, mnB, alB, RELB(NT - 1), kk, TVALID(NT - 1));
  __syncthreads(); RESC(alB);
  finishSM(pB0, pB1, alB, l_reg, pa0, pa1, pa2, pa3); SBAR();
  pv_d0(o, vb0 + (int)SHM_V, pa0, pa1, pa2, pa3);
  if (hi == 0) li_l[r32] = l_reg; asm volatile("s_waitcnt lgkmcnt(0)" ::: "memory");
  float rli[16];
#pragma unroll
  for (int r = 0; r < 16; ++r) rli[r] = __builtin_amdgcn_rcpf(li_l[crow(r, hi)]);
  int hie = hi; asm volatile("" : "+v"(hie));
  float* Ow = Ob + (long)(wid * QBLK + 4 * hie) * ldo + r32;
#pragma unroll
  for (int r = 0; r < 16; ++r) { float* Or = Ow + (long)((r & 3) + 8 * (r >> 2)) * ldo;
#pragma unroll
    for (int d0 = 0; d0 < 4; ++d0) Or[d0 * 32] = o[d0][r] * rli[r]; }
  if (Lb != nullptr && hi == 0) Lb[(long)(wid * QBLK + r32) * ldl] = m_reg * SCALE + __logf(l_reg);
  __syncthreads();
#undef TCL
#undef TVALID
#undef RELB
#undef SLOAD
#undef SWRITE
#undef SWAIT
#undef RESC
}
#undef KSWZ
#undef SBAR
}
constexpr int NWAVES = 8;
#ifndef MK_SPLIT
#define MK_SPLIT 0
#endif
#ifndef DBG_ORACLE
#define DBG_ORACLE 0
#endif
constexpr int N_PHASES = 12;

constexpr int DM = 2048, BATCH = 2, SEQ = 4096, T = BATCH * SEQ;
constexpr int NQKV = 10240;
constexpr int C_QA = 0, C_KA = 1024, C_VA = 2048, C_QB = 3072, C_KB = 4096, C_VB = 5120, C_GA = 6144, C_GB = 8192;
constexpr int NE = 32, TOPK = 4, TK = T * TOPK, TKPAD = TK + NE * 256;
constexpr float EPS = 1e-5f;
constexpr float LAMBDA_INIT = 0.2f;

constexpr size_t MiB = 1u << 20;
constexpr size_t WS_CTL = 0, CTL_ZERO_BYTES = 1 * MiB;
constexpr size_t WS_MOD = 1 * MiB;
constexpr size_t WS_RC = 1 * MiB + 512 * 1024;
constexpr size_t WS_TOPI = 2 * MiB;
constexpr size_t WS_TOPP = 2 * MiB + 256 * 1024;
constexpr size_t WS_POS = 2 * MiB + 512 * 1024;
constexpr size_t WS_ERR = 3 * MiB;
constexpr size_t WS_WINT = 4 * MiB;
constexpr size_t WS_WAT = 44 * MiB;
constexpr size_t WS_WBT = 48 * MiB;
constexpr size_t WS_WOT = 52 * MiB;
constexpr size_t WS_U = 64 * MiB;
constexpr size_t WS_QKV = 96 * MiB;
constexpr size_t WS_OA = 256 * MiB;
constexpr size_t WS_OB = 352 * MiB;
constexpr size_t WS_LSE = 416 * MiB;
constexpr size_t WS_YA = 418 * MiB;
constexpr size_t WS_YB = 434 * MiB;
constexpr size_t WS_M1 = 450 * MiB;
constexpr size_t WS_MG = 514 * MiB;
constexpr size_t WS_H1 = 546 * MiB;
constexpr size_t WS_XS = 610 * MiB;
constexpr size_t WS_YACT = 770 * MiB;
constexpr size_t WS_YSLOT = 930 * MiB;
constexpr size_t WS_WGU = 1090 * MiB;
constexpr size_t WS_WD = 1602 * MiB;
constexpr size_t WS_END = 1858 * MiB;
constexpr int CW_TMO = 0, CW_CODE = 1;
constexpr int CW_BAR = 4096;
constexpr int CW_CNT = 8192;

constexpr int RING_OFF = 0, RING_BYTES = 131072;
constexpr int LDSCTL_OFF = RING_BYTES, MISC_OFF = LDSCTL_OFF + 320;
constexpr int TST_OFF = LDSCTL_OFF + 1024;
constexpr int LDS_BYTES = 147456;

#define GAS __attribute__((address_space(1)))
#define LAS __attribute__((address_space(3)))
typedef unsigned short bf16;
typedef unsigned v4u __attribute__((ext_vector_type(4)));
typedef unsigned v2u __attribute__((ext_vector_type(2)));
typedef float f32x4 __attribute__((ext_vector_type(4)));
typedef GAS unsigned gu32;
#define RLX_AGENT __ATOMIC_RELAXED, __HIP_MEMORY_SCOPE_AGENT
#define LDS_WAIT() asm volatile("s_waitcnt lgkmcnt(0)" ::: "memory")
#define VM_WAIT() asm volatile("s_waitcnt vmcnt(0)" ::: "memory")
__device__ __forceinline__ unsigned f2bf(float f) { unsigned u = __builtin_bit_cast(unsigned, f); return (u + 0x7fffu + ((u >> 16) & 1u)) >> 16; }
__device__ __forceinline__ unsigned pk2(float lo, float hi) { return f2bf(lo) | (f2bf(hi) << 16); }
__device__ __forceinline__ float bf2f(unsigned short h) { return __uint_as_float(((unsigned)h) << 16); }
__device__ __forceinline__ float wave_sum(float v) {
#pragma unroll
    for (int o = 1; o < 64; o <<= 1) v += __shfl_xor(v, o);
    return v;
}
__device__ __forceinline__ float wave_max(float v) {
#pragma unroll
    for (int o = 1; o < 64; o <<= 1) v = fmaxf(v, __shfl_xor(v, o));
    return v;
}
__device__ __forceinline__ float siluf(float x) { return x / (1.0f + __expf(-x)); }
#define XB_TMO      128
#define XB_XCNT(j)  (256  + 64 * (j))
#define XB_XSUB(j)  (1280 + 64 * (j))
#define XB_XGEN(j)  (2304 + 64 * (j))
#define XB_TOP      3328
#define XB_TOPGEN   3392
#define XCD_BAR_WORDS 3456
#define XB_SPIN_CAP (1u << 18)

__device__ __forceinline__ unsigned xb_ld(unsigned* p)              { return __hip_atomic_load(p, __ATOMIC_RELAXED, __HIP_MEMORY_SCOPE_AGENT); }
__device__ __forceinline__ unsigned xb_add(unsigned* p, unsigned v) { return __hip_atomic_fetch_add(p, v, __ATOMIC_RELAXED, __HIP_MEMORY_SCOPE_AGENT); }
__device__ __forceinline__ unsigned xb_xcc_id() { return (unsigned)__builtin_amdgcn_s_getreg((3 << 11) | 20) & 0xFu; }
#define XB_SPIN(cond, bar) do { unsigned _sp = 0; while (cond) { __builtin_amdgcn_s_sleep(1); \
    if ((++_sp & 255u) == 0u) { if (xb_ld(&(bar)[XB_TMO])) break; if (_sp > XB_SPIN_CAP) { atomicAdd(&(bar)[XB_TMO], 1u); break; } } } } while (0)

struct XcdBarrier {
    unsigned* bar; unsigned x;
    volatile LAS unsigned* st;
};

__device__ __forceinline__ XcdBarrier xcd_barrier_post(unsigned* bar, volatile LAS unsigned* st) {
    XcdBarrier b; b.bar = bar; b.x = xb_xcc_id(); b.st = st;
    if (threadIdx.x == 0) (void)xb_add(&bar[XB_XCNT(b.x)], 1u);
    return b;
}
__device__ __forceinline__ void xcd_barrier_complete(unsigned* bar, unsigned x, unsigned& nloc, unsigned& nx) {
    const unsigned G = gridDim.x * gridDim.y * gridDim.z;
    unsigned sum, cnt, mine, sp = 0u;
    for (;;) {
        sum = 0u; cnt = 0u; mine = 0u;
#pragma unroll
        for (unsigned j = 0; j < 16; ++j) { const unsigned c = xb_ld(&bar[XB_XCNT(j)]); sum += c; cnt += (c > 0u) ? 1u : 0u; mine = (j == x) ? c : mine; }
        if (sum == G) break;
        __builtin_amdgcn_s_sleep(1);
        if ((++sp & 255u) == 0u) { if (xb_ld(&bar[XB_TMO])) break; if (sp > XB_SPIN_CAP) { atomicAdd(&bar[XB_TMO], 1u); break; } }
    }
    nloc = mine > 0u ? mine : 1u; nx = cnt > 0u ? cnt : 1u;
}

__device__ __forceinline__ void xcd_barrier(const XcdBarrier& b) {
    asm volatile("s_waitcnt vmcnt(0)" ::: "memory");
    __syncthreads();
    if (threadIdx.x == 0) {
        unsigned* bar = b.bar;
        __builtin_amdgcn_s_waitcnt(0);
        unsigned nloc = b.st[0], nx = b.st[1];
        if (nloc == 0u) { xcd_barrier_complete(bar, b.x, nloc, nx); b.st[0] = nloc; b.st[1] = nx; }
        const unsigned old = xb_add(&bar[XB_XSUB(b.x)], 1u);
        const unsigned gen = old / nloc;
        if (old + 1u == (gen + 1u) * nloc) {
            __builtin_amdgcn_fence(__ATOMIC_RELEASE, "agent");
            asm volatile("s_waitcnt vmcnt(0)" ::: "memory");
            const unsigned og = xb_add(&bar[XB_TOP], 1u);
            const unsigned tg = og / nx;
            if (og + 1u == (tg + 1u) * nx) xb_add(&bar[XB_TOPGEN], 1u);
            else XB_SPIN(xb_ld(&bar[XB_TOPGEN]) == tg, bar);
            __builtin_amdgcn_fence(__ATOMIC_ACQUIRE, "agent");
            xb_add(&bar[XB_XGEN(b.x)], 1u);
            asm volatile("s_waitcnt vmcnt(0)" ::: "memory");
        } else {
            XB_SPIN(xb_ld(&bar[XB_XGEN(b.x)]) == gen, bar);
            __builtin_amdgcn_fence(__ATOMIC_ACQUIRE, "agent");
            asm volatile("s_waitcnt vmcnt(0)" ::: "memory");
        }
    }
    __syncthreads();
}
struct Args { const float* in[24]; float* out; unsigned char* ws; int ph_lo, ph_hi; };
enum { I_X = 0, I_C, I_WADA, I_BADA, I_N1G, I_WIN, I_LQ1, I_LK1, I_LQ2, I_LK2, I_SUBG, I_WOA, I_WOB, I_WO, I_N2G, I_WR, I_BR, I_WG, I_BG, I_WU, I_BU, I_WDN, I_BDN, I_FG };
struct Frame {
    LAS unsigned char* lds; char* ldsg;
    volatile LAS unsigned* MISC;
    gu32* ctl;
    int tid, lane, wave, vcu, G;
    unsigned char* ws;
};
#define WSP(T_, off) ((T_*)(F.ws + (off)))

constexpr float WSCALE = 64.0f;
__device__ __forceinline__ unsigned cvtpk_bf(float lo, float hi) { unsigned r; asm volatile("v_cvt_pk_bf16_f32 %0, %1, %2" : "=v"(r) : "v"(lo), "v"(hi)); return r; }
__device__ __forceinline__ void cvt_load(f32x4 (&v)[8], const float* __restrict__ W, int N, int k0, int n0, int lane) {
    const int lr = lane >> 3, lc = 4 * (lane & 7);
#pragma unroll
    for (int i = 0; i < 8; ++i) v[i] = __builtin_nontemporal_load((const f32x4*)(W + (size_t)(k0 + lr + 8 * i) * N + n0 + lc));
}
template <bool F8>
__device__ __forceinline__ void cvt_store(const f32x4 (&v)[8], int K, void* __restrict__ WT, int k0, long dst_row0, LAS float* scr, int lane) {
    const int lr = lane >> 3, lc = 4 * (lane & 7);
#pragma unroll
    for (int i = 0; i < 8; ++i) { LAS float* s = scr + (lr + 8 * i) * 33 + lc; s[0] = v[i].x; s[1] = v[i].y; s[2] = v[i].z; s[3] = v[i].w; }
    LDS_WAIT(); asm volatile("" ::: "memory");
    const int c = lane & 7;
#pragma unroll
    for (int j = 0; j < 4; ++j) { const int n = (lane >> 3) + 8 * j; const LAS float* s = scr + (8 * c) * 33 + n;
        if constexpr (F8) {
            int w0 = __builtin_amdgcn_cvt_pk_fp8_f32(s[0 * 33] * WSCALE, s[1 * 33] * WSCALE, 0, false); w0 = __builtin_amdgcn_cvt_pk_fp8_f32(s[2 * 33] * WSCALE, s[3 * 33] * WSCALE, w0, true);
            int w1 = __builtin_amdgcn_cvt_pk_fp8_f32(s[4 * 33] * WSCALE, s[5 * 33] * WSCALE, 0, false); w1 = __builtin_amdgcn_cvt_pk_fp8_f32(s[6 * 33] * WSCALE, s[7 * 33] * WSCALE, w1, true);
            *(v2u*)((unsigned char*)WT + (size_t)(dst_row0 + n) * K + k0 + 8 * c) = (v2u){(unsigned)w0, (unsigned)w1};
        } else {
            v4u o; o.x = cvtpk_bf(s[0 * 33], s[1 * 33]); o.y = cvtpk_bf(s[2 * 33], s[3 * 33]); o.z = cvtpk_bf(s[4 * 33], s[5 * 33]); o.w = cvtpk_bf(s[6 * 33], s[7 * 33]);
            *(v4u*)((bf16*)WT + (size_t)(dst_row0 + n) * K + k0 + 8 * c) = o; } }
    LDS_WAIT(); asm volatile("" ::: "memory");
}
struct CvtItem { const float* W; void* WT; int N, K, k0, n0; long dst_row0; bool f8; };
__device__ __forceinline__ void p0_prologue(Frame& F, const Args& A) {
    LAS float* red = (LAS float*)F.lds;
    if (F.vcu < 192) {
        const int col = F.vcu * 64 + F.lane, k0 = F.wave * 256;
        const float* wp = A.in[I_WADA] + (size_t)k0 * 12288 + col; const float* cp = A.in[I_C];
        float a0 = 0.f, a1 = 0.f;
#pragma unroll 8
        for (int k = 0; k < 256; ++k) { const float wv = wp[(size_t)k * 12288]; a0 = fmaf(siluf(cp[k0 + k]), wv, a0); a1 = fmaf(siluf(cp[2048 + k0 + k]), wv, a1); }
        red[(F.wave * 2 + 0) * 64 + F.lane] = a0; red[(F.wave * 2 + 1) * 64 + F.lane] = a1;
    }
    __syncthreads();
    if (F.vcu < 192 && F.tid < 128) { const int b = F.tid >> 6, l = F.tid & 63; float s = 0.f;
#pragma unroll
        for (int w = 0; w < 8; ++w) s += red[(w * 2 + b) * 64 + l];
        const int col = F.vcu * 64 + l; WSP(float, WS_MOD)[b * 12288 + col] = s + A.in[I_BADA][col]; }
    __syncthreads();
    LAS float* scr = (LAS float*)(F.lds + F.wave * 16384);
    const int gw = F.vcu * NWAVES + F.wave, NGW = F.G * NWAVES;
    constexpr int I_IN = 32 * 320, I_A = 16 * 64, I_B = 16 * 64, I_O = 32 * 64, I_E = 32 * 64, NITEMS = I_IN + I_A + I_B + I_O + 96 * I_E;
    auto decode = [&](int it) -> CvtItem {
        int r = it; CvtItem c; c.f8 = false;
        if (r < I_IN) { c.W = A.in[I_WIN]; c.WT = WSP(bf16, WS_WINT); c.N = NQKV; c.K = DM; c.k0 = (r / 320) * 64; c.n0 = (r % 320) * 32; c.dst_row0 = c.n0; return c; } r -= I_IN;
        if (r < I_A) { c.W = A.in[I_WOA]; c.WT = WSP(bf16, WS_WAT); c.N = DM; c.K = 1024; c.k0 = (r / 64) * 64; c.n0 = (r % 64) * 32; c.dst_row0 = c.n0; return c; } r -= I_A;
        if (r < I_B) { c.W = A.in[I_WOB]; c.WT = WSP(bf16, WS_WBT); c.N = DM; c.K = 1024; c.k0 = (r / 64) * 64; c.n0 = (r % 64) * 32; c.dst_row0 = c.n0; return c; } r -= I_B;
        if (r < I_O) { c.W = A.in[I_WO]; c.WT = WSP(bf16, WS_WOT); c.N = DM; c.K = DM; c.k0 = (r / 64) * 64; c.n0 = (r % 64) * 32; c.dst_row0 = c.n0; return c; } r -= I_O;
        const int m = r / I_E, rr = r % I_E, e = m / 3, which = m % 3; const size_t wo = (size_t)e * DM * DM;
        c.f8 = true; c.N = DM; c.K = DM; c.k0 = (rr / 64) * 64; c.n0 = (rr % 64) * 32;
        if (which == 0) { c.W = A.in[I_WG] + wo; c.WT = WSP(unsigned char, WS_WGU); c.dst_row0 = (long)e * 4096 + (c.n0 >> 7) * 256 + (c.n0 & 127); }
        else if (which == 1) { c.W = A.in[I_WU] + wo; c.WT = WSP(unsigned char, WS_WGU); c.dst_row0 = (long)e * 4096 + (c.n0 >> 7) * 256 + 128 + (c.n0 & 127); }
        else { c.W = A.in[I_WDN] + wo; c.WT = WSP(unsigned char, WS_WD); c.dst_row0 = (long)e * 2048 + c.n0; }
        return c; };
    f32x4 va[8], vb[8];
    int it = gw;
    if (it < NITEMS) { CvtItem c0 = decode(it); cvt_load(va, c0.W, c0.N, c0.k0, c0.n0, F.lane); }
    for (; it < NITEMS; it += 2 * NGW) {
        const CvtItem ca = decode(it);
        const bool hb = it + NGW < NITEMS; CvtItem cb = ca;
        if (hb) { cb = decode(it + NGW); cvt_load(vb, cb.W, cb.N, cb.k0, cb.n0, F.lane); }
        if (ca.f8) cvt_store<true>(va, ca.K, ca.WT, ca.k0, ca.dst_row0, scr, F.lane); else cvt_store<false>(va, ca.K, ca.WT, ca.k0, ca.dst_row0, scr, F.lane);
        if (it + 2 * NGW < NITEMS) { const CvtItem cn = decode(it + 2 * NGW); cvt_load(va, cn.W, cn.N, cn.k0, cn.n0, F.lane); }
        if (hb) { if (cb.f8) cvt_store<true>(vb, cb.K, cb.WT, cb.k0, cb.dst_row0, scr, F.lane); else cvt_store<false>(vb, cb.K, cb.WT, cb.k0, cb.dst_row0, scr, F.lane); }
    }
}
__device__ __forceinline__ void p1_modulate(Frame& F, const Args& A) {
    const int gw = F.vcu * NWAVES + F.wave, NGW = F.G * NWAVES; const float* MOD = WSP(float, WS_MOD);
    if (gw < 64) { const int b = gw >> 5, e = gw & 31; float s = 0.f;
        for (int k = F.lane; k < DM; k += 64) s = fmaf(MOD[b * 12288 + 3 * DM + k], A.in[I_WR][k * 32 + e], s);
        s = wave_sum(s); if (F.lane == 0) WSP(float, WS_RC)[b * 32 + e] = s + A.in[I_BR][e]; }
    for (int m = gw; m < T; m += NGW) {
        const int b = m / SEQ; const float* xr = A.in[I_X] + (size_t)m * DM + 4 * F.lane; f32x4 v[8]; float s = 0.f;
#pragma unroll
        for (int j = 0; j < 8; ++j) { v[j] = *(const f32x4*)(xr + 256 * j); s += (v[j].x * v[j].x + v[j].y * v[j].y) + (v[j].z * v[j].z + v[j].w * v[j].w); }
        const float rstd = 1.0f / sqrtf(wave_sum(s) * (1.0f / DM) + EPS);
        bf16* ur = WSP(bf16, WS_U) + (size_t)m * DM + 4 * F.lane;
#pragma unroll
        for (int j = 0; j < 8; ++j) { const int k = 4 * F.lane + 256 * j;
            const f32x4 g = *(const f32x4*)(A.in[I_N1G] + k), sc = *(const f32x4*)(MOD + b * 12288 + 1 * DM + k), sh = *(const f32x4*)(MOD + b * 12288 + k);
            const f32x4 u = v[j] * rstd * g * (sc + 1.0f) + sh; v2u o; o.x = pk2(u.x, u.y); o.y = pk2(u.z, u.w); *(v2u*)(ur + 256 * j) = o; }
    }
}
__device__ __forceinline__ void p3_attention(Frame& F, const Args& A) {
    const bf16* QKV = WSP(bf16, WS_QKV);
    for (int i = F.vcu; i < 1280; i += F.G) {
        if (i < 512) {
            const int c2 = i >> 5, b = c2 >> 3, h = (c2 >> 1) & 3, c = c2 & 1, vh = (i >> 4) & 1, qb = i & 15;
            const size_t rowb = (size_t)b * SEQ;
            const bf16* Qb = QKV + (rowb + qb * 256) * NQKV + C_QB + h * 256 + c * 128;
            const bf16* Kh = QKV + rowb * NQKV + C_KB + h * 256 + c * 128;
            const bf16* Vh = QKV + rowb * NQKV + C_VB + h * 256 + vh * 128;
            float* Ob = WSP(float, WS_OB) + ((size_t)c * T + rowb + qb * 256) * 1024 + h * 256 + vh * 128;
            const float slope = exp2f(-(float)(8 + h + 1) * (8.0f / 12.0f));
            att::attn_body<0>(Qb, NQKV, Kh, Vh, NQKV, 0, SEQ / 64, SEQ / 64, qb * 256, slope / att::SCALE, Ob, 1024, nullptr, 0, F.ldsg);
        } else {
            const int j = i - 512, p = j >> 8, r = j & 255, b = r >> 7, h = (r >> 4) & 7, uu = r & 15;
            const int dil = p == 0 ? 1 : (p == 1 ? 4 : 16), L = SEQ / dil, gpr = L / 256, res = uu / gpr, g = uu % gpr;
            const size_t rowb = (size_t)b * SEQ + res;
            const bf16* Qb = QKV + (rowb + (size_t)g * 256 * dil) * NQKV + C_QA + h * 128;
            const bf16* Kh = QKV + rowb * NQKV + C_KA + h * 128;
            const bf16* Vh = QKV + rowb * NQKV + C_VA + h * 128;
            float* Ob = WSP(float, WS_OA) + ((size_t)p * T + rowb + (size_t)g * 256 * dil) * 1024 + h * 128;
            float* Lb = WSP(float, WS_LSE) + ((size_t)p * T + rowb + (size_t)g * 256 * dil) * 8 + h;
            const float slope = exp2f(-(float)(h + 1) * (8.0f / 12.0f)) * (float)dil;
            att::attn_body<1>(Qb, (long)dil * NQKV, Kh, Vh, (long)dil * NQKV, 4 * g - 1, 6, L / 64, g * 256, slope / att::SCALE, Ob, (long)dil * 1024, Lb, (long)dil * 8, F.ldsg);
        }
    }
}
__device__ __forceinline__ void p4_finalize(Frame& F, const Args& A) {
    const int gw = F.vcu * NWAVES + F.wave, NGW = F.G * NWAVES;
    float s1 = A.in[I_LQ1][F.lane] * A.in[I_LK1][F.lane] + A.in[I_LQ1][F.lane + 64] * A.in[I_LK1][F.lane + 64];
    float s2 = A.in[I_LQ2][F.lane] * A.in[I_LK2][F.lane] + A.in[I_LQ2][F.lane + 64] * A.in[I_LK2][F.lane + 64];
    s1 = wave_sum(s1); s2 = wave_sum(s2);
    const float lam = expf(s1) - expf(s2) + LAMBDA_INIT;
    const float* OA = WSP(float, WS_OA); const float* OB = WSP(float, WS_OB); const float* LS = WSP(float, WS_LSE);
    for (int m = gw; m < T; m += NGW) {
        { const int h = F.lane >> 3; const float l0 = LS[((size_t)0 * T + m) * 8 + h], l1 = LS[((size_t)1 * T + m) * 8 + h], l2 = LS[((size_t)2 * T + m) * 8 + h];
          const float mx = fmaxf(l0, fmaxf(l1, l2)); float w0 = __expf(l0 - mx), w1 = __expf(l1 - mx), w2 = __expf(l2 - mx); const float inv = 1.0f / (w0 + w1 + w2); w0 *= inv; w1 *= inv; w2 *= inv;
          const size_t o = (size_t)m * 1024 + 16 * F.lane; unsigned pk[8];
#pragma unroll
          for (int q = 0; q < 4; ++q) { const f32x4 a0 = *(const f32x4*)(OA + o + 4 * q), a1 = *(const f32x4*)(OA + (size_t)T * 1024 + o + 4 * q), a2 = *(const f32x4*)(OA + (size_t)2 * T * 1024 + o + 4 * q);
              const f32x4 y = a0 * w0 + a1 * w1 + a2 * w2; pk[2 * q] = pk2(y.x, y.y); pk[2 * q + 1] = pk2(y.z, y.w); }
          bf16* ya = WSP(bf16, WS_YA) + o; *(v4u*)ya = (v4u){pk[0], pk[1], pk[2], pk[3]}; *(v4u*)(ya + 8) = (v4u){pk[4], pk[5], pk[6], pk[7]}; }
#pragma unroll
        for (int h = 0; h < 4; ++h) { const size_t o = (size_t)m * 1024 + h * 256 + 4 * F.lane;
            const f32x4 v = *(const f32x4*)(OB + o) - *(const f32x4*)(OB + (size_t)T * 1024 + o) * lam;
            const float ss = wave_sum((v.x * v.x + v.y * v.y) + (v.z * v.z + v.w * v.w)); const float rstd = 1.0f / sqrtf(ss * (1.0f / 256.0f) + EPS);
            const f32x4 g = *(const f32x4*)(A.in[I_SUBG] + 4 * F.lane); const f32x4 y = v * rstd * g * (1.0f - LAMBDA_INIT);
            v2u w; w.x = pk2(y.x, y.y); w.y = pk2(y.z, y.w); *(v2u*)(WSP(bf16, WS_YB) + o) = w; }
    }
}
__device__ __forceinline__ void p7_router(Frame& F, const Args& A) {
    LAS float* gainL = (LAS float*)F.lds;
    LAS float* shiftL = gainL + 2048;
    LAS float* part = shiftL + 2048;
    LAS float* ssp = part + 8 * 32 * 64;
    LAS float* logitL = ssp + 512;
    LAS float* rstdL = logitL + 64 * 33;
    LAS int* lcnt = (LAS int*)(rstdL + 64);
    LAS int* lbase = lcnt + 32;
    const float* H1 = WSP(float, WS_H1); const float* MODp = WSP(float, WS_MOD); const float* RC = WSP(float, WS_RC);
    for (int blk = F.vcu; blk < T / 64; blk += F.G) {
        const int t0 = blk * 64, bb = t0 / SEQ; const float* mod = MODp + bb * 12288;
        for (int k = F.tid; k < DM; k += 512) { gainL[k] = A.in[I_N2G][k] * (1.0f + mod[4 * DM + k]); shiftL[k] = mod[3 * DM + k]; }
        if (F.tid < 32) lcnt[F.tid] = 0;
        __syncthreads();
        {
            float acc[32]; float ss = 0.f;
#pragma unroll
            for (int e = 0; e < 32; ++e) acc[e] = 0.f;
            const float* hrow = H1 + (size_t)(t0 + F.lane) * DM + F.wave * 256;
            const float* wr = A.in[I_WR] + (size_t)(F.wave * 256) * 32;
            for (int kk = 0; kk < 256; kk += 4) {
                const f32x4 hv = *(const f32x4*)(hrow + kk); const f32x4 g4 = *(const LAS f32x4*)(gainL + F.wave * 256 + kk);
                ss += (hv.x * hv.x + hv.y * hv.y) + (hv.z * hv.z + hv.w * hv.w);
#pragma unroll
                for (int c = 0; c < 4; ++c) { const float a = hv[c] * g4[c];
#pragma unroll
                    for (int e = 0; e < 32; ++e) acc[e] = fmaf(a, wr[(kk + c) * 32 + e], acc[e]); }
            }
#pragma unroll
            for (int e = 0; e < 32; ++e) part[(F.wave * 32 + e) * 64 + F.lane] = acc[e];
            ssp[F.wave * 64 + F.lane] = ss;
        }
        __syncthreads();
        { const int token = F.tid & 63, eg = F.tid >> 6; float s2 = 0.f;
#pragma unroll
          for (int w = 0; w < 8; ++w) s2 += ssp[w * 64 + token];
          const float rstd = 1.0f / sqrtf(s2 * (1.0f / DM) + EPS);
#pragma unroll
          for (int q = 0; q < 4; ++q) { const int e = eg * 4 + q; float raw = 0.f;
#pragma unroll
              for (int w = 0; w < 8; ++w) raw += part[(w * 32 + e) * 64 + token];
              logitL[token * 33 + e] = rstd * raw + RC[bb * 32 + e]; }
          if (eg == 0) rstdL[token] = rstd; }
        __syncthreads();
        int se[4] = {0, 0, 0, 0}, lp[4] = {0, 0, 0, 0}; float pv[4] = {0.f, 0.f, 0.f, 0.f};
        if (F.tid < 64) {
            float sv[4];
#pragma unroll
            for (int k = 0; k < 4; ++k) { float best = -INFINITY; int bi = 0;
                for (int e = 0; e < 32; ++e) { const float v = logitL[F.tid * 33 + e]; if (v > best) { best = v; bi = e; } }
                sv[k] = best; se[k] = bi; logitL[F.tid * 33 + bi] = -INFINITY; }
            float sum = 0.f;
#pragma unroll
            for (int k = 0; k < 4; ++k) { pv[k] = expf(sv[k] - sv[0]); sum += pv[k]; }
            const float inv = 1.0f / sum;
#pragma unroll
            for (int k = 0; k < 4; ++k) { pv[k] *= inv; lp[k] = __hip_atomic_fetch_add(lcnt + se[k], 1, __ATOMIC_RELAXED, __HIP_MEMORY_SCOPE_WORKGROUP); }
        }
        __syncthreads();
        if (F.tid < 32) lbase[F.tid] = (int)__hip_atomic_fetch_add((unsigned*)(F.ctl + CW_CNT + 64 * F.tid), (unsigned)lcnt[F.tid], RLX_AGENT);
        __syncthreads();
        if (F.tid < 64) { const int m = t0 + F.tid;
#pragma unroll
            for (int k = 0; k < 4; ++k) { WSP(int, WS_TOPI)[m * 4 + k] = se[k]; WSP(float, WS_TOPP)[m * 4 + k] = pv[k]; WSP(int, WS_POS)[m * 4 + k] = lbase[se[k]] + lp[k]; } }
        for (int i = 0; i < 8; ++i) { const int token = F.wave * 8 + i, m = t0 + token; const float rstd = rstdL[token];
            const float* hr = H1 + (size_t)m * DM + 4 * F.lane; unsigned char* ur = WSP(unsigned char, WS_U) + (size_t)m * DM + 4 * F.lane;
#pragma unroll
            for (int j = 0; j < 8; ++j) { const f32x4 h = *(const f32x4*)(hr + 256 * j), g = *(const LAS f32x4*)(gainL + 4 * F.lane + 256 * j), s = *(const LAS f32x4*)(shiftL + 4 * F.lane + 256 * j);
                const f32x4 u = h * rstd * g + s; int w8 = __builtin_amdgcn_cvt_pk_fp8_f32(u.x, u.y, 0, false); w8 = __builtin_amdgcn_cvt_pk_fp8_f32(u.z, u.w, w8, true); *(int*)(ur + 256 * j) = w8; } }
        __syncthreads();
    }
}
__device__ __forceinline__ void build_tile_table(Frame& F) {
    LAS int* ts = (LAS int*)(F.lds + TST_OFF);
    if (F.tid == 0) { int acc = 0;
        for (int e = 0; e < NE; ++e) { ts[e] = acc; acc += ((int)__hip_atomic_load((unsigned*)(F.ctl + CW_CNT + 64 * e), RLX_AGENT) + 255) >> 8; }
        ts[32] = acc; }
    __syncthreads();
}
__device__ __forceinline__ void p8_gather(Frame& F, const Args& A) {
    build_tile_table(F);
    const LAS int* ts = (const LAS int*)(F.lds + TST_OFF);
    const int gw = F.vcu * NWAVES + F.wave, NGW = F.G * NWAVES;
    for (int m = gw; m < T; m += NGW) {
        const v4u* src = (const v4u*)(WSP(unsigned char, WS_U) + (size_t)m * DM); v4u v[2];
#pragma unroll
        for (int q = 0; q < 2; ++q) v[q] = src[F.lane + 64 * q];
#pragma unroll
        for (int k = 0; k < 4; ++k) { const int e = WSP(int, WS_TOPI)[m * 4 + k], pos = WSP(int, WS_POS)[m * 4 + k]; const size_t row = (size_t)ts[e] * 256 + pos;
            v4u* dst = (v4u*)(WSP(unsigned char, WS_XS) + row * DM);
#pragma unroll
            for (int q = 0; q < 2; ++q) dst[F.lane + 64 * q] = v[q]; }
    }
}
__device__ __forceinline__ void p11_final(Frame& F, const Args& A) {
    build_tile_table(F);
    const LAS int* ts = (const LAS int*)(F.lds + TST_OFF);
    const int gw = F.vcu * NWAVES + F.wave, NGW = F.G * NWAVES; const float* MODp = WSP(float, WS_MOD);
    for (int m = gw; m < T; m += NGW) {
        const int bb = m / SEQ; const bf16* yr[4]; float p[4];
#pragma unroll
        for (int k = 0; k < 4; ++k) { const int e = WSP(int, WS_TOPI)[m * 4 + k], pos = WSP(int, WS_POS)[m * 4 + k]; p[k] = WSP(float, WS_TOPP)[m * 4 + k];
            yr[k] = WSP(bf16, WS_YSLOT) + ((size_t)ts[e] * 256 + pos) * DM + 4 * F.lane; }
        const float* hr = WSP(float, WS_H1) + (size_t)m * DM + 4 * F.lane; f32x4 v[8]; float s = 0.f;
#pragma unroll
        for (int j = 0; j < 8; ++j) { f32x4 a = {0.f, 0.f, 0.f, 0.f};
#pragma unroll
            for (int k = 0; k < 4; ++k) { const v2u w = *(const v2u*)(yr[k] + 256 * j); const f32x4 y = {__uint_as_float(w.x << 16), __uint_as_float(w.x & 0xffff0000u), __uint_as_float(w.y << 16), __uint_as_float(w.y & 0xffff0000u)}; a += y * p[k]; }
            const f32x4 g2 = *(const f32x4*)(MODp + bb * 12288 + 5 * DM + 4 * F.lane + 256 * j);
            v[j] = *(const f32x4*)(hr + 256 * j) + g2 * a; s += (v[j].x * v[j].x + v[j].y * v[j].y) + (v[j].z * v[j].z + v[j].w * v[j].w); }
        const float rstd = 1.0f / sqrtf(wave_sum(s) * (1.0f / DM) + EPS);
        float* orow = A.out + (size_t)m * DM + 4 * F.lane;
#pragma unroll
        for (int j = 0; j < 8; ++j) { const f32x4 g = *(const f32x4*)(A.in[I_FG] + 4 * F.lane + 256 * j); *(f32x4*)(orow + 256 * j) = v[j] * rstd * g; }
    }
}

__global__ void __launch_bounds__(NWAVES * 64, 2) fwd(Args args) {
    extern __shared__ __attribute__((aligned(16))) unsigned char lds[];
    Frame F;
    F.lds = (LAS unsigned char*)lds; F.ldsg = (char*)lds;
    F.MISC = (volatile LAS unsigned*)(F.lds + MISC_OFF);
    F.tid = threadIdx.x; F.lane = F.tid & 63; F.wave = __builtin_amdgcn_readfirstlane(F.tid >> 6);
    F.G = gridDim.x; { const int bx = blockIdx.x; F.vcu = (F.G % 8 == 0) ? (bx % 8) * (F.G / 8) + bx / 8 : bx; }
    F.ws = args.ws; F.ctl = (gu32*)(args.ws + WS_CTL);
    for (int u = F.tid; u < (LDS_BYTES - LDSCTL_OFF) / 4; u += NWAVES * 64) ((LAS unsigned*)(F.lds + LDSCTL_OFF))[u] = 0u;
    __syncthreads();
#if MK_SPLIT
#define GRID_BAR() do { } while (0)
#else
    XcdBarrier bar = xcd_barrier_post((unsigned*)(F.ctl + CW_BAR), F.MISC + 8);
#define GRID_BAR() xcd_barrier(bar)
#endif
    const int lo = args.ph_lo, hi = args.ph_hi;
#define IN(k) (lo <= (k) && (k) < hi)
#define SEAM(k) do { if (IN(k) && IN((k) + 1)) GRID_BAR(); } while (0)
    const Args& A = args;
    constexpr bool AL = true, SP = true;

#ifndef REP_PHASE
#define REP_PHASE -1
#endif
#define REPN(k) ((REP_PHASE == (k)) ? 2 : 1)
    if (IN(0)) { for (int rep = 0; rep < REPN(0); ++rep) p0_prologue(F, A); } SEAM(0);
    if (IN(1)) { p1_modulate(F, A); } SEAM(1);
    if (IN(2)) for (int rep = 0; rep < REPN(2); ++rep) {
        pg8::Gemm g{WSP(bf16, WS_U), WSP(bf16, WS_WINT), T, NQKV, DM}; pg8::StaticOrder S; S.init(T, NQKV, F.G, (int)blockIdx.x);
        pg8::EpiQKV E{WSP(bf16, WS_QKV), NQKV, C_GA / 256};
        pg8::gemm_phase<pg8::EpiQKV, pg8::StaticOrder, AL, SP>(F.lds + RING_OFF, g, S, E);
    } SEAM(2);
    if (IN(3)) { for (int rep = 0; rep < REPN(3); ++rep) p3_attention(F, A); } SEAM(3);
    if (IN(4)) { p4_finalize(F, A); } SEAM(4);
    if (IN(5)) {
        { pg8::Gemm g{WSP(bf16, WS_YA), WSP(bf16, WS_WAT), T, DM, 1024}; pg8::StaticOrder S; S.init(T, DM, F.G, (int)blockIdx.x);
          pg8::EpiM1 E{WSP(float, WS_M1), WSP(bf16, WS_QKV) + C_GA, NQKV};
          pg8::gemm_phase<pg8::EpiM1, pg8::StaticOrder, AL, SP>(F.lds + RING_OFF, g, S, E); }
        VM_WAIT(); __syncthreads();
        { pg8::Gemm g{WSP(bf16, WS_YB), WSP(bf16, WS_WBT), T, DM, 1024}; pg8::StaticOrder S; S.init(T, DM, F.G, (int)blockIdx.x);
          pg8::EpiMerged E{WSP(float, WS_M1), WSP(bf16, WS_QKV) + C_GB, NQKV, WSP(bf16, WS_MG)};
          pg8::gemm_phase<pg8::EpiMerged, pg8::StaticOrder, AL, SP>(F.lds + RING_OFF, g, S, E); }
    } SEAM(5);
    if (IN(6)) {
        pg8::Gemm g{WSP(bf16, WS_MG), WSP(bf16, WS_WOT), T, DM, DM}; pg8::StaticOrder S; S.init(T, DM, F.G, (int)blockIdx.x);
        pg8::EpiH1 E{A.in[I_X], WSP(float, WS_H1), WSP(float, WS_MOD) + 2 * DM, 12288, SEQ / 256};
        pg8::gemm_phase<pg8::EpiH1, pg8::StaticOrder, AL, SP>(F.lds + RING_OFF, g, S, E);
    } SEAM(6);
    if (IN(7)) { p7_router(F, A); } SEAM(7);
    if (IN(8)) { p8_gather(F, A); } SEAM(8);
    if (IN(9)) for (int rep = 0; rep < REPN(9); ++rep) {
        build_tile_table(F);
        pg8::Gemm g{WSP(bf16, WS_XS), WSP(bf16, WS_WGU), TKPAD, NE * 4096, DM / 2}; pg8::MoeOrder S; S.init((const LAS int*)(F.lds + TST_OFF), 16, F.G, (int)blockIdx.x);
        pg8::EpiSwiGLU E{WSP(unsigned char, WS_YACT), A.in[I_BG], A.in[I_BU], 1.0f / WSCALE};
        pg8::gemm_phase<pg8::EpiSwiGLU, pg8::MoeOrder, AL, SP, true>(F.lds + RING_OFF, g, S, E);
    } SEAM(9);
    if (IN(10)) for (int rep = 0; rep < REPN(10); ++rep) {
        build_tile_table(F);
        pg8::Gemm g{WSP(bf16, WS_YACT), WSP(bf16, WS_WD), TKPAD, NE * DM, DM / 2}; pg8::MoeOrder S; S.init((const LAS int*)(F.lds + TST_OFF), 8, F.G, (int)blockIdx.x);
        pg8::EpiBf16B E{WSP(bf16, WS_YSLOT), DM, A.in[I_BDN], 8, 1.0f / WSCALE};
        pg8::gemm_phase<pg8::EpiBf16B, pg8::MoeOrder, AL, SP, true>(F.lds + RING_OFF, g, S, E);
    } SEAM(10);
    if (IN(11)) { p11_final(F, A); }
#undef IN
#undef SEAM
}
extern "C" void kernel_launch(void* const* d_in, const int* in_sizes, int n_in, void* d_out, int out_size, void* d_ws, size_t ws_size, hipStream_t stream) {
    static int grid = 0;
    if (grid == 0) {
        if (n_in != 24 || in_sizes[0] != T * DM || out_size != T * DM || ws_size < WS_END) { fprintf(stderr, "kernel_launch: shape mismatch (n_in %d, in0 %d, out %d, ws %zu < %zu); nothing launched\n", n_in, n_in > 0 ? in_sizes[0] : -1, out_size, ws_size, (size_t)WS_END); grid = -1; return; }
        int dev = 0, cus = 0, per_cu = 0;
        if (hipGetDevice(&dev) != hipSuccess || hipDeviceGetAttribute(&cus, hipDeviceAttributeMultiprocessorCount, dev) != hipSuccess) { grid = -1; return; }
        if (hipFuncSetAttribute((const void*)fwd, hipFuncAttributeMaxDynamicSharedMemorySize, LDS_BYTES) != hipSuccess) { fprintf(stderr, "kernel_launch: hipFuncSetAttribute failed\n"); grid = -1; return; }
        if (hipOccupancyMaxActiveBlocksPerMultiprocessor(&per_cu, (const void*)fwd, NWAVES * 64, LDS_BYTES) != hipSuccess || per_cu < 1)
            fprintf(stderr, "kernel_launch: note: occupancy query reports %d workgroups per CU\n", per_cu);
        (void)hipGetLastError();
        grid = cus;
    }
    if (grid < 0) return;
    if (hipMemsetAsync((char*)d_ws + WS_CTL, 0, CTL_ZERO_BYTES, stream) != hipSuccess) return;
    Args a; memset(&a, 0, sizeof(a));
    for (int i = 0; i < 24; ++i) a.in[i] = (const float*)d_in[i];
    a.out = (float*)d_out; a.ws = (unsigned char*)d_ws;
#if MK_SPLIT
    for (int ph = 0; ph < N_PHASES; ++ph) { a.ph_lo = ph; a.ph_hi = ph + 1; hipLaunchKernelGGL(fwd, dim3(grid), dim3(NWAVES * 64), LDS_BYTES, stream, a); }
#else
    a.ph_lo = 0; a.ph_hi = N_PHASES; hipLaunchKernelGGL(fwd, dim3(grid), dim3(NWAVES * 64), LDS_BYTES, stream, a);
#endif
    const hipError_t le = hipPeekAtLastError();
    if (le != hipSuccess) fprintf(stderr, "kernel_launch: launch failed: %s\n", hipGetErrorName(le));
#if DBG_ORACLE
    dbg_launch(a, stream);
#endif
}
```

```cpp
#include <hip/hip_runtime.h>
#include <cstdio>
#include <cstdint>
#include <cstring>
#include <cmath>
namespace pg8 {
#define PG8_LAS __attribute__((address_space(3)))
typedef unsigned short bf16_t;
typedef short bf16x8 __attribute__((ext_vector_type(8)));
typedef float f32x4 __attribute__((ext_vector_type(4)));
typedef unsigned u32x4 __attribute__((ext_vector_type(4)));
constexpr int BM = 256, BK = 64, HALF = 128, HTB = HALF * BK * 2  , STAGE_BYTES = 8 * HTB, NXCD = 8, WGM = 8;

__host__ __device__ __forceinline__ int lds_byte(int r, int c) { const int st = (r >> 4) * 2 + (c >> 5), rr = r & 15, cc = c & 31, ob = rr * 64 + cc * 2; return st * 1024 + (ob ^ (((ob >> 9) & 1) << 5)); }
__host__ __device__ __forceinline__ void stage_rc(int b, int& R, int& C) { const int st = b / 1024, sb = b % 1024, swz = sb ^ (((sb >> 9) & 1) << 5); R = (st >> 1) * 16 + swz / 64; C = (st & 1) * 32 + (swz % 64) / 2; }
__host__ __device__ __forceinline__ int perm32(int rho) { const int n = rho >> 4, i = rho & 15; return 8 * (i >> 2) + 4 * n + (i & 3); }

struct Unit { int pm, pn; };
struct Gemm { const bf16_t* A; const bf16_t* Bt; int M, N, K; };

struct StaticOrder {
    int nM, nN, nwg, G, c;
    __host__ __device__ void init(int M, int N, int G_, int c_) { nM = M / BM; nN = N / BM; nwg = nM * nN; G = G_; c = c_; }
    __host__ __device__ bool next(int i, Unit& u) const {
        const long L = (long)i * G + c; if (L >= nwg) return false;
        int wgid = (int)L; { const int q = nwg / NXCD, r = nwg % NXCD, xcd = wgid % NXCD, off = wgid / NXCD; wgid = (xcd < r ? xcd * (q + 1) : r * (q + 1) + (xcd - r) * q) + off; }
        const int nig = WGM * nN, gid = wgid / nig, fm = gid * WGM, gsz = (nM - fm) < WGM ? (nM - fm) : WGM;
        u.pm = fm + ((wgid % nig) % gsz); u.pn = (wgid % nig) / gsz; return true;
    }
    __device__ __forceinline__ void a_ready(const Unit&) const {}
    __device__ __forceinline__ void done(const Unit&) const {}
};

__device__ __forceinline__ unsigned cvt_pk_bf16(float lo, float hi) { unsigned r; asm volatile("v_cvt_pk_bf16_f32 %0, %1, %2" : "=v"(r) : "v"(lo), "v"(hi)); return r; }

typedef int v4i_t __attribute__((ext_vector_type(4)));
typedef int v8i_t __attribute__((ext_vector_type(8)));
template <class Epi, class Sched, bool ALIGN_EPI = false, bool SP2 = false, bool F8 = false>
__device__ __forceinline__ void gemm_phase(PG8_LAS unsigned char* lds, const Gemm g, const Sched& S, const Epi& E) {
    const int tid = threadIdx.x, wid = __builtin_amdgcn_readfirstlane(tid >> 6), lane = tid & 63, wr = wid >> 2, wc = wid & 3, fr = lane & 15, fq = lane >> 4;
    const int K = g.K, nt = K / BK;
    unsigned voffA[2], voffB[2];
#pragma unroll
    for (int i = 0; i < 2; ++i) { int R, C; stage_rc(tid * 16 + i * 8192, R, C); const int Rb = Epi::PERM ? ((R & ~31) + perm32(R & 31)) : R;
        voffA[i] = (unsigned)(R * K + C) * 2u; voffB[i] = (unsigned)(Rb * K + C) * 2u; }
    const size_t kstep = (size_t)(BK * 2);
    const size_t hstep = (size_t)HALF * K * 2;
    const size_t tstep = 2 * hstep;
    const unsigned ldsw = (unsigned)wid * 1024u;
    const int aoff = lds_byte(wr * 64 + fr, fq * 8), boff = lds_byte(wc * 32 + fr, fq * 8);
#define PG8_SA(b, h) (((b) * 2 + (h)) * HTB)
#define PG8_SB(b, h) ((4 + (b) * 2 + (h)) * HTB)
#define PG8_STAGE(bufoff, gbase, voff) do { _Pragma("unroll") for (int _i = 0; _i < 2; ++_i) \
        __builtin_amdgcn_global_load_lds((const unsigned*)((const char*)(gbase) + (voff)[_i]), (PG8_LAS unsigned*)(lds + (bufoff) + ldsw + _i * 8192), 16, 0, 0); } while (0)
#define PG8_LDA(dst, b, h) do { _Pragma("unroll") for (int m = 0; m < 4; ++m) _Pragma("unroll") for (int k = 0; k < 2; ++k) dst[m][k] = *(const PG8_LAS bf16x8*)(lds + PG8_SA(b, h) + aoff + m * 2048 + k * 1024); } while (0)
#define PG8_LDB(dst, b, h) do { _Pragma("unroll") for (int n = 0; n < 2; ++n) _Pragma("unroll") for (int k = 0; k < 2; ++k) dst[n][k] = *(const PG8_LAS bf16x8*)(lds + PG8_SB(b, h) + boff + n * 2048 + k * 1024); } while (0)
#define PG8_MMA(ai, bj, At, Bt) do { __builtin_amdgcn_s_setprio(1); _Pragma("unroll") for (int m = 0; m < 4; ++m) _Pragma("unroll") for (int n = 0; n < 2; ++n) { \
        if constexpr (F8) { const v8i_t _b = __builtin_shufflevector(__builtin_bit_cast(v4i_t, Bt[n][0]), __builtin_bit_cast(v4i_t, Bt[n][1]), 0, 1, 2, 3, 4, 5, 6, 7); \
            const v8i_t _a = __builtin_shufflevector(__builtin_bit_cast(v4i_t, At[m][0]), __builtin_bit_cast(v4i_t, At[m][1]), 0, 1, 2, 3, 4, 5, 6, 7); \
            asm volatile("v_mfma_scale_f32_16x16x128_f8f6f4 %0, %1, %2, %0, %3, %3 op_sel_hi:[0,0,0]" : "+v"(acc[ai][bj][m][n]) : "v"(_b), "v"(_a), "v"(f8scale)); } \
        else { _Pragma("unroll") for (int k = 0; k < 2; ++k) acc[ai][bj][m][n] = __builtin_amdgcn_mfma_f32_16x16x32_bf16(Bt[n][k], At[m][k], acc[ai][bj][m][n], 0, 0, 0); } } \
        __builtin_amdgcn_s_setprio(0); } while (0)
#define PG8_WAIT_V(n) asm volatile("s_waitcnt vmcnt(" #n ")" ::: "memory")
#define PG8_WAIT_L(n) asm volatile("s_waitcnt lgkmcnt(" #n ")" ::: "memory")
#define PG8_BAR __builtin_amdgcn_s_barrier()
#define PG8_SCHED __builtin_amdgcn_sched_barrier(0)
    Unit cur, nxt; int ui = 0;
    if (!S.next(0, cur)) return;
    const int f8scale = 0x7f7f7f7f;
    f32x4 acc[2][2][4][2];
#pragma unroll
    for (int a = 0; a < 2; ++a)
#pragma unroll
        for (int b = 0; b < 2; ++b)
#pragma unroll
            for (int m = 0; m < 4; ++m)
#pragma unroll
                for (int n = 0; n < 2; ++n) acc[a][b][m][n] = (f32x4){0.f, 0.f, 0.f, 0.f};
    bf16x8 At[4][2], B0[2][2], B1[2][2];
    const char* cA = (const char*)g.A + (size_t)cur.pm * tstep; const char* cB = (const char*)g.Bt + (size_t)cur.pn * tstep;
    S.a_ready(cur);
    if constexpr (SP2) {
        PG8_STAGE(PG8_SB(0, 0), cB, voffB); PG8_STAGE(PG8_SB(0, 1), cB + hstep, voffB); PG8_STAGE(PG8_SA(0, 0), cA, voffA); PG8_STAGE(PG8_SA(0, 1), cA + hstep, voffA);
        if (wr == 1) PG8_BAR;
        PG8_WAIT_V(2); PG8_BAR;
        PG8_STAGE(PG8_SB(1, 0), cB + kstep, voffB); PG8_STAGE(PG8_SA(1, 0), cA + kstep, voffA); PG8_STAGE(PG8_SB(1, 1), cB + hstep + kstep, voffB);
        PG8_WAIT_V(6); PG8_BAR;
    } else {
        PG8_STAGE(PG8_SB(0, 0), cB, voffB); PG8_STAGE(PG8_SA(0, 0), cA, voffA); PG8_STAGE(PG8_SB(0, 1), cB + hstep, voffB); PG8_STAGE(PG8_SA(0, 1), cA + hstep, voffA);
        if (wr == 1) PG8_BAR;
        PG8_WAIT_V(4); PG8_BAR;
        PG8_STAGE(PG8_SB(1, 0), cB + kstep, voffB); PG8_STAGE(PG8_SA(1, 0), cA + kstep, voffA); PG8_STAGE(PG8_SB(1, 1), cB + hstep + kstep, voffB);
        PG8_WAIT_V(6); PG8_BAR;
    }
    for (;;) {
        const bool has_next = S.next(ui + 1, nxt);
        const char* nA = has_next ? (const char*)g.A + (size_t)nxt.pm * tstep : cA; const char* nB = has_next ? (const char*)g.Bt + (size_t)nxt.pn * tstep : cB;
        for (int t = 0; t < nt; t += 2) {
            const bool last = (t == nt - 2);
            const char* a1 = cA + (size_t)(t + 1) * kstep;
            const char* a2 = last ? nA : cA + (size_t)(t + 2) * kstep; const char* b2 = last ? nB : cB + (size_t)(t + 2) * kstep;
            const char* a3 = a2 + kstep; const char* b3 = b2 + kstep;
            if (last && has_next) S.a_ready(nxt);
            if constexpr (SP2) {
            PG8_LDB(B0, 0, 0); PG8_LDB(B1, 0, 1); PG8_SCHED; PG8_LDA(At, 0, 0); PG8_STAGE(PG8_SA(1, 1), a1 + hstep, voffA);
            PG8_WAIT_V(8); PG8_WAIT_L(0); PG8_BAR; PG8_MMA(0, 0, At, B0); PG8_MMA(0, 1, At, B1); PG8_BAR; PG8_SCHED;
            PG8_LDA(At, 0, 1); PG8_STAGE(PG8_SB(0, 0), b2, voffB); PG8_STAGE(PG8_SB(0, 1), b2 + hstep, voffB); PG8_STAGE(PG8_SA(0, 0), a2, voffA);
            PG8_WAIT_V(8); PG8_WAIT_L(0); PG8_BAR; PG8_MMA(1, 0, At, B0); PG8_MMA(1, 1, At, B1); PG8_BAR; PG8_SCHED;
            PG8_LDB(B0, 1, 0); PG8_LDB(B1, 1, 1); PG8_SCHED; PG8_LDA(At, 1, 0); PG8_STAGE(PG8_SA(0, 1), a2 + hstep, voffA);
            PG8_WAIT_V(8); PG8_WAIT_L(0); PG8_BAR; PG8_MMA(0, 0, At, B0); PG8_MMA(0, 1, At, B1); PG8_BAR; PG8_SCHED;
            PG8_LDA(At, 1, 1); PG8_STAGE(PG8_SB(1, 0), b3, voffB); PG8_STAGE(PG8_SB(1, 1), b3 + hstep, voffB); PG8_STAGE(PG8_SA(1, 0), a3, voffA);
            PG8_WAIT_V(8); PG8_WAIT_L(0); PG8_BAR; PG8_MMA(1, 0, At, B0); PG8_MMA(1, 1, At, B1); PG8_BAR; PG8_SCHED;
            } else {
            PG8_LDB(B0, 0, 0); PG8_SCHED; PG8_LDA(At, 0, 0); PG8_STAGE(PG8_SA(1, 1), a1 + hstep, voffA);
            PG8_WAIT_L(8); PG8_BAR; PG8_WAIT_L(0); PG8_MMA(0, 0, At, B0); PG8_BAR; PG8_SCHED;
            PG8_LDB(B1, 0, 1); PG8_STAGE(PG8_SB(0, 0), b2, voffB);
            PG8_BAR; PG8_WAIT_L(0); PG8_MMA(0, 1, At, B1); PG8_BAR;
            PG8_LDA(At, 0, 1); PG8_STAGE(PG8_SA(0, 0), a2, voffA);
            PG8_BAR; PG8_WAIT_L(0); PG8_MMA(1, 0, At, B0); PG8_BAR; PG8_SCHED;
            PG8_STAGE(PG8_SB(0, 1), b2 + hstep, voffB);
            PG8_WAIT_V(6); PG8_BAR; PG8_MMA(1, 1, At, B1); PG8_BAR;
            PG8_LDB(B0, 1, 0); PG8_SCHED; PG8_LDA(At, 1, 0); PG8_STAGE(PG8_SA(0, 1), a2 + hstep, voffA);
            PG8_WAIT_L(8); PG8_BAR; PG8_WAIT_L(0); PG8_MMA(0, 0, At, B0); PG8_BAR; PG8_SCHED;
            PG8_LDB(B1, 1, 1); PG8_STAGE(PG8_SB(1, 0), b3, voffB);
            PG8_BAR; PG8_WAIT_L(0); PG8_MMA(0, 1, At, B1); PG8_BAR;
            PG8_LDA(At, 1, 1); PG8_STAGE(PG8_SA(1, 0), a3, voffA);
            PG8_BAR; PG8_WAIT_L(0); PG8_MMA(1, 0, At, B0); PG8_BAR; PG8_SCHED;
            PG8_STAGE(PG8_SB(1, 1), b3 + hstep, voffB);
            PG8_WAIT_V(6); PG8_BAR; PG8_MMA(1, 1, At, B1); PG8_BAR;
            }
        }
        if constexpr (F8) asm volatile("s_nop 15\n\ts_nop 7" ::: "memory");
        if constexpr (ALIGN_EPI) { if (wr == 0) PG8_BAR; }
        if constexpr (!Epi::AFTER_DRAIN) { E(acc, cur, wr, wc, fr, fq); S.done(cur); }
        if (!has_next) break;
#pragma unroll
        for (int a = 0; a < 2; ++a)
#pragma unroll
            for (int b = 0; b < 2; ++b)
#pragma unroll
                for (int m = 0; m < 4; ++m)
#pragma unroll
                    for (int n = 0; n < 2; ++n) acc[a][b][m][n] = (f32x4){0.f, 0.f, 0.f, 0.f};
        cur = nxt; cA = nA; cB = nB; ++ui;
        if constexpr (ALIGN_EPI) { if (wr == 1) PG8_BAR; }
    }
    PG8_WAIT_V(0);
    if constexpr (!ALIGN_EPI) { if (wr == 0) PG8_BAR; }
    PG8_BAR;
    if constexpr (Epi::AFTER_DRAIN) { E.fused(acc, cur, wr, wc, fr, fq, lds, wid, lane); S.done(cur); }
#undef PG8_SA
#undef PG8_SB
#undef PG8_STAGE
#undef PG8_LDA
#undef PG8_LDB
#undef PG8_MMA
#undef PG8_WAIT_V
#undef PG8_WAIT_L
#undef PG8_BAR
#undef PG8_SCHED
}
}
namespace pg8 {
typedef float f32x2e __attribute__((ext_vector_type(2)));
__device__ __forceinline__ float bf_lo(unsigned w) { return __uint_as_float(w << 16); }
__device__ __forceinline__ float bf_hi(unsigned w) { return __uint_as_float(w & 0xffff0000u); }
__device__ __forceinline__ float sigmoidf_fast(float x) { return __builtin_amdgcn_rcpf(1.0f + __expf(-x)); }

struct EpiBf16B {
    static constexpr bool PERM = true, AFTER_DRAIN = false;
    bf16_t* O; int ldc; const float* bias; int ntile_mod; float scale;
    __device__ __forceinline__ void operator()(const f32x4 (&acc)[2][2][4][2], const Unit& u, int wr, int wc, int fr, int fq) const {
        const int row0 = u.pm * BM + wr * 64 + fr; const int colt = (u.pn % ntile_mod) * BM;
        const int col0 = colt + wc * 32 + 8 * fq, bcol0 = u.pn * BM + wc * 32 + 8 * fq;
        f32x4 bv[2][2];
#pragma unroll
        for (int bj = 0; bj < 2; ++bj)
#pragma unroll
            for (int n = 0; n < 2; ++n) bv[bj][n] = bias ? *(const f32x4*)(bias + bcol0 + bj * HALF + 4 * n) : (f32x4){0.f, 0.f, 0.f, 0.f};
#pragma unroll
        for (int ai = 0; ai < 2; ++ai)
#pragma unroll
            for (int m = 0; m < 4; ++m) { bf16_t* rowp = O + (size_t)(row0 + ai * HALF + m * 16) * ldc + col0;
#pragma unroll
                for (int bj = 0; bj < 2; ++bj) { const f32x4 v0 = acc[ai][bj][m][0] * scale + bv[bj][0], v1 = acc[ai][bj][m][1] * scale + bv[bj][1];
                    u32x4 w; w.x = cvt_pk_bf16(v0[0], v0[1]); w.y = cvt_pk_bf16(v0[2], v0[3]); w.z = cvt_pk_bf16(v1[0], v1[1]); w.w = cvt_pk_bf16(v1[2], v1[3]);
                    *(u32x4*)(rowp + bj * HALF) = w; } }
    }
};
struct EpiQKV {
    static constexpr bool PERM = true, AFTER_DRAIN = false;
    bf16_t* O; int ldc; int sig_tile0;
    __device__ __forceinline__ void operator()(const f32x4 (&acc)[2][2][4][2], const Unit& u, int wr, int wc, int fr, int fq) const {
        const int row0 = u.pm * BM + wr * 64 + fr; const int col0 = u.pn * BM + wc * 32 + 8 * fq; const bool sg = u.pn >= sig_tile0;
#pragma unroll
        for (int ai = 0; ai < 2; ++ai)
#pragma unroll
            for (int m = 0; m < 4; ++m) { bf16_t* rowp = O + (size_t)(row0 + ai * HALF + m * 16) * ldc + col0;
#pragma unroll
                for (int bj = 0; bj < 2; ++bj) { f32x4 v0 = acc[ai][bj][m][0], v1 = acc[ai][bj][m][1];
                    if (sg) {
#pragma unroll
                        for (int i = 0; i < 4; ++i) { v0[i] = sigmoidf_fast(v0[i]); v1[i] = sigmoidf_fast(v1[i]); } }
                    u32x4 w; w.x = cvt_pk_bf16(v0[0], v0[1]); w.y = cvt_pk_bf16(v0[2], v0[3]); w.z = cvt_pk_bf16(v1[0], v1[1]); w.w = cvt_pk_bf16(v1[2], v1[3]);
                    *(u32x4*)(rowp + bj * HALF) = w; } }
    }
};
struct EpiM1 {
    static constexpr bool PERM = true, AFTER_DRAIN = false;
    float* M1; const bf16_t* G; int ldg;
    __device__ __forceinline__ void operator()(const f32x4 (&acc)[2][2][4][2], const Unit& u, int wr, int wc, int fr, int fq) const {
        const int row0 = u.pm * BM + wr * 64 + fr; const int col0 = u.pn * BM + wc * 32 + 8 * fq;
#pragma unroll
        for (int ai = 0; ai < 2; ++ai)
#pragma unroll
            for (int m = 0; m < 4; ++m) { const size_t row = (size_t)(row0 + ai * HALF + m * 16);
#pragma unroll
                for (int bj = 0; bj < 2; ++bj) { const int col = col0 + bj * HALF; const u32x4 g = *(const u32x4*)(G + row * ldg + col);
                    const f32x4 a0 = acc[ai][bj][m][0], a1 = acc[ai][bj][m][1];
                    const f32x4 o0 = {a0[0] * bf_lo(g.x), a0[1] * bf_hi(g.x), a0[2] * bf_lo(g.y), a0[3] * bf_hi(g.y)};
                    const f32x4 o1 = {a1[0] * bf_lo(g.z), a1[1] * bf_hi(g.z), a1[2] * bf_lo(g.w), a1[3] * bf_hi(g.w)};
                    float* p = M1 + row * 2048 + col; *(f32x4*)p = o0; *(f32x4*)(p + 4) = o1; } }
    }
};
struct EpiMerged {
    static constexpr bool PERM = true, AFTER_DRAIN = false;
    const float* M1; const bf16_t* G; int ldg; bf16_t* MG;
    __device__ __forceinline__ void operator()(const f32x4 (&acc)[2][2][4][2], const Unit& u, int wr, int wc, int fr, int fq) const {
        const int row0 = u.pm * BM + wr * 64 + fr; const int col0 = u.pn * BM + wc * 32 + 8 * fq;
#pragma unroll
        for (int ai = 0; ai < 2; ++ai)
#pragma unroll
            for (int m = 0; m < 4; ++m) { const size_t row = (size_t)(row0 + ai * HALF + m * 16);
#pragma unroll
                for (int bj = 0; bj < 2; ++bj) { const int col = col0 + bj * HALF; const u32x4 g = *(const u32x4*)(G + row * ldg + col);
                    const float* p = M1 + row * 2048 + col; const f32x4 m0 = *(const f32x4*)p, m1 = *(const f32x4*)(p + 4);
                    const f32x4 a0 = acc[ai][bj][m][0], a1 = acc[ai][bj][m][1];
                    const f32x4 o0 = {m0[0] + a0[0] * bf_lo(g.x), m0[1] + a0[1] * bf_hi(g.x), m0[2] + a0[2] * bf_lo(g.y), m0[3] + a0[3] * bf_hi(g.y)};
                    const f32x4 o1 = {m1[0] + a1[0] * bf_lo(g.z), m1[1] + a1[1] * bf_hi(g.z), m1[2] + a1[2] * bf_lo(g.w), m1[3] + a1[3] * bf_hi(g.w)};
                    u32x4 w; w.x = cvt_pk_bf16(o0[0], o0[1]); w.y = cvt_pk_bf16(o0[2], o0[3]); w.z = cvt_pk_bf16(o1[0], o1[1]); w.w = cvt_pk_bf16(o1[2], o1[3]);
                    *(u32x4*)(MG + row * 2048 + col) = w; } }
    }
};
struct EpiH1 {
    static constexpr bool PERM = false, AFTER_DRAIN = false;
    const float* X; float* H1; const float* g1; int g1_stride; int tiles_per_batch;
    __device__ __forceinline__ void operator()(const f32x4 (&acc)[2][2][4][2], const Unit& u, int wr, int wc, int fr, int fq) const {
        const int row0 = u.pm * BM + wr * 64 + fr; const int col0 = u.pn * BM + wc * 32 + 4 * fq; const float* gb = g1 + (size_t)(u.pm / tiles_per_batch) * g1_stride;
        f32x4 gv[2][2];
#pragma unroll
        for (int bj = 0; bj < 2; ++bj)
#pragma unroll
            for (int n = 0; n < 2; ++n) gv[bj][n] = *(const f32x4*)(gb + col0 + bj * HALF + n * 16);
#pragma unroll
        for (int ai = 0; ai < 2; ++ai)
#pragma unroll
            for (int m = 0; m < 4; ++m) { const size_t off = (size_t)(row0 + ai * HALF + m * 16) * 2048 + col0;
#pragma unroll
                for (int bj = 0; bj < 2; ++bj)
#pragma unroll
                    for (int n = 0; n < 2; ++n) { const f32x4 xv = *(const f32x4*)(X + off + bj * HALF + n * 16);
                        *(f32x4*)(H1 + off + bj * HALF + n * 16) = xv + gv[bj][n] * acc[ai][bj][m][n]; } }
    }
};
struct EpiSwiGLU {
    static constexpr bool PERM = true, AFTER_DRAIN = false;
    unsigned char* Y; const float* bg; const float* bu; float wscale;
    __device__ __forceinline__ void operator()(const f32x4 (&acc)[2][2][4][2], const Unit& u, int wr, int wc, int fr, int fq) const {
        const int e = u.pn >> 4, pnl = u.pn & 15; const int row0 = u.pm * BM + wr * 64 + fr; const int col0 = pnl * HALF + wc * 32 + 8 * fq;
        f32x4 bgv[2], buv[2];
#pragma unroll
        for (int n = 0; n < 2; ++n) { bgv[n] = *(const f32x4*)(bg + (size_t)e * 2048 + col0 + 4 * n); buv[n] = *(const f32x4*)(bu + (size_t)e * 2048 + col0 + 4 * n); }
#pragma unroll
        for (int ai = 0; ai < 2; ++ai)
#pragma unroll
            for (int m = 0; m < 4; ++m) { unsigned char* rowp = Y + (size_t)(row0 + ai * HALF + m * 16) * 2048 + col0; f32x4 y[2];
#pragma unroll
                for (int n = 0; n < 2; ++n) { const f32x4 g4 = acc[ai][0][m][n] * wscale + bgv[n], u4 = acc[ai][1][m][n] * wscale + buv[n];
#pragma unroll
                    for (int i = 0; i < 4; ++i) { const float g = fminf(g4[i], 7.0f), uu = fminf(fmaxf(u4[i], -7.0f), 7.0f); y[n][i] = (uu + 1.0f) * (g * sigmoidf_fast(1.702f * g)); } }
                int w0 = __builtin_amdgcn_cvt_pk_fp8_f32(y[0][0], y[0][1], 0, false); w0 = __builtin_amdgcn_cvt_pk_fp8_f32(y[0][2], y[0][3], w0, true);
                int w1 = __builtin_amdgcn_cvt_pk_fp8_f32(y[1][0], y[1][1], 0, false); w1 = __builtin_amdgcn_cvt_pk_fp8_f32(y[1][2], y[1][3], w1, true);
                typedef int v2i_t __attribute__((ext_vector_type(2))); *(v2i_t*)rowp = (v2i_t){w0, w1}; }
    }
};
struct MoeOrder {
    const PG8_LAS int* tstart; int npn, lo, hi, rank, W;
    __device__ __forceinline__ void init(const PG8_LAS int* ts, int npn_, int G, int c) { tstart = ts; npn = npn_; const int U = ts[32] * npn_; const int x = c % NXCD; rank = c / NXCD; W = G / NXCD;
        lo = (int)(((long)U * x) / NXCD); hi = (int)(((long)U * (x + 1)) / NXCD); }
    __device__ __forceinline__ bool next(int i, Unit& u) const {
        const int q = lo + rank + W * i; if (q >= hi) return false;
        int e = 0;
#pragma unroll 1
        for (int k = 1; k < 32; ++k) if (tstart[k] * npn <= q) e = k;
        const int ts = tstart[e], te = tstart[e + 1] - ts, qq = q - ts * npn;
        u.pm = ts + qq % te; u.pn = e * npn + qq / te; return true;
    }
    __device__ __forceinline__ void a_ready(const Unit&) const {}
    __device__ __forceinline__ void done(const Unit&) const {}
};
}
namespace att {
using bf16x8 = __attribute__((ext_vector_type(8))) short;
using s16x4  = __attribute__((ext_vector_type(4))) short;
using f32x16 = __attribute__((ext_vector_type(16))) float;
using u32x4  = __attribute__((ext_vector_type(4))) unsigned;
typedef unsigned short bf16;
constexpr int   D = 128, NW = 8, QBLK = 32, KVBLK = 64;
constexpr float SCALE = 0.088388347648318440f;
constexpr float THR = 8.f;
constexpr size_t SHM_V = KVBLK * D * 2, SHM_K = KVBLK * D * 2, SHM_ATTN = 2 * SHM_V + 2 * SHM_K + NW * 64 * 4;
#define KSWZ(row, colB) ((row) * 256 + ((colB) ^ (((row) & 7) << 4)))
#define SBAR() __builtin_amdgcn_sched_barrier(0)
__device__ __forceinline__ int crow(int r, int hi) { return (r & 3) + 8 * (r >> 2) + 4 * hi; }
__device__ __forceinline__ unsigned cvtpk(float lo, float hi) { unsigned r; asm volatile("v_cvt_pk_bf16_f32 %0, %1, %2" : "=v"(r) : "v"(lo), "v"(hi)); return r; }

template <int MODE>
__device__ __forceinline__ void partialSM(f32x16& p0, f32x16& p1, float& m_reg, float& mn, float& alpha, float relb, float kk, bool valid) {
  constexpr float C = SCALE * 1.4426950408889634f;
#pragma unroll
  for (int r = 0; r < 16; ++r) {
    const float d0 = relb - (float)((r & 3) + 8 * (r >> 2)), a0 = __builtin_fabsf(d0), a1 = __builtin_fabsf(d0 - 32.f);
    p0[r] = fmaf(a0, -kk, p0[r]); p1[r] = fmaf(a1, -kk, p1[r]);
    if (MODE == 1) { if (!(valid && a0 <= 64.f)) p0[r] = -INFINITY; if (!(valid && a1 <= 64.f)) p1[r] = -INFINITY; }
  }
  float pmax = p0[0];
#pragma unroll
  for (int r = 1; r < 16; ++r) pmax = fmaxf(pmax, p0[r]);
#pragma unroll
  for (int r = 0; r < 16; ++r) pmax = fmaxf(pmax, p1[r]);
  { auto rr = __builtin_amdgcn_permlane32_swap(__float_as_uint(pmax), __float_as_uint(pmax), false, false);
    pmax = fmaxf(__uint_as_float(rr[0]), __uint_as_float(rr[1])); }
  if (__builtin_expect(__all(pmax - m_reg <= THR / SCALE), 1)) { mn = m_reg; alpha = 1.f; }
  else { mn = fmaxf(m_reg, pmax); alpha = __builtin_amdgcn_exp2f((m_reg - mn) * C); m_reg = mn; }
  const float mnC = -mn * C;
#pragma unroll
  for (int r = 0; r < 16; ++r) p0[r] = fmaf(p0[r], C, mnC);
#pragma unroll
  for (int r = 0; r < 16; ++r) p1[r] = fmaf(p1[r], C, mnC);
#pragma unroll
  for (int r = 0; r < 16; ++r) p0[r] = __builtin_amdgcn_exp2f(p0[r]);
}
__device__ __forceinline__ void finishSM(f32x16& p0, f32x16& p1, float alpha, float& l_reg, bf16x8& pa0, bf16x8& pa1, bf16x8& pa2, bf16x8& pa3) {
#pragma unroll
  for (int r = 0; r < 16; ++r) p1[r] = __builtin_amdgcn_exp2f(p1[r]);
  float ps = 0;
#pragma unroll
  for (int r = 0; r < 16; ++r) ps += p0[r];
#pragma unroll
  for (int r = 0; r < 16; ++r) ps += p1[r];
  { auto rr = __builtin_amdgcn_permlane32_swap(__float_as_uint(ps), __float_as_uint(ps), false, false);
    ps = __uint_as_float(rr[0]) + __uint_as_float(rr[1]); }
  l_reg = l_reg * alpha + ps;
#define PK4(P, BASE, OUT) do { unsigned a0 = cvtpk(P[BASE + 0], P[BASE + 1]), a1 = cvtpk(P[BASE + 2], P[BASE + 3]);   \
    unsigned b0 = cvtpk(P[BASE + 4], P[BASE + 5]), b1 = cvtpk(P[BASE + 6], P[BASE + 7]);                              \
    auto r0 = __builtin_amdgcn_permlane32_swap(a0, b0, false, false); auto r1 = __builtin_amdgcn_permlane32_swap(a1, b1, false, false); \
    u32x4 w = {r0[0], r1[0], r0[1], r1[1]}; OUT = *reinterpret_cast<bf16x8*>(&w); } while (0)
  PK4(p0, 0, pa0); PK4(p0, 8, pa1); PK4(p1, 0, pa2); PK4(p1, 8, pa3);
#undef PK4
}
__device__ __forceinline__ void qkt(f32x16& p0, f32x16& p1, const bf16* Ks, const bf16x8* qr, int r32, int hi) {
  p0 = f32x16{}; p1 = f32x16{};
#pragma unroll
  for (int d0 = 0; d0 < 8; ++d0) { const int cb = (d0 * 16 + hi * 8) * 2;
    bf16x8 b0 = *reinterpret_cast<const bf16x8*>((const char*)Ks + KSWZ(r32, cb));
    bf16x8 b1 = *reinterpret_cast<const bf16x8*>((const char*)Ks + KSWZ(32 + r32, cb));
    p0 = __builtin_amdgcn_mfma_f32_32x32x16_bf16(b0, qr[d0], p0, 0, 0, 0);
    p1 = __builtin_amdgcn_mfma_f32_32x32x16_bf16(b1, qr[d0], p1, 0, 0, 0); }
}
__device__ __forceinline__ int v_st(int k, int c) { const int kk = (k & ~0xC) | ((k & 4) << 1) | ((k & 8) >> 1); return ((kk >> 3) * 4 + (c >> 5)) * 512 + ((kk & 7) * 32 + (c & 31)) * 2; }
__device__ __forceinline__ int v_rd_base(int lane) { return ((lane & 3) << 3) | (((lane >> 2) & 3) << 6) | (((lane >> 4) & 1) << 5) | (((lane >> 5) & 1) << 8); }
constexpr int v_rd_off(int d0, int ks, int half) { return d0 * 512 + ks * 4096 + half * 2048; }
template <int OFF> __device__ __forceinline__ s16x4 tr_read(int vb) {
  s16x4 r; asm volatile("ds_read_b64_tr_b16 %0, %1 offset:%2" : "=&v"(r) : "v"(vb), "i"(OFF) : "memory"); return r;
}
template <int D0> __device__ __forceinline__ void pv_one(f32x16& od, int vb, bf16x8 pa0, bf16x8 pa1, bf16x8 pa2, bf16x8 pa3) {
  const s16x4 l0 = tr_read<v_rd_off(D0, 0, 0)>(vb), h0 = tr_read<v_rd_off(D0, 0, 1)>(vb), l1 = tr_read<v_rd_off(D0, 1, 0)>(vb), h1 = tr_read<v_rd_off(D0, 1, 1)>(vb);
  const s16x4 l2 = tr_read<v_rd_off(D0, 2, 0)>(vb), h2 = tr_read<v_rd_off(D0, 2, 1)>(vb), l3 = tr_read<v_rd_off(D0, 3, 0)>(vb), h3 = tr_read<v_rd_off(D0, 3, 1)>(vb);
  asm volatile("s_waitcnt lgkmcnt(0)" ::: "memory"); SBAR();
#define PK(L, H) (bf16x8){L[0], L[1], L[2], L[3], H[0], H[1], H[2], H[3]}
  od = __builtin_amdgcn_mfma_f32_32x32x16_bf16(pa0, PK(l0, h0), od, 0, 0, 0);
  od = __builtin_amdgcn_mfma_f32_32x32x16_bf16(pa1, PK(l1, h1), od, 0, 0, 0);
  od = __builtin_amdgcn_mfma_f32_32x32x16_bf16(pa2, PK(l2, h2), od, 0, 0, 0);
  od = __builtin_amdgcn_mfma_f32_32x32x16_bf16(pa3, PK(l3, h3), od, 0, 0, 0);
#undef PK
}
__device__ __forceinline__ void pv_d0(f32x16* o, int vb, bf16x8 pa0, bf16x8 pa1, bf16x8 pa2, bf16x8 pa3) {
  pv_one<0>(o[0], vb, pa0, pa1, pa2, pa3); pv_one<1>(o[1], vb, pa0, pa1, pa2, pa3); pv_one<2>(o[2], vb, pa0, pa1, pa2, pa3); pv_one<3>(o[3], vb, pa0, pa1, pa2, pa3);
}

template <int MODE>
__device__ __forceinline__ void attn_body(const bf16* __restrict__ Qb, long ldq, const bf16* __restrict__ Kh, const bf16* __restrict__ Vh, long ldk,
                                          int t0, int NT, int ntmax, int qpos0, float kk, float* __restrict__ Ob, long ldo, float* __restrict__ Lb, long ldl, char* lds) {
  const int tid = threadIdx.x, wid = tid >> 6, lane = tid & 63, r32 = lane & 31, hi = lane >> 5;
  bf16* V_lds = (bf16*)lds; bf16* K_lds = (bf16*)(lds + 2 * SHM_V);
  float* ws = (float*)(lds + 2 * SHM_V + 2 * SHM_K) + wid * 64; float* li_l = ws; float* al_l = ws + 32;
  float m_reg = -1e30f, l_reg = 0; f32x16 o[4] = {}; bf16x8 qr[8];
  const bf16* Qw = Qb + (long)(wid * QBLK + r32) * ldq + hi * 8;
#pragma unroll
  for (int d0 = 0; d0 < 8; ++d0) qr[d0] = *reinterpret_cast<const bf16x8*>(Qw + d0 * 16);
  const int sr = tid >> 4, sc = (tid & 15) * 8, vst0 = v_st(sr, sc), vst1 = v_st(32 + sr, sc);
  const int vb0 = (int)(uintptr_t)V_lds + v_rd_base(lane);
  const unsigned so0 = (unsigned)(sr * (int)ldk + sc), so1 = so0 + 32u * (unsigned)ldk;
  const float qposf = (float)(qpos0 + wid * QBLK + r32 - 4 * hi);
  struct { bf16x8 vs0, vs1, ks0, ks1; } sr_[2];
#define TCL(jt) ({ int _t = t0 + (jt); _t = _t < 0 ? 0 : (_t >= ntmax ? ntmax - 1 : _t); _t * KVBLK; })
#define TVALID(jt) ((t0 + (jt)) >= 0 && (t0 + (jt)) < ntmax)
#define RELB(jt) (qposf - (float)((t0 + (jt)) * KVBLK))
#define SLOAD(i, jt) do { const long _k0 = (long)TCL(jt) * ldk; const bf16* _vp = Vh + _k0; const bf16* _kp = Kh + _k0; \
    sr_[i].vs0 = *reinterpret_cast<const bf16x8*>(_vp + so0); sr_[i].vs1 = *reinterpret_cast<const bf16x8*>(_vp + so1); \
    sr_[i].ks0 = *reinterpret_cast<const bf16x8*>(_kp + so0); sr_[i].ks1 = *reinterpret_cast<const bf16x8*>(_kp + so1); } while (0)
#define SWRITE(b, i) do { *(bf16x8*)((char*)V_lds + (b) * SHM_V + vst0) = sr_[i].vs0;          \
    *(bf16x8*)((char*)V_lds + (b) * SHM_V + vst1) = sr_[i].vs1; const int kc = sc * 2;               \
    *(bf16x8*)((char*)K_lds + (b) * SHM_K + KSWZ(sr, kc)) = sr_[i].ks0;                       \
    *(bf16x8*)((char*)K_lds + (b) * SHM_K + KSWZ(32 + sr, kc)) = sr_[i].ks1; } while (0)
#define SWAIT() asm volatile("s_waitcnt vmcnt(4)" ::: "memory")
#define RESC(a) do { if (__any((a) < 1.f)) { if (hi == 0) al_l[r32] = (a); asm volatile("s_waitcnt lgkmcnt(0)" ::: "memory"); \
    _Pragma("unroll") for (int d = 0; d < 4; ++d) _Pragma("unroll") for (int r = 0; r < 16; ++r) o[d][r] *= al_l[crow(r, hi)]; } } while (0)
  f32x16 pA0, pA1, pB0, pB1; float mnA, mnB, alA, alB; bf16x8 pa0, pa1, pa2, pa3;
  constexpr int SE = 0, SO = 1;
  SLOAD(SE, 0); asm volatile("s_waitcnt vmcnt(0)" ::: "memory"); SWRITE(0, SE); __syncthreads();
  qkt(pA0, pA1, K_lds, qr, r32, hi); partialSM<MODE>(pA0, pA1, m_reg, mnA, alA, RELB(0), kk, TVALID(0));
  SLOAD(SO, 1); if (2 < NT) SLOAD(SE, 2);
  SWAIT(); SWRITE(1, SO); __syncthreads();
  for (int j = 1; j + 1 < NT; j += 2) {
    SBAR(); qkt(pB0, pB1, (bf16*)((char*)K_lds + SHM_K), qr, r32, hi);
    finishSM(pA0, pA1, alA, l_reg, pa0, pa1, pa2, pa3); SBAR();
    SLOAD(SO, j + 2); SBAR();
    pv_d0(o, vb0, pa0, pa1, pa2, pa3); partialSM<MODE>(pB0, pB1, m_reg, mnB, alB, RELB(j), kk, TVALID(j));
    __syncthreads(); SWAIT(); SWRITE(0, SE);
    RESC(alB); __syncthreads();
    SBAR(); qkt(pA0, pA1, K_lds, qr, r32, hi);
    finishSM(pB0, pB1, alB, l_reg, pa0, pa1, pa2, pa3); SBAR();
    if (j + 3 < NT) SLOAD(SE, j + 3); SBAR();
    pv_d0(o, vb0 + (int)SHM_V, pa0, pa1, pa2, pa3); partialSM<MODE>(pA0, pA1, m_reg, mnA, alA, RELB(j + 1), kk, TVALID(j + 1));
    __syncthreads(); SWAIT(); SWRITE(1, SO);
    RESC(alA); __syncthreads();
  }
  SBAR(); qkt(pB0, pB1, (bf16*)((char*)K_lds + SHM_K), qr, r32, hi);
  finishSM(pA0, pA1, alA, l_reg, pa0, pa1, pa2, pa3); SBAR();
  pv_d0(o, vb0, pa0, pa1, pa2, pa3); partialSM<MODE>(pB0, pB1, m_reg, mnB, alB, RELB(NT - 1), kk, TVALID(NT - 1));
  __syncthreads(); RESC(alB);
  finishSM(pB0, pB1, alB, l_reg, pa0, pa1, pa2, pa3); SBAR();
  pv_d0(o, vb0 + (int)SHM_V, pa0, pa1, pa2, pa3);
  if (hi == 0) li_l[r32] = l_reg; asm volatile("s_waitcnt lgkmcnt(0)" ::: "memory");
  float rli[16];
#pragma unroll
  for (int r = 0; r < 16; ++r) rli[r] = __builtin_amdgcn_rcpf(li_l[crow(r, hi)]);
  int hie = hi; asm volatile("" : "+v"(hie));
  float* Ow = Ob + (long)(wid * QBLK + 4 * hie) * ldo + r32;
#pragma unroll
  for (int r = 0; r < 16; ++r) { float* Or = Ow + (long)((r & 3) + 8 * (r >> 2)) * ldo;
#pragma unroll
    for (int d0 = 0; d0 < 4; ++d0) Or[d0 * 32] = o[d0][r] * rli[r]; }
  if (Lb != nullptr && hi == 0) Lb[(long)(wid * QBLK + r32) * ldl] = m_reg * SCALE + __logf(l_reg);
  __syncthreads();
#undef TCL
#undef TVALID
#undef RELB
#undef SLOAD
#undef SWRITE
#undef SWAIT
#undef RESC
}
#undef KSWZ
#undef SBAR
}
constexpr int NWAVES = 8;
#ifndef MK_SPLIT
#define MK_SPLIT 0
#endif
#ifndef DBG_ORACLE
#define DBG_ORACLE 0
#endif
constexpr int N_PHASES = 12;

constexpr int DM = 2048, BATCH = 2, SEQ = 4096, T = BATCH * SEQ;
constexpr int NQKV = 10240;
constexpr int C_QA = 0, C_KA = 1024, C_VA = 2048, C_QB = 3072, C_KB = 4096, C_VB = 5120, C_GA = 6144, C_GB = 8192;
constexpr int NE = 32, TOPK = 4, TK = T * TOPK, TKPAD = TK + NE * 256;
constexpr float EPS = 1e-5f;
constexpr float LAMBDA_INIT = 0.2f;

constexpr size_t MiB = 1u << 20;
constexpr size_t WS_CTL = 0, CTL_ZERO_BYTES = 1 * MiB;
constexpr size_t WS_MOD = 1 * MiB;
constexpr size_t WS_RC = 1 * MiB + 512 * 1024;
constexpr size_t WS_TOPI = 2 * MiB;
constexpr size_t WS_TOPP = 2 * MiB + 256 * 1024;
constexpr size_t WS_POS = 2 * MiB + 512 * 1024;
constexpr size_t WS_ERR = 3 * MiB;
constexpr size_t WS_WINT = 4 * MiB;
constexpr size_t WS_WAT = 44 * MiB;
constexpr size_t WS_WBT = 48 * MiB;
constexpr size_t WS_WOT = 52 * MiB;
constexpr size_t WS_U = 64 * MiB;
constexpr size_t WS_QKV = 96 * MiB;
constexpr size_t WS_OA = 256 * MiB;
constexpr size_t WS_OB = 352 * MiB;
constexpr size_t WS_LSE = 416 * MiB;
constexpr size_t WS_YA = 418 * MiB;
constexpr size_t WS_YB = 434 * MiB;
constexpr size_t WS_M1 = 450 * MiB;
constexpr size_t WS_MG = 514 * MiB;
constexpr size_t WS_H1 = 546 * MiB;
constexpr size_t WS_XS = 610 * MiB;
constexpr size_t WS_YACT = 770 * MiB;
constexpr size_t WS_YSLOT = 930 * MiB;
constexpr size_t WS_WGU = 1090 * MiB;
constexpr size_t WS_WD = 1602 * MiB;
constexpr size_t WS_END = 1858 * MiB;
constexpr int CW_TMO = 0, CW_CODE = 1;
constexpr int CW_BAR = 4096;
constexpr int CW_CNT = 8192;

constexpr int RING_OFF = 0, RING_BYTES = 131072;
constexpr int LDSCTL_OFF = 139264, MISC_OFF = LDSCTL_OFF + 320;
constexpr int TST_OFF = LDSCTL_OFF + 1024;
constexpr int LDS_BYTES = 147456;

#define GAS __attribute__((address_space(1)))
#define LAS __attribute__((address_space(3)))
typedef unsigned short bf16;
typedef unsigned v4u __attribute__((ext_vector_type(4)));
typedef unsigned v2u __attribute__((ext_vector_type(2)));
typedef float f32x4 __attribute__((ext_vector_type(4)));
typedef GAS unsigned gu32;
#define RLX_AGENT __ATOMIC_RELAXED, __HIP_MEMORY_SCOPE_AGENT
#define LDS_WAIT() asm volatile("s_waitcnt lgkmcnt(0)" ::: "memory")
#define VM_WAIT() asm volatile("s_waitcnt vmcnt(0)" ::: "memory")
__device__ __forceinline__ unsigned f2bf(float f) { unsigned u = __builtin_bit_cast(unsigned, f); return (u + 0x7fffu + ((u >> 16) & 1u)) >> 16; }
__device__ __forceinline__ unsigned pk2(float lo, float hi) { return f2bf(lo) | (f2bf(hi) << 16); }
__device__ __forceinline__ float bf2f(unsigned short h) { return __uint_as_float(((unsigned)h) << 16); }
__device__ __forceinline__ float wave_sum(float v) {
#pragma unroll
    for (int o = 1; o < 64; o <<= 1) v += __shfl_xor(v, o);
    return v;
}
__device__ __forceinline__ float wave_max(float v) {
#pragma unroll
    for (int o = 1; o < 64; o <<= 1) v = fmaxf(v, __shfl_xor(v, o));
    return v;
}
__device__ __forceinline__ float siluf(float x) { return x / (1.0f + __expf(-x)); }
#define XB_TMO      128
#define XB_XCNT(j)  (256  + 64 * (j))
#define XB_XSUB(j)  (1280 + 64 * (j))
#define XB_XGEN(j)  (2304 + 64 * (j))
#define XB_TOP      3328
#define XB_TOPGEN   3392
#define XCD_BAR_WORDS 3456
#define XB_SPIN_CAP (1u << 18)

__device__ __forceinline__ unsigned xb_ld(unsigned* p)              { return __hip_atomic_load(p, __ATOMIC_RELAXED, __HIP_MEMORY_SCOPE_AGENT); }
__device__ __forceinline__ unsigned xb_add(unsigned* p, unsigned v) { return __hip_atomic_fetch_add(p, v, __ATOMIC_RELAXED, __HIP_MEMORY_SCOPE_AGENT); }
__device__ __forceinline__ unsigned xb_xcc_id() { return (unsigned)__builtin_amdgcn_s_getreg((3 << 11) | 20) & 0xFu; }
#define XB_SPIN(cond, bar) do { unsigned _sp = 0; while (cond) { __builtin_amdgcn_s_sleep(1); \
    if ((++_sp & 255u) == 0u) { if (xb_ld(&(bar)[XB_TMO])) break; if (_sp > XB_SPIN_CAP) { atomicAdd(&(bar)[XB_TMO], 1u); break; } } } } while (0)

struct XcdBarrier {
    unsigned* bar; unsigned x;
    volatile LAS unsigned* st;
};

__device__ __forceinline__ XcdBarrier xcd_barrier_post(unsigned* bar, volatile LAS unsigned* st) {
    XcdBarrier b; b.bar = bar; b.x = xb_xcc_id(); b.st = st;
    if (threadIdx.x == 0) (void)xb_add(&bar[XB_XCNT(b.x)], 1u);
    return b;
}
__device__ __forceinline__ void xcd_barrier_complete(unsigned* bar, unsigned x, unsigned& nloc, unsigned& nx) {
    const unsigned G = gridDim.x * gridDim.y * gridDim.z;
    unsigned sum, cnt, mine, sp = 0u;
    for (;;) {
        sum = 0u; cnt = 0u; mine = 0u;
#pragma unroll
        for (unsigned j = 0; j < 16; ++j) { const unsigned c = xb_ld(&bar[XB_XCNT(j)]); sum += c; cnt += (c > 0u) ? 1u : 0u; mine = (j == x) ? c : mine; }
        if (sum == G) break;
        __builtin_amdgcn_s_sleep(1);
        if ((++sp & 255u) == 0u) { if (xb_ld(&bar[XB_TMO])) break; if (sp > XB_SPIN_CAP) { atomicAdd(&bar[XB_TMO], 1u); break; } }
    }
    nloc = mine > 0u ? mine : 1u; nx = cnt > 0u ? cnt : 1u;
}

__device__ __forceinline__ void xcd_barrier(const XcdBarrier& b) {
    asm volatile("s_waitcnt vmcnt(0)" ::: "memory");
    __syncthreads();
    if (threadIdx.x == 0) {
        unsigned* bar = b.bar;
        __builtin_amdgcn_s_waitcnt(0);
        unsigned nloc = b.st[0], nx = b.st[1];
        if (nloc == 0u) { xcd_barrier_complete(bar, b.x, nloc, nx); b.st[0] = nloc; b.st[1] = nx; }
        const unsigned old = xb_add(&bar[XB_XSUB(b.x)], 1u);
        const unsigned gen = old / nloc;
        if (old + 1u == (gen + 1u) * nloc) {
            __builtin_amdgcn_fence(__ATOMIC_RELEASE, "agent");
            asm volatile("s_waitcnt vmcnt(0)" ::: "memory");
            const unsigned og = xb_add(&bar[XB_TOP], 1u);
            const unsigned tg = og / nx;
            if (og + 1u == (tg + 1u) * nx) xb_add(&bar[XB_TOPGEN], 1u);
            else XB_SPIN(xb_ld(&bar[XB_TOPGEN]) == tg, bar);
            __builtin_amdgcn_fence(__ATOMIC_ACQUIRE, "agent");
            xb_add(&bar[XB_XGEN(b.x)], 1u);
            asm volatile("s_waitcnt vmcnt(0)" ::: "memory");
        } else {
            XB_SPIN(xb_ld(&bar[XB_XGEN(b.x)]) == gen, bar);
            __builtin_amdgcn_fence(__ATOMIC_ACQUIRE, "agent");
            asm volatile("s_waitcnt vmcnt(0)" ::: "memory");
        }
    }
    __syncthreads();
}
struct Args { const float* in[24]; float* out; unsigned char* ws; int ph_lo, ph_hi; };
enum { I_X = 0, I_C, I_WADA, I_BADA, I_N1G, I_WIN, I_LQ1, I_LK1, I_LQ2, I_LK2, I_SUBG, I_WOA, I_WOB, I_WO, I_N2G, I_WR, I_BR, I_WG, I_BG, I_WU, I_BU, I_WDN, I_BDN, I_FG };
struct Frame {
    LAS unsigned char* lds; char* ldsg;
    volatile LAS unsigned* MISC;
    gu32* ctl;
    int tid, lane, wave, vcu, G;
    unsigned char* ws;
};
#define WSP(T_, off) ((T_*)(F.ws + (off)))

constexpr float WSCALE = 64.0f;
__device__ __forceinline__ unsigned cvtpk_bf(float lo, float hi) { unsigned r; asm volatile("v_cvt_pk_bf16_f32 %0, %1, %2" : "=v"(r) : "v"(lo), "v"(hi)); return r; }
__device__ __forceinline__ void cvt_load(f32x4 (&v)[8], const float* __restrict__ W, int N, int k0, int n0, int lane) {
    const int lr = lane >> 3, lc = 4 * (lane & 7);
#pragma unroll
    for (int i = 0; i < 8; ++i) v[i] = __builtin_nontemporal_load((const f32x4*)(W + (size_t)(k0 + lr + 8 * i) * N + n0 + lc));
}
template <bool F8>
__device__ __forceinline__ void cvt_store(const f32x4 (&v)[8], int K, void* __restrict__ WT, int k0, long dst_row0, LAS float* scr, int lane) {
    const int lr = lane >> 3, lc = 4 * (lane & 7);
#pragma unroll
    for (int i = 0; i < 8; ++i) { LAS float* s = scr + (lr + 8 * i) * 33 + lc; s[0] = v[i].x; s[1] = v[i].y; s[2] = v[i].z; s[3] = v[i].w; }
    LDS_WAIT(); asm volatile("" ::: "memory");
    const int c = lane & 7;
#pragma unroll
    for (int j = 0; j < 4; ++j) { const int n = (lane >> 3) + 8 * j; const LAS float* s = scr + (8 * c) * 33 + n;
        if constexpr (F8) {
            int w0 = __builtin_amdgcn_cvt_pk_fp8_f32(s[0 * 33] * WSCALE, s[1 * 33] * WSCALE, 0, false); w0 = __builtin_amdgcn_cvt_pk_fp8_f32(s[2 * 33] * WSCALE, s[3 * 33] * WSCALE, w0, true);
            int w1 = __builtin_amdgcn_cvt_pk_fp8_f32(s[4 * 33] * WSCALE, s[5 * 33] * WSCALE, 0, false); w1 = __builtin_amdgcn_cvt_pk_fp8_f32(s[6 * 33] * WSCALE, s[7 * 33] * WSCALE, w1, true);
            *(v2u*)((unsigned char*)WT + (size_t)(dst_row0 + n) * K + k0 + 8 * c) = (v2u){(unsigned)w0, (unsigned)w1};
        } else {
            v4u o; o.x = cvtpk_bf(s[0 * 33], s[1 * 33]); o.y = cvtpk_bf(s[2 * 33], s[3 * 33]); o.z = cvtpk_bf(s[4 * 33], s[5 * 33]); o.w = cvtpk_bf(s[6 * 33], s[7 * 33]);
            *(v4u*)((bf16*)WT + (size_t)(dst_row0 + n) * K + k0 + 8 * c) = o; } }
    LDS_WAIT(); asm volatile("" ::: "memory");
}
__device__ __forceinline__ void cvt8_load(f32x4 (&v)[16], const float* __restrict__ W, int k0, int n0, int lane) {
    const float* p = W + (size_t)(k0 + (lane >> 3)) * DM + n0 + 4 * (lane & 7);
#pragma unroll
    for (int i = 0; i < 16; ++i) v[i] = __builtin_nontemporal_load((const f32x4*)(p + (size_t)(8 * i) * DM));
}
__device__ __forceinline__ void cvt8_store(const f32x4 (&v)[16], unsigned char* __restrict__ WT, int k0, long dst_row0, LAS float* scr, int lane) {
    const int lr = lane >> 3, lc = 4 * (lane & 7);
#pragma unroll
    for (int i = 0; i < 16; ++i) { const int k = lr + 8 * i, sw = 4 * (k >> 4); LAS float* s = scr + k * 33;
        s[(lc + 0 + sw) & 31] = v[i].x; s[(lc + 1 + sw) & 31] = v[i].y; s[(lc + 2 + sw) & 31] = v[i].z; s[(lc + 3 + sw) & 31] = v[i].w; }
    LDS_WAIT(); asm volatile("" ::: "memory");
    const int c = lane & 7;
#pragma unroll
    for (int j = 0; j < 4; ++j) { const int n = (lane >> 3) + 8 * j; const LAS float* s = scr + (16 * c) * 33 + ((n + 4 * c) & 31);
        v4u o;
#pragma unroll
        for (int h = 0; h < 4; ++h) { int w = __builtin_amdgcn_cvt_pk_fp8_f32(s[(4 * h + 0) * 33] * WSCALE, s[(4 * h + 1) * 33] * WSCALE, 0, false);
            w = __builtin_amdgcn_cvt_pk_fp8_f32(s[(4 * h + 2) * 33] * WSCALE, s[(4 * h + 3) * 33] * WSCALE, w, true); o[h] = (unsigned)w; }
        *(v4u*)(WT + (size_t)(dst_row0 + n) * DM + k0 + 16 * c) = o; }
    LDS_WAIT(); asm volatile("" ::: "memory");
}
__device__ __forceinline__ void p0_mod(Frame& F, const Args& A) {
    LAS float* red = (LAS float*)F.lds;
    if (F.vcu < 192) {
        const int col = F.vcu * 64 + F.lane, k0 = F.wave * 256;
        const float* wp = A.in[I_WADA] + (size_t)k0 * 12288 + col; const float* cp = A.in[I_C];
        float a0 = 0.f, a1 = 0.f;
#pragma unroll 16
        for (int k = 0; k < 256; ++k) { const float wv = __builtin_nontemporal_load(wp + (size_t)k * 12288); a0 = fmaf(siluf(cp[k0 + k]), wv, a0); a1 = fmaf(siluf(cp[2048 + k0 + k]), wv, a1); }
        red[(F.wave * 2 + 0) * 64 + F.lane] = a0; red[(F.wave * 2 + 1) * 64 + F.lane] = a1;
    }
    __syncthreads();
    if (F.vcu < 192 && F.tid < 128) { const int b = F.tid >> 6, l = F.tid & 63; float s = 0.f;
#pragma unroll
        for (int w = 0; w < 8; ++w) s += red[(w * 2 + b) * 64 + l];
        const int col = F.vcu * 64 + l; WSP(float, WS_MOD)[b * 12288 + col] = s + A.in[I_BADA][col]; }
    __syncthreads();
}
__device__ __forceinline__ void p0_convert(Frame& F, const Args& A) {
    LAS float* scr = (LAS float*)(F.lds + F.wave * 16384);
    const int gw = F.vcu * NWAVES + F.wave, NGW = F.G * NWAVES;
    constexpr int I_IN = 32 * 320, I_A = 16 * 64, I_B = 16 * 64, I_O = 32 * 64, I_E = 32 * 64, NSMALL = I_IN + I_A + I_B + I_O;
    f32x4 v0[8];
    if (NGW == I_E) {
#pragma unroll 1
        for (int j = 0; j < 7; ++j) {
            const float* W; bf16* WT; int N, K, r;
            if (j < 5) { W = A.in[I_WIN]; WT = WSP(bf16, WS_WINT); N = NQKV; K = DM; r = gw + j * NGW; }
            else if (j == 5) { const bool a = gw < I_A; W = a ? A.in[I_WOA] : A.in[I_WOB]; WT = a ? WSP(bf16, WS_WAT) : WSP(bf16, WS_WBT); N = DM; K = 1024; r = a ? gw : gw - I_A; }
            else { W = A.in[I_WO]; WT = WSP(bf16, WS_WOT); N = DM; K = DM; r = gw; }
            const int nnb = N / 32, k0 = (r / nnb) * 64, n0 = (r % nnb) * 32;
            cvt_load(v0, W, N, k0, n0, F.lane); cvt_store<false>(v0, K, WT, k0, n0, scr, F.lane);
        }
        {
            LAS float* scr8 = (LAS float*)(F.lds + F.wave * 16896);
            const int tp = gw & 1023, par = gw >> 10, k0 = (tp >> 6) * 128, n0 = (tp & 63) * 32;
            const long rowg = (long)(n0 >> 7) * 256 + (n0 & 127);
            f32x4 va[16], vb[16];
            const float* pg_ = A.in[I_WG]; const float* pu_ = A.in[I_WU]; const float* pd_ = A.in[I_WDN];
            asm volatile("" : "+s"(pg_), "+s"(pu_), "+s"(pd_));
#define CV_LOAD(buf, m) do { if ((m) < 96) { const int e_ = (m) / 3, w_ = (m) % 3; const float* W_ = (w_ == 0 ? pg_ : (w_ == 1 ? pu_ : pd_)) + (size_t)e_ * DM * DM; \
        cvt8_load(buf, W_, k0, n0, F.lane); } } while (0)
#define CV_STORE(buf, m) do { if ((m) < 96) { const int e_ = (m) / 3, w_ = (m) % 3; \
        if (w_ == 2) cvt8_store(buf, WSP(unsigned char, WS_WD), k0, (long)e_ * 2048 + n0, scr8, F.lane); \
        else cvt8_store(buf, WSP(unsigned char, WS_WGU), k0, (long)e_ * 4096 + rowg + (w_ == 1 ? 128 : 0), scr8, F.lane); } } while (0)
            __syncthreads();
            CV_LOAD(va, par);
#pragma unroll 1
            for (int m = par; m < 96; m += 4) {
                CV_LOAD(vb, m + 2); CV_STORE(va, m);
                CV_LOAD(va, m + 4); CV_STORE(vb, m + 2);
            }
#undef CV_LOAD
#undef CV_STORE
        }
    } else {
        for (int it = gw; it < NSMALL + 96 * I_E; it += NGW) {
            if (it < NSMALL) { int r = it; const float* W; bf16* WT; int N, K;
                if (r < I_IN) { W = A.in[I_WIN]; WT = WSP(bf16, WS_WINT); N = NQKV; K = DM; }
                else if ((r -= I_IN) < I_A) { W = A.in[I_WOA]; WT = WSP(bf16, WS_WAT); N = DM; K = 1024; }
                else if ((r -= I_A) < I_B) { W = A.in[I_WOB]; WT = WSP(bf16, WS_WBT); N = DM; K = 1024; }
                else { r -= I_B; W = A.in[I_WO]; WT = WSP(bf16, WS_WOT); N = DM; K = DM; }
                const int nnb = N / 32, k0 = (r / nnb) * 64, n0 = (r % nnb) * 32;
                cvt_load(v0, W, N, k0, n0, F.lane); cvt_store<false>(v0, K, WT, k0, n0, scr, F.lane); }
            else { const int r = it - NSMALL, m = r / I_E, rr = r % I_E, e = m / 3, w = m % 3, k0 = (rr >> 6) * 64, n0 = (rr & 63) * 32;
                const float* pg_ = A.in[I_WG]; const float* pu_ = A.in[I_WU]; const float* pd_ = A.in[I_WDN]; asm volatile("" : "+s"(pg_), "+s"(pu_), "+s"(pd_));
                const float* W = (w == 0 ? pg_ : (w == 1 ? pu_ : pd_)) + (size_t)e * DM * DM; cvt_load(v0, W, DM, k0, n0, F.lane);
                if (w == 2) cvt_store<true>(v0, DM, WSP(unsigned char, WS_WD), k0, (long)e * 2048 + n0, scr, F.lane);
                else cvt_store<true>(v0, DM, WSP(unsigned char, WS_WGU), k0, (long)e * 4096 + (long)(n0 >> 7) * 256 + (n0 & 127) + (w == 1 ? 128 : 0), scr, F.lane); }
        }
    }
}
__device__ __forceinline__ void p1_modulate(Frame& F, const Args& A) {
    const int gw = F.vcu * NWAVES + F.wave, NGW = F.G * NWAVES; const float* MOD = WSP(float, WS_MOD);
    if (gw < 64) { const int b = gw >> 5, e = gw & 31; float s = 0.f;
        for (int k = F.lane; k < DM; k += 64) s = fmaf(MOD[b * 12288 + 3 * DM + k], A.in[I_WR][k * 32 + e], s);
        s = wave_sum(s); if (F.lane == 0) WSP(float, WS_RC)[b * 32 + e] = s + A.in[I_BR][e]; }
    for (int m = gw; m < T; m += NGW) {
        const int b = m / SEQ; const float* xr = A.in[I_X] + (size_t)m * DM + 4 * F.lane; f32x4 v[8]; float s = 0.f;
#pragma unroll
        for (int j = 0; j < 8; ++j) { v[j] = *(const f32x4*)(xr + 256 * j); s += (v[j].x * v[j].x + v[j].y * v[j].y) + (v[j].z * v[j].z + v[j].w * v[j].w); }
        const float rstd = 1.0f / sqrtf(wave_sum(s) * (1.0f / DM) + EPS);
        bf16* ur = WSP(bf16, WS_U) + (size_t)m * DM + 4 * F.lane;
#pragma unroll
        for (int j = 0; j < 8; ++j) { const int k = 4 * F.lane + 256 * j;
            const f32x4 g = *(const f32x4*)(A.in[I_N1G] + k), sc = *(const f32x4*)(MOD + b * 12288 + 1 * DM + k), sh = *(const f32x4*)(MOD + b * 12288 + k);
            const f32x4 u = v[j] * rstd * g * (sc + 1.0f) + sh; v2u o; o.x = pk2(u.x, u.y); o.y = pk2(u.z, u.w); *(v2u*)(ur + 256 * j) = o; }
    }
}
__device__ __forceinline__ void p3_attention(Frame& F, const Args& A) {
    const bf16* QKV = WSP(bf16, WS_QKV);
    for (int i = F.vcu; i < 1280; i += F.G) {
        if (i < 512) {
            const int c2 = i >> 5, b = c2 >> 3, h = (c2 >> 1) & 3, c = c2 & 1, vh = (i >> 4) & 1, qb = i & 15;
            const size_t rowb = (size_t)b * SEQ;
            const bf16* Qb = QKV + (rowb + qb * 256) * NQKV + C_QB + h * 256 + c * 128;
            const bf16* Kh = QKV + rowb * NQKV + C_KB + h * 256 + c * 128;
            const bf16* Vh = QKV + rowb * NQKV + C_VB + h * 256 + vh * 128;
            float* Ob = WSP(float, WS_OB) + ((size_t)c * T + rowb + qb * 256) * 1024 + h * 256 + vh * 128;
            const float slope = exp2f(-(float)(8 + h + 1) * (8.0f / 12.0f));
            att::attn_body<0>(Qb, NQKV, Kh, Vh, NQKV, 0, SEQ / 64, SEQ / 64, qb * 256, slope / att::SCALE, Ob, 1024, nullptr, 0, F.ldsg);
        } else {
            const int j = i - 512, p = j >> 8, r = j & 255, b = r >> 7, h = (r >> 4) & 7, uu = r & 15;
            const int dil = p == 0 ? 1 : (p == 1 ? 4 : 16), L = SEQ / dil, gpr = L / 256, res = uu / gpr, g = uu % gpr;
            const size_t rowb = (size_t)b * SEQ + res;
            const bf16* Qb = QKV + (rowb + (size_t)g * 256 * dil) * NQKV + C_QA + h * 128;
            const bf16* Kh = QKV + rowb * NQKV + C_KA + h * 128;
            const bf16* Vh = QKV + rowb * NQKV + C_VA + h * 128;
            float* Ob = WSP(float, WS_OA) + ((size_t)p * T + rowb + (size_t)g * 256 * dil) * 1024 + h * 128;
            float* Lb = WSP(float, WS_LSE) + ((size_t)p * T + rowb + (size_t)g * 256 * dil) * 8 + h;
            const float slope = exp2f(-(float)(h + 1) * (8.0f / 12.0f)) * (float)dil;
            att::attn_body<1>(Qb, (long)dil * NQKV, Kh, Vh, (long)dil * NQKV, 4 * g - 1, 6, L / 64, g * 256, slope / att::SCALE, Ob, (long)dil * 1024, Lb, (long)dil * 8, F.ldsg);
        }
    }
}
__device__ __forceinline__ void p4_finalize(Frame& F, const Args& A) {
    const int gw = F.vcu * NWAVES + F.wave, NGW = F.G * NWAVES;
    float s1 = A.in[I_LQ1][F.lane] * A.in[I_LK1][F.lane] + A.in[I_LQ1][F.lane + 64] * A.in[I_LK1][F.lane + 64];
    float s2 = A.in[I_LQ2][F.lane] * A.in[I_LK2][F.lane] + A.in[I_LQ2][F.lane + 64] * A.in[I_LK2][F.lane + 64];
    s1 = wave_sum(s1); s2 = wave_sum(s2);
    const float lam = expf(s1) - expf(s2) + LAMBDA_INIT;
    const float* OA = WSP(float, WS_OA); const float* OB = WSP(float, WS_OB); const float* LS = WSP(float, WS_LSE);
    for (int m = gw; m < T; m += NGW) {
        { const int h = F.lane >> 3; const float l0 = LS[((size_t)0 * T + m) * 8 + h], l1 = LS[((size_t)1 * T + m) * 8 + h], l2 = LS[((size_t)2 * T + m) * 8 + h];
          const float mx = fmaxf(l0, fmaxf(l1, l2)); float w0 = __expf(l0 - mx), w1 = __expf(l1 - mx), w2 = __expf(l2 - mx); const float inv = 1.0f / (w0 + w1 + w2); w0 *= inv; w1 *= inv; w2 *= inv;
          const size_t o = (size_t)m * 1024 + 16 * F.lane; unsigned pk[8];
#pragma unroll
          for (int q = 0; q < 4; ++q) { const f32x4 a0 = *(const f32x4*)(OA + o + 4 * q), a1 = *(const f32x4*)(OA + (size_t)T * 1024 + o + 4 * q), a2 = *(const f32x4*)(OA + (size_t)2 * T * 1024 + o + 4 * q);
              const f32x4 y = a0 * w0 + a1 * w1 + a2 * w2; pk[2 * q] = pk2(y.x, y.y); pk[2 * q + 1] = pk2(y.z, y.w); }
          bf16* ya = WSP(bf16, WS_YA) + o; *(v4u*)ya = (v4u){pk[0], pk[1], pk[2], pk[3]}; *(v4u*)(ya + 8) = (v4u){pk[4], pk[5], pk[6], pk[7]}; }
#pragma unroll
        for (int h = 0; h < 4; ++h) { const size_t o = (size_t)m * 1024 + h * 256 + 4 * F.lane;
            const f32x4 v = *(const f32x4*)(OB + o) - *(const f32x4*)(OB + (size_t)T * 1024 + o) * lam;
            const float ss = wave_sum((v.x * v.x + v.y * v.y) + (v.z * v.z + v.w * v.w)); const float rstd = 1.0f / sqrtf(ss * (1.0f / 256.0f) + EPS);
            const f32x4 g = *(const f32x4*)(A.in[I_SUBG] + 4 * F.lane); const f32x4 y = v * rstd * g * (1.0f - LAMBDA_INIT);
            v2u w; w.x = pk2(y.x, y.y); w.y = pk2(y.z, y.w); *(v2u*)(WSP(bf16, WS_YB) + o) = w; }
    }
}
typedef float f32x16r __attribute__((ext_vector_type(16)));
__device__ __forceinline__ void p7_router(Frame& F, const Args& A, bool commit = true) {
    LAS float* gainL = (LAS float*)F.lds;
    LAS float* shiftL = gainL + 2048;
    LAS float* part = shiftL + 2048;
    LAS float* ssp = part + 8 * 32 * 32;
    LAS float* logitL = ssp + 512;
    LAS float* rstdL = logitL + 32 * 33;
    LAS int* lcnt = (LAS int*)(rstdL + 32);
    LAS int* lbase = lcnt + 32;
    const float* H1 = WSP(float, WS_H1); const float* MODp = WSP(float, WS_MOD); const float* RC = WSP(float, WS_RC);
    for (int blk = F.vcu; blk < T / 32; blk += F.G) {
        const int t0 = blk * 32, bb = t0 / SEQ; const float* mod = MODp + bb * 12288;
        for (int k = F.tid; k < DM; k += 512) { gainL[k] = A.in[I_N2G][k] * (1.0f + mod[4 * DM + k]); shiftL[k] = mod[3 * DM + k]; }
        if (F.tid < 32) lcnt[F.tid] = 0;
        __syncthreads();
        {
            const int i = F.lane & 31, kk = F.lane >> 5, kb = F.wave * 256 + kk * 128;
            const float* hp = H1 + (size_t)(t0 + i) * DM + kb; const float* wp = A.in[I_WR] + (size_t)kb * 32 + i; const LAS float* gp = gainL + kb;
            f32x16r acc = {}; float ss = 0.f;
#pragma unroll 4
            for (int s0 = 0; s0 < 128; s0 += 4) {
                const f32x4 hv = *(const f32x4*)(hp + s0); const f32x4 g4 = *(const LAS f32x4*)(gp + s0);
                const float b0 = wp[(s0 + 0) * 32], b1 = wp[(s0 + 1) * 32], b2 = wp[(s0 + 2) * 32], b3 = wp[(s0 + 3) * 32];
                ss += (hv.x * hv.x + hv.y * hv.y) + (hv.z * hv.z + hv.w * hv.w);
                acc = __builtin_amdgcn_mfma_f32_32x32x2f32(hv.x * g4.x, b0, acc, 0, 0, 0);
                acc = __builtin_amdgcn_mfma_f32_32x32x2f32(hv.y * g4.y, b1, acc, 0, 0, 0);
                acc = __builtin_amdgcn_mfma_f32_32x32x2f32(hv.z * g4.z, b2, acc, 0, 0, 0);
                acc = __builtin_amdgcn_mfma_f32_32x32x2f32(hv.w * g4.w, b3, acc, 0, 0, 0);
            }
#pragma unroll
            for (int r = 0; r < 16; ++r) part[(F.wave * 32 + (r & 3) + 8 * (r >> 2) + 4 * kk) * 32 + i] = acc[r];
            ssp[F.wave * 64 + F.lane] = ss;
        }
        __syncthreads();
        { const int token = F.tid & 31, eg = F.tid >> 5; float s2 = 0.f;
#pragma unroll
          for (int w = 0; w < 8; ++w) s2 += ssp[w * 64 + token] + ssp[w * 64 + 32 + token];
          const float rstd = 1.0f / sqrtf(s2 * (1.0f / DM) + EPS);
#pragma unroll
          for (int q = 0; q < 2; ++q) { const int e = eg * 2 + q; float raw = 0.f;
#pragma unroll
              for (int w = 0; w < 8; ++w) raw += part[(w * 32 + token) * 32 + e];
              logitL[token * 33 + e] = rstd * raw + RC[bb * 32 + e]; }
          if (eg == 0) rstdL[token] = rstd; }
        __syncthreads();
        int se[4] = {0, 0, 0, 0}, lp[4] = {0, 0, 0, 0}; float pv[4] = {0.f, 0.f, 0.f, 0.f};
        if (F.tid < 32) {
            float sv[4];
#pragma unroll
            for (int k = 0; k < 4; ++k) { float best = -INFINITY; int bi = 0;
                for (int e = 0; e < 32; ++e) { const float v = logitL[F.tid * 33 + e]; if (v > best) { best = v; bi = e; } }
                sv[k] = best; se[k] = bi; logitL[F.tid * 33 + bi] = -INFINITY; }
            float sum = 0.f;
#pragma unroll
            for (int k = 0; k < 4; ++k) { pv[k] = expf(sv[k] - sv[0]); sum += pv[k]; }
            const float inv = 1.0f / sum;
#pragma unroll
            for (int k = 0; k < 4; ++k) { pv[k] *= inv; lp[k] = __hip_atomic_fetch_add(lcnt + se[k], 1, __ATOMIC_RELAXED, __HIP_MEMORY_SCOPE_WORKGROUP); }
        }
        __syncthreads();
        if (F.tid < 32 && commit) lbase[F.tid] = (int)__hip_atomic_fetch_add((unsigned*)(F.ctl + CW_CNT + 64 * F.tid), (unsigned)lcnt[F.tid], RLX_AGENT);
        __syncthreads();
        if (F.tid < 32 && commit) { const int m = t0 + F.tid;
#pragma unroll
            for (int k = 0; k < 4; ++k) { WSP(int, WS_TOPI)[m * 4 + k] = se[k]; WSP(float, WS_TOPP)[m * 4 + k] = pv[k]; WSP(int, WS_POS)[m * 4 + k] = lbase[se[k]] + lp[k]; } }
        for (int i = 0; i < 4; ++i) { const int token = F.wave * 4 + i, m = t0 + token; const float rstd = rstdL[token];
            const float* hr = H1 + (size_t)m * DM + 4 * F.lane; unsigned char* ur = WSP(unsigned char, WS_U) + (size_t)m * DM + 4 * F.lane;
#pragma unroll
            for (int j = 0; j < 8; ++j) { const f32x4 h = *(const f32x4*)(hr + 256 * j), g = *(const LAS f32x4*)(gainL + 4 * F.lane + 256 * j), s = *(const LAS f32x4*)(shiftL + 4 * F.lane + 256 * j);
                const f32x4 u = h * rstd * g + s; int w8 = __builtin_amdgcn_cvt_pk_fp8_f32(u.x, u.y, 0, false); w8 = __builtin_amdgcn_cvt_pk_fp8_f32(u.z, u.w, w8, true); *(int*)(ur + 256 * j) = w8; } }
        __syncthreads();
    }
}
__device__ __forceinline__ void build_tile_table(Frame& F) {
    LAS int* ts = (LAS int*)(F.lds + TST_OFF);
    if (F.tid == 0) { int acc = 0;
        for (int e = 0; e < NE; ++e) { ts[e] = acc; acc += ((int)__hip_atomic_load((unsigned*)(F.ctl + CW_CNT + 64 * e), RLX_AGENT) + 255) >> 8; }
        ts[32] = acc; }
    __syncthreads();
}
__device__ __forceinline__ void p8_gather(Frame& F, const Args& A) {
    build_tile_table(F);
    const LAS int* ts = (const LAS int*)(F.lds + TST_OFF);
    const int gw = F.vcu * NWAVES + F.wave, NGW = F.G * NWAVES;
    for (int m = gw; m < T; m += NGW) {
        const v4u* src = (const v4u*)(WSP(unsigned char, WS_U) + (size_t)m * DM); v4u v[2];
#pragma unroll
        for (int q = 0; q < 2; ++q) v[q] = src[F.lane + 64 * q];
#pragma unroll
        for (int k = 0; k < 4; ++k) { const int e = WSP(int, WS_TOPI)[m * 4 + k], pos = WSP(int, WS_POS)[m * 4 + k]; const size_t row = (size_t)ts[e] * 256 + pos;
            v4u* dst = (v4u*)(WSP(unsigned char, WS_XS) + row * DM);
#pragma unroll
            for (int q = 0; q < 2; ++q) dst[F.lane + 64 * q] = v[q]; }
    }
}
__device__ __forceinline__ void p11_final(Frame& F, const Args& A) {
    build_tile_table(F);
    const LAS int* ts = (const LAS int*)(F.lds + TST_OFF);
    const int gw = F.vcu * NWAVES + F.wave, NGW = F.G * NWAVES; const float* MODp = WSP(float, WS_MOD);
    for (int m = gw; m < T; m += NGW) {
        const int bb = m / SEQ; const bf16* yr[4]; float p[4];
#pragma unroll
        for (int k = 0; k < 4; ++k) { const int e = WSP(int, WS_TOPI)[m * 4 + k], pos = WSP(int, WS_POS)[m * 4 + k]; p[k] = WSP(float, WS_TOPP)[m * 4 + k];
            yr[k] = WSP(bf16, WS_YSLOT) + ((size_t)ts[e] * 256 + pos) * DM + 4 * F.lane; }
        const float* hr = WSP(float, WS_H1) + (size_t)m * DM + 4 * F.lane; f32x4 v[8]; float s = 0.f;
#pragma unroll
        for (int j = 0; j < 8; ++j) { f32x4 a = {0.f, 0.f, 0.f, 0.f};
#pragma unroll
            for (int k = 0; k < 4; ++k) { const v2u w = *(const v2u*)(yr[k] + 256 * j); const f32x4 y = {__uint_as_float(w.x << 16), __uint_as_float(w.x & 0xffff0000u), __uint_as_float(w.y << 16), __uint_as_float(w.y & 0xffff0000u)}; a += y * p[k]; }
            const f32x4 g2 = *(const f32x4*)(MODp + bb * 12288 + 5 * DM + 4 * F.lane + 256 * j);
            v[j] = *(const f32x4*)(hr + 256 * j) + g2 * a; s += (v[j].x * v[j].x + v[j].y * v[j].y) + (v[j].z * v[j].z + v[j].w * v[j].w); }
        const float rstd = 1.0f / sqrtf(wave_sum(s) * (1.0f / DM) + EPS);
        float* orow = A.out + (size_t)m * DM + 4 * F.lane;
#pragma unroll
        for (int j = 0; j < 8; ++j) { const f32x4 g = *(const f32x4*)(A.in[I_FG] + 4 * F.lane + 256 * j); *(f32x4*)(orow + 256 * j) = v[j] * rstd * g; }
    }
}

__global__ void __launch_bounds__(NWAVES * 64, 2) fwd(Args args) {
    extern __shared__ __attribute__((aligned(16))) unsigned char lds[];
    Frame F;
    F.lds = (LAS unsigned char*)lds; F.ldsg = (char*)lds;
    F.MISC = (volatile LAS unsigned*)(F.lds + MISC_OFF);
    F.tid = threadIdx.x; F.lane = F.tid & 63; F.wave = __builtin_amdgcn_readfirstlane(F.tid >> 6);
    F.G = gridDim.x; { const int bx = blockIdx.x; F.vcu = (F.G % 8 == 0) ? (bx % 8) * (F.G / 8) + bx / 8 : bx; }
    F.ws = args.ws; F.ctl = (gu32*)(args.ws + WS_CTL);
    for (int u = F.tid; u < (LDS_BYTES - LDSCTL_OFF) / 4; u += NWAVES * 64) ((LAS unsigned*)(F.lds + LDSCTL_OFF))[u] = 0u;
    __syncthreads();
#if MK_SPLIT
#define GRID_BAR() do { } while (0)
#else
    XcdBarrier bar = xcd_barrier_post((unsigned*)(F.ctl + CW_BAR), F.MISC + 8);
#define GRID_BAR() xcd_barrier(bar)
#endif
    const int lo = args.ph_lo, hi = args.ph_hi;
#define IN(k) (lo <= (k) && (k) < hi)
#define SEAM(k) do { if (IN(k) && IN((k) + 1)) GRID_BAR(); } while (0)
    const Args& A = args;
    constexpr bool AL = true, SP = true;

#ifndef REP_PHASE
#define REP_PHASE -1
#endif
#define REPN(k) ((REP_PHASE == (k)) ? 2 : 1)
    if (IN(0)) { for (int rep = 0; rep < REPN(0); ++rep) p0_mod(F, A); for (int rep = 0; rep < REPN(12); ++rep) p0_convert(F, A); } SEAM(0);
    if (IN(1)) { for (int rep = 0; rep < REPN(1); ++rep) p1_modulate(F, A); } SEAM(1);
    if (IN(2)) for (int rep = 0; rep < REPN(2); ++rep) {
        pg8::Gemm g{WSP(bf16, WS_U), WSP(bf16, WS_WINT), T, NQKV, DM}; pg8::StaticOrder S; S.init(T, NQKV, F.G, (int)blockIdx.x);
        pg8::EpiQKV E{WSP(bf16, WS_QKV), NQKV, C_GA / 256};
        pg8::gemm_phase<pg8::EpiQKV, pg8::StaticOrder, AL, SP>(F.lds + RING_OFF, g, S, E);
    } SEAM(2);
    if (IN(3)) { for (int rep = 0; rep < REPN(3); ++rep) p3_attention(F, A); } SEAM(3);
    if (IN(4)) { for (int rep = 0; rep < REPN(4); ++rep) p4_finalize(F, A); } SEAM(4);
    if (IN(5)) for (int rep = 0; rep < REPN(5); ++rep) {
        { pg8::Gemm g{WSP(bf16, WS_YA), WSP(bf16, WS_WAT), T, DM, 1024}; pg8::StaticOrder S; S.init(T, DM, F.G, (int)blockIdx.x);
          pg8::EpiM1 E{WSP(float, WS_M1), WSP(bf16, WS_QKV) + C_GA, NQKV};
          pg8::gemm_phase<pg8::EpiM1, pg8::StaticOrder, AL, SP>(F.lds + RING_OFF, g, S, E); }
        VM_WAIT(); __syncthreads();
        { pg8::Gemm g{WSP(bf16, WS_YB), WSP(bf16, WS_WBT), T, DM, 1024}; pg8::StaticOrder S; S.init(T, DM, F.G, (int)blockIdx.x);
          pg8::EpiMerged E{WSP(float, WS_M1), WSP(bf16, WS_QKV) + C_GB, NQKV, WSP(bf16, WS_MG)};
          pg8::gemm_phase<pg8::EpiMerged, pg8::StaticOrder, AL, SP>(F.lds + RING_OFF, g, S, E); }
    } SEAM(5);
    if (IN(6)) for (int rep = 0; rep < REPN(6); ++rep) {
        pg8::Gemm g{WSP(bf16, WS_MG), WSP(bf16, WS_WOT), T, DM, DM}; pg8::StaticOrder S; S.init(T, DM, F.G, (int)blockIdx.x);
        pg8::EpiH1 E{A.in[I_X], WSP(float, WS_H1), WSP(float, WS_MOD) + 2 * DM, 12288, SEQ / 256};
        pg8::gemm_phase<pg8::EpiH1, pg8::StaticOrder, AL, SP>(F.lds + RING_OFF, g, S, E);
    } SEAM(6);
    if (IN(7)) { for (int rep = 0; rep < REPN(7); ++rep) p7_router(F, A, rep == 0); } SEAM(7);
    if (IN(8)) { for (int rep = 0; rep < REPN(8); ++rep) p8_gather(F, A); } SEAM(8);
    if (IN(9)) for (int rep = 0; rep < REPN(9); ++rep) {
        build_tile_table(F);
        pg8::Gemm g{WSP(bf16, WS_XS), WSP(bf16, WS_WGU), TKPAD, NE * 4096, DM / 2}; pg8::MoeOrder S; S.init((const LAS int*)(F.lds + TST_OFF), 16, F.G, (int)blockIdx.x);
        pg8::EpiSwiGLU E{WSP(unsigned char, WS_YACT), A.in[I_BG], A.in[I_BU], 1.0f / WSCALE};
        pg8::gemm_phase<pg8::EpiSwiGLU, pg8::MoeOrder, AL, SP, true>(F.lds + RING_OFF, g, S, E);
    } SEAM(9);
    if (IN(10)) for (int rep = 0; rep < REPN(10); ++rep) {
        build_tile_table(F);
        pg8::Gemm g{WSP(bf16, WS_YACT), WSP(bf16, WS_WD), TKPAD, NE * DM, DM / 2}; pg8::MoeOrder S; S.init((const LAS int*)(F.lds + TST_OFF), 8, F.G, (int)blockIdx.x);
        pg8::EpiBf16B E{WSP(bf16, WS_YSLOT), DM, A.in[I_BDN], 8, 1.0f / WSCALE};
        pg8::gemm_phase<pg8::EpiBf16B, pg8::MoeOrder, AL, SP, true>(F.lds + RING_OFF, g, S, E);
    } SEAM(10);
    if (IN(11)) { for (int rep = 0; rep < REPN(11); ++rep) p11_final(F, A); }
#undef IN
#undef SEAM
}
extern "C" void kernel_launch(void* const* d_in, const int* in_sizes, int n_in, void* d_out, int out_size, void* d_ws, size_t ws_size, hipStream_t stream) {
    static int grid = 0;
    if (grid == 0) {
        if (n_in != 24 || in_sizes[0] != T * DM || out_size != T * DM || ws_size < WS_END) { fprintf(stderr, "kernel_launch: shape mismatch (n_in %d, in0 %d, out %d, ws %zu < %zu); nothing launched\n", n_in, n_in > 0 ? in_sizes[0] : -1, out_size, ws_size, (size_t)WS_END); grid = -1; return; }
        int dev = 0, cus = 0, per_cu = 0;
        if (hipGetDevice(&dev) != hipSuccess || hipDeviceGetAttribute(&cus, hipDeviceAttributeMultiprocessorCount, dev) != hipSuccess) { grid = -1; return; }
        if (hipFuncSetAttribute((const void*)fwd, hipFuncAttributeMaxDynamicSharedMemorySize, LDS_BYTES) != hipSuccess) { fprintf(stderr, "kernel_launch: hipFuncSetAttribute failed\n"); grid = -1; return; }
        if (hipOccupancyMaxActiveBlocksPerMultiprocessor(&per_cu, (const void*)fwd, NWAVES * 64, LDS_BYTES) != hipSuccess || per_cu < 1)
            fprintf(stderr, "kernel_launch: note: occupancy query reports %d workgroups per CU\n", per_cu);
        (void)hipGetLastError();
        grid = cus;
    }
    if (grid < 0) return;
    if (hipMemsetAsync((char*)d_ws + WS_CTL, 0, CTL_ZERO_BYTES, stream) != hipSuccess) return;
    Args a; memset(&a, 0, sizeof(a));
    for (int i = 0; i < 24; ++i) a.in[i] = (const float*)d_in[i];
    a.out = (float*)d_out; a.ws = (unsigned char*)d_ws;
#if MK_SPLIT
    for (int ph = 0; ph < N_PHASES; ++ph) { a.ph_lo = ph; a.ph_hi = ph + 1; hipLaunchKernelGGL(fwd, dim3(grid), dim3(NWAVES * 64), LDS_BYTES, stream, a); }
#else
    a.ph_lo = 0; a.ph_hi = N_PHASES; hipLaunchKernelGGL(fwd, dim3(grid), dim3(NWAVES * 64), LDS_BYTES, stream, a);
#endif
    const hipError_t le = hipPeekAtLastError();
    if (le != hipSuccess) fprintf(stderr, "kernel_launch: launch failed: %s\n", hipGetErrorName(le));
#if DBG_ORACLE
    dbg_launch(a, stream);
#endif
}
```

```cpp
#include <hip/hip_runtime.h>
#include <cstdio>
#include <cstdint>
#include <cstring>
#include <cmath>
namespace pg8 {
#define PG8_LAS __attribute__((address_space(3)))
typedef unsigned short bf16_t;
typedef short bf16x8 __attribute__((ext_vector_type(8)));
typedef float f32x4 __attribute__((ext_vector_type(4)));
typedef unsigned u32x4 __attribute__((ext_vector_type(4)));
constexpr int BM = 256, BK = 64, HALF = 128, HTB = HALF * BK * 2  , STAGE_BYTES = 8 * HTB, NXCD = 8, WGM = 8;

__host__ __device__ __forceinline__ int lds_byte(int r, int c) { const int st = (r >> 4) * 2 + (c >> 5), rr = r & 15, cc = c & 31, ob = rr * 64 + cc * 2; return st * 1024 + (ob ^ (((ob >> 9) & 1) << 5)); }
__host__ __device__ __forceinline__ void stage_rc(int b, int& R, int& C) { const int st = b / 1024, sb = b % 1024, swz = sb ^ (((sb >> 9) & 1) << 5); R = (st >> 1) * 16 + swz / 64; C = (st & 1) * 32 + (swz % 64) / 2; }
__host__ __device__ __forceinline__ int perm32(int rho) { const int n = rho >> 4, i = rho & 15; return 8 * (i >> 2) + 4 * n + (i & 3); }

struct Unit { int pm, pn; };
struct Gemm { const bf16_t* A; const bf16_t* Bt; int M, N, K; };

struct StaticOrder {
    int nM, nN, nwg, G, c;
    __host__ __device__ void init(int M, int N, int G_, int c_) { nM = M / BM; nN = N / BM; nwg = nM * nN; G = G_; c = c_; }
    __host__ __device__ bool next(int i, Unit& u) const {
        const long L = (long)i * G + c; if (L >= nwg) return false;
        int wgid = (int)L; { const int q = nwg / NXCD, r = nwg % NXCD, xcd = wgid % NXCD, off = wgid / NXCD; wgid = (xcd < r ? xcd * (q + 1) : r * (q + 1) + (xcd - r) * q) + off; }
        const int nig = WGM * nN, gid = wgid / nig, fm = gid * WGM, gsz = (nM - fm) < WGM ? (nM - fm) : WGM;
        u.pm = fm + ((wgid % nig) % gsz); u.pn = (wgid % nig) / gsz; return true;
    }
    __device__ __forceinline__ void a_ready(const Unit&) const {}
    __device__ __forceinline__ void done(const Unit&) const {}
};

__device__ __forceinline__ unsigned cvt_pk_bf16(float lo, float hi) { unsigned r; asm volatile("v_cvt_pk_bf16_f32 %0, %1, %2" : "=v"(r) : "v"(lo), "v"(hi)); return r; }

typedef int v4i_t __attribute__((ext_vector_type(4)));
typedef int v8i_t __attribute__((ext_vector_type(8)));
template <class Epi, class Sched, bool ALIGN_EPI = false, bool SP2 = false, bool F8 = false>
__device__ __forceinline__ void gemm_phase(PG8_LAS unsigned char* lds, const Gemm g, const Sched& S, const Epi& E) {
    const int tid = threadIdx.x, wid = __builtin_amdgcn_readfirstlane(tid >> 6), lane = tid & 63, wr = wid >> 2, wc = wid & 3, fr = lane & 15, fq = lane >> 4;
    const int K = g.K, nt = K / BK;
    unsigned voffA[2], voffB[2];
#pragma unroll
    for (int i = 0; i < 2; ++i) { int R, C; stage_rc(tid * 16 + i * 8192, R, C); const int Rb = Epi::PERM ? ((R & ~31) + perm32(R & 31)) : R;
        voffA[i] = (unsigned)(R * K + C) * 2u; voffB[i] = (unsigned)(Rb * K + C) * 2u; }
    const size_t kstep = (size_t)(BK * 2);
    const size_t hstep = (size_t)HALF * K * 2;
    const size_t tstep = 2 * hstep;
    const unsigned ldsw = (unsigned)wid * 1024u;
    const int aoff = lds_byte(wr * 64 + fr, fq * 8), boff = lds_byte(wc * 32 + fr, fq * 8);
#define PG8_SA(b, h) (((b) * 2 + (h)) * HTB)
#define PG8_SB(b, h) ((4 + (b) * 2 + (h)) * HTB)
#define PG8_STAGE(bufoff, gbase, voff) do { _Pragma("unroll") for (int _i = 0; _i < 2; ++_i) \
        __builtin_amdgcn_global_load_lds((const unsigned*)((const char*)(gbase) + (voff)[_i]), (PG8_LAS unsigned*)(lds + (bufoff) + ldsw + _i * 8192), 16, 0, 0); } while (0)
#define PG8_LDA(dst, b, h) do { _Pragma("unroll") for (int m = 0; m < 4; ++m) _Pragma("unroll") for (int k = 0; k < 2; ++k) dst[m][k] = *(const PG8_LAS bf16x8*)(lds + PG8_SA(b, h) + aoff + m * 2048 + k * 1024); } while (0)
#define PG8_LDB(dst, b, h) do { _Pragma("unroll") for (int n = 0; n < 2; ++n) _Pragma("unroll") for (int k = 0; k < 2; ++k) dst[n][k] = *(const PG8_LAS bf16x8*)(lds + PG8_SB(b, h) + boff + n * 2048 + k * 1024); } while (0)
#define PG8_MMA(ai, bj, At, Bt) do { __builtin_amdgcn_s_setprio(1); _Pragma("unroll") for (int m = 0; m < 4; ++m) _Pragma("unroll") for (int n = 0; n < 2; ++n) { \
        if constexpr (F8) { const v8i_t _b = __builtin_shufflevector(__builtin_bit_cast(v4i_t, Bt[n][0]), __builtin_bit_cast(v4i_t, Bt[n][1]), 0, 1, 2, 3, 4, 5, 6, 7); \
            const v8i_t _a = __builtin_shufflevector(__builtin_bit_cast(v4i_t, At[m][0]), __builtin_bit_cast(v4i_t, At[m][1]), 0, 1, 2, 3, 4, 5, 6, 7); \
            asm volatile("v_mfma_scale_f32_16x16x128_f8f6f4 %0, %1, %2, %0, %3, %3 op_sel_hi:[0,0,0]" : "+v"(acc[ai][bj][m][n]) : "v"(_b), "v"(_a), "v"(f8scale)); } \
        else { _Pragma("unroll") for (int k = 0; k < 2; ++k) acc[ai][bj][m][n] = __builtin_amdgcn_mfma_f32_16x16x32_bf16(Bt[n][k], At[m][k], acc[ai][bj][m][n], 0, 0, 0); } } \
        __builtin_amdgcn_s_setprio(0); } while (0)
#define PG8_WAIT_V(n) asm volatile("s_waitcnt vmcnt(" #n ")" ::: "memory")
#define PG8_WAIT_L(n) asm volatile("s_waitcnt lgkmcnt(" #n ")" ::: "memory")
#define PG8_BAR __builtin_amdgcn_s_barrier()
#define PG8_SCHED __builtin_amdgcn_sched_barrier(0)
    Unit cur, nxt; int ui = 0;
    if (!S.next(0, cur)) return;
    const int f8scale = 0x7f7f7f7f;
    f32x4 acc[2][2][4][2];
#pragma unroll
    for (int a = 0; a < 2; ++a)
#pragma unroll
        for (int b = 0; b < 2; ++b)
#pragma unroll
            for (int m = 0; m < 4; ++m)
#pragma unroll
                for (int n = 0; n < 2; ++n) acc[a][b][m][n] = (f32x4){0.f, 0.f, 0.f, 0.f};
    bf16x8 At[4][2], B0[2][2], B1[2][2];
    const char* cA = (const char*)g.A + (size_t)cur.pm * tstep; const char* cB = (const char*)g.Bt + (size_t)cur.pn * tstep;
    S.a_ready(cur);
    if constexpr (SP2) {
        PG8_STAGE(PG8_SB(0, 0), cB, voffB); PG8_STAGE(PG8_SB(0, 1), cB + hstep, voffB); PG8_STAGE(PG8_SA(0, 0), cA, voffA); PG8_STAGE(PG8_SA(0, 1), cA + hstep, voffA);
        if (wr == 1) PG8_BAR;
        PG8_WAIT_V(2); PG8_BAR;
        PG8_STAGE(PG8_SB(1, 0), cB + kstep, voffB); PG8_STAGE(PG8_SA(1, 0), cA + kstep, voffA); PG8_STAGE(PG8_SB(1, 1), cB + hstep + kstep, voffB);
        PG8_WAIT_V(6); PG8_BAR;
    } else {
        PG8_STAGE(PG8_SB(0, 0), cB, voffB); PG8_STAGE(PG8_SA(0, 0), cA, voffA); PG8_STAGE(PG8_SB(0, 1), cB + hstep, voffB); PG8_STAGE(PG8_SA(0, 1), cA + hstep, voffA);
        if (wr == 1) PG8_BAR;
        PG8_WAIT_V(4); PG8_BAR;
        PG8_STAGE(PG8_SB(1, 0), cB + kstep, voffB); PG8_STAGE(PG8_SA(1, 0), cA + kstep, voffA); PG8_STAGE(PG8_SB(1, 1), cB + hstep + kstep, voffB);
        PG8_WAIT_V(6); PG8_BAR;
    }
    for (;;) {
        const bool has_next = S.next(ui + 1, nxt);
        const char* nA = has_next ? (const char*)g.A + (size_t)nxt.pm * tstep : cA; const char* nB = has_next ? (const char*)g.Bt + (size_t)nxt.pn * tstep : cB;
        for (int t = 0; t < nt; t += 2) {
            const bool last = (t == nt - 2);
            const char* a1 = cA + (size_t)(t + 1) * kstep;
            const char* a2 = last ? nA : cA + (size_t)(t + 2) * kstep; const char* b2 = last ? nB : cB + (size_t)(t + 2) * kstep;
            const char* a3 = a2 + kstep; const char* b3 = b2 + kstep;
            if (last && has_next) S.a_ready(nxt);
            if constexpr (SP2) {
            PG8_LDB(B0, 0, 0); PG8_LDB(B1, 0, 1); PG8_SCHED; PG8_LDA(At, 0, 0); PG8_STAGE(PG8_SA(1, 1), a1 + hstep, voffA);
            PG8_WAIT_V(8); PG8_WAIT_L(0); PG8_BAR; PG8_MMA(0, 0, At, B0); PG8_MMA(0, 1, At, B1); PG8_BAR; PG8_SCHED;
            PG8_LDA(At, 0, 1); PG8_STAGE(PG8_SB(0, 0), b2, voffB); PG8_STAGE(PG8_SB(0, 1), b2 + hstep, voffB); PG8_STAGE(PG8_SA(0, 0), a2, voffA);
            PG8_WAIT_V(8); PG8_WAIT_L(0); PG8_BAR; PG8_MMA(1, 0, At, B0); PG8_MMA(1, 1, At, B1); PG8_BAR; PG8_SCHED;
            PG8_LDB(B0, 1, 0); PG8_LDB(B1, 1, 1); PG8_SCHED; PG8_LDA(At, 1, 0); PG8_STAGE(PG8_SA(0, 1), a2 + hstep, voffA);
            PG8_WAIT_V(8); PG8_WAIT_L(0); PG8_BAR; PG8_MMA(0, 0, At, B0); PG8_MMA(0, 1, At, B1); PG8_BAR; PG8_SCHED;
            PG8_LDA(At, 1, 1); PG8_STAGE(PG8_SB(1, 0), b3, voffB); PG8_STAGE(PG8_SB(1, 1), b3 + hstep, voffB); PG8_STAGE(PG8_SA(1, 0), a3, voffA);
            PG8_WAIT_V(8); PG8_WAIT_L(0); PG8_BAR; PG8_MMA(1, 0, At, B0); PG8_MMA(1, 1, At, B1); PG8_BAR; PG8_SCHED;
            } else {
            PG8_LDB(B0, 0, 0); PG8_SCHED; PG8_LDA(At, 0, 0); PG8_STAGE(PG8_SA(1, 1), a1 + hstep, voffA);
            PG8_WAIT_L(8); PG8_BAR; PG8_WAIT_L(0); PG8_MMA(0, 0, At, B0); PG8_BAR; PG8_SCHED;
            PG8_LDB(B1, 0, 1); PG8_STAGE(PG8_SB(0, 0), b2, voffB);
            PG8_BAR; PG8_WAIT_L(0); PG8_MMA(0, 1, At, B1); PG8_BAR;
            PG8_LDA(At, 0, 1); PG8_STAGE(PG8_SA(0, 0), a2, voffA);
            PG8_BAR; PG8_WAIT_L(0); PG8_MMA(1, 0, At, B0); PG8_BAR; PG8_SCHED;
            PG8_STAGE(PG8_SB(0, 1), b2 + hstep, voffB);
            PG8_WAIT_V(6); PG8_BAR; PG8_MMA(1, 1, At, B1); PG8_BAR;
            PG8_LDB(B0, 1, 0); PG8_SCHED; PG8_LDA(At, 1, 0); PG8_STAGE(PG8_SA(0, 1), a2 + hstep, voffA);
            PG8_WAIT_L(8); PG8_BAR; PG8_WAIT_L(0); PG8_MMA(0, 0, At, B0); PG8_BAR; PG8_SCHED;
            PG8_LDB(B1, 1, 1); PG8_STAGE(PG8_SB(1, 0), b3, voffB);
            PG8_BAR; PG8_WAIT_L(0); PG8_MMA(0, 1, At, B1); PG8_BAR;
            PG8_LDA(At, 1, 1); PG8_STAGE(PG8_SA(1, 0), a3, voffA);
            PG8_BAR; PG8_WAIT_L(0); PG8_MMA(1, 0, At, B0); PG8_BAR; PG8_SCHED;
            PG8_STAGE(PG8_SB(1, 1), b3 + hstep, voffB);
            PG8_WAIT_V(6); PG8_BAR; PG8_MMA(1, 1, At, B1); PG8_BAR;
            }
        }
        if constexpr (F8) asm volatile("s_nop 15\n\ts_nop 7" ::: "memory");
        if constexpr (ALIGN_EPI) { if (wr == 0) PG8_BAR; }
        if constexpr (!Epi::AFTER_DRAIN) { E(acc, cur, wr, wc, fr, fq); S.done(cur); }
        if (!has_next) break;
#pragma unroll
        for (int a = 0; a < 2; ++a)
#pragma unroll
            for (int b = 0; b < 2; ++b)
#pragma unroll
                for (int m = 0; m < 4; ++m)
#pragma unroll
                    for (int n = 0; n < 2; ++n) acc[a][b][m][n] = (f32x4){0.f, 0.f, 0.f, 0.f};
        cur = nxt; cA = nA; cB = nB; ++ui;
        if constexpr (ALIGN_EPI) { if (wr == 1) PG8_BAR; }
    }
    PG8_WAIT_V(0);
    if constexpr (!ALIGN_EPI) { if (wr == 0) PG8_BAR; }
    PG8_BAR;
    if constexpr (Epi::AFTER_DRAIN) { E.fused(acc, cur, wr, wc, fr, fq, lds, wid, lane); S.done(cur); }
#undef PG8_SA
#undef PG8_SB
#undef PG8_STAGE
#undef PG8_LDA
#undef PG8_LDB
#undef PG8_MMA
#undef PG8_WAIT_V
#undef PG8_WAIT_L
#undef PG8_BAR
#undef PG8_SCHED
}
}
namespace pg8 {
typedef float f32x2e __attribute__((ext_vector_type(2)));
__device__ __forceinline__ float bf_lo(unsigned w) { return __uint_as_float(w << 16); }
__device__ __forceinline__ float bf_hi(unsigned w) { return __uint_as_float(w & 0xffff0000u); }
__device__ __forceinline__ float sigmoidf_fast(float x) { return __builtin_amdgcn_rcpf(1.0f + __expf(-x)); }

struct EpiBf16B {
    static constexpr bool PERM = true, AFTER_DRAIN = false;
    bf16_t* O; int ldc; const float* bias; int ntile_mod; float scale;
    __device__ __forceinline__ void operator()(const f32x4 (&acc)[2][2][4][2], const Unit& u, int wr, int wc, int fr, int fq) const {
        const int row0 = u.pm * BM + wr * 64 + fr; const int colt = (u.pn % ntile_mod) * BM;
        const int col0 = colt + wc * 32 + 8 * fq, bcol0 = u.pn * BM + wc * 32 + 8 * fq;
        f32x4 bv[2][2];
#pragma unroll
        for (int bj = 0; bj < 2; ++bj)
#pragma unroll
            for (int n = 0; n < 2; ++n) bv[bj][n] = bias ? *(const f32x4*)(bias + bcol0 + bj * HALF + 4 * n) : (f32x4){0.f, 0.f, 0.f, 0.f};
#pragma unroll
        for (int ai = 0; ai < 2; ++ai)
#pragma unroll
            for (int m = 0; m < 4; ++m) { bf16_t* rowp = O + (size_t)(row0 + ai * HALF + m * 16) * ldc + col0;
#pragma unroll
                for (int bj = 0; bj < 2; ++bj) { const f32x4 v0 = acc[ai][bj][m][0] * scale + bv[bj][0], v1 = acc[ai][bj][m][1] * scale + bv[bj][1];
                    u32x4 w; w.x = cvt_pk_bf16(v0[0], v0[1]); w.y = cvt_pk_bf16(v0[2], v0[3]); w.z = cvt_pk_bf16(v1[0], v1[1]); w.w = cvt_pk_bf16(v1[2], v1[3]);
                    *(u32x4*)(rowp + bj * HALF) = w; } }
    }
};
struct EpiQKV {
    static constexpr bool PERM = true, AFTER_DRAIN = false;
    bf16_t* O; int ldc; int sig_tile0;
    __device__ __forceinline__ void operator()(const f32x4 (&acc)[2][2][4][2], const Unit& u, int wr, int wc, int fr, int fq) const {
        const int row0 = u.pm * BM + wr * 64 + fr; const int col0 = u.pn * BM + wc * 32 + 8 * fq; const bool sg = u.pn >= sig_tile0;
#pragma unroll
        for (int ai = 0; ai < 2; ++ai)
#pragma unroll
            for (int m = 0; m < 4; ++m) { bf16_t* rowp = O + (size_t)(row0 + ai * HALF + m * 16) * ldc + col0;
#pragma unroll
                for (int bj = 0; bj < 2; ++bj) { f32x4 v0 = acc[ai][bj][m][0], v1 = acc[ai][bj][m][1];
                    if (sg) {
#pragma unroll
                        for (int i = 0; i < 4; ++i) { v0[i] = sigmoidf_fast(v0[i]); v1[i] = sigmoidf_fast(v1[i]); } }
                    u32x4 w; w.x = cvt_pk_bf16(v0[0], v0[1]); w.y = cvt_pk_bf16(v0[2], v0[3]); w.z = cvt_pk_bf16(v1[0], v1[1]); w.w = cvt_pk_bf16(v1[2], v1[3]);
                    *(u32x4*)(rowp + bj * HALF) = w; } }
    }
};
struct EpiM1 {
    static constexpr bool PERM = true, AFTER_DRAIN = false;
    float* M1; const bf16_t* G; int ldg;
    __device__ __forceinline__ void operator()(const f32x4 (&acc)[2][2][4][2], const Unit& u, int wr, int wc, int fr, int fq) const {
        const int row0 = u.pm * BM + wr * 64 + fr; const int col0 = u.pn * BM + wc * 32 + 8 * fq;
#pragma unroll
        for (int ai = 0; ai < 2; ++ai)
#pragma unroll
            for (int m = 0; m < 4; ++m) { const size_t row = (size_t)(row0 + ai * HALF + m * 16);
#pragma unroll
                for (int bj = 0; bj < 2; ++bj) { const int col = col0 + bj * HALF; const u32x4 g = *(const u32x4*)(G + row * ldg + col);
                    const f32x4 a0 = acc[ai][bj][m][0], a1 = acc[ai][bj][m][1];
                    const f32x4 o0 = {a0[0] * bf_lo(g.x), a0[1] * bf_hi(g.x), a0[2] * bf_lo(g.y), a0[3] * bf_hi(g.y)};
                    const f32x4 o1 = {a1[0] * bf_lo(g.z), a1[1] * bf_hi(g.z), a1[2] * bf_lo(g.w), a1[3] * bf_hi(g.w)};
                    float* p = M1 + row * 2048 + col; *(f32x4*)p = o0; *(f32x4*)(p + 4) = o1; } }
    }
};
struct EpiMerged {
    static constexpr bool PERM = true, AFTER_DRAIN = false;
    const float* M1; const bf16_t* G; int ldg; bf16_t* MG;
    __device__ __forceinline__ void operator()(const f32x4 (&acc)[2][2][4][2], const Unit& u, int wr, int wc, int fr, int fq) const {
        const int row0 = u.pm * BM + wr * 64 + fr; const int col0 = u.pn * BM + wc * 32 + 8 * fq;
#pragma unroll
        for (int ai = 0; ai < 2; ++ai)
#pragma unroll
            for (int m = 0; m < 4; ++m) { const size_t row = (size_t)(row0 + ai * HALF + m * 16);
#pragma unroll
                for (int bj = 0; bj < 2; ++bj) { const int col = col0 + bj * HALF; const u32x4 g = *(const u32x4*)(G + row * ldg + col);
                    const float* p = M1 + row * 2048 + col; const f32x4 m0 = *(const f32x4*)p, m1 = *(const f32x4*)(p + 4);
                    const f32x4 a0 = acc[ai][bj][m][0], a1 = acc[ai][bj][m][1];
                    const f32x4 o0 = {m0[0] + a0[0] * bf_lo(g.x), m0[1] + a0[1] * bf_hi(g.x), m0[2] + a0[2] * bf_lo(g.y), m0[3] + a0[3] * bf_hi(g.y)};
                    const f32x4 o1 = {m1[0] + a1[0] * bf_lo(g.z), m1[1] + a1[1] * bf_hi(g.z), m1[2] + a1[2] * bf_lo(g.w), m1[3] + a1[3] * bf_hi(g.w)};
                    u32x4 w; w.x = cvt_pk_bf16(o0[0], o0[1]); w.y = cvt_pk_bf16(o0[2], o0[3]); w.z = cvt_pk_bf16(o1[0], o1[1]); w.w = cvt_pk_bf16(o1[2], o1[3]);
                    *(u32x4*)(MG + row * 2048 + col) = w; } }
    }
};
struct EpiH1 {
    static constexpr bool PERM = false, AFTER_DRAIN = false;
    const float* X; float* H1; const float* g1; int g1_stride; int tiles_per_batch;
    __device__ __forceinline__ void operator()(const f32x4 (&acc)[2][2][4][2], const Unit& u, int wr, int wc, int fr, int fq) const {
        const int row0 = u.pm * BM + wr * 64 + fr; const int col0 = u.pn * BM + wc * 32 + 4 * fq; const float* gb = g1 + (size_t)(u.pm / tiles_per_batch) * g1_stride;
        f32x4 gv[2][2];
#pragma unroll
        for (int bj = 0; bj < 2; ++bj)
#pragma unroll
            for (int n = 0; n < 2; ++n) gv[bj][n] = *(const f32x4*)(gb + col0 + bj * HALF + n * 16);
#pragma unroll
        for (int ai = 0; ai < 2; ++ai)
#pragma unroll
            for (int m = 0; m < 4; ++m) { const size_t off = (size_t)(row0 + ai * HALF + m * 16) * 2048 + col0;
#pragma unroll
                for (int bj = 0; bj < 2; ++bj)
#pragma unroll
                    for (int n = 0; n < 2; ++n) { const f32x4 xv = *(const f32x4*)(X + off + bj * HALF + n * 16);
                        *(f32x4*)(H1 + off + bj * HALF + n * 16) = xv + gv[bj][n] * acc[ai][bj][m][n]; } }
    }
};
struct EpiSwiGLU {
    static constexpr bool PERM = true, AFTER_DRAIN = false;
    unsigned char* Y; const float* bg; const float* bu; float wscale;
    __device__ __forceinline__ void operator()(const f32x4 (&acc)[2][2][4][2], const Unit& u, int wr, int wc, int fr, int fq) const {
        const int e = u.pn >> 4, pnl = u.pn & 15; const int row0 = u.pm * BM + wr * 64 + fr; const int col0 = pnl * HALF + wc * 32 + 8 * fq;
        f32x4 bgv[2], buv[2];
#pragma unroll
        for (int n = 0; n < 2; ++n) { bgv[n] = *(const f32x4*)(bg + (size_t)e * 2048 + col0 + 4 * n); buv[n] = *(const f32x4*)(bu + (size_t)e * 2048 + col0 + 4 * n); }
#pragma unroll
        for (int ai = 0; ai < 2; ++ai)
#pragma unroll
            for (int m = 0; m < 4; ++m) { unsigned char* rowp = Y + (size_t)(row0 + ai * HALF + m * 16) * 2048 + col0; f32x4 y[2];
#pragma unroll
                for (int n = 0; n < 2; ++n) { const f32x4 g4 = acc[ai][0][m][n] * wscale + bgv[n], u4 = acc[ai][1][m][n] * wscale + buv[n];
#pragma unroll
                    for (int i = 0; i < 4; ++i) { const float g = fminf(g4[i], 7.0f), uu = fminf(fmaxf(u4[i], -7.0f), 7.0f); y[n][i] = (uu + 1.0f) * (g * sigmoidf_fast(1.702f * g)); } }
                int w0 = __builtin_amdgcn_cvt_pk_fp8_f32(y[0][0], y[0][1], 0, false); w0 = __builtin_amdgcn_cvt_pk_fp8_f32(y[0][2], y[0][3], w0, true);
                int w1 = __builtin_amdgcn_cvt_pk_fp8_f32(y[1][0], y[1][1], 0, false); w1 = __builtin_amdgcn_cvt_pk_fp8_f32(y[1][2], y[1][3], w1, true);
                typedef int v2i_t __attribute__((ext_vector_type(2))); *(v2i_t*)rowp = (v2i_t){w0, w1}; }
    }
};
struct MoeOrder {
    const PG8_LAS int* tstart; int npn, lo, hi, rank, W;
    __device__ __forceinline__ void init(const PG8_LAS int* ts, int npn_, int G, int c) { tstart = ts; npn = npn_; const int U = ts[32] * npn_; const int x = c % NXCD; rank = c / NXCD; W = G / NXCD;
        lo = (int)(((long)U * x) / NXCD); hi = (int)(((long)U * (x + 1)) / NXCD); }
    __device__ __forceinline__ bool next(int i, Unit& u) const {
        const int q = lo + rank + W * i; if (q >= hi) return false;
        int e = 0;
#pragma unroll 1
        for (int k = 1; k < 32; ++k) if (tstart[k] * npn <= q) e = k;
        const int ts = tstart[e], te = tstart[e + 1] - ts, qq = q - ts * npn;
        u.pm = ts + qq % te; u.pn = e * npn + qq / te; return true;
    }
    __device__ __forceinline__ void a_ready(const Unit&) const {}
    __device__ __forceinline__ void done(const Unit&) const {}
};
}
namespace att {
using bf16x8 = __attribute__((ext_vector_type(8))) short;
using s16x4  = __attribute__((ext_vector_type(4))) short;
using f32x16 = __attribute__((ext_vector_type(16))) float;
using u32x4  = __attribute__((ext_vector_type(4))) unsigned;
typedef unsigned short bf16;
constexpr int   D = 128, NW = 8, QBLK = 32, KVBLK = 64;
constexpr float SCALE = 0.088388347648318440f;
constexpr float THR = 8.f;
constexpr size_t SHM_V = KVBLK * D * 2, SHM_K = KVBLK * D * 2, SHM_ATTN = 2 * SHM_V + 2 * SHM_K + NW * 64 * 4;
#define KSWZ(row, colB) ((row) * 256 + ((colB) ^ (((row) & 7) << 4)))
#define SBAR() __builtin_amdgcn_sched_barrier(0)
__device__ __forceinline__ int crow(int r, int hi) { return (r & 3) + 8 * (r >> 2) + 4 * hi; }
__device__ __forceinline__ unsigned cvtpk(float lo, float hi) { unsigned r; asm volatile("v_cvt_pk_bf16_f32 %0, %1, %2" : "=v"(r) : "v"(lo), "v"(hi)); return r; }

template <int MODE>
__device__ __forceinline__ void partialSM(f32x16& p0, f32x16& p1, float& m_reg, float& mn, float& alpha, float relb, float kk, bool valid) {
  constexpr float C = SCALE * 1.4426950408889634f;
#pragma unroll
  for (int r = 0; r < 16; ++r) {
    const float d0 = relb - (float)((r & 3) + 8 * (r >> 2)), a0 = __builtin_fabsf(d0), a1 = __builtin_fabsf(d0 - 32.f);
    p0[r] = fmaf(a0, -kk, p0[r]); p1[r] = fmaf(a1, -kk, p1[r]);
    if (MODE == 1) { if (!(valid && a0 <= 64.f)) p0[r] = -INFINITY; if (!(valid && a1 <= 64.f)) p1[r] = -INFINITY; }
  }
  float pmax = p0[0];
#pragma unroll
  for (int r = 1; r < 16; ++r) pmax = fmaxf(pmax, p0[r]);
#pragma unroll
  for (int r = 0; r < 16; ++r) pmax = fmaxf(pmax, p1[r]);
  { auto rr = __builtin_amdgcn_permlane32_swap(__float_as_uint(pmax), __float_as_uint(pmax), false, false);
    pmax = fmaxf(__uint_as_float(rr[0]), __uint_as_float(rr[1])); }
  if (__builtin_expect(__all(pmax - m_reg <= THR / SCALE), 1)) { mn = m_reg; alpha = 1.f; }
  else { mn = fmaxf(m_reg, pmax); alpha = __builtin_amdgcn_exp2f((m_reg - mn) * C); m_reg = mn; }
  const float mnC = -mn * C;
#pragma unroll
  for (int r = 0; r < 16; ++r) p0[r] = fmaf(p0[r], C, mnC);
#pragma unroll
  for (int r = 0; r < 16; ++r) p1[r] = fmaf(p1[r], C, mnC);
#pragma unroll
  for (int r = 0; r < 16; ++r) p0[r] = __builtin_amdgcn_exp2f(p0[r]);
}
__device__ __forceinline__ void finishSM(f32x16& p0, f32x16& p1, float alpha, float& l_reg, bf16x8& pa0, bf16x8& pa1, bf16x8& pa2, bf16x8& pa3) {
#pragma unroll
  for (int r = 0; r < 16; ++r) p1[r] = __builtin_amdgcn_exp2f(p1[r]);
  float ps = 0;
#pragma unroll
  for (int r = 0; r < 16; ++r) ps += p0[r];
#pragma unroll
  for (int r = 0; r < 16; ++r) ps += p1[r];
  { auto rr = __builtin_amdgcn_permlane32_swap(__float_as_uint(ps), __float_as_uint(ps), false, false);
    ps = __uint_as_float(rr[0]) + __uint_as_float(rr[1]); }
  l_reg = l_reg * alpha + ps;
#define PK4(P, BASE, OUT) do { unsigned a0 = cvtpk(P[BASE + 0], P[BASE + 1]), a1 = cvtpk(P[BASE + 2], P[BASE + 3]);   \
    unsigned b0 = cvtpk(P[BASE + 4], P[BASE + 5]), b1 = cvtpk(P[BASE + 6], P[BASE + 7]);                              \
    auto r0 = __builtin_amdgcn_permlane32_swap(a0, b0, false, false); auto r1 = __builtin_amdgcn_permlane32_swap(a1, b1, false, false); \
    u32x4 w = {r0[0], r1[0], r0[1], r1[1]}; OUT = *reinterpret_cast<bf16x8*>(&w); } while (0)
  PK4(p0, 0, pa0); PK4(p0, 8, pa1); PK4(p1, 0, pa2); PK4(p1, 8, pa3);
#undef PK4
}
__device__ __forceinline__ void qkt(f32x16& p0, f32x16& p1, const bf16* Ks, const bf16x8* qr, int r32, int hi) {
  p0 = f32x16{}; p1 = f32x16{};
#pragma unroll
  for (int d0 = 0; d0 < 8; ++d0) { const int cb = (d0 * 16 + hi * 8) * 2;
    bf16x8 b0 = *reinterpret_cast<const bf16x8*>((const char*)Ks + KSWZ(r32, cb));
    bf16x8 b1 = *reinterpret_cast<const bf16x8*>((const char*)Ks + KSWZ(32 + r32, cb));
    p0 = __builtin_amdgcn_mfma_f32_32x32x16_bf16(b0, qr[d0], p0, 0, 0, 0);
    p1 = __builtin_amdgcn_mfma_f32_32x32x16_bf16(b1, qr[d0], p1, 0, 0, 0); }
}
__device__ __forceinline__ int v_st(int k, int c) { const int kk = (k & ~0xC) | ((k & 4) << 1) | ((k & 8) >> 1); return ((kk >> 3) * 4 + (c >> 5)) * 512 + ((kk & 7) * 32 + (c & 31)) * 2; }
__device__ __forceinline__ int v_rd_base(int lane) { return ((lane & 3) << 3) | (((lane >> 2) & 3) << 6) | (((lane >> 4) & 1) << 5) | (((lane >> 5) & 1) << 8); }
constexpr int v_rd_off(int d0, int ks, int half) { return d0 * 512 + ks * 4096 + half * 2048; }
template <int OFF> __device__ __forceinline__ s16x4 tr_read(int vb) {
  s16x4 r; asm volatile("ds_read_b64_tr_b16 %0, %1 offset:%2" : "=&v"(r) : "v"(vb), "i"(OFF) : "memory"); return r;
}
template <int D0> __device__ __forceinline__ void pv_one(f32x16& od, int vb, bf16x8 pa0, bf16x8 pa1, bf16x8 pa2, bf16x8 pa3) {
  const s16x4 l0 = tr_read<v_rd_off(D0, 0, 0)>(vb), h0 = tr_read<v_rd_off(D0, 0, 1)>(vb), l1 = tr_read<v_rd_off(D0, 1, 0)>(vb), h1 = tr_read<v_rd_off(D0, 1, 1)>(vb);
  const s16x4 l2 = tr_read<v_rd_off(D0, 2, 0)>(vb), h2 = tr_read<v_rd_off(D0, 2, 1)>(vb), l3 = tr_read<v_rd_off(D0, 3, 0)>(vb), h3 = tr_read<v_rd_off(D0, 3, 1)>(vb);
  asm volatile("s_waitcnt lgkmcnt(0)" ::: "memory"); SBAR();
#define PK(L, H) (bf16x8){L[0], L[1], L[2], L[3], H[0], H[1], H[2], H[3]}
  od = __builtin_amdgcn_mfma_f32_32x32x16_bf16(pa0, PK(l0, h0), od, 0, 0, 0);
  od = __builtin_amdgcn_mfma_f32_32x32x16_bf16(pa1, PK(l1, h1), od, 0, 0, 0);
  od = __builtin_amdgcn_mfma_f32_32x32x16_bf16(pa2, PK(l2, h2), od, 0, 0, 0);
  od = __builtin_amdgcn_mfma_f32_32x32x16_bf16(pa3, PK(l3, h3), od, 0, 0, 0);
#undef PK
}
__device__ __forceinline__ void pv_d0(f32x16* o, int vb, bf16x8 pa0, bf16x8 pa1, bf16x8 pa2, bf16x8 pa3) {
  pv_one<0>(o[0], vb, pa0, pa1, pa2, pa3); pv_one<1>(o[1], vb, pa0, pa1, pa2, pa3); pv_one<2>(o[2], vb, pa0, pa1, pa2, pa3); pv_one<3>(o[3], vb, pa0, pa1, pa2, pa3);
}

template <int MODE>
__device__ __forceinline__ void attn_body(const bf16* __restrict__ Qb, long ldq, const bf16* __restrict__ Kh, const bf16* __restrict__ Vh, long ldk,
                                          int t0, int NT, int ntmax, int qpos0, float kk, float* __restrict__ Ob, long ldo, float* __restrict__ Lb, long ldl, char* lds) {
  const int tid = threadIdx.x, wid = tid >> 6, lane = tid & 63, r32 = lane & 31, hi = lane >> 5;
  bf16* V_lds = (bf16*)lds; bf16* K_lds = (bf16*)(lds + 2 * SHM_V);
  float* ws = (float*)(lds + 2 * SHM_V + 2 * SHM_K) + wid * 64; float* li_l = ws; float* al_l = ws + 32;
  float m_reg = -1e30f, l_reg = 0; f32x16 o[4] = {}; bf16x8 qr[8];
  const bf16* Qw = Qb + (long)(wid * QBLK + r32) * ldq + hi * 8;
#pragma unroll
  for (int d0 = 0; d0 < 8; ++d0) qr[d0] = *reinterpret_cast<const bf16x8*>(Qw + d0 * 16);
  const int sr = tid >> 4, sc = (tid & 15) * 8, vst0 = v_st(sr, sc), vst1 = v_st(32 + sr, sc);
  const int vb0 = (int)(uintptr_t)V_lds + v_rd_base(lane);
  const unsigned so0 = (unsigned)(sr * (int)ldk + sc), so1 = so0 + 32u * (unsigned)ldk;
  const float qposf = (float)(qpos0 + wid * QBLK + r32 - 4 * hi);
  struct { bf16x8 vs0, vs1, ks0, ks1; } sr_[2];
#define TCL(jt) ({ int _t = t0 + (jt); _t = _t < 0 ? 0 : (_t >= ntmax ? ntmax - 1 : _t); _t * KVBLK; })
#define TVALID(jt) ((t0 + (jt)) >= 0 && (t0 + (jt)) < ntmax)
#define RELB(jt) (qposf - (float)((t0 + (jt)) * KVBLK))
#define SLOAD(i, jt) do { const long _k0 = (long)TCL(jt) * ldk; const bf16* _vp = Vh + _k0; const bf16* _kp = Kh + _k0; \
    sr_[i].vs0 = *reinterpret_cast<const bf16x8*>(_vp + so0); sr_[i].vs1 = *reinterpret_cast<const bf16x8*>(_vp + so1); \
    sr_[i].ks0 = *reinterpret_cast<const bf16x8*>(_kp + so0); sr_[i].ks1 = *reinterpret_cast<const bf16x8*>(_kp + so1); } while (0)
#define SWRITE(b, i) do { *(bf16x8*)((char*)V_lds + (b) * SHM_V + vst0) = sr_[i].vs0;          \
    *(bf16x8*)((char*)V_lds + (b) * SHM_V + vst1) = sr_[i].vs1; const int kc = sc * 2;               \
    *(bf16x8*)((char*)K_lds + (b) * SHM_K + KSWZ(sr, kc)) = sr_[i].ks0;                       \
    *(bf16x8*)((char*)K_lds + (b) * SHM_K + KSWZ(32 + sr, kc)) = sr_[i].ks1; } while (0)
#define SWAIT() asm volatile("s_waitcnt vmcnt(4)" ::: "memory")
#define RESC(a) do { if (__any((a) < 1.f)) { if (hi == 0) al_l[r32] = (a); asm volatile("s_waitcnt lgkmcnt(0)" ::: "memory"); \
    _Pragma("unroll") for (int d = 0; d < 4; ++d) _Pragma("unroll") for (int r = 0; r < 16; ++r) o[d][r] *= al_l[crow(r, hi)]; } } while (0)
  f32x16 pA0, pA1, pB0, pB1; float mnA, mnB, alA, alB; bf16x8 pa0, pa1, pa2, pa3;
  constexpr int SE = 0, SO = 1;
  SLOAD(SE, 0); asm volatile("s_waitcnt vmcnt(0)" ::: "memory"); SWRITE(0, SE); __syncthreads();
  qkt(pA0, pA1, K_lds, qr, r32, hi); partialSM<MODE>(pA0, pA1, m_reg, mnA, alA, RELB(0), kk, TVALID(0));
  SLOAD(SO, 1); if (2 < NT) SLOAD(SE, 2);
  SWAIT(); SWRITE(1, SO); __syncthreads();
  for (int j = 1; j + 1 < NT; j += 2) {
    SBAR(); qkt(pB0, pB1, (bf16*)((char*)K_lds + SHM_K), qr, r32, hi);
    finishSM(pA0, pA1, alA, l_reg, pa0, pa1, pa2, pa3); SBAR();
    SLOAD(SO, j + 2); SBAR();
    pv_d0(o, vb0, pa0, pa1, pa2, pa3); partialSM<MODE>(pB0, pB1, m_reg, mnB, alB, RELB(j), kk, TVALID(j));
    __syncthreads(); SWAIT(); SWRITE(0, SE);
    RESC(alB); __syncthreads();
    SBAR(); qkt(pA0, pA1, K_lds, qr, r32, hi);
    finishSM(pB0, pB1, alB, l_reg, pa0, pa1, pa2, pa3); SBAR();
    if (j + 3 < NT) SLOAD(SE, j + 3); SBAR();
    pv_d0(o, vb0 + (int)SHM_V, pa0, pa1, pa2, pa3); partialSM<MODE>(pA0, pA1, m_reg, mnA, alA, RELB(j + 1), kk, TVALID(j + 1));
    __syncthreads(); SWAIT(); SWRITE(1, SO);
    RESC(alA); __syncthreads();
  }
  SBAR(); qkt(pB0, pB1, (bf16*)((char*)K_lds + SHM_K), qr, r32, hi);
  finishSM(pA0, pA1, alA, l_reg, pa0, pa1, pa2, pa3); SBAR();
  pv_d0(o, vb0, pa0, pa1, pa2, pa3); partialSM<MODE>(pB0, pB1, m_reg, mnB, alB, RELB(NT - 1), kk, TVALID(NT - 1));
  __syncthreads(); RESC(alB);
  finishSM(pB0, pB1, alB, l_reg, pa0, pa1, pa2, pa3); SBAR();
  pv_d0(o, vb0 + (int)SHM_V, pa0, pa1, pa2, pa3);
  if (hi == 0) li_l[r32] = l_reg; asm volatile("s_waitcnt lgkmcnt(0)" ::: "memory");
  float rli[16];
#pragma unroll
  for (int r = 0; r < 16; ++r) rli[r] = __builtin_amdgcn_rcpf(li_l[crow(r, hi)]);
  int hie = hi; asm volatile("" : "+v"(hie));
  float* Ow = Ob + (long)(wid * QBLK + 4 * hie) * ldo + r32;
#pragma unroll
  for (int r = 0; r < 16; ++r) { float* Or = Ow + (long)((r & 3) + 8 * (r >> 2)) * ldo;
#pragma unroll
    for (int d0 = 0; d0 < 4; ++d0) Or[d0 * 32] = o[d0][r] * rli[r]; }
  if (Lb != nullptr && hi == 0) Lb[(long)(wid * QBLK + r32) * ldl] = m_reg * SCALE + __logf(l_reg);
  __syncthreads();
#undef TCL
#undef TVALID
#undef RELB
#undef SLOAD
#undef SWRITE
#undef SWAIT
#undef RESC
}
#undef KSWZ
#undef SBAR
}
constexpr int NWAVES = 8;
#ifndef MK_SPLIT
#define MK_SPLIT 0
#endif
#ifndef DBG_ORACLE
#define DBG_ORACLE 0
#endif
constexpr int N_PHASES = 12;

constexpr int DM = 2048, BATCH = 2, SEQ = 4096, T = BATCH * SEQ;
constexpr int NQKV = 10240;
constexpr int C_QA = 0, C_KA = 1024, C_VA = 2048, C_QB = 3072, C_KB = 4096, C_VB = 5120, C_GA = 6144, C_GB = 8192;
constexpr int NE = 32, TOPK = 4, TK = T * TOPK, TKPAD = TK + NE * 256;
constexpr float EPS = 1e-5f;
constexpr float LAMBDA_INIT = 0.2f;

constexpr size_t MiB = 1u << 20;
constexpr size_t WS_CTL = 0, CTL_ZERO_BYTES = 1 * MiB;
constexpr size_t WS_MOD = 1 * MiB;
constexpr size_t WS_RC = 1 * MiB + 512 * 1024;
constexpr size_t WS_TOPI = 2 * MiB;
constexpr size_t WS_TOPP = 2 * MiB + 256 * 1024;
constexpr size_t WS_POS = 2 * MiB + 512 * 1024;
constexpr size_t WS_ERR = 3 * MiB;
constexpr size_t WS_WINT = 4 * MiB;
constexpr size_t WS_WAT = 44 * MiB;
constexpr size_t WS_WBT = 48 * MiB;
constexpr size_t WS_WOT = 52 * MiB;
constexpr size_t WS_U = 64 * MiB;
constexpr size_t WS_QKV = 96 * MiB;
constexpr size_t WS_OA = 256 * MiB;
constexpr size_t WS_OB = 352 * MiB;
constexpr size_t WS_LSE = 416 * MiB;
constexpr size_t WS_YA = 418 * MiB;
constexpr size_t WS_YB = 434 * MiB;
constexpr size_t WS_M1 = 450 * MiB;
constexpr size_t WS_MG = 514 * MiB;
constexpr size_t WS_H1 = 546 * MiB;
constexpr size_t WS_XS = 610 * MiB;
constexpr size_t WS_YACT = 770 * MiB;
constexpr size_t WS_YSLOT = 930 * MiB;
constexpr size_t WS_WGU = 1090 * MiB;
constexpr size_t WS_WD = 1602 * MiB;
constexpr size_t WS_END = 1858 * MiB;
constexpr int CW_TMO = 0, CW_CODE = 1;
constexpr int CW_BAR = 4096;
constexpr int CW_CNT = 8192;

constexpr int RING_OFF = 0, RING_BYTES = 131072;
constexpr int LDSCTL_OFF = 139264, MISC_OFF = LDSCTL_OFF + 320;
constexpr int TST_OFF = LDSCTL_OFF + 1024;
constexpr int LDS_BYTES = 147456;

#define GAS __attribute__((address_space(1)))
#define LAS __attribute__((address_space(3)))
typedef unsigned short bf16;
typedef unsigned v4u __attribute__((ext_vector_type(4)));
typedef unsigned v2u __attribute__((ext_vector_type(2)));
typedef float f32x4 __attribute__((ext_vector_type(4)));
typedef GAS unsigned gu32;
#define RLX_AGENT __ATOMIC_RELAXED, __HIP_MEMORY_SCOPE_AGENT
#define LDS_WAIT() asm volatile("s_waitcnt lgkmcnt(0)" ::: "memory")
#define VM_WAIT() asm volatile("s_waitcnt vmcnt(0)" ::: "memory")
__device__ __forceinline__ unsigned f2bf(float f) { unsigned u = __builtin_bit_cast(unsigned, f); return (u + 0x7fffu + ((u >> 16) & 1u)) >> 16; }
__device__ __forceinline__ unsigned pk2(float lo, float hi) { return f2bf(lo) | (f2bf(hi) << 16); }
__device__ __forceinline__ float bf2f(unsigned short h) { return __uint_as_float(((unsigned)h) << 16); }
__device__ __forceinline__ float wave_sum(float v) {
#pragma unroll
    for (int o = 1; o < 64; o <<= 1) v += __shfl_xor(v, o);
    return v;
}
__device__ __forceinline__ float wave_max(float v) {
#pragma unroll
    for (int o = 1; o < 64; o <<= 1) v = fmaxf(v, __shfl_xor(v, o));
    return v;
}
__device__ __forceinline__ float siluf(float x) { return x / (1.0f + __expf(-x)); }
#define XB_TMO      128
#define XB_XCNT(j)  (256  + 64 * (j))
#define XB_XSUB(j)  (1280 + 64 * (j))
#define XB_XGEN(j)  (2304 + 64 * (j))
#define XB_TOP      3328
#define XB_TOPGEN   3392
#define XCD_BAR_WORDS 3456
#define XB_SPIN_CAP (1u << 18)

__device__ __forceinline__ unsigned xb_ld(unsigned* p)              { return __hip_atomic_load(p, __ATOMIC_RELAXED, __HIP_MEMORY_SCOPE_AGENT); }
__device__ __forceinline__ unsigned xb_add(unsigned* p, unsigned v) { return __hip_atomic_fetch_add(p, v, __ATOMIC_RELAXED, __HIP_MEMORY_SCOPE_AGENT); }
__device__ __forceinline__ unsigned xb_xcc_id() { return (unsigned)__builtin_amdgcn_s_getreg((3 << 11) | 20) & 0xFu; }
#define XB_SPIN(cond, bar) do { unsigned _sp = 0; while (cond) { __builtin_amdgcn_s_sleep(1); \
    if ((++_sp & 255u) == 0u) { if (xb_ld(&(bar)[XB_TMO])) break; if (_sp > XB_SPIN_CAP) { atomicAdd(&(bar)[XB_TMO], 1u); break; } } } } while (0)

struct XcdBarrier {
    unsigned* bar; unsigned x;
    volatile LAS unsigned* st;
};

__device__ __forceinline__ XcdBarrier xcd_barrier_post(unsigned* bar, volatile LAS unsigned* st) {
    XcdBarrier b; b.bar = bar; b.x = xb_xcc_id(); b.st = st;
    if (threadIdx.x == 0) (void)xb_add(&bar[XB_XCNT(b.x)], 1u);
    return b;
}
__device__ __forceinline__ void xcd_barrier_complete(unsigned* bar, unsigned x, unsigned& nloc, unsigned& nx) {
    const unsigned G = gridDim.x * gridDim.y * gridDim.z;
    unsigned sum, cnt, mine, sp = 0u;
    for (;;) {
        sum = 0u; cnt = 0u; mine = 0u;
#pragma unroll
        for (unsigned j = 0; j < 16; ++j) { const unsigned c = xb_ld(&bar[XB_XCNT(j)]); sum += c; cnt += (c > 0u) ? 1u : 0u; mine = (j == x) ? c : mine; }
        if (sum == G) break;
        __builtin_amdgcn_s_sleep(1);
        if ((++sp & 255u) == 0u) { if (xb_ld(&bar[XB_TMO])) break; if (sp > XB_SPIN_CAP) { atomicAdd(&bar[XB_TMO], 1u); break; } }
    }
    nloc = mine > 0u ? mine : 1u; nx = cnt > 0u ? cnt : 1u;
}

__device__ __forceinline__ void xcd_barrier(const XcdBarrier& b) {
    asm volatile("s_waitcnt vmcnt(0)" ::: "memory");
    __syncthreads();
    if (threadIdx.x == 0) {
        unsigned* bar = b.bar;
        __builtin_amdgcn_s_waitcnt(0);
        unsigned nloc = b.st[0], nx = b.st[1];
        if (nloc == 0u) { xcd_barrier_complete(bar, b.x, nloc, nx); b.st[0] = nloc; b.st[1] = nx; }
        const unsigned old = xb_add(&bar[XB_XSUB(b.x)], 1u);
        const unsigned gen = old / nloc;
        if (old + 1u == (gen + 1u) * nloc) {
            __builtin_amdgcn_fence(__ATOMIC_RELEASE, "agent");
            asm volatile("s_waitcnt vmcnt(0)" ::: "memory");
            const unsigned og = xb_add(&bar[XB_TOP], 1u);
            const unsigned tg = og / nx;
            if (og + 1u == (tg + 1u) * nx) xb_add(&bar[XB_TOPGEN], 1u);
            else XB_SPIN(xb_ld(&bar[XB_TOPGEN]) == tg, bar);
            __builtin_amdgcn_fence(__ATOMIC_ACQUIRE, "agent");
            xb_add(&bar[XB_XGEN(b.x)], 1u);
            asm volatile("s_waitcnt vmcnt(0)" ::: "memory");
        } else {
            XB_SPIN(xb_ld(&bar[XB_XGEN(b.x)]) == gen, bar);
            __builtin_amdgcn_fence(__ATOMIC_ACQUIRE, "agent");
            asm volatile("s_waitcnt vmcnt(0)" ::: "memory");
        }
    }
    __syncthreads();
}
struct Args { const float* in[24]; float* out; unsigned char* ws; int ph_lo, ph_hi; };
enum { I_X = 0, I_C, I_WADA, I_BADA, I_N1G, I_WIN, I_LQ1, I_LK1, I_LQ2, I_LK2, I_SUBG, I_WOA, I_WOB, I_WO, I_N2G, I_WR, I_BR, I_WG, I_BG, I_WU, I_BU, I_WDN, I_BDN, I_FG };
struct Frame {
    LAS unsigned char* lds; char* ldsg;
    volatile LAS unsigned* MISC;
    gu32* ctl;
    int tid, lane, wave, vcu, G;
    unsigned char* ws;
};
#define WSP(T_, off) ((T_*)(F.ws + (off)))

constexpr float WSCALE = 64.0f;
__device__ __forceinline__ unsigned cvtpk_bf(float lo, float hi) { unsigned r; asm volatile("v_cvt_pk_bf16_f32 %0, %1, %2" : "=v"(r) : "v"(lo), "v"(hi)); return r; }
__device__ __forceinline__ void cvt_load(f32x4 (&v)[8], const float* __restrict__ W, int N, int k0, int n0, int lane) {
    const int lr = lane >> 3, lc = 4 * (lane & 7);
#pragma unroll
    for (int i = 0; i < 8; ++i) v[i] = __builtin_nontemporal_load((const f32x4*)(W + (size_t)(k0 + lr + 8 * i) * N + n0 + lc));
}
template <bool F8>
__device__ __forceinline__ void cvt_store(const f32x4 (&v)[8], int K, void* __restrict__ WT, int k0, long dst_row0, LAS float* scr, int lane) {
    const int lr = lane >> 3, lc = 4 * (lane & 7);
#pragma unroll
    for (int i = 0; i < 8; ++i) { LAS float* s = scr + (lr + 8 * i) * 33 + lc; s[0] = v[i].x; s[1] = v[i].y; s[2] = v[i].z; s[3] = v[i].w; }
    LDS_WAIT(); asm volatile("" ::: "memory");
    const int c = lane & 7;
#pragma unroll
    for (int j = 0; j < 4; ++j) { const int n = (lane >> 3) + 8 * j; const LAS float* s = scr + (8 * c) * 33 + n;
        if constexpr (F8) {
            int w0 = __builtin_amdgcn_cvt_pk_fp8_f32(s[0 * 33] * WSCALE, s[1 * 33] * WSCALE, 0, false); w0 = __builtin_amdgcn_cvt_pk_fp8_f32(s[2 * 33] * WSCALE, s[3 * 33] * WSCALE, w0, true);
            int w1 = __builtin_amdgcn_cvt_pk_fp8_f32(s[4 * 33] * WSCALE, s[5 * 33] * WSCALE, 0, false); w1 = __builtin_amdgcn_cvt_pk_fp8_f32(s[6 * 33] * WSCALE, s[7 * 33] * WSCALE, w1, true);
            *(v2u*)((unsigned char*)WT + (size_t)(dst_row0 + n) * K + k0 + 8 * c) = (v2u){(unsigned)w0, (unsigned)w1};
        } else {
            v4u o; o.x = cvtpk_bf(s[0 * 33], s[1 * 33]); o.y = cvtpk_bf(s[2 * 33], s[3 * 33]); o.z = cvtpk_bf(s[4 * 33], s[5 * 33]); o.w = cvtpk_bf(s[6 * 33], s[7 * 33]);
            *(v4u*)((bf16*)WT + (size_t)(dst_row0 + n) * K + k0 + 8 * c) = o; } }
    LDS_WAIT(); asm volatile("" ::: "memory");
}
__device__ __forceinline__ void cvt8_load(f32x4 (&v)[16], const float* __restrict__ W, int k0, int n0, int lane) {
    const float* p = W + (size_t)(k0 + (lane >> 3)) * DM + n0 + 4 * (lane & 7);
#pragma unroll
    for (int i = 0; i < 16; ++i) v[i] = __builtin_nontemporal_load((const f32x4*)(p + (size_t)(8 * i) * DM));
}
__device__ __forceinline__ void cvt8_store(const f32x4 (&v)[16], unsigned char* __restrict__ WT, int k0, long dst_row0, LAS float* scr, int lane) {
    const int lr = lane >> 3, lc = 4 * (lane & 7);
#pragma unroll
    for (int i = 0; i < 16; ++i) { LAS float* s = scr + (lr + 8 * i) * 33 + ((lc + 4 * (i >> 1)) & 31);
        s[0] = v[i].x; s[1] = v[i].y; s[2] = v[i].z; s[3] = v[i].w; }
    LDS_WAIT(); asm volatile("" ::: "memory");
    const int c = lane & 7;
#pragma unroll
    for (int j = 0; j < 4; ++j) { const int n = (lane >> 3) + 8 * j; const LAS float* s = scr + (16 * c) * 33 + ((n + 4 * c) & 31);
        v4u o;
#pragma unroll
        for (int h = 0; h < 4; ++h) { int w = __builtin_amdgcn_cvt_pk_fp8_f32(s[(4 * h + 0) * 33] * WSCALE, s[(4 * h + 1) * 33] * WSCALE, 0, false);
            w = __builtin_amdgcn_cvt_pk_fp8_f32(s[(4 * h + 2) * 33] * WSCALE, s[(4 * h + 3) * 33] * WSCALE, w, true); o[h] = (unsigned)w; }
        *(v4u*)(WT + (size_t)(dst_row0 + n) * DM + k0 + 16 * c) = o; }
    LDS_WAIT(); asm volatile("" ::: "memory");
}
__device__ __forceinline__ void p0_mod(Frame& F, const Args& A) {
    LAS float* red = (LAS float*)F.lds;
    if (F.vcu < 192) {
        const int col = F.vcu * 64 + F.lane, k0 = F.wave * 256;
        const float* wp = A.in[I_WADA] + (size_t)k0 * 12288 + col; const float* cp = A.in[I_C];
        float a0 = 0.f, a1 = 0.f;
#pragma unroll 16
        for (int k = 0; k < 256; ++k) { const float wv = __builtin_nontemporal_load(wp + (size_t)k * 12288); a0 = fmaf(siluf(cp[k0 + k]), wv, a0); a1 = fmaf(siluf(cp[2048 + k0 + k]), wv, a1); }
        red[(F.wave * 2 + 0) * 64 + F.lane] = a0; red[(F.wave * 2 + 1) * 64 + F.lane] = a1;
    }
    __syncthreads();
    if (F.vcu < 192 && F.tid < 128) { const int b = F.tid >> 6, l = F.tid & 63; float s = 0.f;
#pragma unroll
        for (int w = 0; w < 8; ++w) s += red[(w * 2 + b) * 64 + l];
        const int col = F.vcu * 64 + l; WSP(float, WS_MOD)[b * 12288 + col] = s + A.in[I_BADA][col]; }
    __syncthreads();
}
__device__ __forceinline__ void p0_convert(Frame& F, const Args& A) {
    LAS float* scr = (LAS float*)(F.lds + F.wave * 16384);
    const int gw = F.vcu * NWAVES + F.wave, NGW = F.G * NWAVES;
    constexpr int I_IN = 32 * 320, I_A = 16 * 64, I_B = 16 * 64, I_O = 32 * 64, NSMALL = I_IN + I_A + I_B + I_O;
    f32x4 v0[8];
#pragma unroll 1
    for (int it = gw; it < NSMALL; it += NGW) { int r = it; const float* W; bf16* WT; int N, K;
        if (r < I_IN) { W = A.in[I_WIN]; WT = WSP(bf16, WS_WINT); N = NQKV; K = DM; }
        else if ((r -= I_IN) < I_A) { W = A.in[I_WOA]; WT = WSP(bf16, WS_WAT); N = DM; K = 1024; }
        else if ((r -= I_A) < I_B) { W = A.in[I_WOB]; WT = WSP(bf16, WS_WBT); N = DM; K = 1024; }
        else { r -= I_B; W = A.in[I_WO]; WT = WSP(bf16, WS_WOT); N = DM; K = DM; }
        const int nnb = N / 32, k0 = (r / nnb) * 64, n0 = (r % nnb) * 32;
        cvt_load(v0, W, N, k0, n0, F.lane); cvt_store<false>(v0, K, WT, k0, n0, scr, F.lane); }
}
__device__ __forceinline__ void convert_experts(Frame& F, const Args& A) {
    int lane_ = F.lane, wave_ = F.wave; asm volatile("" : "+v"(lane_), "+s"(wave_));
    LAS float* scr8 = (LAS float*)(F.lds + wave_ * 16896);
    const int gw = F.vcu * NWAVES + wave_, NGW = F.G * NWAVES; constexpr int NIT = 96 * 1024;
    f32x4 va[16], vb[16];
    const float* pg_ = A.in[I_WG]; const float* pu_ = A.in[I_WU]; const float* pd_ = A.in[I_WDN];
    asm volatile("" : "+s"(pg_), "+s"(pu_), "+s"(pd_));
#define CV_LOAD(buf, it_) do { if ((it_) < NIT) { const int m_ = (it_) >> 10, tp_ = (it_) & 1023, e_ = m_ / 3, w_ = m_ % 3; const float* W_ = (w_ == 0 ? pg_ : (w_ == 1 ? pu_ : pd_)) + (size_t)e_ * DM * DM; \
        cvt8_load(buf, W_, (tp_ >> 6) * 128, (tp_ & 63) * 32, lane_); } } while (0)
#define CV_STORE(buf, it_) do { if ((it_) < NIT) { const int m_ = (it_) >> 10, tp_ = (it_) & 1023, e_ = m_ / 3, w_ = m_ % 3, k0_ = (tp_ >> 6) * 128, n0_ = (tp_ & 63) * 32; \
        if (w_ == 2) cvt8_store(buf, WSP(unsigned char, WS_WD), k0_, (long)e_ * 2048 + n0_, scr8, lane_); \
        else cvt8_store(buf, WSP(unsigned char, WS_WGU), k0_, (long)e_ * 4096 + (long)(n0_ >> 7) * 256 + (n0_ & 127) + (w_ == 1 ? 128 : 0), scr8, lane_); } } while (0)
    __syncthreads();
#if defined(PROBE_RO2)
#pragma unroll 1
    for (int it = gw; it < NIT; it += 2 * NGW) { CV_LOAD(va, it); CV_LOAD(vb, it + NGW);
#pragma unroll
        for (int q = 0; q < 16; ++q) asm volatile("" :: "v"(va[q]), "v"(vb[q])); }
#endif
    CV_LOAD(va, gw);
#pragma unroll 1
    for (int it = gw; it < NIT; it += 2 * NGW) {
        CV_LOAD(vb, it + NGW); CV_STORE(va, it);
        CV_LOAD(va, it + 2 * NGW); CV_STORE(vb, it + NGW);
    }
#undef CV_LOAD
#undef CV_STORE
    __syncthreads();
}
__device__ __forceinline__ void p1_modulate(Frame& F, const Args& A) {
    const int gw = F.vcu * NWAVES + F.wave, NGW = F.G * NWAVES; const float* MOD = WSP(float, WS_MOD);
    if (gw < 64) { const int b = gw >> 5, e = gw & 31; float s = 0.f;
        for (int k = F.lane; k < DM; k += 64) s = fmaf(MOD[b * 12288 + 3 * DM + k], A.in[I_WR][k * 32 + e], s);
        s = wave_sum(s); if (F.lane == 0) WSP(float, WS_RC)[b * 32 + e] = s + A.in[I_BR][e]; }
    for (int m = gw; m < T; m += NGW) {
        const int b = m / SEQ; const float* xr = A.in[I_X] + (size_t)m * DM + 4 * F.lane; f32x4 v[8]; float s = 0.f;
#pragma unroll
        for (int j = 0; j < 8; ++j) { v[j] = *(const f32x4*)(xr + 256 * j); s += (v[j].x * v[j].x + v[j].y * v[j].y) + (v[j].z * v[j].z + v[j].w * v[j].w); }
        const float rstd = 1.0f / sqrtf(wave_sum(s) * (1.0f / DM) + EPS);
        bf16* ur = WSP(bf16, WS_U) + (size_t)m * DM + 4 * F.lane;
#pragma unroll
        for (int j = 0; j < 8; ++j) { const int k = 4 * F.lane + 256 * j;
            const f32x4 g = *(const f32x4*)(A.in[I_N1G] + k), sc = *(const f32x4*)(MOD + b * 12288 + 1 * DM + k), sh = *(const f32x4*)(MOD + b * 12288 + k);
            const f32x4 u = v[j] * rstd * g * (sc + 1.0f) + sh; v2u o; o.x = pk2(u.x, u.y); o.y = pk2(u.z, u.w); *(v2u*)(ur + 256 * j) = o; }
    }
}
__device__ __forceinline__ void p3_attention(Frame& F, const Args& A) {
    const bf16* QKV = WSP(bf16, WS_QKV);
    const int nsteps = (1280 + F.G - 1) / F.G, grp = (F.vcu >> 3) & 3;
    const int cstep = grp == 0 ? 0 : (grp == 1 ? 1 : (grp == 2 ? 2 : nsteps));
#pragma unroll 1
    for (int step = 0; step <= nsteps; ++step) {
        if (step == (cstep < nsteps ? cstep : nsteps)) convert_experts(F, A);
        const int i = F.vcu + step * F.G;
        if (step == nsteps || i >= 1280) continue;
        if (i < 512) {
            const int c2 = i >> 5, b = c2 >> 3, h = (c2 >> 1) & 3, c = c2 & 1, vh = (i >> 4) & 1, qb = i & 15;
            const size_t rowb = (size_t)b * SEQ;
            const bf16* Qb = QKV + (rowb + qb * 256) * NQKV + C_QB + h * 256 + c * 128;
            const bf16* Kh = QKV + rowb * NQKV + C_KB + h * 256 + c * 128;
            const bf16* Vh = QKV + rowb * NQKV + C_VB + h * 256 + vh * 128;
            float* Ob = WSP(float, WS_OB) + ((size_t)c * T + rowb + qb * 256) * 1024 + h * 256 + vh * 128;
            const float slope = exp2f(-(float)(8 + h + 1) * (8.0f / 12.0f));
            att::attn_body<0>(Qb, NQKV, Kh, Vh, NQKV, 0, SEQ / 64, SEQ / 64, qb * 256, slope / att::SCALE, Ob, 1024, nullptr, 0, F.ldsg);
        } else {
            const int j = i - 512, p = j >> 8, r = j & 255, b = r >> 7, h = (r >> 4) & 7, uu = r & 15;
            const int dil = p == 0 ? 1 : (p == 1 ? 4 : 16), L = SEQ / dil, gpr = L / 256, res = uu / gpr, g = uu % gpr;
            const size_t rowb = (size_t)b * SEQ + res;
            const bf16* Qb = QKV + (rowb + (size_t)g * 256 * dil) * NQKV + C_QA + h * 128;
            const bf16* Kh = QKV + rowb * NQKV + C_KA + h * 128;
            const bf16* Vh = QKV + rowb * NQKV + C_VA + h * 128;
            float* Ob = WSP(float, WS_OA) + ((size_t)p * T + rowb + (size_t)g * 256 * dil) * 1024 + h * 128;
            float* Lb = WSP(float, WS_LSE) + ((size_t)p * T + rowb + (size_t)g * 256 * dil) * 8 + h;
            const float slope = exp2f(-(float)(h + 1) * (8.0f / 12.0f)) * (float)dil;
            att::attn_body<1>(Qb, (long)dil * NQKV, Kh, Vh, (long)dil * NQKV, 4 * g - 1, 6, L / 64, g * 256, slope / att::SCALE, Ob, (long)dil * 1024, Lb, (long)dil * 8, F.ldsg);
        }
    }
}
__device__ __forceinline__ void p4_finalize(Frame& F, const Args& A) {
    const int gw = F.vcu * NWAVES + F.wave, NGW = F.G * NWAVES;
    float s1 = A.in[I_LQ1][F.lane] * A.in[I_LK1][F.lane] + A.in[I_LQ1][F.lane + 64] * A.in[I_LK1][F.lane + 64];
    float s2 = A.in[I_LQ2][F.lane] * A.in[I_LK2][F.lane] + A.in[I_LQ2][F.lane + 64] * A.in[I_LK2][F.lane + 64];
    s1 = wave_sum(s1); s2 = wave_sum(s2);
    const float lam = expf(s1) - expf(s2) + LAMBDA_INIT;
    const float* OA = WSP(float, WS_OA); const float* OB = WSP(float, WS_OB); const float* LS = WSP(float, WS_LSE);
    for (int m = gw; m < T; m += NGW) {
        { const int h = F.lane >> 3; const float l0 = LS[((size_t)0 * T + m) * 8 + h], l1 = LS[((size_t)1 * T + m) * 8 + h], l2 = LS[((size_t)2 * T + m) * 8 + h];
          const float mx = fmaxf(l0, fmaxf(l1, l2)); float w0 = __expf(l0 - mx), w1 = __expf(l1 - mx), w2 = __expf(l2 - mx); const float inv = 1.0f / (w0 + w1 + w2); w0 *= inv; w1 *= inv; w2 *= inv;
          const size_t o = (size_t)m * 1024 + 16 * F.lane; unsigned pk[8];
#pragma unroll
          for (int q = 0; q < 4; ++q) { const f32x4 a0 = *(const f32x4*)(OA + o + 4 * q), a1 = *(const f32x4*)(OA + (size_t)T * 1024 + o + 4 * q), a2 = *(const f32x4*)(OA + (size_t)2 * T * 1024 + o + 4 * q);
              const f32x4 y = a0 * w0 + a1 * w1 + a2 * w2; pk[2 * q] = pk2(y.x, y.y); pk[2 * q + 1] = pk2(y.z, y.w); }
          bf16* ya = WSP(bf16, WS_YA) + o; *(v4u*)ya = (v4u){pk[0], pk[1], pk[2], pk[3]}; *(v4u*)(ya + 8) = (v4u){pk[4], pk[5], pk[6], pk[7]}; }
#pragma unroll
        for (int h = 0; h < 4; ++h) { const size_t o = (size_t)m * 1024 + h * 256 + 4 * F.lane;
            const f32x4 v = *(const f32x4*)(OB + o) - *(const f32x4*)(OB + (size_t)T * 1024 + o) * lam;
            const float ss = wave_sum((v.x * v.x + v.y * v.y) + (v.z * v.z + v.w * v.w)); const float rstd = 1.0f / sqrtf(ss * (1.0f / 256.0f) + EPS);
            const f32x4 g = *(const f32x4*)(A.in[I_SUBG] + 4 * F.lane); const f32x4 y = v * rstd * g * (1.0f - LAMBDA_INIT);
            v2u w; w.x = pk2(y.x, y.y); w.y = pk2(y.z, y.w); *(v2u*)(WSP(bf16, WS_YB) + o) = w; }
    }
}
typedef float f32x16r __attribute__((ext_vector_type(16)));
__device__ __forceinline__ void p7_router(Frame& F, const Args& A, bool commit = true) {
    LAS float* gainL = (LAS float*)F.lds;
    LAS float* shiftL = gainL + 2048;
    LAS float* part = shiftL + 2048;
    LAS float* ssp = part + 8 * 32 * 32;
    LAS float* logitL = ssp + 512;
    LAS float* rstdL = logitL + 32 * 33;
    LAS int* lcnt = (LAS int*)(rstdL + 32);
    LAS int* lbase = lcnt + 32;
    const float* H1 = WSP(float, WS_H1); const float* MODp = WSP(float, WS_MOD); const float* RC = WSP(float, WS_RC);
    for (int blk = F.vcu; blk < T / 32; blk += F.G) {
        const int t0 = blk * 32, bb = t0 / SEQ; const float* mod = MODp + bb * 12288;
        for (int k = F.tid; k < DM; k += 512) { gainL[k] = A.in[I_N2G][k] * (1.0f + mod[4 * DM + k]); shiftL[k] = mod[3 * DM + k]; }
        if (F.tid < 32) lcnt[F.tid] = 0;
        __syncthreads();
        {
            const int i = F.lane & 31, kk = F.lane >> 5, kb = F.wave * 256 + kk * 128;
            const float* hp = H1 + (size_t)(t0 + i) * DM + kb; const float* wp = A.in[I_WR] + (size_t)kb * 32 + i; const LAS float* gp = gainL + kb;
            f32x16r acc = {}; float ss = 0.f;
#pragma unroll 4
            for (int s0 = 0; s0 < 128; s0 += 4) {
                const f32x4 hv = *(const f32x4*)(hp + s0); const f32x4 g4 = *(const LAS f32x4*)(gp + s0);
                const float b0 = wp[(s0 + 0) * 32], b1 = wp[(s0 + 1) * 32], b2 = wp[(s0 + 2) * 32], b3 = wp[(s0 + 3) * 32];
                ss += (hv.x * hv.x + hv.y * hv.y) + (hv.z * hv.z + hv.w * hv.w);
                acc = __builtin_amdgcn_mfma_f32_32x32x2f32(hv.x * g4.x, b0, acc, 0, 0, 0);
                acc = __builtin_amdgcn_mfma_f32_32x32x2f32(hv.y * g4.y, b1, acc, 0, 0, 0);
                acc = __builtin_amdgcn_mfma_f32_32x32x2f32(hv.z * g4.z, b2, acc, 0, 0, 0);
                acc = __builtin_amdgcn_mfma_f32_32x32x2f32(hv.w * g4.w, b3, acc, 0, 0, 0);
            }
#pragma unroll
            for (int r = 0; r < 16; ++r) part[(F.wave * 32 + (r & 3) + 8 * (r >> 2) + 4 * kk) * 32 + i] = acc[r];
            ssp[F.wave * 64 + F.lane] = ss;
        }
        __syncthreads();
        { const int token = F.tid & 31, eg = F.tid >> 5; float s2 = 0.f;
#pragma unroll
          for (int w = 0; w < 8; ++w) s2 += ssp[w * 64 + token] + ssp[w * 64 + 32 + token];
          const float rstd = 1.0f / sqrtf(s2 * (1.0f / DM) + EPS);
#pragma unroll
          for (int q = 0; q < 2; ++q) { const int e = eg * 2 + q; float raw = 0.f;
#pragma unroll
              for (int w = 0; w < 8; ++w) raw += part[(w * 32 + token) * 32 + e];
              logitL[token * 33 + e] = rstd * raw + RC[bb * 32 + e]; }
          if (eg == 0) rstdL[token] = rstd; }
        __syncthreads();
        int se[4] = {0, 0, 0, 0}, lp[4] = {0, 0, 0, 0}; float pv[4] = {0.f, 0.f, 0.f, 0.f};
        if (F.tid < 32) {
            float sv[4];
#pragma unroll
            for (int k = 0; k < 4; ++k) { float best = -INFINITY; int bi = 0;
                for (int e = 0; e < 32; ++e) { const float v = logitL[F.tid * 33 + e]; if (v > best) { best = v; bi = e; } }
                sv[k] = best; se[k] = bi; logitL[F.tid * 33 + bi] = -INFINITY; }
            float sum = 0.f;
#pragma unroll
            for (int k = 0; k < 4; ++k) { pv[k] = expf(sv[k] - sv[0]); sum += pv[k]; }
            const float inv = 1.0f / sum;
#pragma unroll
            for (int k = 0; k < 4; ++k) { pv[k] *= inv; lp[k] = __hip_atomic_fetch_add(lcnt + se[k], 1, __ATOMIC_RELAXED, __HIP_MEMORY_SCOPE_WORKGROUP); }
        }
        __syncthreads();
        if (F.tid < 32 && commit) lbase[F.tid] = (int)__hip_atomic_fetch_add((unsigned*)(F.ctl + CW_CNT + 64 * F.tid), (unsigned)lcnt[F.tid], RLX_AGENT);
        __syncthreads();
        if (F.tid < 32 && commit) { const int m = t0 + F.tid;
#pragma unroll
            for (int k = 0; k < 4; ++k) { WSP(int, WS_TOPI)[m * 4 + k] = se[k]; WSP(float, WS_TOPP)[m * 4 + k] = pv[k]; WSP(int, WS_POS)[m * 4 + k] = lbase[se[k]] + lp[k]; } }
        for (int i = 0; i < 4; ++i) { const int token = F.wave * 4 + i, m = t0 + token; const float rstd = rstdL[token];
            const float* hr = H1 + (size_t)m * DM + 4 * F.lane; unsigned char* ur = WSP(unsigned char, WS_U) + (size_t)m * DM + 4 * F.lane;
#pragma unroll
            for (int j = 0; j < 8; ++j) { const f32x4 h = *(const f32x4*)(hr + 256 * j), g = *(const LAS f32x4*)(gainL + 4 * F.lane + 256 * j), s = *(const LAS f32x4*)(shiftL + 4 * F.lane + 256 * j);
                const f32x4 u = h * rstd * g + s; int w8 = __builtin_amdgcn_cvt_pk_fp8_f32(u.x, u.y, 0, false); w8 = __builtin_amdgcn_cvt_pk_fp8_f32(u.z, u.w, w8, true); *(int*)(ur + 256 * j) = w8; } }
        __syncthreads();
    }
}
__device__ __forceinline__ void build_tile_table(Frame& F) {
    LAS int* ts = (LAS int*)(F.lds + TST_OFF);
    if (F.tid == 0) { int acc = 0;
        for (int e = 0; e < NE; ++e) { ts[e] = acc; acc += ((int)__hip_atomic_load((unsigned*)(F.ctl + CW_CNT + 64 * e), RLX_AGENT) + 255) >> 8; }
        ts[32] = acc; }
    __syncthreads();
}
__device__ __forceinline__ void p8_gather(Frame& F, const Args& A) {
    build_tile_table(F);
    const LAS int* ts = (const LAS int*)(F.lds + TST_OFF);
    const int gw = F.vcu * NWAVES + F.wave, NGW = F.G * NWAVES;
    for (int m = gw; m < T; m += NGW) {
        const v4u* src = (const v4u*)(WSP(unsigned char, WS_U) + (size_t)m * DM); v4u v[2];
#pragma unroll
        for (int q = 0; q < 2; ++q) v[q] = src[F.lane + 64 * q];
#pragma unroll
        for (int k = 0; k < 4; ++k) { const int e = WSP(int, WS_TOPI)[m * 4 + k], pos = WSP(int, WS_POS)[m * 4 + k]; const size_t row = (size_t)ts[e] * 256 + pos;
            v4u* dst = (v4u*)(WSP(unsigned char, WS_XS) + row * DM);
#pragma unroll
            for (int q = 0; q < 2; ++q) dst[F.lane + 64 * q] = v[q]; }
    }
}
__device__ __forceinline__ void p11_final(Frame& F, const Args& A) {
    build_tile_table(F);
    const LAS int* ts = (const LAS int*)(F.lds + TST_OFF);
    const int gw = F.vcu * NWAVES + F.wave, NGW = F.G * NWAVES; const float* MODp = WSP(float, WS_MOD);
    for (int m = gw; m < T; m += NGW) {
        const int bb = m / SEQ; const bf16* yr[4]; float p[4];
#pragma unroll
        for (int k = 0; k < 4; ++k) { const int e = WSP(int, WS_TOPI)[m * 4 + k], pos = WSP(int, WS_POS)[m * 4 + k]; p[k] = WSP(float, WS_TOPP)[m * 4 + k];
            yr[k] = WSP(bf16, WS_YSLOT) + ((size_t)ts[e] * 256 + pos) * DM + 4 * F.lane; }
        const float* hr = WSP(float, WS_H1) + (size_t)m * DM + 4 * F.lane; f32x4 v[8]; float s = 0.f;
#pragma unroll
        for (int j = 0; j < 8; ++j) { f32x4 a = {0.f, 0.f, 0.f, 0.f};
#pragma unroll
            for (int k = 0; k < 4; ++k) { const v2u w = *(const v2u*)(yr[k] + 256 * j); const f32x4 y = {__uint_as_float(w.x << 16), __uint_as_float(w.x & 0xffff0000u), __uint_as_float(w.y << 16), __uint_as_float(w.y & 0xffff0000u)}; a += y * p[k]; }
            const f32x4 g2 = *(const f32x4*)(MODp + bb * 12288 + 5 * DM + 4 * F.lane + 256 * j);
            v[j] = *(const f32x4*)(hr + 256 * j) + g2 * a; s += (v[j].x * v[j].x + v[j].y * v[j].y) + (v[j].z * v[j].z + v[j].w * v[j].w); }
        const float rstd = 1.0f / sqrtf(wave_sum(s) * (1.0f / DM) + EPS);
        float* orow = A.out + (size_t)m * DM + 4 * F.lane;
#pragma unroll
        for (int j = 0; j < 8; ++j) { const f32x4 g = *(const f32x4*)(A.in[I_FG] + 4 * F.lane + 256 * j); *(f32x4*)(orow + 256 * j) = v[j] * rstd * g; }
    }
}

__global__ void __launch_bounds__(NWAVES * 64, 2) fwd(Args args) {
    extern __shared__ __attribute__((aligned(16))) unsigned char lds[];
    Frame F;
    F.lds = (LAS unsigned char*)lds; F.ldsg = (char*)lds;
    F.MISC = (volatile LAS unsigned*)(F.lds + MISC_OFF);
    F.tid = threadIdx.x; F.lane = F.tid & 63; F.wave = __builtin_amdgcn_readfirstlane(F.tid >> 6);
    F.G = gridDim.x; { const int bx = blockIdx.x; F.vcu = (F.G % 8 == 0) ? (bx % 8) * (F.G / 8) + bx / 8 : bx; }
    F.ws = args.ws; F.ctl = (gu32*)(args.ws + WS_CTL);
    for (int u = F.tid; u < (LDS_BYTES - LDSCTL_OFF) / 4; u += NWAVES * 64) ((LAS unsigned*)(F.lds + LDSCTL_OFF))[u] = 0u;
    __syncthreads();
#if MK_SPLIT
#define GRID_BAR() do { } while (0)
#else
    XcdBarrier bar = xcd_barrier_post((unsigned*)(F.ctl + CW_BAR), F.MISC + 8);
#define GRID_BAR() xcd_barrier(bar)
#endif
    const int lo = args.ph_lo, hi = args.ph_hi;
#define IN(k) (lo <= (k) && (k) < hi)
#define SEAM(k) do { if (IN(k) && IN((k) + 1)) GRID_BAR(); } while (0)
    const Args& A = args;
    constexpr bool AL = true, SP = true;

#ifndef REP_PHASE
#define REP_PHASE -1
#endif
#define REPN(k) ((REP_PHASE == (k)) ? 2 : 1)
    if (IN(0)) { for (int rep = 0; rep < REPN(0); ++rep) p0_mod(F, A); p0_convert(F, A); } SEAM(0);
    if (IN(1)) { for (int rep = 0; rep < REPN(1); ++rep) p1_modulate(F, A); } SEAM(1);
    if (IN(2)) for (int rep = 0; rep < REPN(2); ++rep) {
        pg8::Gemm g{WSP(bf16, WS_U), WSP(bf16, WS_WINT), T, NQKV, DM}; pg8::StaticOrder S; S.init(T, NQKV, F.G, (int)blockIdx.x);
        pg8::EpiQKV E{WSP(bf16, WS_QKV), NQKV, C_GA / 256};
        pg8::gemm_phase<pg8::EpiQKV, pg8::StaticOrder, AL, SP>(F.lds + RING_OFF, g, S, E);
    } SEAM(2);
    if (IN(3)) { for (int rep = 0; rep < REPN(3); ++rep) p3_attention(F, A); } SEAM(3);
    if (IN(4)) { for (int rep = 0; rep < REPN(4); ++rep) p4_finalize(F, A); } SEAM(4);
    if (IN(5)) for (int rep = 0; rep < REPN(5); ++rep) {
        { pg8::Gemm g{WSP(bf16, WS_YA), WSP(bf16, WS_WAT), T, DM, 1024}; pg8::StaticOrder S; S.init(T, DM, F.G, (int)blockIdx.x);
          pg8::EpiM1 E{WSP(float, WS_M1), WSP(bf16, WS_QKV) + C_GA, NQKV};
          pg8::gemm_phase<pg8::EpiM1, pg8::StaticOrder, AL, SP>(F.lds + RING_OFF, g, S, E); }
        VM_WAIT(); __syncthreads();
        { pg8::Gemm g{WSP(bf16, WS_YB), WSP(bf16, WS_WBT), T, DM, 1024}; pg8::StaticOrder S; S.init(T, DM, F.G, (int)blockIdx.x);
          pg8::EpiMerged E{WSP(float, WS_M1), WSP(bf16, WS_QKV) + C_GB, NQKV, WSP(bf16, WS_MG)};
          pg8::gemm_phase<pg8::EpiMerged, pg8::StaticOrder, AL, SP>(F.lds + RING_OFF, g, S, E); }
    } SEAM(5);
    if (IN(6)) for (int rep = 0; rep < REPN(6); ++rep) {
        pg8::Gemm g{WSP(bf16, WS_MG), WSP(bf16, WS_WOT), T, DM, DM}; pg8::StaticOrder S; S.init(T, DM, F.G, (int)blockIdx.x);
        pg8::EpiH1 E{A.in[I_X], WSP(float, WS_H1), WSP(float, WS_MOD) + 2 * DM, 12288, SEQ / 256};
        pg8::gemm_phase<pg8::EpiH1, pg8::StaticOrder, AL, SP>(F.lds + RING_OFF, g, S, E);
    } SEAM(6);
    if (IN(7)) { for (int rep = 0; rep < REPN(7); ++rep) p7_router(F, A, rep == 0); } SEAM(7);
    if (IN(8)) { for (int rep = 0; rep < REPN(8); ++rep) p8_gather(F, A); } SEAM(8);
    if (IN(9)) for (int rep = 0; rep < REPN(9); ++rep) {
        build_tile_table(F);
        pg8::Gemm g{WSP(bf16, WS_XS), WSP(bf16, WS_WGU), TKPAD, NE * 4096, DM / 2}; pg8::MoeOrder S; S.init((const LAS int*)(F.lds + TST_OFF), 16, F.G, (int)blockIdx.x);
        pg8::EpiSwiGLU E{WSP(unsigned char, WS_YACT), A.in[I_BG], A.in[I_BU], 1.0f / WSCALE};
        pg8::gemm_phase<pg8::EpiSwiGLU, pg8::MoeOrder, AL, SP, true>(F.lds + RING_OFF, g, S, E);
    } SEAM(9);
    if (IN(10)) for (int rep = 0; rep < REPN(10); ++rep) {
        build_tile_table(F);
        pg8::Gemm g{WSP(bf16, WS_YACT), WSP(bf16, WS_WD), TKPAD, NE * DM, DM / 2}; pg8::MoeOrder S; S.init((const LAS int*)(F.lds + TST_OFF), 8, F.G, (int)blockIdx.x);
        pg8::EpiBf16B E{WSP(bf16, WS_YSLOT), DM, A.in[I_BDN], 8, 1.0f / WSCALE};
        pg8::gemm_phase<pg8::EpiBf16B, pg8::MoeOrder, AL, SP, true>(F.lds + RING_OFF, g, S, E);
    } SEAM(10);
    if (IN(11)) { for (int rep = 0; rep < REPN(11); ++rep) p11_final(F, A); }
#undef IN
#undef SEAM
}
extern "C" void kernel_launch(void* const* d_in, const int* in_sizes, int n_in, void* d_out, int out_size, void* d_ws, size_t ws_size, hipStream_t stream) {
    static int grid = 0;
    if (grid == 0) {
        if (n_in != 24 || in_sizes[0] != T * DM || out_size != T * DM || ws_size < WS_END) { fprintf(stderr, "kernel_launch: shape mismatch (n_in %d, in0 %d, out %d, ws %zu < %zu); nothing launched\n", n_in, n_in > 0 ? in_sizes[0] : -1, out_size, ws_size, (size_t)WS_END); grid = -1; return; }
        int dev = 0, cus = 0, per_cu = 0;
        if (hipGetDevice(&dev) != hipSuccess || hipDeviceGetAttribute(&cus, hipDeviceAttributeMultiprocessorCount, dev) != hipSuccess) { grid = -1; return; }
        if (hipFuncSetAttribute((const void*)fwd, hipFuncAttributeMaxDynamicSharedMemorySize, LDS_BYTES) != hipSuccess) { fprintf(stderr, "kernel_launch: hipFuncSetAttribute failed\n"); grid = -1; return; }
        if (hipOccupancyMaxActiveBlocksPerMultiprocessor(&per_cu, (const void*)fwd, NWAVES * 64, LDS_BYTES) != hipSuccess || per_cu < 1)
            fprintf(stderr, "kernel_launch: note: occupancy query reports %d workgroups per CU\n", per_cu);
        (void)hipGetLastError();
        grid = cus;
    }
    if (grid < 0) return;
    if (hipMemsetAsync((char*)d_ws + WS_CTL, 0, CTL_ZERO_BYTES, stream) != hipSuccess) return;
    Args a; memset(&a, 0, sizeof(a));
    for (int i = 0; i < 24; ++i) a.in[i] = (const float*)d_in[i];
    a.out = (float*)d_out; a.ws = (unsigned char*)d_ws;
#if MK_SPLIT
    for (int ph = 0; ph < N_PHASES; ++ph) { a.ph_lo = ph; a.ph_hi = ph + 1; hipLaunchKernelGGL(fwd, dim3(grid), dim3(NWAVES * 64), LDS_BYTES, stream, a); }
#else
    a.ph_lo = 0; a.ph_hi = N_PHASES; hipLaunchKernelGGL(fwd, dim3(grid), dim3(NWAVES * 64), LDS_BYTES, stream, a);
#endif
    const hipError_t le = hipPeekAtLastError();
    if (le != hipSuccess) fprintf(stderr, "kernel_launch: launch failed: %s\n", hipGetErrorName(le));
#if DBG_ORACLE
    dbg_launch(a, stream);
#endif
}
```

```cpp
#include <hip/hip_runtime.h>
#include <cstdio>
#include <cstdint>
#include <cstring>
#include <cmath>
namespace pg8 {
#define PG8_LAS __attribute__((address_space(3)))
typedef unsigned short bf16_t;
typedef short bf16x8 __attribute__((ext_vector_type(8)));
typedef float f32x4 __attribute__((ext_vector_type(4)));
typedef unsigned u32x4 __attribute__((ext_vector_type(4)));
constexpr int BM = 256, BK = 64, HALF = 128, HTB = HALF * BK * 2  , STAGE_BYTES = 8 * HTB, NXCD = 8, WGM = 8;

__host__ __device__ __forceinline__ int lds_byte(int r, int c) { const int st = (r >> 4) * 2 + (c >> 5), rr = r & 15, cc = c & 31, ob = rr * 64 + cc * 2; return st * 1024 + (ob ^ (((ob >> 9) & 1) << 5)); }
__host__ __device__ __forceinline__ void stage_rc(int b, int& R, int& C) { const int st = b / 1024, sb = b % 1024, swz = sb ^ (((sb >> 9) & 1) << 5); R = (st >> 1) * 16 + swz / 64; C = (st & 1) * 32 + (swz % 64) / 2; }
__host__ __device__ __forceinline__ int perm32(int rho) { const int n = rho >> 4, i = rho & 15; return 8 * (i >> 2) + 4 * n + (i & 3); }

struct Unit { int pm, pn; };
struct Gemm { const bf16_t* A; const bf16_t* Bt; int M, N, K; };

struct StaticOrder {
    int nM, nN, nwg, G, c;
    __host__ __device__ void init(int M, int N, int G_, int c_) { nM = M / BM; nN = N / BM; nwg = nM * nN; G = G_; c = c_; }
    __host__ __device__ bool next(int i, Unit& u) const {
        const long L = (long)i * G + c; if (L >= nwg) return false;
        int wgid = (int)L; { const int q = nwg / NXCD, r = nwg % NXCD, xcd = wgid % NXCD, off = wgid / NXCD; wgid = (xcd < r ? xcd * (q + 1) : r * (q + 1) + (xcd - r) * q) + off; }
        const int nig = WGM * nN, gid = wgid / nig, fm = gid * WGM, gsz = (nM - fm) < WGM ? (nM - fm) : WGM;
        u.pm = fm + ((wgid % nig) % gsz); u.pn = (wgid % nig) / gsz; return true;
    }
    __device__ __forceinline__ void a_ready(const Unit&) const {}
    __device__ __forceinline__ void done(const Unit&) const {}
};

__device__ __forceinline__ unsigned cvt_pk_bf16(float lo, float hi) { unsigned r; asm volatile("v_cvt_pk_bf16_f32 %0, %1, %2" : "=v"(r) : "v"(lo), "v"(hi)); return r; }

typedef int v4i_t __attribute__((ext_vector_type(4)));
typedef int v8i_t __attribute__((ext_vector_type(8)));
template <class Epi, class Sched, bool ALIGN_EPI = false, bool SP2 = false, bool F8 = false>
__device__ __forceinline__ void gemm_phase(PG8_LAS unsigned char* lds, const Gemm g, const Sched& S, const Epi& E) {
    const int tid = threadIdx.x, wid = __builtin_amdgcn_readfirstlane(tid >> 6), lane = tid & 63, wr = wid >> 2, wc = wid & 3, fr = lane & 15, fq = lane >> 4;
    const int K = g.K, nt = K / BK;
    unsigned voffA[2], voffB[2];
#pragma unroll
    for (int i = 0; i < 2; ++i) { int R, C; stage_rc(tid * 16 + i * 8192, R, C); const int Rb = Epi::PERM ? ((R & ~31) + perm32(R & 31)) : R;
        voffA[i] = (unsigned)(R * K + C) * 2u; voffB[i] = (unsigned)(Rb * K + C) * 2u; }
    const size_t kstep = (size_t)(BK * 2);
    const size_t hstep = (size_t)HALF * K * 2;
    const size_t tstep = 2 * hstep;
    const unsigned ldsw = (unsigned)wid * 1024u;
    const int aoff = lds_byte(wr * 64 + fr, fq * 8), boff = lds_byte(wc * 32 + fr, fq * 8);
#define PG8_SA(b, h) (((b) * 2 + (h)) * HTB)
#define PG8_SB(b, h) ((4 + (b) * 2 + (h)) * HTB)
#define PG8_STAGE(bufoff, gbase, voff) do { _Pragma("unroll") for (int _i = 0; _i < 2; ++_i) \
        __builtin_amdgcn_global_load_lds((const unsigned*)((const char*)(gbase) + (voff)[_i]), (PG8_LAS unsigned*)(lds + (bufoff) + ldsw + _i * 8192), 16, 0, 0); } while (0)
#define PG8_LDA(dst, b, h) do { _Pragma("unroll") for (int m = 0; m < 4; ++m) _Pragma("unroll") for (int k = 0; k < 2; ++k) dst[m][k] = *(const PG8_LAS bf16x8*)(lds + PG8_SA(b, h) + aoff + m * 2048 + k * 1024); } while (0)
#define PG8_LDB(dst, b, h) do { _Pragma("unroll") for (int n = 0; n < 2; ++n) _Pragma("unroll") for (int k = 0; k < 2; ++k) dst[n][k] = *(const PG8_LAS bf16x8*)(lds + PG8_SB(b, h) + boff + n * 2048 + k * 1024); } while (0)
#define PG8_MMA(ai, bj, At, Bt) do { __builtin_amdgcn_s_setprio(1); _Pragma("unroll") for (int m = 0; m < 4; ++m) _Pragma("unroll") for (int n = 0; n < 2; ++n) { \
        if constexpr (F8) { const v8i_t _b = __builtin_shufflevector(__builtin_bit_cast(v4i_t, Bt[n][0]), __builtin_bit_cast(v4i_t, Bt[n][1]), 0, 1, 2, 3, 4, 5, 6, 7); \
            const v8i_t _a = __builtin_shufflevector(__builtin_bit_cast(v4i_t, At[m][0]), __builtin_bit_cast(v4i_t, At[m][1]), 0, 1, 2, 3, 4, 5, 6, 7); \
            asm volatile("v_mfma_scale_f32_16x16x128_f8f6f4 %0, %1, %2, %0, %3, %3 op_sel_hi:[0,0,0]" : "+v"(acc[ai][bj][m][n]) : "v"(_b), "v"(_a), "v"(f8scale)); } \
        else { _Pragma("unroll") for (int k = 0; k < 2; ++k) acc[ai][bj][m][n] = __builtin_amdgcn_mfma_f32_16x16x32_bf16(Bt[n][k], At[m][k], acc[ai][bj][m][n], 0, 0, 0); } } \
        __builtin_amdgcn_s_setprio(0); } while (0)
#define PG8_WAIT_V(n) asm volatile("s_waitcnt vmcnt(" #n ")" ::: "memory")
#define PG8_WAIT_L(n) asm volatile("s_waitcnt lgkmcnt(" #n ")" ::: "memory")
#define PG8_BAR __builtin_amdgcn_s_barrier()
#define PG8_SCHED __builtin_amdgcn_sched_barrier(0)
    Unit cur, nxt; int ui = 0;
    if (!S.next(0, cur)) return;
    const int f8scale = 0x7f7f7f7f;
    f32x4 acc[2][2][4][2];
#pragma unroll
    for (int a = 0; a < 2; ++a)
#pragma unroll
        for (int b = 0; b < 2; ++b)
#pragma unroll
            for (int m = 0; m < 4; ++m)
#pragma unroll
                for (int n = 0; n < 2; ++n) acc[a][b][m][n] = (f32x4){0.f, 0.f, 0.f, 0.f};
    bf16x8 At[4][2], B0[2][2], B1[2][2];
    const char* cA = (const char*)g.A + (size_t)cur.pm * tstep; const char* cB = (const char*)g.Bt + (size_t)cur.pn * tstep;
    S.a_ready(cur);
    if constexpr (SP2) {
        PG8_STAGE(PG8_SB(0, 0), cB, voffB); PG8_STAGE(PG8_SB(0, 1), cB + hstep, voffB); PG8_STAGE(PG8_SA(0, 0), cA, voffA); PG8_STAGE(PG8_SA(0, 1), cA + hstep, voffA);
        if (wr == 1) PG8_BAR;
        PG8_WAIT_V(2); PG8_BAR;
        PG8_STAGE(PG8_SB(1, 0), cB + kstep, voffB); PG8_STAGE(PG8_SA(1, 0), cA + kstep, voffA); PG8_STAGE(PG8_SB(1, 1), cB + hstep + kstep, voffB);
        PG8_WAIT_V(6); PG8_BAR;
    } else {
        PG8_STAGE(PG8_SB(0, 0), cB, voffB); PG8_STAGE(PG8_SA(0, 0), cA, voffA); PG8_STAGE(PG8_SB(0, 1), cB + hstep, voffB); PG8_STAGE(PG8_SA(0, 1), cA + hstep, voffA);
        if (wr == 1) PG8_BAR;
        PG8_WAIT_V(4); PG8_BAR;
        PG8_STAGE(PG8_SB(1, 0), cB + kstep, voffB); PG8_STAGE(PG8_SA(1, 0), cA + kstep, voffA); PG8_STAGE(PG8_SB(1, 1), cB + hstep + kstep, voffB);
        PG8_WAIT_V(6); PG8_BAR;
    }
    for (;;) {
        const bool has_next = S.next(ui + 1, nxt);
        const char* nA = has_next ? (const char*)g.A + (size_t)nxt.pm * tstep : cA; const char* nB = has_next ? (const char*)g.Bt + (size_t)nxt.pn * tstep : cB;
        for (int t = 0; t < nt; t += 2) {
            const bool last = (t == nt - 2);
            const char* a1 = cA + (size_t)(t + 1) * kstep;
            const char* a2 = last ? nA : cA + (size_t)(t + 2) * kstep; const char* b2 = last ? nB : cB + (size_t)(t + 2) * kstep;
            const char* a3 = a2 + kstep; const char* b3 = b2 + kstep;
            if (last && has_next) S.a_ready(nxt);
            if constexpr (SP2) {
            PG8_LDB(B0, 0, 0); PG8_LDB(B1, 0, 1); PG8_SCHED; PG8_LDA(At, 0, 0); PG8_STAGE(PG8_SA(1, 1), a1 + hstep, voffA);
            PG8_WAIT_V(8); PG8_WAIT_L(0); PG8_BAR; PG8_MMA(0, 0, At, B0); PG8_MMA(0, 1, At, B1); PG8_BAR; PG8_SCHED;
            PG8_LDA(At, 0, 1); PG8_STAGE(PG8_SB(0, 0), b2, voffB); PG8_STAGE(PG8_SB(0, 1), b2 + hstep, voffB); PG8_STAGE(PG8_SA(0, 0), a2, voffA);
            PG8_WAIT_V(8); PG8_WAIT_L(0); PG8_BAR; PG8_MMA(1, 0, At, B0); PG8_MMA(1, 1, At, B1); PG8_BAR; PG8_SCHED;
            PG8_LDB(B0, 1, 0); PG8_LDB(B1, 1, 1); PG8_SCHED; PG8_LDA(At, 1, 0); PG8_STAGE(PG8_SA(0, 1), a2 + hstep, voffA);
            PG8_WAIT_V(8); PG8_WAIT_L(0); PG8_BAR; PG8_MMA(0, 0, At, B0); PG8_MMA(0, 1, At, B1); PG8_BAR; PG8_SCHED;
            PG8_LDA(At, 1, 1); PG8_STAGE(PG8_SB(1, 0), b3, voffB); PG8_STAGE(PG8_SB(1, 1), b3 + hstep, voffB); PG8_STAGE(PG8_SA(1, 0), a3, voffA);
            PG8_WAIT_V(8); PG8_WAIT_L(0); PG8_BAR; PG8_MMA(1, 0, At, B0); PG8_MMA(1, 1, At, B1); PG8_BAR; PG8_SCHED;
            } else {
            PG8_LDB(B0, 0, 0); PG8_SCHED; PG8_LDA(At, 0, 0); PG8_STAGE(PG8_SA(1, 1), a1 + hstep, voffA);
            PG8_WAIT_L(8); PG8_BAR; PG8_WAIT_L(0); PG8_MMA(0, 0, At, B0); PG8_BAR; PG8_SCHED;
            PG8_LDB(B1, 0, 1); PG8_STAGE(PG8_SB(0, 0), b2, voffB);
            PG8_BAR; PG8_WAIT_L(0); PG8_MMA(0, 1, At, B1); PG8_BAR;
            PG8_LDA(At, 0, 1); PG8_STAGE(PG8_SA(0, 0), a2, voffA);
            PG8_BAR; PG8_WAIT_L(0); PG8_MMA(1, 0, At, B0); PG8_BAR; PG8_SCHED;
            PG8_STAGE(PG8_SB(0, 1), b2 + hstep, voffB);
            PG8_WAIT_V(6); PG8_BAR; PG8_MMA(1, 1, At, B1); PG8_BAR;
            PG8_LDB(B0, 1, 0); PG8_SCHED; PG8_LDA(At, 1, 0); PG8_STAGE(PG8_SA(0, 1), a2 + hstep, voffA);
            PG8_WAIT_L(8); PG8_BAR; PG8_WAIT_L(0); PG8_MMA(0, 0, At, B0); PG8_BAR; PG8_SCHED;
            PG8_LDB(B1, 1, 1); PG8_STAGE(PG8_SB(1, 0), b3, voffB);
            PG8_BAR; PG8_WAIT_L(0); PG8_MMA(0, 1, At, B1); PG8_BAR;
            PG8_LDA(At, 1, 1); PG8_STAGE(PG8_SA(1, 0), a3, voffA);
            PG8_BAR; PG8_WAIT_L(0); PG8_MMA(1, 0, At, B0); PG8_BAR; PG8_SCHED;
            PG8_STAGE(PG8_SB(1, 1), b3 + hstep, voffB);
            PG8_WAIT_V(6); PG8_BAR; PG8_MMA(1, 1, At, B1); PG8_BAR;
            }
        }
        if constexpr (F8) asm volatile("s_nop 15\n\ts_nop 7" ::: "memory");
        if constexpr (ALIGN_EPI) { if (wr == 0) PG8_BAR; }
        if constexpr (!Epi::AFTER_DRAIN) { E(acc, cur, wr, wc, fr, fq); S.done(cur); }
        if (!has_next) break;
#pragma unroll
        for (int a = 0; a < 2; ++a)
#pragma unroll
            for (int b = 0; b < 2; ++b)
#pragma unroll
                for (int m = 0; m < 4; ++m)
#pragma unroll
                    for (int n = 0; n < 2; ++n) acc[a][b][m][n] = (f32x4){0.f, 0.f, 0.f, 0.f};
        cur = nxt; cA = nA; cB = nB; ++ui;
        if constexpr (ALIGN_EPI) { if (wr == 1) PG8_BAR; }
    }
    PG8_WAIT_V(0);
    if constexpr (!ALIGN_EPI) { if (wr == 0) PG8_BAR; }
    PG8_BAR;
    if constexpr (Epi::AFTER_DRAIN) { E.fused(acc, cur, wr, wc, fr, fq, lds, wid, lane); S.done(cur); }
#undef PG8_SA
#undef PG8_SB
#undef PG8_STAGE
#undef PG8_LDA
#undef PG8_LDB
#undef PG8_MMA
#undef PG8_WAIT_V
#undef PG8_WAIT_L
#undef PG8_BAR
#undef PG8_SCHED
}
}
namespace pg8 {
typedef float f32x2e __attribute__((ext_vector_type(2)));
__device__ __forceinline__ float bf_lo(unsigned w) { return __uint_as_float(w << 16); }
__device__ __forceinline__ float bf_hi(unsigned w) { return __uint_as_float(w & 0xffff0000u); }
__device__ __forceinline__ float sigmoidf_fast(float x) { return __builtin_amdgcn_rcpf(1.0f + __expf(-x)); }

struct EpiBf16B {
    static constexpr bool PERM = true, AFTER_DRAIN = false;
    bf16_t* O; int ldc; const float* bias; int ntile_mod; float scale;
    __device__ __forceinline__ void operator()(const f32x4 (&acc)[2][2][4][2], const Unit& u, int wr, int wc, int fr, int fq) const {
        const int row0 = u.pm * BM + wr * 64 + fr; const int colt = (u.pn % ntile_mod) * BM;
        const int col0 = colt + wc * 32 + 8 * fq, bcol0 = u.pn * BM + wc * 32 + 8 * fq;
        f32x4 bv[2][2];
#pragma unroll
        for (int bj = 0; bj < 2; ++bj)
#pragma unroll
            for (int n = 0; n < 2; ++n) bv[bj][n] = bias ? *(const f32x4*)(bias + bcol0 + bj * HALF + 4 * n) : (f32x4){0.f, 0.f, 0.f, 0.f};
#pragma unroll
        for (int ai = 0; ai < 2; ++ai)
#pragma unroll
            for (int m = 0; m < 4; ++m) { bf16_t* rowp = O + (size_t)(row0 + ai * HALF + m * 16) * ldc + col0;
#pragma unroll
                for (int bj = 0; bj < 2; ++bj) { const f32x4 v0 = acc[ai][bj][m][0] * scale + bv[bj][0], v1 = acc[ai][bj][m][1] * scale + bv[bj][1];
                    u32x4 w; w.x = cvt_pk_bf16(v0[0], v0[1]); w.y = cvt_pk_bf16(v0[2], v0[3]); w.z = cvt_pk_bf16(v1[0], v1[1]); w.w = cvt_pk_bf16(v1[2], v1[3]);
                    *(u32x4*)(rowp + bj * HALF) = w; } }
    }
};
struct EpiQKV {
    static constexpr bool PERM = true, AFTER_DRAIN = false;
    bf16_t* O; int ldc; int sig_tile0; int tile_off; float scale;
    __device__ __forceinline__ void operator()(const f32x4 (&acc)[2][2][4][2], const Unit& u, int wr, int wc, int fr, int fq) const {
        const int row0 = u.pm * BM + wr * 64 + fr; const int col0 = (u.pn + tile_off) * BM + wc * 32 + 8 * fq; const bool sg = u.pn >= sig_tile0;
#pragma unroll
        for (int ai = 0; ai < 2; ++ai)
#pragma unroll
            for (int m = 0; m < 4; ++m) { bf16_t* rowp = O + (size_t)(row0 + ai * HALF + m * 16) * ldc + col0;
#pragma unroll
                for (int bj = 0; bj < 2; ++bj) { f32x4 v0 = acc[ai][bj][m][0], v1 = acc[ai][bj][m][1];
                    if (sg) {
#pragma unroll
                        for (int i = 0; i < 4; ++i) { v0[i] = sigmoidf_fast(v0[i] * scale); v1[i] = sigmoidf_fast(v1[i] * scale); } }
                    u32x4 w; w.x = cvt_pk_bf16(v0[0], v0[1]); w.y = cvt_pk_bf16(v0[2], v0[3]); w.z = cvt_pk_bf16(v1[0], v1[1]); w.w = cvt_pk_bf16(v1[2], v1[3]);
                    *(u32x4*)(rowp + bj * HALF) = w; } }
    }
};
struct EpiM1 {
    static constexpr bool PERM = true, AFTER_DRAIN = false;
    float* M1; const bf16_t* G; int ldg;
    __device__ __forceinline__ void operator()(const f32x4 (&acc)[2][2][4][2], const Unit& u, int wr, int wc, int fr, int fq) const {
        const int row0 = u.pm * BM + wr * 64 + fr; const int col0 = u.pn * BM + wc * 32 + 8 * fq;
#pragma unroll
        for (int ai = 0; ai < 2; ++ai)
#pragma unroll
            for (int m = 0; m < 4; ++m) { const size_t row = (size_t)(row0 + ai * HALF + m * 16);
#pragma unroll
                for (int bj = 0; bj < 2; ++bj) { const int col = col0 + bj * HALF; const u32x4 g = *(const u32x4*)(G + row * ldg + col);
                    const f32x4 a0 = acc[ai][bj][m][0], a1 = acc[ai][bj][m][1];
                    const f32x4 o0 = {a0[0] * bf_lo(g.x), a0[1] * bf_hi(g.x), a0[2] * bf_lo(g.y), a0[3] * bf_hi(g.y)};
                    const f32x4 o1 = {a1[0] * bf_lo(g.z), a1[1] * bf_hi(g.z), a1[2] * bf_lo(g.w), a1[3] * bf_hi(g.w)};
                    float* p = M1 + row * 2048 + col; *(f32x4*)p = o0; *(f32x4*)(p + 4) = o1; } }
    }
};
struct EpiMerged {
    static constexpr bool PERM = true, AFTER_DRAIN = false;
    const float* M1; const bf16_t* G; int ldg; bf16_t* MG;
    __device__ __forceinline__ void operator()(const f32x4 (&acc)[2][2][4][2], const Unit& u, int wr, int wc, int fr, int fq) const {
        const int row0 = u.pm * BM + wr * 64 + fr; const int col0 = u.pn * BM + wc * 32 + 8 * fq;
#pragma unroll
        for (int ai = 0; ai < 2; ++ai)
#pragma unroll
            for (int m = 0; m < 4; ++m) { const size_t row = (size_t)(row0 + ai * HALF + m * 16);
#pragma unroll
                for (int bj = 0; bj < 2; ++bj) { const int col = col0 + bj * HALF; const u32x4 g = *(const u32x4*)(G + row * ldg + col);
                    const float* p = M1 + row * 2048 + col; const f32x4 m0 = *(const f32x4*)p, m1 = *(const f32x4*)(p + 4);
                    const f32x4 a0 = acc[ai][bj][m][0], a1 = acc[ai][bj][m][1];
                    const f32x4 o0 = {m0[0] + a0[0] * bf_lo(g.x), m0[1] + a0[1] * bf_hi(g.x), m0[2] + a0[2] * bf_lo(g.y), m0[3] + a0[3] * bf_hi(g.y)};
                    const f32x4 o1 = {m1[0] + a1[0] * bf_lo(g.z), m1[1] + a1[1] * bf_hi(g.z), m1[2] + a1[2] * bf_lo(g.w), m1[3] + a1[3] * bf_hi(g.w)};
                    u32x4 w; w.x = cvt_pk_bf16(o0[0], o0[1]); w.y = cvt_pk_bf16(o0[2], o0[3]); w.z = cvt_pk_bf16(o1[0], o1[1]); w.w = cvt_pk_bf16(o1[2], o1[3]);
                    *(u32x4*)(MG + row * 2048 + col) = w; } }
    }
};
struct EpiH1 {
    static constexpr bool PERM = false, AFTER_DRAIN = false;
    const float* X; float* H1; const float* g1; int g1_stride; int tiles_per_batch;
    __device__ __forceinline__ void operator()(const f32x4 (&acc)[2][2][4][2], const Unit& u, int wr, int wc, int fr, int fq) const {
        const int row0 = u.pm * BM + wr * 64 + fr; const int col0 = u.pn * BM + wc * 32 + 4 * fq; const float* gb = g1 + (size_t)(u.pm / tiles_per_batch) * g1_stride;
        f32x4 gv[2][2];
#pragma unroll
        for (int bj = 0; bj < 2; ++bj)
#pragma unroll
            for (int n = 0; n < 2; ++n) gv[bj][n] = *(const f32x4*)(gb + col0 + bj * HALF + n * 16);
#pragma unroll
        for (int ai = 0; ai < 2; ++ai)
#pragma unroll
            for (int m = 0; m < 4; ++m) { const size_t off = (size_t)(row0 + ai * HALF + m * 16) * 2048 + col0;
#pragma unroll
                for (int bj = 0; bj < 2; ++bj)
#pragma unroll
                    for (int n = 0; n < 2; ++n) { const f32x4 xv = *(const f32x4*)(X + off + bj * HALF + n * 16);
                        *(f32x4*)(H1 + off + bj * HALF + n * 16) = xv + gv[bj][n] * acc[ai][bj][m][n]; } }
    }
};
struct EpiSwiGLU {
    static constexpr bool PERM = true, AFTER_DRAIN = false;
    unsigned char* Y; const float* bg; const float* bu; float wscale;
    __device__ __forceinline__ void operator()(const f32x4 (&acc)[2][2][4][2], const Unit& u, int wr, int wc, int fr, int fq) const {
        const int e = u.pn >> 4, pnl = u.pn & 15; const int row0 = u.pm * BM + wr * 64 + fr; const int col0 = pnl * HALF + wc * 32 + 8 * fq;
        f32x4 bgv[2], buv[2];
#pragma unroll
        for (int n = 0; n < 2; ++n) { bgv[n] = *(const f32x4*)(bg + (size_t)e * 2048 + col0 + 4 * n); buv[n] = *(const f32x4*)(bu + (size_t)e * 2048 + col0 + 4 * n); }
#pragma unroll
        for (int ai = 0; ai < 2; ++ai)
#pragma unroll
            for (int m = 0; m < 4; ++m) { unsigned char* rowp = Y + (size_t)(row0 + ai * HALF + m * 16) * 2048 + col0; f32x4 y[2];
#pragma unroll
                for (int n = 0; n < 2; ++n) { const f32x4 g4 = acc[ai][0][m][n] * wscale + bgv[n], u4 = acc[ai][1][m][n] * wscale + buv[n];
#pragma unroll
                    for (int i = 0; i < 4; ++i) { const float g = fminf(g4[i], 7.0f), uu = fminf(fmaxf(u4[i], -7.0f), 7.0f); y[n][i] = (uu + 1.0f) * (g * sigmoidf_fast(1.702f * g)); } }
                int w0 = __builtin_amdgcn_cvt_pk_fp8_f32(y[0][0], y[0][1], 0, false); w0 = __builtin_amdgcn_cvt_pk_fp8_f32(y[0][2], y[0][3], w0, true);
                int w1 = __builtin_amdgcn_cvt_pk_fp8_f32(y[1][0], y[1][1], 0, false); w1 = __builtin_amdgcn_cvt_pk_fp8_f32(y[1][2], y[1][3], w1, true);
                typedef int v2i_t __attribute__((ext_vector_type(2))); *(v2i_t*)rowp = (v2i_t){w0, w1}; }
    }
};
struct MoeOrder {
    const PG8_LAS int* tstart; int npn, lo, hi, rank, W;
    __device__ __forceinline__ void init(const PG8_LAS int* ts, int npn_, int G, int c) { tstart = ts; npn = npn_; const int U = ts[32] * npn_; const int x = c % NXCD; rank = c / NXCD; W = G / NXCD;
        lo = (int)(((long)U * x) / NXCD); hi = (int)(((long)U * (x + 1)) / NXCD); }
    __device__ __forceinline__ bool next(int i, Unit& u) const {
        const int q = lo + rank + W * i; if (q >= hi) return false;
        int e = 0;
#pragma unroll 1
        for (int k = 1; k < 32; ++k) if (tstart[k] * npn <= q) e = k;
        const int ts = tstart[e], te = tstart[e + 1] - ts, qq = q - ts * npn;
        u.pm = ts + qq % te; u.pn = e * npn + qq / te; return true;
    }
    __device__ __forceinline__ void a_ready(const Unit&) const {}
    __device__ __forceinline__ void done(const Unit&) const {}
};
}
namespace att {
using bf16x8 = __attribute__((ext_vector_type(8))) short;
using s16x4  = __attribute__((ext_vector_type(4))) short;
using f32x16 = __attribute__((ext_vector_type(16))) float;
using u32x4  = __attribute__((ext_vector_type(4))) unsigned;
typedef unsigned short bf16;
constexpr int   D = 128, NW = 8, QBLK = 32, KVBLK = 64;
constexpr float SCALE = 0.088388347648318440f;
constexpr float THR = 8.f;
constexpr size_t SHM_V = KVBLK * D * 2, SHM_K = KVBLK * D * 2, SHM_ATTN = 2 * SHM_V + 2 * SHM_K + NW * 64 * 4;
#define KSWZ(row, colB) ((row) * 256 + ((colB) ^ (((row) & 7) << 4)))
#define SBAR() __builtin_amdgcn_sched_barrier(0)
__device__ __forceinline__ int crow(int r, int hi) { return (r & 3) + 8 * (r >> 2) + 4 * hi; }
__device__ __forceinline__ unsigned cvtpk(float lo, float hi) { unsigned r; asm volatile("v_cvt_pk_bf16_f32 %0, %1, %2" : "=v"(r) : "v"(lo), "v"(hi)); return r; }

template <int MODE>
__device__ __forceinline__ void partialSM(f32x16& p0, f32x16& p1, float& m_reg, float& mn, float& alpha, float relb, float kk, bool valid) {
  constexpr float C = SCALE * 1.4426950408889634f;
#pragma unroll
  for (int r = 0; r < 16; ++r) {
    const float d0 = relb - (float)((r & 3) + 8 * (r >> 2)), a0 = __builtin_fabsf(d0), a1 = __builtin_fabsf(d0 - 32.f);
    p0[r] = fmaf(a0, -kk, p0[r]); p1[r] = fmaf(a1, -kk, p1[r]);
    if (MODE == 1) { if (!(valid && a0 <= 64.f)) p0[r] = -INFINITY; if (!(valid && a1 <= 64.f)) p1[r] = -INFINITY; }
  }
  float pmax = p0[0];
#pragma unroll
  for (int r = 1; r < 16; ++r) pmax = fmaxf(pmax, p0[r]);
#pragma unroll
  for (int r = 0; r < 16; ++r) pmax = fmaxf(pmax, p1[r]);
  { auto rr = __builtin_amdgcn_permlane32_swap(__float_as_uint(pmax), __float_as_uint(pmax), false, false);
    pmax = fmaxf(__uint_as_float(rr[0]), __uint_as_float(rr[1])); }
  if (__builtin_expect(__all(pmax - m_reg <= THR / SCALE), 1)) { mn = m_reg; alpha = 1.f; }
  else { mn = fmaxf(m_reg, pmax); alpha = __builtin_amdgcn_exp2f((m_reg - mn) * C); m_reg = mn; }
  const float mnC = -mn * C;
#pragma unroll
  for (int r = 0; r < 16; ++r) p0[r] = fmaf(p0[r], C, mnC);
#pragma unroll
  for (int r = 0; r < 16; ++r) p1[r] = fmaf(p1[r], C, mnC);
#pragma unroll
  for (int r = 0; r < 16; ++r) p0[r] = __builtin_amdgcn_exp2f(p0[r]);
}
__device__ __forceinline__ void finishSM(f32x16& p0, f32x16& p1, float alpha, float& l_reg, bf16x8& pa0, bf16x8& pa1, bf16x8& pa2, bf16x8& pa3) {
#pragma unroll
  for (int r = 0; r < 16; ++r) p1[r] = __builtin_amdgcn_exp2f(p1[r]);
  float ps = 0;
#pragma unroll
  for (int r = 0; r < 16; ++r) ps += p0[r];
#pragma unroll
  for (int r = 0; r < 16; ++r) ps += p1[r];
  { auto rr = __builtin_amdgcn_permlane32_swap(__float_as_uint(ps), __float_as_uint(ps), false, false);
    ps = __uint_as_float(rr[0]) + __uint_as_float(rr[1]); }
  l_reg = l_reg * alpha + ps;
#define PK4(P, BASE, OUT) do { unsigned a0 = cvtpk(P[BASE + 0], P[BASE + 1]), a1 = cvtpk(P[BASE + 2], P[BASE + 3]);   \
    unsigned b0 = cvtpk(P[BASE + 4], P[BASE + 5]), b1 = cvtpk(P[BASE + 6], P[BASE + 7]);                              \
    auto r0 = __builtin_amdgcn_permlane32_swap(a0, b0, false, false); auto r1 = __builtin_amdgcn_permlane32_swap(a1, b1, false, false); \
    u32x4 w = {r0[0], r1[0], r0[1], r1[1]}; OUT = *reinterpret_cast<bf16x8*>(&w); } while (0)
  PK4(p0, 0, pa0); PK4(p0, 8, pa1); PK4(p1, 0, pa2); PK4(p1, 8, pa3);
#undef PK4
}
__device__ __forceinline__ void qkt(f32x16& p0, f32x16& p1, const bf16* Ks, const bf16x8* qr, int r32, int hi) {
  p0 = f32x16{}; p1 = f32x16{};
#pragma unroll
  for (int d0 = 0; d0 < 8; ++d0) { const int cb = (d0 * 16 + hi * 8) * 2;
    bf16x8 b0 = *reinterpret_cast<const bf16x8*>((const char*)Ks + KSWZ(r32, cb));
    bf16x8 b1 = *reinterpret_cast<const bf16x8*>((const char*)Ks + KSWZ(32 + r32, cb));
    p0 = __builtin_amdgcn_mfma_f32_32x32x16_bf16(b0, qr[d0], p0, 0, 0, 0);
    p1 = __builtin_amdgcn_mfma_f32_32x32x16_bf16(b1, qr[d0], p1, 0, 0, 0); }
}
__device__ __forceinline__ int v_st(int k, int c) { const int kk = (k & ~0xC) | ((k & 4) << 1) | ((k & 8) >> 1); return ((kk >> 3) * 4 + (c >> 5)) * 512 + ((kk & 7) * 32 + (c & 31)) * 2; }
__device__ __forceinline__ int v_rd_base(int lane) { return ((lane & 3) << 3) | (((lane >> 2) & 3) << 6) | (((lane >> 4) & 1) << 5) | (((lane >> 5) & 1) << 8); }
constexpr int v_rd_off(int d0, int ks, int half) { return d0 * 512 + ks * 4096 + half * 2048; }
template <int OFF> __device__ __forceinline__ s16x4 tr_read(int vb) {
  s16x4 r; asm volatile("ds_read_b64_tr_b16 %0, %1 offset:%2" : "=&v"(r) : "v"(vb), "i"(OFF) : "memory"); return r;
}
template <int D0> __device__ __forceinline__ void pv_one(f32x16& od, int vb, bf16x8 pa0, bf16x8 pa1, bf16x8 pa2, bf16x8 pa3) {
  const s16x4 l0 = tr_read<v_rd_off(D0, 0, 0)>(vb), h0 = tr_read<v_rd_off(D0, 0, 1)>(vb), l1 = tr_read<v_rd_off(D0, 1, 0)>(vb), h1 = tr_read<v_rd_off(D0, 1, 1)>(vb);
  const s16x4 l2 = tr_read<v_rd_off(D0, 2, 0)>(vb), h2 = tr_read<v_rd_off(D0, 2, 1)>(vb), l3 = tr_read<v_rd_off(D0, 3, 0)>(vb), h3 = tr_read<v_rd_off(D0, 3, 1)>(vb);
  asm volatile("s_waitcnt lgkmcnt(0)" ::: "memory"); SBAR();
#define PK(L, H) (bf16x8){L[0], L[1], L[2], L[3], H[0], H[1], H[2], H[3]}
  od = __builtin_amdgcn_mfma_f32_32x32x16_bf16(pa0, PK(l0, h0), od, 0, 0, 0);
  od = __builtin_amdgcn_mfma_f32_32x32x16_bf16(pa1, PK(l1, h1), od, 0, 0, 0);
  od = __builtin_amdgcn_mfma_f32_32x32x16_bf16(pa2, PK(l2, h2), od, 0, 0, 0);
  od = __builtin_amdgcn_mfma_f32_32x32x16_bf16(pa3, PK(l3, h3), od, 0, 0, 0);
#undef PK
}
__device__ __forceinline__ void pv_d0(f32x16* o, int vb, bf16x8 pa0, bf16x8 pa1, bf16x8 pa2, bf16x8 pa3) {
  pv_one<0>(o[0], vb, pa0, pa1, pa2, pa3); pv_one<1>(o[1], vb, pa0, pa1, pa2, pa3); pv_one<2>(o[2], vb, pa0, pa1, pa2, pa3); pv_one<3>(o[3], vb, pa0, pa1, pa2, pa3);
}

template <int MODE>
__device__ __forceinline__ void attn_body(const bf16* __restrict__ Qb, long ldq, const bf16* __restrict__ Kh, const bf16* __restrict__ Vh, long ldk,
                                          int t0, int NT, int ntmax, int qpos0, float kk, float* __restrict__ Ob, long ldo, float* __restrict__ Lb, long ldl, char* lds) {
  const int tid = threadIdx.x, wid = tid >> 6, lane = tid & 63, r32 = lane & 31, hi = lane >> 5;
  bf16* V_lds = (bf16*)lds; bf16* K_lds = (bf16*)(lds + 2 * SHM_V);
  float* ws = (float*)(lds + 2 * SHM_V + 2 * SHM_K) + wid * 64; float* li_l = ws; float* al_l = ws + 32;
  float m_reg = -1e30f, l_reg = 0; f32x16 o[4] = {}; bf16x8 qr[8];
  const bf16* Qw = Qb + (long)(wid * QBLK + r32) * ldq + hi * 8;
#pragma unroll
  for (int d0 = 0; d0 < 8; ++d0) qr[d0] = *reinterpret_cast<const bf16x8*>(Qw + d0 * 16);
  const int sr = tid >> 4, sc = (tid & 15) * 8, vst0 = v_st(sr, sc), vst1 = v_st(32 + sr, sc);
  const int vb0 = (int)(uintptr_t)V_lds + v_rd_base(lane);
  const unsigned so0 = (unsigned)(sr * (int)ldk + sc), so1 = so0 + 32u * (unsigned)ldk;
  const float qposf = (float)(qpos0 + wid * QBLK + r32 - 4 * hi);
  struct { bf16x8 vs0, vs1, ks0, ks1; } sr_[2];
#define TCL(jt) ({ int _t = t0 + (jt); _t = _t < 0 ? 0 : (_t >= ntmax ? ntmax - 1 : _t); _t * KVBLK; })
#define TVALID(jt) ((t0 + (jt)) >= 0 && (t0 + (jt)) < ntmax)
#define RELB(jt) (qposf - (float)((t0 + (jt)) * KVBLK))
#define SLOAD(i, jt) do { const long _k0 = (long)TCL(jt) * ldk; const bf16* _vp = Vh + _k0; const bf16* _kp = Kh + _k0; \
    sr_[i].vs0 = *reinterpret_cast<const bf16x8*>(_vp + so0); sr_[i].vs1 = *reinterpret_cast<const bf16x8*>(_vp + so1); \
    sr_[i].ks0 = *reinterpret_cast<const bf16x8*>(_kp + so0); sr_[i].ks1 = *reinterpret_cast<const bf16x8*>(_kp + so1); } while (0)
#define SWRITE(b, i) do { *(bf16x8*)((char*)V_lds + (b) * SHM_V + vst0) = sr_[i].vs0;          \
    *(bf16x8*)((char*)V_lds + (b) * SHM_V + vst1) = sr_[i].vs1; const int kc = sc * 2;               \
    *(bf16x8*)((char*)K_lds + (b) * SHM_K + KSWZ(sr, kc)) = sr_[i].ks0;                       \
    *(bf16x8*)((char*)K_lds + (b) * SHM_K + KSWZ(32 + sr, kc)) = sr_[i].ks1; } while (0)
#define SWAIT() asm volatile("s_waitcnt vmcnt(4)" ::: "memory")
#define RESC(a) do { if (__any((a) < 1.f)) { if (hi == 0) al_l[r32] = (a); asm volatile("s_waitcnt lgkmcnt(0)" ::: "memory"); \
    _Pragma("unroll") for (int d = 0; d < 4; ++d) _Pragma("unroll") for (int r = 0; r < 16; ++r) o[d][r] *= al_l[crow(r, hi)]; } } while (0)
  f32x16 pA0, pA1, pB0, pB1; float mnA, mnB, alA, alB; bf16x8 pa0, pa1, pa2, pa3;
  constexpr int SE = 0, SO = 1;
  SLOAD(SE, 0); asm volatile("s_waitcnt vmcnt(0)" ::: "memory"); SWRITE(0, SE); __syncthreads();
  qkt(pA0, pA1, K_lds, qr, r32, hi); partialSM<MODE>(pA0, pA1, m_reg, mnA, alA, RELB(0), kk, TVALID(0));
  SLOAD(SO, 1); if (2 < NT) SLOAD(SE, 2);
  SWAIT(); SWRITE(1, SO); __syncthreads();
  for (int j = 1; j + 1 < NT; j += 2) {
    SBAR(); qkt(pB0, pB1, (bf16*)((char*)K_lds + SHM_K), qr, r32, hi);
    finishSM(pA0, pA1, alA, l_reg, pa0, pa1, pa2, pa3); SBAR();
    SLOAD(SO, j + 2); SBAR();
    pv_d0(o, vb0, pa0, pa1, pa2, pa3); partialSM<MODE>(pB0, pB1, m_reg, mnB, alB, RELB(j), kk, TVALID(j));
    __syncthreads(); SWAIT(); SWRITE(0, SE);
    RESC(alB); __syncthreads();
    SBAR(); qkt(pA0, pA1, K_lds, qr, r32, hi);
    finishSM(pB0, pB1, alB, l_reg, pa0, pa1, pa2, pa3); SBAR();
    if (j + 3 < NT) SLOAD(SE, j + 3); SBAR();
    pv_d0(o, vb0 + (int)SHM_V, pa0, pa1, pa2, pa3); partialSM<MODE>(pA0, pA1, m_reg, mnA, alA, RELB(j + 1), kk, TVALID(j + 1));
    __syncthreads(); SWAIT(); SWRITE(1, SO);
    RESC(alA); __syncthreads();
  }
  SBAR(); qkt(pB0, pB1, (bf16*)((char*)K_lds + SHM_K), qr, r32, hi);
  finishSM(pA0, pA1, alA, l_reg, pa0, pa1, pa2, pa3); SBAR();
  pv_d0(o, vb0, pa0, pa1, pa2, pa3); partialSM<MODE>(pB0, pB1, m_reg, mnB, alB, RELB(NT - 1), kk, TVALID(NT - 1));
  __syncthreads(); RESC(alB);
  finishSM(pB0, pB1, alB, l_reg, pa0, pa1, pa2, pa3); SBAR();
  pv_d0(o, vb0 + (int)SHM_V, pa0, pa1, pa2, pa3);
  if (hi == 0) li_l[r32] = l_reg; asm volatile("s_waitcnt lgkmcnt(0)" ::: "memory");
  float rli[16];
#pragma unroll
  for (int r = 0; r < 16; ++r) rli[r] = __builtin_amdgcn_rcpf(li_l[crow(r, hi)]);
  int hie = hi; asm volatile("" : "+v"(hie));
  float* Ow = Ob + (long)(wid * QBLK + 4 * hie) * ldo + r32;
#pragma unroll
  for (int r = 0; r < 16; ++r) { float* Or = Ow + (long)((r & 3) + 8 * (r >> 2)) * ldo;
#pragma unroll
    for (int d0 = 0; d0 < 4; ++d0) Or[d0 * 32] = o[d0][r] * rli[r]; }
  if (Lb != nullptr && hi == 0) Lb[(long)(wid * QBLK + r32) * ldl] = m_reg * SCALE + __logf(l_reg);
  __syncthreads();
#undef TCL
#undef TVALID
#undef RELB
#undef SLOAD
#undef SWRITE
#undef SWAIT
#undef RESC
}
#undef KSWZ
#undef SBAR
}
constexpr int NWAVES = 8;
#ifndef MK_SPLIT
#define MK_SPLIT 0
#endif
#ifndef DBG_ORACLE
#define DBG_ORACLE 0
#endif
constexpr int N_PHASES = 12;

constexpr int DM = 2048, BATCH = 2, SEQ = 4096, T = BATCH * SEQ;
constexpr int NQKV = 10240;
constexpr int C_QA = 0, C_KA = 1024, C_VA = 2048, C_QB = 3072, C_KB = 4096, C_VB = 5120, C_GA = 6144, C_GB = 8192;
constexpr int NE = 32, TOPK = 4, TK = T * TOPK, TKPAD = TK + NE * 256;
constexpr float EPS = 1e-5f;
constexpr float LAMBDA_INIT = 0.2f;

constexpr size_t MiB = 1u << 20;
constexpr size_t WS_CTL = 0, CTL_ZERO_BYTES = 1 * MiB;
constexpr size_t WS_MOD = 1 * MiB;
constexpr size_t WS_RC = 1 * MiB + 512 * 1024;
constexpr size_t WS_TOPI = 2 * MiB;
constexpr size_t WS_TOPP = 2 * MiB + 256 * 1024;
constexpr size_t WS_POS = 2 * MiB + 512 * 1024;
constexpr size_t WS_ERR = 3 * MiB;
constexpr size_t WS_WINT = 4 * MiB;
constexpr size_t WS_WING = 4 * MiB + (size_t)6144 * 4096;
constexpr size_t WS_U8Q = 770 * MiB;
constexpr size_t WS_WAT = 44 * MiB;
constexpr size_t WS_WBT = 48 * MiB;
constexpr size_t WS_WOT = 52 * MiB;
constexpr size_t WS_U = 64 * MiB;
constexpr size_t WS_QKV = 96 * MiB;
constexpr size_t WS_OA = 256 * MiB;
constexpr size_t WS_OB = 352 * MiB;
constexpr size_t WS_LSE = 416 * MiB;
constexpr size_t WS_YA = 418 * MiB;
constexpr size_t WS_YB = 434 * MiB;
constexpr size_t WS_M1 = 450 * MiB;
constexpr size_t WS_MG = 514 * MiB;
constexpr size_t WS_H1 = 546 * MiB;
constexpr size_t WS_XS = 610 * MiB;
constexpr size_t WS_YACT = 770 * MiB;
constexpr size_t WS_YSLOT = 930 * MiB;
constexpr size_t WS_WGU = 1090 * MiB;
constexpr size_t WS_WD = 1602 * MiB;
constexpr size_t WS_END = 1858 * MiB;
constexpr int CW_TMO = 0, CW_CODE = 1;
constexpr int CW_BAR = 4096;
constexpr int CW_CNT = 8192;

constexpr int RING_OFF = 0, RING_BYTES = 131072;
constexpr int LDSCTL_OFF = 139264, MISC_OFF = LDSCTL_OFF + 320;
constexpr int TST_OFF = LDSCTL_OFF + 1024;
constexpr int LDS_BYTES = 147456;

#define GAS __attribute__((address_space(1)))
#define LAS __attribute__((address_space(3)))
typedef unsigned short bf16;
typedef unsigned v4u __attribute__((ext_vector_type(4)));
typedef unsigned v2u __attribute__((ext_vector_type(2)));
typedef float f32x4 __attribute__((ext_vector_type(4)));
typedef GAS unsigned gu32;
#define RLX_AGENT __ATOMIC_RELAXED, __HIP_MEMORY_SCOPE_AGENT
#define LDS_WAIT() asm volatile("s_waitcnt lgkmcnt(0)" ::: "memory")
#define VM_WAIT() asm volatile("s_waitcnt vmcnt(0)" ::: "memory")
__device__ __forceinline__ unsigned f2bf(float f) { unsigned u = __builtin_bit_cast(unsigned, f); return (u + 0x7fffu + ((u >> 16) & 1u)) >> 16; }
__device__ __forceinline__ unsigned pk2(float lo, float hi) { return f2bf(lo) | (f2bf(hi) << 16); }
__device__ __forceinline__ float bf2f(unsigned short h) { return __uint_as_float(((unsigned)h) << 16); }
__device__ __forceinline__ float wave_sum(float v) {
#pragma unroll
    for (int o = 1; o < 64; o <<= 1) v += __shfl_xor(v, o);
    return v;
}
__device__ __forceinline__ float wave_max(float v) {
#pragma unroll
    for (int o = 1; o < 64; o <<= 1) v = fmaxf(v, __shfl_xor(v, o));
    return v;
}
__device__ __forceinline__ float siluf(float x) { return x / (1.0f + __expf(-x)); }
#define XB_TMO      128
#define XB_XCNT(j)  (256  + 64 * (j))
#define XB_XSUB(j)  (1280 + 64 * (j))
#define XB_XGEN(j)  (2304 + 64 * (j))
#define XB_TOP      3328
#define XB_TOPGEN   3392
#define XCD_BAR_WORDS 3456
#define XB_SPIN_CAP (1u << 18)

__device__ __forceinline__ unsigned xb_ld(unsigned* p)              { return __hip_atomic_load(p, __ATOMIC_RELAXED, __HIP_MEMORY_SCOPE_AGENT); }
__device__ __forceinline__ unsigned xb_add(unsigned* p, unsigned v) { return __hip_atomic_fetch_add(p, v, __ATOMIC_RELAXED, __HIP_MEMORY_SCOPE_AGENT); }
__device__ __forceinline__ unsigned xb_xcc_id() { return (unsigned)__builtin_amdgcn_s_getreg((3 << 11) | 20) & 0xFu; }
#define XB_SPIN(cond, bar) do { unsigned _sp = 0; while (cond) { __builtin_amdgcn_s_sleep(1); \
    if ((++_sp & 255u) == 0u) { if (xb_ld(&(bar)[XB_TMO])) break; if (_sp > XB_SPIN_CAP) { atomicAdd(&(bar)[XB_TMO], 1u); break; } } } } while (0)

struct XcdBarrier {
    unsigned* bar; unsigned x;
    volatile LAS unsigned* st;
};

__device__ __forceinline__ XcdBarrier xcd_barrier_post(unsigned* bar, volatile LAS unsigned* st) {
    XcdBarrier b; b.bar = bar; b.x = xb_xcc_id(); b.st = st;
    if (threadIdx.x == 0) (void)xb_add(&bar[XB_XCNT(b.x)], 1u);
    return b;
}
__device__ __forceinline__ void xcd_barrier_complete(unsigned* bar, unsigned x, unsigned& nloc, unsigned& nx) {
    const unsigned G = gridDim.x * gridDim.y * gridDim.z;
    unsigned sum, cnt, mine, sp = 0u;
    for (;;) {
        sum = 0u; cnt = 0u; mine = 0u;
#pragma unroll
        for (unsigned j = 0; j < 16; ++j) { const unsigned c = xb_ld(&bar[XB_XCNT(j)]); sum += c; cnt += (c > 0u) ? 1u : 0u; mine = (j == x) ? c : mine; }
        if (sum == G) break;
        __builtin_amdgcn_s_sleep(1);
        if ((++sp & 255u) == 0u) { if (xb_ld(&bar[XB_TMO])) break; if (sp > XB_SPIN_CAP) { atomicAdd(&bar[XB_TMO], 1u); break; } }
    }
    nloc = mine > 0u ? mine : 1u; nx = cnt > 0u ? cnt : 1u;
}

__device__ __forceinline__ void xcd_barrier(const XcdBarrier& b) {
    asm volatile("s_waitcnt vmcnt(0)" ::: "memory");
    __syncthreads();
    if (threadIdx.x == 0) {
        unsigned* bar = b.bar;
        __builtin_amdgcn_s_waitcnt(0);
        unsigned nloc = b.st[0], nx = b.st[1];
        if (nloc == 0u) { xcd_barrier_complete(bar, b.x, nloc, nx); b.st[0] = nloc; b.st[1] = nx; }
        const unsigned old = xb_add(&bar[XB_XSUB(b.x)], 1u);
        const unsigned gen = old / nloc;
        if (old + 1u == (gen + 1u) * nloc) {
            __builtin_amdgcn_fence(__ATOMIC_RELEASE, "agent");
            asm volatile("s_waitcnt vmcnt(0)" ::: "memory");
            const unsigned og = xb_add(&bar[XB_TOP], 1u);
            const unsigned tg = og / nx;
            if (og + 1u == (tg + 1u) * nx) xb_add(&bar[XB_TOPGEN], 1u);
            else XB_SPIN(xb_ld(&bar[XB_TOPGEN]) == tg, bar);
            __builtin_amdgcn_fence(__ATOMIC_ACQUIRE, "agent");
            xb_add(&bar[XB_XGEN(b.x)], 1u);
            asm volatile("s_waitcnt vmcnt(0)" ::: "memory");
        } else {
            XB_SPIN(xb_ld(&bar[XB_XGEN(b.x)]) == gen, bar);
            __builtin_amdgcn_fence(__ATOMIC_ACQUIRE, "agent");
            asm volatile("s_waitcnt vmcnt(0)" ::: "memory");
        }
    }
    __syncthreads();
}
struct Args { const float* in[24]; float* out; unsigned char* ws; int ph_lo, ph_hi; };
enum { I_X = 0, I_C, I_WADA, I_BADA, I_N1G, I_WIN, I_LQ1, I_LK1, I_LQ2, I_LK2, I_SUBG, I_WOA, I_WOB, I_WO, I_N2G, I_WR, I_BR, I_WG, I_BG, I_WU, I_BU, I_WDN, I_BDN, I_FG };
struct Frame {
    LAS unsigned char* lds; char* ldsg;
    volatile LAS unsigned* MISC;
    gu32* ctl;
    int tid, lane, wave, vcu, G;
    unsigned char* ws;
};
#define WSP(T_, off) ((T_*)(F.ws + (off)))

constexpr float WSCALE = 64.0f;
__device__ __forceinline__ unsigned cvtpk_bf(float lo, float hi) { unsigned r; asm volatile("v_cvt_pk_bf16_f32 %0, %1, %2" : "=v"(r) : "v"(lo), "v"(hi)); return r; }
__device__ __forceinline__ void cvt_load(f32x4 (&v)[8], const float* __restrict__ W, int N, int k0, int n0, int lane) {
    const int lr = lane >> 3, lc = 4 * (lane & 7);
#pragma unroll
    for (int i = 0; i < 8; ++i) v[i] = __builtin_nontemporal_load((const f32x4*)(W + (size_t)(k0 + lr + 8 * i) * N + n0 + lc));
}
template <bool F8>
__device__ __forceinline__ void cvt_store(const f32x4 (&v)[8], int K, void* __restrict__ WT, int k0, long dst_row0, LAS float* scr, int lane) {
    const int lr = lane >> 3, lc = 4 * (lane & 7);
#pragma unroll
    for (int i = 0; i < 8; ++i) { LAS float* s = scr + (lr + 8 * i) * 33 + lc; s[0] = v[i].x; s[1] = v[i].y; s[2] = v[i].z; s[3] = v[i].w; }
    LDS_WAIT(); asm volatile("" ::: "memory");
    const int c = lane & 7;
#pragma unroll
    for (int j = 0; j < 4; ++j) { const int n = (lane >> 3) + 8 * j; const LAS float* s = scr + (8 * c) * 33 + n;
        if constexpr (F8) {
            int w0 = __builtin_amdgcn_cvt_pk_fp8_f32(s[0 * 33] * WSCALE, s[1 * 33] * WSCALE, 0, false); w0 = __builtin_amdgcn_cvt_pk_fp8_f32(s[2 * 33] * WSCALE, s[3 * 33] * WSCALE, w0, true);
            int w1 = __builtin_amdgcn_cvt_pk_fp8_f32(s[4 * 33] * WSCALE, s[5 * 33] * WSCALE, 0, false); w1 = __builtin_amdgcn_cvt_pk_fp8_f32(s[6 * 33] * WSCALE, s[7 * 33] * WSCALE, w1, true);
            *(v2u*)((unsigned char*)WT + (size_t)(dst_row0 + n) * K + k0 + 8 * c) = (v2u){(unsigned)w0, (unsigned)w1};
        } else {
            v4u o; o.x = cvtpk_bf(s[0 * 33], s[1 * 33]); o.y = cvtpk_bf(s[2 * 33], s[3 * 33]); o.z = cvtpk_bf(s[4 * 33], s[5 * 33]); o.w = cvtpk_bf(s[6 * 33], s[7 * 33]);
            *(v4u*)((bf16*)WT + (size_t)(dst_row0 + n) * K + k0 + 8 * c) = o; } }
    LDS_WAIT(); asm volatile("" ::: "memory");
}
__device__ __forceinline__ void cvt8_load(f32x4 (&v)[16], const float* __restrict__ W, int k0, int n0, int lane, int N = DM) {
    const float* p = W + (size_t)(k0 + (lane >> 3)) * N + n0 + 4 * (lane & 7);
#pragma unroll
    for (int i = 0; i < 16; ++i) v[i] = __builtin_nontemporal_load((const f32x4*)(p + (size_t)(8 * i) * N));
}
__device__ __forceinline__ void cvt8_store(const f32x4 (&v)[16], unsigned char* __restrict__ WT, int k0, long dst_row0, LAS float* scr, int lane) {
    const int lr = lane >> 3, lc = 4 * (lane & 7);
#pragma unroll
    for (int i = 0; i < 16; ++i) { LAS float* s = scr + (lr + 8 * i) * 33 + ((lc + 4 * (i >> 1)) & 31);
        s[0] = v[i].x; s[1] = v[i].y; s[2] = v[i].z; s[3] = v[i].w; }
    LDS_WAIT(); asm volatile("" ::: "memory");
    const int c = lane & 7;
#pragma unroll
    for (int j = 0; j < 4; ++j) { const int n = (lane >> 3) + 8 * j; const LAS float* s = scr + (16 * c) * 33 + ((n + 4 * c) & 31);
        v4u o;
#pragma unroll
        for (int h = 0; h < 4; ++h) { int w = __builtin_amdgcn_cvt_pk_fp8_f32(s[(4 * h + 0) * 33] * WSCALE, s[(4 * h + 1) * 33] * WSCALE, 0, false);
            w = __builtin_amdgcn_cvt_pk_fp8_f32(s[(4 * h + 2) * 33] * WSCALE, s[(4 * h + 3) * 33] * WSCALE, w, true); o[h] = (unsigned)w; }
        *(v4u*)(WT + (size_t)(dst_row0 + n) * DM + k0 + 16 * c) = o; }
    LDS_WAIT(); asm volatile("" ::: "memory");
}
__device__ __forceinline__ void p0_mod(Frame& F, const Args& A) {
    LAS float* red = (LAS float*)F.lds;
    if (F.vcu < 192) {
        const int col = F.vcu * 64 + F.lane, k0 = F.wave * 256;
        const float* wp = A.in[I_WADA] + (size_t)k0 * 12288 + col; const float* cp = A.in[I_C];
        float a0 = 0.f, a1 = 0.f;
#pragma unroll 16
        for (int k = 0; k < 256; ++k) { const float wv = __builtin_nontemporal_load(wp + (size_t)k * 12288); a0 = fmaf(siluf(cp[k0 + k]), wv, a0); a1 = fmaf(siluf(cp[2048 + k0 + k]), wv, a1); }
        red[(F.wave * 2 + 0) * 64 + F.lane] = a0; red[(F.wave * 2 + 1) * 64 + F.lane] = a1;
    }
    __syncthreads();
    if (F.vcu < 192 && F.tid < 128) { const int b = F.tid >> 6, l = F.tid & 63; float s = 0.f;
#pragma unroll
        for (int w = 0; w < 8; ++w) s += red[(w * 2 + b) * 64 + l];
        const int col = F.vcu * 64 + l; WSP(float, WS_MOD)[b * 12288 + col] = s + A.in[I_BADA][col]; }
    __syncthreads();
}
__device__ __forceinline__ void p0_convert(Frame& F, const Args& A) {
    LAS float* scr = (LAS float*)(F.lds + F.wave * 16384);
    const int gw = F.vcu * NWAVES + F.wave, NGW = F.G * NWAVES;
    constexpr int I_IN = 32 * 320, I_A = 16 * 64, I_B = 16 * 64, I_O = 32 * 64, NSMALL = I_IN + I_A + I_B + I_O;
    f32x4 v0[8];
#pragma unroll 1
    for (int it = gw; it < NSMALL; it += NGW) { int r = it; const float* W; bf16* WT; int N, K;
        if (r < I_IN) { W = A.in[I_WIN]; WT = WSP(bf16, WS_WINT); N = NQKV; K = DM; if ((r % 320) * 32 >= C_GA) continue; }
        else if ((r -= I_IN) < I_A) { W = A.in[I_WOA]; WT = WSP(bf16, WS_WAT); N = DM; K = 1024; }
        else if ((r -= I_A) < I_B) { W = A.in[I_WOB]; WT = WSP(bf16, WS_WBT); N = DM; K = 1024; }
        else { r -= I_B; W = A.in[I_WO]; WT = WSP(bf16, WS_WOT); N = DM; K = DM; }
        const int nnb = N / 32, k0 = (r / nnb) * 64, n0 = (r % nnb) * 32;
        cvt_load(v0, W, N, k0, n0, F.lane); cvt_store<false>(v0, K, WT, k0, n0, scr, F.lane); }
    { __syncthreads(); LAS float* scr8 = (LAS float*)(F.lds + F.wave * 16896); f32x4 va[16];
#pragma unroll 1
      for (int it = gw; it < 16 * 128; it += NGW) { const int k0 = (it >> 7) * 128, n0 = (it & 127) * 32;
          cvt8_load(va, A.in[I_WIN], k0, C_GA + n0, F.lane, NQKV); cvt8_store(va, WSP(unsigned char, WS_WING), k0, n0, scr8, F.lane); } }
}
__device__ __forceinline__ void convert_experts(Frame& F, const Args& A) {
    int lane_ = F.lane, wave_ = F.wave; asm volatile("" : "+v"(lane_), "+s"(wave_));
    LAS float* scr8 = (LAS float*)(F.lds + wave_ * 16896);
    const int gw = F.vcu * NWAVES + wave_, NGW = F.G * NWAVES; constexpr int NIT = 96 * 1024;
    f32x4 va[16], vb[16];
    const float* pg_ = A.in[I_WG]; const float* pu_ = A.in[I_WU]; const float* pd_ = A.in[I_WDN];
    asm volatile("" : "+s"(pg_), "+s"(pu_), "+s"(pd_));
#define CV_LOAD(buf, it_) do { if ((it_) < NIT) { const int m_ = (it_) >> 10, tp_ = (it_) & 1023, e_ = m_ / 3, w_ = m_ % 3; const float* W_ = (w_ == 0 ? pg_ : (w_ == 1 ? pu_ : pd_)) + (size_t)e_ * DM * DM; \
        cvt8_load(buf, W_, (tp_ >> 6) * 128, (tp_ & 63) * 32, lane_); } } while (0)
#define CV_STORE(buf, it_) do { if ((it_) < NIT) { const int m_ = (it_) >> 10, tp_ = (it_) & 1023, e_ = m_ / 3, w_ = m_ % 3, k0_ = (tp_ >> 6) * 128, n0_ = (tp_ & 63) * 32; \
        if (w_ == 2) cvt8_store(buf, WSP(unsigned char, WS_WD), k0_, (long)e_ * 2048 + n0_, scr8, lane_); \
        else cvt8_store(buf, WSP(unsigned char, WS_WGU), k0_, (long)e_ * 4096 + (long)(n0_ >> 7) * 256 + (n0_ & 127) + (w_ == 1 ? 128 : 0), scr8, lane_); } } while (0)
    __syncthreads();
#if defined(PROBE_RO2)
#pragma unroll 1
    for (int it = gw; it < NIT; it += 2 * NGW) { CV_LOAD(va, it); CV_LOAD(vb, it + NGW);
#pragma unroll
        for (int q = 0; q < 16; ++q) asm volatile("" :: "v"(va[q]), "v"(vb[q])); }
#endif
    CV_LOAD(va, gw);
#pragma unroll 1
    for (int it = gw; it < NIT; it += 2 * NGW) {
        CV_LOAD(vb, it + NGW); CV_STORE(va, it);
        CV_LOAD(va, it + 2 * NGW); CV_STORE(vb, it + NGW);
    }
#undef CV_LOAD
#undef CV_STORE
    __syncthreads();
}
__device__ __forceinline__ void p1_modulate(Frame& F, const Args& A) {
    const int gw = F.vcu * NWAVES + F.wave, NGW = F.G * NWAVES; const float* MOD = WSP(float, WS_MOD);
    if (gw < 64) { const int b = gw >> 5, e = gw & 31; float s = 0.f;
        for (int k = F.lane; k < DM; k += 64) s = fmaf(MOD[b * 12288 + 3 * DM + k], A.in[I_WR][k * 32 + e], s);
        s = wave_sum(s); if (F.lane == 0) WSP(float, WS_RC)[b * 32 + e] = s + A.in[I_BR][e]; }
    for (int m = gw; m < T; m += NGW) {
        const int b = m / SEQ; const float* xr = A.in[I_X] + (size_t)m * DM + 4 * F.lane; f32x4 v[8]; float s = 0.f;
#pragma unroll
        for (int j = 0; j < 8; ++j) { v[j] = *(const f32x4*)(xr + 256 * j); s += (v[j].x * v[j].x + v[j].y * v[j].y) + (v[j].z * v[j].z + v[j].w * v[j].w); }
        const float rstd = 1.0f / sqrtf(wave_sum(s) * (1.0f / DM) + EPS);
        bf16* ur = WSP(bf16, WS_U) + (size_t)m * DM + 4 * F.lane;
#pragma unroll
        for (int j = 0; j < 8; ++j) { const int k = 4 * F.lane + 256 * j;
            const f32x4 g = *(const f32x4*)(A.in[I_N1G] + k), sc = *(const f32x4*)(MOD + b * 12288 + 1 * DM + k), sh = *(const f32x4*)(MOD + b * 12288 + k);
            const f32x4 u = v[j] * rstd * g * (sc + 1.0f) + sh; v2u o; o.x = pk2(u.x, u.y); o.y = pk2(u.z, u.w); *(v2u*)(ur + 256 * j) = o;
            int w8 = __builtin_amdgcn_cvt_pk_fp8_f32(u.x, u.y, 0, false); w8 = __builtin_amdgcn_cvt_pk_fp8_f32(u.z, u.w, w8, true); *(int*)(WSP(unsigned char, WS_U8Q) + (size_t)m * DM + 4 * F.lane + 256 * j) = w8; }
    }
}
__device__ __forceinline__ void p3_attention(Frame& F, const Args& A) {
    const bf16* QKV = WSP(bf16, WS_QKV);
    const int nsteps = (1280 + F.G - 1) / F.G, grp = (F.vcu >> 3) & 3;
    const int cstep = grp == 0 ? 0 : (grp == 1 ? 1 : (grp == 2 ? 2 : nsteps));
#pragma unroll 1
    for (int step = 0; step <= nsteps; ++step) {
        if (step == (cstep < nsteps ? cstep : nsteps)) convert_experts(F, A);
        const int i = F.vcu + step * F.G;
        if (step == nsteps || i >= 1280) continue;
        if (i < 512) {
            const int c2 = i >> 5, b = c2 >> 3, h = (c2 >> 1) & 3, c = c2 & 1, vh = (i >> 4) & 1, qb = i & 15;
            const size_t rowb = (size_t)b * SEQ;
            const bf16* Qb = QKV + (rowb + qb * 256) * NQKV + C_QB + h * 256 + c * 128;
            const bf16* Kh = QKV + rowb * NQKV + C_KB + h * 256 + c * 128;
            const bf16* Vh = QKV + rowb * NQKV + C_VB + h * 256 + vh * 128;
            float* Ob = WSP(float, WS_OB) + ((size_t)c * T + rowb + qb * 256) * 1024 + h * 256 + vh * 128;
            const float slope = exp2f(-(float)(8 + h + 1) * (8.0f / 12.0f));
            att::attn_body<0>(Qb, NQKV, Kh, Vh, NQKV, 0, SEQ / 64, SEQ / 64, qb * 256, slope / att::SCALE, Ob, 1024, nullptr, 0, F.ldsg);
        } else {
            const int j = i - 512, p = j >> 8, r = j & 255, b = r >> 7, h = (r >> 4) & 7, uu = r & 15;
            const int dil = p == 0 ? 1 : (p == 1 ? 4 : 16), L = SEQ / dil, gpr = L / 256, res = uu / gpr, g = uu % gpr;
            const size_t rowb = (size_t)b * SEQ + res;
            const bf16* Qb = QKV + (rowb + (size_t)g * 256 * dil) * NQKV + C_QA + h * 128;
            const bf16* Kh = QKV + rowb * NQKV + C_KA + h * 128;
            const bf16* Vh = QKV + rowb * NQKV + C_VA + h * 128;
            float* Ob = WSP(float, WS_OA) + ((size_t)p * T + rowb + (size_t)g * 256 * dil) * 1024 + h * 128;
            float* Lb = WSP(float, WS_LSE) + ((size_t)p * T + rowb + (size_t)g * 256 * dil) * 8 + h;
            const float slope = exp2f(-(float)(h + 1) * (8.0f / 12.0f)) * (float)dil;
            att::attn_body<1>(Qb, (long)dil * NQKV, Kh, Vh, (long)dil * NQKV, 4 * g - 1, 6, L / 64, g * 256, slope / att::SCALE, Ob, (long)dil * 1024, Lb, (long)dil * 8, F.ldsg);
        }
    }
}
__device__ __forceinline__ void p4_finalize(Frame& F, const Args& A) {
    const int gw = F.vcu * NWAVES + F.wave, NGW = F.G * NWAVES;
    float s1 = A.in[I_LQ1][F.lane] * A.in[I_LK1][F.lane] + A.in[I_LQ1][F.lane + 64] * A.in[I_LK1][F.lane + 64];
    float s2 = A.in[I_LQ2][F.lane] * A.in[I_LK2][F.lane] + A.in[I_LQ2][F.lane + 64] * A.in[I_LK2][F.lane + 64];
    s1 = wave_sum(s1); s2 = wave_sum(s2);
    const float lam = expf(s1) - expf(s2) + LAMBDA_INIT;
    const float* OA = WSP(float, WS_OA); const float* OB = WSP(float, WS_OB); const float* LS = WSP(float, WS_LSE);
    for (int m = gw; m < T; m += NGW) {
        { const int h = F.lane >> 3; const float l0 = LS[((size_t)0 * T + m) * 8 + h], l1 = LS[((size_t)1 * T + m) * 8 + h], l2 = LS[((size_t)2 * T + m) * 8 + h];
          const float mx = fmaxf(l0, fmaxf(l1, l2)); float w0 = __expf(l0 - mx), w1 = __expf(l1 - mx), w2 = __expf(l2 - mx); const float inv = 1.0f / (w0 + w1 + w2); w0 *= inv; w1 *= inv; w2 *= inv;
          const size_t o = (size_t)m * 1024 + 16 * F.lane; unsigned pk[8];
#pragma unroll
          for (int q = 0; q < 4; ++q) { const f32x4 a0 = *(const f32x4*)(OA + o + 4 * q), a1 = *(const f32x4*)(OA + (size_t)T * 1024 + o + 4 * q), a2 = *(const f32x4*)(OA + (size_t)2 * T * 1024 + o + 4 * q);
              const f32x4 y = a0 * w0 + a1 * w1 + a2 * w2; pk[2 * q] = pk2(y.x, y.y); pk[2 * q + 1] = pk2(y.z, y.w); }
          bf16* ya = WSP(bf16, WS_YA) + o; *(v4u*)ya = (v4u){pk[0], pk[1], pk[2], pk[3]}; *(v4u*)(ya + 8) = (v4u){pk[4], pk[5], pk[6], pk[7]}; }
#pragma unroll
        for (int h = 0; h < 4; ++h) { const size_t o = (size_t)m * 1024 + h * 256 + 4 * F.lane;
            const f32x4 v = *(const f32x4*)(OB + o) - *(const f32x4*)(OB + (size_t)T * 1024 + o) * lam;
            const float ss = wave_sum((v.x * v.x + v.y * v.y) + (v.z * v.z + v.w * v.w)); const float rstd = 1.0f / sqrtf(ss * (1.0f / 256.0f) + EPS);
            const f32x4 g = *(const f32x4*)(A.in[I_SUBG] + 4 * F.lane); const f32x4 y = v * rstd * g * (1.0f - LAMBDA_INIT);
            v2u w; w.x = pk2(y.x, y.y); w.y = pk2(y.z, y.w); *(v2u*)(WSP(bf16, WS_YB) + o) = w; }
    }
}
typedef float f32x16r __attribute__((ext_vector_type(16)));
__device__ __forceinline__ void p7_router(Frame& F, const Args& A, bool commit = true) {
    LAS float* gainL = (LAS float*)F.lds;
    LAS float* shiftL = gainL + 2048;
    LAS float* part = shiftL + 2048;
    LAS float* ssp = part + 8 * 32 * 32;
    LAS float* logitL = ssp + 512;
    LAS float* rstdL = logitL + 32 * 33;
    LAS int* lcnt = (LAS int*)(rstdL + 32);
    LAS int* lbase = lcnt + 32;
    const float* H1 = WSP(float, WS_H1); const float* MODp = WSP(float, WS_MOD); const float* RC = WSP(float, WS_RC);
    for (int blk = F.vcu; blk < T / 32; blk += F.G) {
        const int t0 = blk * 32, bb = t0 / SEQ; const float* mod = MODp + bb * 12288;
        for (int k = F.tid; k < DM; k += 512) { gainL[k] = A.in[I_N2G][k] * (1.0f + mod[4 * DM + k]); shiftL[k] = mod[3 * DM + k]; }
        if (F.tid < 32) lcnt[F.tid] = 0;
        __syncthreads();
        {
            const int i = F.lane & 31, kk = F.lane >> 5, kb = F.wave * 256 + kk * 128;
            const float* hp = H1 + (size_t)(t0 + i) * DM + kb; const float* wp = A.in[I_WR] + (size_t)kb * 32 + i; const LAS float* gp = gainL + kb;
            f32x16r acc = {}; float ss = 0.f;
#pragma unroll 4
            for (int s0 = 0; s0 < 128; s0 += 4) {
                const f32x4 hv = *(const f32x4*)(hp + s0); const f32x4 g4 = *(const LAS f32x4*)(gp + s0);
                const float b0 = wp[(s0 + 0) * 32], b1 = wp[(s0 + 1) * 32], b2 = wp[(s0 + 2) * 32], b3 = wp[(s0 + 3) * 32];
                ss += (hv.x * hv.x + hv.y * hv.y) + (hv.z * hv.z + hv.w * hv.w);
                acc = __builtin_amdgcn_mfma_f32_32x32x2f32(hv.x * g4.x, b0, acc, 0, 0, 0);
                acc = __builtin_amdgcn_mfma_f32_32x32x2f32(hv.y * g4.y, b1, acc, 0, 0, 0);
                acc = __builtin_amdgcn_mfma_f32_32x32x2f32(hv.z * g4.z, b2, acc, 0, 0, 0);
                acc = __builtin_amdgcn_mfma_f32_32x32x2f32(hv.w * g4.w, b3, acc, 0, 0, 0);
            }
#pragma unroll
            for (int r = 0; r < 16; ++r) part[(F.wave * 32 + (r & 3) + 8 * (r >> 2) + 4 * kk) * 32 + i] = acc[r];
            ssp[F.wave * 64 + F.lane] = ss;
        }
        __syncthreads();
        { const int token = F.tid & 31, eg = F.tid >> 5; float s2 = 0.f;
#pragma unroll
          for (int w = 0; w < 8; ++w) s2 += ssp[w * 64 + token] + ssp[w * 64 + 32 + token];
          const float rstd = 1.0f / sqrtf(s2 * (1.0f / DM) + EPS);
#pragma unroll
          for (int q = 0; q < 2; ++q) { const int e = eg * 2 + q; float raw = 0.f;
#pragma unroll
              for (int w = 0; w < 8; ++w) raw += part[(w * 32 + token) * 32 + e];
              logitL[token * 33 + e] = rstd * raw + RC[bb * 32 + e]; }
          if (eg == 0) rstdL[token] = rstd; }
        __syncthreads();
        int se[4] = {0, 0, 0, 0}, lp[4] = {0, 0, 0, 0}; float pv[4] = {0.f, 0.f, 0.f, 0.f};
        if (F.tid < 32) {
            float sv[4];
#pragma unroll
            for (int k = 0; k < 4; ++k) { float best = -INFINITY; int bi = 0;
                for (int e = 0; e < 32; ++e) { const float v = logitL[F.tid * 33 + e]; if (v > best) { best = v; bi = e; } }
                sv[k] = best; se[k] = bi; logitL[F.tid * 33 + bi] = -INFINITY; }
            float sum = 0.f;
#pragma unroll
            for (int k = 0; k < 4; ++k) { pv[k] = expf(sv[k] - sv[0]); sum += pv[k]; }
            const float inv = 1.0f / sum;
#pragma unroll
            for (int k = 0; k < 4; ++k) { pv[k] *= inv; lp[k] = __hip_atomic_fetch_add(lcnt + se[k], 1, __ATOMIC_RELAXED, __HIP_MEMORY_SCOPE_WORKGROUP); }
        }
        __syncthreads();
        if (F.tid < 32 && commit) lbase[F.tid] = (int)__hip_atomic_fetch_add((unsigned*)(F.ctl + CW_CNT + 64 * F.tid), (unsigned)lcnt[F.tid], RLX_AGENT);
        __syncthreads();
        if (F.tid < 32 && commit) { const int m = t0 + F.tid;
#pragma unroll
            for (int k = 0; k < 4; ++k) { WSP(int, WS_TOPI)[m * 4 + k] = se[k]; WSP(float, WS_TOPP)[m * 4 + k] = pv[k]; WSP(int, WS_POS)[m * 4 + k] = lbase[se[k]] + lp[k]; } }
        for (int i = 0; i < 4; ++i) { const int token = F.wave * 4 + i, m = t0 + token; const float rstd = rstdL[token];
            const float* hr = H1 + (size_t)m * DM + 4 * F.lane; unsigned char* ur = WSP(unsigned char, WS_U) + (size_t)m * DM + 4 * F.lane;
#pragma unroll
            for (int j = 0; j < 8; ++j) { const f32x4 h = *(const f32x4*)(hr + 256 * j), g = *(const LAS f32x4*)(gainL + 4 * F.lane + 256 * j), s = *(const LAS f32x4*)(shiftL + 4 * F.lane + 256 * j);
                const f32x4 u = h * rstd * g + s; int w8 = __builtin_amdgcn_cvt_pk_fp8_f32(u.x, u.y, 0, false); w8 = __builtin_amdgcn_cvt_pk_fp8_f32(u.z, u.w, w8, true); *(int*)(ur + 256 * j) = w8; } }
        __syncthreads();
    }
}
__device__ __forceinline__ void build_tile_table(Frame& F) {
    LAS int* ts = (LAS int*)(F.lds + TST_OFF);
    if (F.tid == 0) { int acc = 0;
        for (int e = 0; e < NE; ++e) { ts[e] = acc; acc += ((int)__hip_atomic_load((unsigned*)(F.ctl + CW_CNT + 64 * e), RLX_AGENT) + 255) >> 8; }
        ts[32] = acc; }
    __syncthreads();
}
__device__ __forceinline__ void p8_gather(Frame& F, const Args& A) {
    build_tile_table(F);
    const LAS int* ts = (const LAS int*)(F.lds + TST_OFF);
    const int gw = F.vcu * NWAVES + F.wave, NGW = F.G * NWAVES;
    for (int m = gw; m < T; m += NGW) {
        const v4u* src = (const v4u*)(WSP(unsigned char, WS_U) + (size_t)m * DM); v4u v[2];
#pragma unroll
        for (int q = 0; q < 2; ++q) v[q] = src[F.lane + 64 * q];
#pragma unroll
        for (int k = 0; k < 4; ++k) { const int e = WSP(int, WS_TOPI)[m * 4 + k], pos = WSP(int, WS_POS)[m * 4 + k]; const size_t row = (size_t)ts[e] * 256 + pos;
            v4u* dst = (v4u*)(WSP(unsigned char, WS_XS) + row * DM);
#pragma unroll
            for (int q = 0; q < 2; ++q) dst[F.lane + 64 * q] = v[q]; }
    }
}
__device__ __forceinline__ void p11_final(Frame& F, const Args& A) {
    build_tile_table(F);
    const LAS int* ts = (const LAS int*)(F.lds + TST_OFF);
    const int gw = F.vcu * NWAVES + F.wave, NGW = F.G * NWAVES; const float* MODp = WSP(float, WS_MOD);
    for (int m = gw; m < T; m += NGW) {
        const int bb = m / SEQ; const bf16* yr[4]; float p[4];
#pragma unroll
        for (int k = 0; k < 4; ++k) { const int e = WSP(int, WS_TOPI)[m * 4 + k], pos = WSP(int, WS_POS)[m * 4 + k]; p[k] = WSP(float, WS_TOPP)[m * 4 + k];
            yr[k] = WSP(bf16, WS_YSLOT) + ((size_t)ts[e] * 256 + pos) * DM + 4 * F.lane; }
        const float* hr = WSP(float, WS_H1) + (size_t)m * DM + 4 * F.lane; f32x4 v[8]; float s = 0.f;
#pragma unroll
        for (int j = 0; j < 8; ++j) { f32x4 a = {0.f, 0.f, 0.f, 0.f};
#pragma unroll
            for (int k = 0; k < 4; ++k) { const v2u w = *(const v2u*)(yr[k] + 256 * j); const f32x4 y = {__uint_as_float(w.x << 16), __uint_as_float(w.x & 0xffff0000u), __uint_as_float(w.y << 16), __uint_as_float(w.y & 0xffff0000u)}; a += y * p[k]; }
            const f32x4 g2 = *(const f32x4*)(MODp + bb * 12288 + 5 * DM + 4 * F.lane + 256 * j);
            v[j] = *(const f32x4*)(hr + 256 * j) + g2 * a; s += (v[j].x * v[j].x + v[j].y * v[j].y) + (v[j].z * v[j].z + v[j].w * v[j].w); }
        const float rstd = 1.0f / sqrtf(wave_sum(s) * (1.0f / DM) + EPS);
        float* orow = A.out + (size_t)m * DM + 4 * F.lane;
#pragma unroll
        for (int j = 0; j < 8; ++j) { const f32x4 g = *(const f32x4*)(A.in[I_FG] + 4 * F.lane + 256 * j); *(f32x4*)(orow + 256 * j) = v[j] * rstd * g; }
    }
}

__global__ void __launch_bounds__(NWAVES * 64, 2) fwd(Args args) {
    extern __shared__ __attribute__((aligned(16))) unsigned char lds[];
    Frame F;
    F.lds = (LAS unsigned char*)lds; F.ldsg = (char*)lds;
    F.MISC = (volatile LAS unsigned*)(F.lds + MISC_OFF);
    F.tid = threadIdx.x; F.lane = F.tid & 63; F.wave = __builtin_amdgcn_readfirstlane(F.tid >> 6);
    F.G = gridDim.x; { const int bx = blockIdx.x; F.vcu = (F.G % 8 == 0) ? (bx % 8) * (F.G / 8) + bx / 8 : bx; }
    F.ws = args.ws; F.ctl = (gu32*)(args.ws + WS_CTL);
    for (int u = F.tid; u < (LDS_BYTES - LDSCTL_OFF) / 4; u += NWAVES * 64) ((LAS unsigned*)(F.lds + LDSCTL_OFF))[u] = 0u;
    __syncthreads();
#if MK_SPLIT
#define GRID_BAR() do { } while (0)
#else
    XcdBarrier bar = xcd_barrier_post((unsigned*)(F.ctl + CW_BAR), F.MISC + 8);
#define GRID_BAR() xcd_barrier(bar)
#endif
    const int lo = args.ph_lo, hi = args.ph_hi;
#define IN(k) (lo <= (k) && (k) < hi)
#define SEAM(k) do { if (IN(k) && IN((k) + 1)) GRID_BAR(); } while (0)
    const Args& A = args;
    constexpr bool AL = true, SP = true;

#ifndef REP_PHASE
#define REP_PHASE -1
#endif
#define REPN(k) ((REP_PHASE == (k)) ? 2 : 1)
    if (IN(0)) { for (int rep = 0; rep < REPN(0); ++rep) p0_mod(F, A); p0_convert(F, A); } SEAM(0);
    if (IN(1)) { for (int rep = 0; rep < REPN(1); ++rep) p1_modulate(F, A); } SEAM(1);
    if (IN(2)) {
        { pg8::Gemm g{WSP(bf16, WS_U), WSP(bf16, WS_WINT), T, C_GA, DM}; pg8::StaticOrder S; S.init(T, C_GA, F.G, (int)blockIdx.x);
          pg8::EpiQKV E{WSP(bf16, WS_QKV), NQKV, 1 << 30, 0, 1.0f};
          pg8::gemm_phase<pg8::EpiQKV, pg8::StaticOrder, AL, SP>(F.lds + RING_OFF, g, S, E); }
        VM_WAIT(); __syncthreads();
        { pg8::Gemm g{WSP(bf16, WS_U8Q), WSP(bf16, WS_WING), T, NQKV - C_GA, DM / 2}; pg8::StaticOrder S; S.init(T, NQKV - C_GA, F.G, (int)blockIdx.x);
          pg8::EpiQKV E{WSP(bf16, WS_QKV), NQKV, 0, C_GA / 256, 1.0f / WSCALE};
          pg8::gemm_phase<pg8::EpiQKV, pg8::StaticOrder, AL, SP, true>(F.lds + RING_OFF, g, S, E); }
    } SEAM(2);
    if (IN(3)) { for (int rep = 0; rep < REPN(3); ++rep) p3_attention(F, A); } SEAM(3);
    if (IN(4)) { for (int rep = 0; rep < REPN(4); ++rep) p4_finalize(F, A); } SEAM(4);
    if (IN(5)) for (int rep = 0; rep < REPN(5); ++rep) {
        { pg8::Gemm g{WSP(bf16, WS_YA), WSP(bf16, WS_WAT), T, DM, 1024}; pg8::StaticOrder S; S.init(T, DM, F.G, (int)blockIdx.x);
          pg8::EpiM1 E{WSP(float, WS_M1), WSP(bf16, WS_QKV) + C_GA, NQKV};
          pg8::gemm_phase<pg8::EpiM1, pg8::StaticOrder, AL, SP>(F.lds + RING_OFF, g, S, E); }
        VM_WAIT(); __syncthreads();
        { pg8::Gemm g{WSP(bf16, WS_YB), WSP(bf16, WS_WBT), T, DM, 1024}; pg8::StaticOrder S; S.init(T, DM, F.G, (int)blockIdx.x);
          pg8::EpiMerged E{WSP(float, WS_M1), WSP(bf16, WS_QKV) + C_GB, NQKV, WSP(bf16, WS_MG)};
          pg8::gemm_phase<pg8::EpiMerged, pg8::StaticOrder, AL, SP>(F.lds + RING_OFF, g, S, E); }
    } SEAM(5);
    if (IN(6)) for (int rep = 0; rep < REPN(6); ++rep) {
        pg8::Gemm g{WSP(bf16, WS_MG), WSP(bf16, WS_WOT), T, DM, DM}; pg8::StaticOrder S; S.init(T, DM, F.G, (int)blockIdx.x);
        pg8::EpiH1 E{A.in[I_X], WSP(float, WS_H1), WSP(float, WS_MOD) + 2 * DM, 12288, SEQ / 256};
        pg8::gemm_phase<pg8::EpiH1, pg8::StaticOrder, AL, SP>(F.lds + RING_OFF, g, S, E);
    } SEAM(6);
    if (IN(7)) { for (int rep = 0; rep < REPN(7); ++rep) p7_router(F, A, rep == 0); } SEAM(7);
    if (IN(8)) { for (int rep = 0; rep < REPN(8); ++rep) p8_gather(F, A); } SEAM(8);
    if (IN(9)) for (int rep = 0; rep < REPN(9); ++rep) {
        build_tile_table(F);
        pg8::Gemm g{WSP(bf16, WS_XS), WSP(bf16, WS_WGU), TKPAD, NE * 4096, DM / 2}; pg8::MoeOrder S; S.init((const LAS int*)(F.lds + TST_OFF), 16, F.G, (int)blockIdx.x);
        pg8::EpiSwiGLU E{WSP(unsigned char, WS_YACT), A.in[I_BG], A.in[I_BU], 1.0f / WSCALE};
        pg8::gemm_phase<pg8::EpiSwiGLU, pg8::MoeOrder, AL, SP, true>(F.lds + RING_OFF, g, S, E);
    } SEAM(9);
    if (IN(10)) for (int rep = 0; rep < REPN(10); ++rep) {
        build_tile_table(F);
        pg8::Gemm g{WSP(bf16, WS_YACT), WSP(bf16, WS_WD), TKPAD, NE * DM, DM / 2}; pg8::MoeOrder S; S.init((const LAS int*)(F.lds + TST_OFF), 8, F.G, (int)blockIdx.x);
        pg8::EpiBf16B E{WSP(bf16, WS_YSLOT), DM, A.in[I_BDN], 8, 1.0f / WSCALE};
        pg8::gemm_phase<pg8::EpiBf16B, pg8::MoeOrder, AL, SP, true>(F.lds + RING_OFF, g, S, E);
    } SEAM(10);
    if (IN(11)) { for (int rep = 0; rep < REPN(11); ++rep) p11_final(F, A); }
#undef IN
#undef SEAM
}
extern "C" void kernel_launch(void* const* d_in, const int* in_sizes, int n_in, void* d_out, int out_size, void* d_ws, size_t ws_size, hipStream_t stream) {
    static int grid = 0;
    if (grid == 0) {
        if (n_in != 24 || in_sizes[0] != T * DM || out_size != T * DM || ws_size < WS_END) { fprintf(stderr, "kernel_launch: shape mismatch (n_in %d, in0 %d, out %d, ws %zu < %zu); nothing launched\n", n_in, n_in > 0 ? in_sizes[0] : -1, out_size, ws_size, (size_t)WS_END); grid = -1; return; }
        int dev = 0, cus = 0, per_cu = 0;
        if (hipGetDevice(&dev) != hipSuccess || hipDeviceGetAttribute(&cus, hipDeviceAttributeMultiprocessorCount, dev) != hipSuccess) { grid = -1; return; }
        if (hipFuncSetAttribute((const void*)fwd, hipFuncAttributeMaxDynamicSharedMemorySize, LDS_BYTES) != hipSuccess) { fprintf(stderr, "kernel_launch: hipFuncSetAttribute failed\n"); grid = -1; return; }
        if (hipOccupancyMaxActiveBlocksPerMultiprocessor(&per_cu, (const void*)fwd, NWAVES * 64, LDS_BYTES) != hipSuccess || per_cu < 1)
            fprintf(stderr, "kernel_launch: note: occupancy query reports %d workgroups per CU\n", per_cu);
        (void)hipGetLastError();
        grid = cus;
    }
    if (grid < 0) return;
    if (hipMemsetAsync((char*)d_ws + WS_CTL, 0, CTL_ZERO_BYTES, stream) != hipSuccess) return;
    Args a; memset(&a, 0, sizeof(a));
    for (int i = 0; i < 24; ++i) a.in[i] = (const float*)d_in[i];
    a.out = (float*)d_out; a.ws = (unsigned char*)d_ws;
#if MK_SPLIT
    for (int ph = 0; ph < N_PHASES; ++ph) { a.ph_lo = ph; a.ph_hi = ph + 1; hipLaunchKernelGGL(fwd, dim3(grid), dim3(NWAVES * 64), LDS_BYTES, stream, a); }
#else
    a.ph_lo = 0; a.ph_hi = N_PHASES; hipLaunchKernelGGL(fwd, dim3(grid), dim3(NWAVES * 64), LDS_BYTES, stream, a);
#endif
    const hipError_t le = hipPeekAtLastError();
    if (le != hipSuccess) fprintf(stderr, "kernel_launch: launch failed: %s\n", hipGetErrorName(le));
#if DBG_ORACLE
    dbg_launch(a, stream);
#endif
}
```

```cpp
#include <hip/hip_runtime.h>
#include <cstdio>
#include <cstdint>
#include <cstring>
#include <cmath>
namespace pg8 {
#define PG8_LAS __attribute__((address_space(3)))
typedef unsigned short bf16_t;
typedef short bf16x8 __attribute__((ext_vector_type(8)));
typedef float f32x4 __attribute__((ext_vector_type(4)));
typedef unsigned u32x4 __attribute__((ext_vector_type(4)));
constexpr int BM = 256, BK = 64, HALF = 128, HTB = HALF * BK * 2  , STAGE_BYTES = 8 * HTB, NXCD = 8, WGM = 8;

__host__ __device__ __forceinline__ int lds_byte(int r, int c) { const int st = (r >> 4) * 2 + (c >> 5), rr = r & 15, cc = c & 31, ob = rr * 64 + cc * 2; return st * 1024 + (ob ^ (((ob >> 9) & 1) << 5)); }
__host__ __device__ __forceinline__ void stage_rc(int b, int& R, int& C) { const int st = b / 1024, sb = b % 1024, swz = sb ^ (((sb >> 9) & 1) << 5); R = (st >> 1) * 16 + swz / 64; C = (st & 1) * 32 + (swz % 64) / 2; }
__host__ __device__ __forceinline__ int perm32(int rho) { const int n = rho >> 4, i = rho & 15; return 8 * (i >> 2) + 4 * n + (i & 3); }

struct Unit { int pm, pn; };
struct Gemm { const bf16_t* A; const bf16_t* Bt; int M, N, K; };

struct StaticOrder {
    int nM, nN, nwg, G, c;
    __host__ __device__ void init(int M, int N, int G_, int c_) { nM = M / BM; nN = N / BM; nwg = nM * nN; G = G_; c = c_; }
    __host__ __device__ bool next(int i, Unit& u) const {
        const long L = (long)i * G + c; if (L >= nwg) return false;
        int wgid = (int)L; { const int q = nwg / NXCD, r = nwg % NXCD, xcd = wgid % NXCD, off = wgid / NXCD; wgid = (xcd < r ? xcd * (q + 1) : r * (q + 1) + (xcd - r) * q) + off; }
        const int nig = WGM * nN, gid = wgid / nig, fm = gid * WGM, gsz = (nM - fm) < WGM ? (nM - fm) : WGM;
        u.pm = fm + ((wgid % nig) % gsz); u.pn = (wgid % nig) / gsz; return true;
    }
    __device__ __forceinline__ void a_ready(const Unit&) const {}
    __device__ __forceinline__ void done(const Unit&) const {}
    __device__ __forceinline__ int arow(const Unit&, int R) const { return R; }
};

__device__ __forceinline__ unsigned cvt_pk_bf16(float lo, float hi) { unsigned r; asm volatile("v_cvt_pk_bf16_f32 %0, %1, %2" : "=v"(r) : "v"(lo), "v"(hi)); return r; }

typedef int v4i_t __attribute__((ext_vector_type(4)));
typedef int v8i_t __attribute__((ext_vector_type(8)));
template <class Epi, class Sched, bool ALIGN_EPI = false, bool SP2 = false, bool F8 = false, bool GATHER = false>
__device__ __forceinline__ void gemm_phase(PG8_LAS unsigned char* lds, const Gemm g, const Sched& S, const Epi& E) {
    int tid = threadIdx.x; asm volatile("" : "+v"(tid));
    const int wid = __builtin_amdgcn_readfirstlane(tid >> 6), lane = tid & 63, wr = wid >> 2, wc = wid & 3, fr = lane & 15, fq = lane >> 4;
    const int K = g.K, nt = K / BK;
    unsigned voffA[2], voffB[2];
#pragma unroll
    for (int i = 0; i < 2; ++i) { int R, C; stage_rc(tid * 16 + i * 8192, R, C); const int Rb = Epi::PERM ? ((R & ~31) + perm32(R & 31)) : R;
        voffA[i] = (unsigned)(R * K + C) * 2u; voffB[i] = (unsigned)(Rb * K + C) * 2u; }
    static_assert(!GATHER || SP2, "the gather form is written for the two-super-phase loop");
    unsigned vo[2][2], nvo[2][2];
#define PG8_SETVO(dst, u) do { _Pragma("unroll") for (int _h = 0; _h < 2; ++_h) _Pragma("unroll") for (int _i = 0; _i < 2; ++_i) { \
        if constexpr (GATHER) { int R_, C_; stage_rc(tid * 16 + _i * 8192, R_, C_); dst[_h][_i] = (unsigned)(S.arow(u, R_ + HALF * _h) * K + C_) * 2u; } \
        else dst[_h][_i] = voffA[_i] + (unsigned)_h * (unsigned)(HALF * K * 2); } } while (0)
    const size_t kstep = (size_t)(BK * 2);
    const size_t hstep = (size_t)HALF * K * 2;
    const size_t tstep = 2 * hstep;
    const unsigned ldsw = (unsigned)wid * 1024u;
    const int aoff = lds_byte(wr * 64 + fr, fq * 8), boff = lds_byte(wc * 32 + fr, fq * 8);
#define PG8_SA(b, h) (((b) * 2 + (h)) * HTB)
#define PG8_SB(b, h) ((4 + (b) * 2 + (h)) * HTB)
#define PG8_STAGE(bufoff, gbase, voff) do { _Pragma("unroll") for (int _i = 0; _i < 2; ++_i) \
        __builtin_amdgcn_global_load_lds((const unsigned*)((const char*)(gbase) + (voff)[_i]), (PG8_LAS unsigned*)(lds + (bufoff) + ldsw + _i * 8192), 16, 0, 0); } while (0)
#define PG8_LDA(dst, b, h) do { _Pragma("unroll") for (int m = 0; m < 4; ++m) _Pragma("unroll") for (int k = 0; k < 2; ++k) dst[m][k] = *(const PG8_LAS bf16x8*)(lds + PG8_SA(b, h) + aoff + m * 2048 + k * 1024); } while (0)
#define PG8_LDB(dst, b, h) do { _Pragma("unroll") for (int n = 0; n < 2; ++n) _Pragma("unroll") for (int k = 0; k < 2; ++k) dst[n][k] = *(const PG8_LAS bf16x8*)(lds + PG8_SB(b, h) + boff + n * 2048 + k * 1024); } while (0)
#define PG8_MMA(ai, bj, At, Bt) do { __builtin_amdgcn_s_setprio(1); _Pragma("unroll") for (int m = 0; m < 4; ++m) _Pragma("unroll") for (int n = 0; n < 2; ++n) { \
        if constexpr (F8) { const v8i_t _b = __builtin_shufflevector(__builtin_bit_cast(v4i_t, Bt[n][0]), __builtin_bit_cast(v4i_t, Bt[n][1]), 0, 1, 2, 3, 4, 5, 6, 7); \
            const v8i_t _a = __builtin_shufflevector(__builtin_bit_cast(v4i_t, At[m][0]), __builtin_bit_cast(v4i_t, At[m][1]), 0, 1, 2, 3, 4, 5, 6, 7); \
            asm volatile("v_mfma_scale_f32_16x16x128_f8f6f4 %0, %1, %2, %0, %3, %3 op_sel_hi:[0,0,0]" : "+v"(acc[ai][bj][m][n]) : "v"(_b), "v"(_a), "v"(f8scale)); } \
        else { _Pragma("unroll") for (int k = 0; k < 2; ++k) acc[ai][bj][m][n] = __builtin_amdgcn_mfma_f32_16x16x32_bf16(Bt[n][k], At[m][k], acc[ai][bj][m][n], 0, 0, 0); } } \
        __builtin_amdgcn_s_setprio(0); } while (0)
#define PG8_WAIT_V(n) asm volatile("s_waitcnt vmcnt(" #n ")" ::: "memory")
#define PG8_WAIT_L(n) asm volatile("s_waitcnt lgkmcnt(" #n ")" ::: "memory")
#define PG8_BAR __builtin_amdgcn_s_barrier()
#define PG8_SCHED __builtin_amdgcn_sched_barrier(0)
    Unit cur, nxt; int ui = 0;
    if (!S.next(0, cur)) return;
    const int f8scale = 0x7f7f7f7f;
    f32x4 acc[2][2][4][2];
#pragma unroll
    for (int a = 0; a < 2; ++a)
#pragma unroll
        for (int b = 0; b < 2; ++b)
#pragma unroll
            for (int m = 0; m < 4; ++m)
#pragma unroll
                for (int n = 0; n < 2; ++n) acc[a][b][m][n] = (f32x4){0.f, 0.f, 0.f, 0.f};
    bf16x8 At[4][2], B0[2][2], B1[2][2];
    const char* cA = (const char*)g.A + (GATHER ? (size_t)0 : (size_t)cur.pm * tstep); const char* cB = (const char*)g.Bt + (size_t)cur.pn * tstep;
    PG8_SETVO(vo, cur);
    S.a_ready(cur);
    if constexpr (SP2) {
        PG8_STAGE(PG8_SB(0, 0), cB, voffB); PG8_STAGE(PG8_SB(0, 1), cB + hstep, voffB); PG8_STAGE(PG8_SA(0, 0), cA, vo[0]); PG8_STAGE(PG8_SA(0, 1), cA, vo[1]);
        if (wr == 1) PG8_BAR;
        PG8_WAIT_V(2); PG8_BAR;
        PG8_STAGE(PG8_SB(1, 0), cB + kstep, voffB); PG8_STAGE(PG8_SA(1, 0), cA + kstep, vo[0]); PG8_STAGE(PG8_SB(1, 1), cB + hstep + kstep, voffB);
        PG8_WAIT_V(6); PG8_BAR;
    } else {
        PG8_STAGE(PG8_SB(0, 0), cB, voffB); PG8_STAGE(PG8_SA(0, 0), cA, vo[0]); PG8_STAGE(PG8_SB(0, 1), cB + hstep, voffB); PG8_STAGE(PG8_SA(0, 1), cA, vo[1]);
        if (wr == 1) PG8_BAR;
        PG8_WAIT_V(4); PG8_BAR;
        PG8_STAGE(PG8_SB(1, 0), cB + kstep, voffB); PG8_STAGE(PG8_SA(1, 0), cA + kstep, vo[0]); PG8_STAGE(PG8_SB(1, 1), cB + hstep + kstep, voffB);
        PG8_WAIT_V(6); PG8_BAR;
    }
    for (;;) {
        const bool has_next = S.next(ui + 1, nxt);
        const char* nA = (has_next && !GATHER) ? (const char*)g.A + (size_t)nxt.pm * tstep : cA; const char* nB = has_next ? (const char*)g.Bt + (size_t)nxt.pn * tstep : cB;
        if (has_next) { PG8_SETVO(nvo, nxt); } else {
#pragma unroll
            for (int _h = 0; _h < 2; ++_h)
#pragma unroll
                for (int _i = 0; _i < 2; ++_i) nvo[_h][_i] = vo[_h][_i]; }
        for (int t = 0; t < nt; t += 2) {
            const bool last = (t == nt - 2);
            const char* a1 = cA + (size_t)(t + 1) * kstep;
            const char* a2 = last ? nA : cA + (size_t)(t + 2) * kstep; const char* b2 = last ? nB : cB + (size_t)(t + 2) * kstep;
            const char* a3 = a2 + kstep; const char* b3 = b2 + kstep;
            unsigned s0[2], s1[2];
#pragma unroll
            for (int _i = 0; _i < 2; ++_i) { s0[_i] = last ? nvo[0][_i] : vo[0][_i]; s1[_i] = last ? nvo[1][_i] : vo[1][_i]; }
            if (last && has_next) S.a_ready(nxt);
            if constexpr (SP2) {
            PG8_LDB(B0, 0, 0); PG8_LDB(B1, 0, 1); PG8_SCHED; PG8_LDA(At, 0, 0); PG8_STAGE(PG8_SA(1, 1), a1, vo[1]);
            PG8_WAIT_V(8); PG8_WAIT_L(0); PG8_BAR; PG8_MMA(0, 0, At, B0); PG8_MMA(0, 1, At, B1); PG8_BAR; PG8_SCHED;
            PG8_LDA(At, 0, 1); PG8_STAGE(PG8_SB(0, 0), b2, voffB); PG8_STAGE(PG8_SB(0, 1), b2 + hstep, voffB); PG8_STAGE(PG8_SA(0, 0), a2, s0);
            PG8_WAIT_V(8); PG8_WAIT_L(0); PG8_BAR; PG8_MMA(1, 0, At, B0); PG8_MMA(1, 1, At, B1); PG8_BAR; PG8_SCHED;
            PG8_LDB(B0, 1, 0); PG8_LDB(B1, 1, 1); PG8_SCHED; PG8_LDA(At, 1, 0); PG8_STAGE(PG8_SA(0, 1), a2, s1);
            PG8_WAIT_V(8); PG8_WAIT_L(0); PG8_BAR; PG8_MMA(0, 0, At, B0); PG8_MMA(0, 1, At, B1); PG8_BAR; PG8_SCHED;
            PG8_LDA(At, 1, 1); PG8_STAGE(PG8_SB(1, 0), b3, voffB); PG8_STAGE(PG8_SB(1, 1), b3 + hstep, voffB); PG8_STAGE(PG8_SA(1, 0), a3, s0);
            PG8_WAIT_V(8); PG8_WAIT_L(0); PG8_BAR; PG8_MMA(1, 0, At, B0); PG8_MMA(1, 1, At, B1); PG8_BAR; PG8_SCHED;
            } else {
            PG8_LDB(B0, 0, 0); PG8_SCHED; PG8_LDA(At, 0, 0); PG8_STAGE(PG8_SA(1, 1), a1, vo[1]);
            PG8_WAIT_L(8); PG8_BAR; PG8_WAIT_L(0); PG8_MMA(0, 0, At, B0); PG8_BAR; PG8_SCHED;
            PG8_LDB(B1, 0, 1); PG8_STAGE(PG8_SB(0, 0), b2, voffB);
            PG8_BAR; PG8_WAIT_L(0); PG8_MMA(0, 1, At, B1); PG8_BAR;
            PG8_LDA(At, 0, 1); PG8_STAGE(PG8_SA(0, 0), a2, s0);
            PG8_BAR; PG8_WAIT_L(0); PG8_MMA(1, 0, At, B0); PG8_BAR; PG8_SCHED;
            PG8_STAGE(PG8_SB(0, 1), b2 + hstep, voffB);
            PG8_WAIT_V(6); PG8_BAR; PG8_MMA(1, 1, At, B1); PG8_BAR;
            PG8_LDB(B0, 1, 0); PG8_SCHED; PG8_LDA(At, 1, 0); PG8_STAGE(PG8_SA(0, 1), a2, s1);
            PG8_WAIT_L(8); PG8_BAR; PG8_WAIT_L(0); PG8_MMA(0, 0, At, B0); PG8_BAR; PG8_SCHED;
            PG8_LDB(B1, 1, 1); PG8_STAGE(PG8_SB(1, 0), b3, voffB);
            PG8_BAR; PG8_WAIT_L(0); PG8_MMA(0, 1, At, B1); PG8_BAR;
            PG8_LDA(At, 1, 1); PG8_STAGE(PG8_SA(1, 0), a3, s0);
            PG8_BAR; PG8_WAIT_L(0); PG8_MMA(1, 0, At, B0); PG8_BAR; PG8_SCHED;
            PG8_STAGE(PG8_SB(1, 1), b3 + hstep, voffB);
            PG8_WAIT_V(6); PG8_BAR; PG8_MMA(1, 1, At, B1); PG8_BAR;
            }
        }
        if constexpr (F8) asm volatile("s_nop 15\n\ts_nop 7" ::: "memory");
        if constexpr (ALIGN_EPI) { if (wr == 0) PG8_BAR; }
        if constexpr (!Epi::AFTER_DRAIN) { E(acc, cur, wr, wc, fr, fq); S.done(cur); }
        if (!has_next) break;
#pragma unroll
        for (int a = 0; a < 2; ++a)
#pragma unroll
            for (int b = 0; b < 2; ++b)
#pragma unroll
                for (int m = 0; m < 4; ++m)
#pragma unroll
                    for (int n = 0; n < 2; ++n) acc[a][b][m][n] = (f32x4){0.f, 0.f, 0.f, 0.f};
        cur = nxt; cA = nA; cB = nB; ++ui;
#pragma unroll
        for (int _h = 0; _h < 2; ++_h)
#pragma unroll
            for (int _i = 0; _i < 2; ++_i) vo[_h][_i] = nvo[_h][_i];
        if constexpr (ALIGN_EPI) { if (wr == 1) PG8_BAR; }
    }
    PG8_WAIT_V(0);
    if constexpr (!ALIGN_EPI) { if (wr == 0) PG8_BAR; }
    PG8_BAR;
    if constexpr (Epi::AFTER_DRAIN) { E.fused(acc, cur, wr, wc, fr, fq, lds, wid, lane); S.done(cur); }
#undef PG8_SA
#undef PG8_SETVO
#undef PG8_SB
#undef PG8_STAGE
#undef PG8_LDA
#undef PG8_LDB
#undef PG8_MMA
#undef PG8_WAIT_V
#undef PG8_WAIT_L
#undef PG8_BAR
#undef PG8_SCHED
}
}
namespace pg8 {
typedef float f32x2e __attribute__((ext_vector_type(2)));
__device__ __forceinline__ float bf_lo(unsigned w) { return __uint_as_float(w << 16); }
__device__ __forceinline__ float bf_hi(unsigned w) { return __uint_as_float(w & 0xffff0000u); }
__device__ __forceinline__ float sigmoidf_fast(float x) { return __builtin_amdgcn_rcpf(1.0f + __expf(-x)); }

struct EpiBf16B {
    static constexpr bool PERM = true, AFTER_DRAIN = false;
    bf16_t* O; int ldc; const float* bias; int ntile_mod; float scale;
    __device__ __forceinline__ void operator()(const f32x4 (&acc)[2][2][4][2], const Unit& u, int wr, int wc, int fr, int fq) const {
        const int row0 = u.pm * BM + wr * 64 + fr; const int colt = (u.pn % ntile_mod) * BM;
        const int col0 = colt + wc * 32 + 8 * fq, bcol0 = u.pn * BM + wc * 32 + 8 * fq;
        f32x4 bv[2][2];
#pragma unroll
        for (int bj = 0; bj < 2; ++bj)
#pragma unroll
            for (int n = 0; n < 2; ++n) bv[bj][n] = bias ? *(const f32x4*)(bias + bcol0 + bj * HALF + 4 * n) : (f32x4){0.f, 0.f, 0.f, 0.f};
#pragma unroll
        for (int ai = 0; ai < 2; ++ai)
#pragma unroll
            for (int m = 0; m < 4; ++m) { bf16_t* rowp = O + (size_t)(row0 + ai * HALF + m * 16) * ldc + col0;
#pragma unroll
                for (int bj = 0; bj < 2; ++bj) { const f32x4 v0 = acc[ai][bj][m][0] * scale + bv[bj][0], v1 = acc[ai][bj][m][1] * scale + bv[bj][1];
                    u32x4 w; w.x = cvt_pk_bf16(v0[0], v0[1]); w.y = cvt_pk_bf16(v0[2], v0[3]); w.z = cvt_pk_bf16(v1[0], v1[1]); w.w = cvt_pk_bf16(v1[2], v1[3]);
                    *(u32x4*)(rowp + bj * HALF) = w; } }
    }
};
struct EpiQKV {
    static constexpr bool PERM = true, AFTER_DRAIN = false;
    bf16_t* O; int ldc; unsigned long long gmap; float scale;
    __device__ __forceinline__ void operator()(const f32x4 (&acc)[2][2][4][2], const Unit& u, int wr, int wc, int fr, int fq) const {
        const int og = (int)((gmap >> (4 * (u.pn >> 2))) & 15ull); const bool sg = og >= 6;
        const int row0 = u.pm * BM + wr * 64 + fr; const int col0 = (og * 4 + (u.pn & 3)) * BM + wc * 32 + 8 * fq;
#pragma unroll
        for (int ai = 0; ai < 2; ++ai)
#pragma unroll
            for (int m = 0; m < 4; ++m) { bf16_t* rowp = O + (size_t)(row0 + ai * HALF + m * 16) * ldc + col0;
#pragma unroll
                for (int bj = 0; bj < 2; ++bj) { f32x4 v0 = acc[ai][bj][m][0] * scale, v1 = acc[ai][bj][m][1] * scale;
                    if (sg) {
#pragma unroll
                        for (int i = 0; i < 4; ++i) { v0[i] = sigmoidf_fast(v0[i]); v1[i] = sigmoidf_fast(v1[i]); } }
                    u32x4 w; w.x = cvt_pk_bf16(v0[0], v0[1]); w.y = cvt_pk_bf16(v0[2], v0[3]); w.z = cvt_pk_bf16(v1[0], v1[1]); w.w = cvt_pk_bf16(v1[2], v1[3]);
                    *(u32x4*)(rowp + bj * HALF) = w; } }
    }
};
struct EpiM1 {
    static constexpr bool PERM = true, AFTER_DRAIN = false;
    bf16_t* M1; const bf16_t* G; int ldg;
    __device__ __forceinline__ void operator()(const f32x4 (&acc)[2][2][4][2], const Unit& u, int wr, int wc, int fr, int fq) const {
        const int row0 = u.pm * BM + wr * 64 + fr; const int col0 = u.pn * BM + wc * 32 + 8 * fq;
#pragma unroll
        for (int ai = 0; ai < 2; ++ai)
#pragma unroll
            for (int m = 0; m < 4; ++m) { const size_t row = (size_t)(row0 + ai * HALF + m * 16);
#pragma unroll
                for (int bj = 0; bj < 2; ++bj) { const int col = col0 + bj * HALF; const u32x4 g = *(const u32x4*)(G + row * ldg + col);
                    const f32x4 a0 = acc[ai][bj][m][0], a1 = acc[ai][bj][m][1];
                    const f32x4 o0 = {a0[0] * bf_lo(g.x), a0[1] * bf_hi(g.x), a0[2] * bf_lo(g.y), a0[3] * bf_hi(g.y)};
                    const f32x4 o1 = {a1[0] * bf_lo(g.z), a1[1] * bf_hi(g.z), a1[2] * bf_lo(g.w), a1[3] * bf_hi(g.w)};
                    u32x4 w; w.x = cvt_pk_bf16(o0[0], o0[1]); w.y = cvt_pk_bf16(o0[2], o0[3]); w.z = cvt_pk_bf16(o1[0], o1[1]); w.w = cvt_pk_bf16(o1[2], o1[3]);
                    *(u32x4*)(M1 + row * 2048 + col) = w; } }
    }
};
struct EpiMerged {
    static constexpr bool PERM = true, AFTER_DRAIN = false;
    const bf16_t* M1; const bf16_t* G; int ldg; unsigned char* MG;
    __device__ __forceinline__ void operator()(const f32x4 (&acc)[2][2][4][2], const Unit& u, int wr, int wc, int fr, int fq) const {
        const int row0 = u.pm * BM + wr * 64 + fr; const int col0 = u.pn * BM + wc * 32 + 8 * fq;
#pragma unroll
        for (int ai = 0; ai < 2; ++ai)
#pragma unroll
            for (int m = 0; m < 4; ++m) { const size_t row = (size_t)(row0 + ai * HALF + m * 16);
#pragma unroll
                for (int bj = 0; bj < 2; ++bj) { const int col = col0 + bj * HALF; const u32x4 g = *(const u32x4*)(G + row * ldg + col);
                    const u32x4 mw = *(const u32x4*)(M1 + row * 2048 + col);
                    const f32x4 m0 = {bf_lo(mw.x), bf_hi(mw.x), bf_lo(mw.y), bf_hi(mw.y)}, m1 = {bf_lo(mw.z), bf_hi(mw.z), bf_lo(mw.w), bf_hi(mw.w)};
                    const f32x4 a0 = acc[ai][bj][m][0], a1 = acc[ai][bj][m][1];
                    const f32x4 o0 = {m0[0] + a0[0] * bf_lo(g.x), m0[1] + a0[1] * bf_hi(g.x), m0[2] + a0[2] * bf_lo(g.y), m0[3] + a0[3] * bf_hi(g.y)};
                    const f32x4 o1 = {m1[0] + a1[0] * bf_lo(g.z), m1[1] + a1[1] * bf_hi(g.z), m1[2] + a1[2] * bf_lo(g.w), m1[3] + a1[3] * bf_hi(g.w)};
                    int w0 = __builtin_amdgcn_cvt_pk_fp8_f32(o0[0] * 16.f, o0[1] * 16.f, 0, false); w0 = __builtin_amdgcn_cvt_pk_fp8_f32(o0[2] * 16.f, o0[3] * 16.f, w0, true);
                    int w1 = __builtin_amdgcn_cvt_pk_fp8_f32(o1[0] * 16.f, o1[1] * 16.f, 0, false); w1 = __builtin_amdgcn_cvt_pk_fp8_f32(o1[2] * 16.f, o1[3] * 16.f, w1, true);
                    typedef int v2i_m __attribute__((ext_vector_type(2))); *(v2i_m*)(MG + row * 2048 + col) = (v2i_m){w0, w1}; } }
    }
};
struct EpiH1 {
    static constexpr bool PERM = false, AFTER_DRAIN = false;
    const float* X; float* H1; const float* g1; int g1_stride; int tiles_per_batch; float wscale;
    __device__ __forceinline__ void operator()(const f32x4 (&acc)[2][2][4][2], const Unit& u, int wr, int wc, int fr, int fq) const {
        const int row0 = u.pm * BM + wr * 64 + fr; const int col0 = u.pn * BM + wc * 32 + 4 * fq; const float* gb = g1 + (size_t)(u.pm / tiles_per_batch) * g1_stride;
        f32x4 gv[2][2];
#pragma unroll
        for (int bj = 0; bj < 2; ++bj)
#pragma unroll
            for (int n = 0; n < 2; ++n) gv[bj][n] = *(const f32x4*)(gb + col0 + bj * HALF + n * 16);
#pragma unroll
        for (int ai = 0; ai < 2; ++ai)
#pragma unroll
            for (int m = 0; m < 4; ++m) { const size_t off = (size_t)(row0 + ai * HALF + m * 16) * 2048 + col0;
#pragma unroll
                for (int bj = 0; bj < 2; ++bj)
#pragma unroll
                    for (int n = 0; n < 2; ++n) { const f32x4 xv = *(const f32x4*)(X + off + bj * HALF + n * 16);
                        *(f32x4*)(H1 + off + bj * HALF + n * 16) = xv + gv[bj][n] * (acc[ai][bj][m][n] * wscale); } }
    }
};
struct EpiSwiGLU {
    static constexpr bool PERM = true, AFTER_DRAIN = false;
    unsigned char* Y; const float* bg; const float* bu; float wscale;
    __device__ __forceinline__ void operator()(const f32x4 (&acc)[2][2][4][2], const Unit& u, int wr, int wc, int fr, int fq) const {
        const int e = u.pn >> 4, pnl = u.pn & 15; const int row0 = u.pm * BM + wr * 64 + fr; const int col0 = pnl * HALF + wc * 32 + 8 * fq;
        f32x4 bgv[2], buv[2];
#pragma unroll
        for (int n = 0; n < 2; ++n) { bgv[n] = *(const f32x4*)(bg + (size_t)e * 2048 + col0 + 4 * n); buv[n] = *(const f32x4*)(bu + (size_t)e * 2048 + col0 + 4 * n); }
#pragma unroll
        for (int ai = 0; ai < 2; ++ai)
#pragma unroll
            for (int m = 0; m < 4; ++m) { unsigned char* rowp = Y + (size_t)(row0 + ai * HALF + m * 16) * 2048 + col0; f32x4 y[2];
#pragma unroll
                for (int n = 0; n < 2; ++n) { const f32x4 g4 = acc[ai][0][m][n] * wscale + bgv[n], u4 = acc[ai][1][m][n] * wscale + buv[n];
                    f32x4 gc, uc, ex;
#pragma unroll
                    for (int i = 0; i < 4; ++i) { gc[i] = fminf(g4[i], 7.0f); uc[i] = __builtin_amdgcn_fmed3f(u4[i], -7.0f, 7.0f); }
                    const f32x4 t = gc * (-1.702f * 1.4426950408889634f);
#pragma unroll
                    for (int i = 0; i < 4; ++i) ex[i] = __builtin_amdgcn_rcpf(1.0f + __builtin_amdgcn_exp2f(t[i]));
                    y[n] = (uc + 1.0f) * (gc * ex); }
                int w0 = __builtin_amdgcn_cvt_pk_fp8_f32(y[0][0], y[0][1], 0, false); w0 = __builtin_amdgcn_cvt_pk_fp8_f32(y[0][2], y[0][3], w0, true);
                int w1 = __builtin_amdgcn_cvt_pk_fp8_f32(y[1][0], y[1][1], 0, false); w1 = __builtin_amdgcn_cvt_pk_fp8_f32(y[1][2], y[1][3], w1, true);
                typedef int v2i_t __attribute__((ext_vector_type(2))); *(v2i_t*)rowp = (v2i_t){w0, w1}; }
    }
};
struct MoeOrder {
    const PG8_LAS int* tstart; int npn, lo, hi, rank, W; const int* tokof;
    __device__ __forceinline__ int arow(const Unit& u, int R) const { const int e = u.pn / npn, slot = (u.pm - tstart[e]) * 256 + R;
        return slot < tstart[40 + e] ? tokof[e * 8192 + slot] : 0; }
    __device__ __forceinline__ void init(const PG8_LAS int* ts, int npn_, int G, int c, const int* tk = nullptr) { tstart = ts; npn = npn_; tokof = tk; const int U = ts[32] * npn_; const int x = c % NXCD; rank = c / NXCD; W = G / NXCD;
        lo = (int)(((long)U * x) / NXCD); hi = (int)(((long)U * (x + 1)) / NXCD); }
    __device__ __forceinline__ bool next(int i, Unit& u) const {
        const int q = lo + rank + W * i; if (q >= hi) return false;
        const int lk = (int)(threadIdx.x & 31u);
        const int e = __builtin_popcountll(__ballot(tstart[lk] * npn <= q) & 0xffffffffull) - 1;
        const int ts = tstart[e], te = tstart[e + 1] - ts, qq = q - ts * npn;
        u.pm = ts + qq % te; u.pn = e * npn + qq / te; return true;
    }
    __device__ __forceinline__ void a_ready(const Unit&) const {}
    __device__ __forceinline__ void done(const Unit&) const {}
};
}
namespace att {
using bf16x8 = __attribute__((ext_vector_type(8))) short;
using s16x4  = __attribute__((ext_vector_type(4))) short;
using f32x16 = __attribute__((ext_vector_type(16))) float;
using u32x4  = __attribute__((ext_vector_type(4))) unsigned;
using f32x4v = __attribute__((ext_vector_type(4))) float;
typedef unsigned short bf16;
constexpr int   D = 128, NW = 8, QBLK = 32, KVBLK = 64;
constexpr float SCALE = 0.088388347648318440f;
constexpr float THR = 8.f;
constexpr size_t SHM_V = KVBLK * D * 2, SHM_K = KVBLK * D * 2, SHM_ATTN = 2 * SHM_V + 2 * SHM_K + NW * 64 * 4;
#define KSWZ(row, colB) ((row) * 256 + ((colB) ^ (((row) & 7) << 4)))
#define SBAR() __builtin_amdgcn_sched_barrier(0)
__device__ __forceinline__ int crow(int r, int hi) { return (r & 3) + 8 * (r >> 2) + 4 * hi; }
__device__ __forceinline__ unsigned cvtpk(float lo, float hi) { unsigned r; asm volatile("v_cvt_pk_bf16_f32 %0, %1, %2" : "=v"(r) : "v"(lo), "v"(hi)); return r; }

template <int MODE>
__device__ __forceinline__ void partialSM(f32x16& p0, f32x16& p1, float& m_reg, float& mn, float& alpha, float relb, float kk, bool valid, int side = 0) {
  constexpr float C = SCALE * 1.4426950408889634f;
  float base = 0.f;
  if (MODE == 0 && side != 0) {
    const float skk = side > 0 ? kk : -kk; base = -skk * relb;
#pragma unroll
    for (int r = 0; r < 16; ++r) { p0[r] = fmaf(skk, (float)((r & 3) + 8 * (r >> 2)), p0[r]); p1[r] = fmaf(skk, (float)((r & 3) + 8 * (r >> 2) + 32), p1[r]); }
  } else {
#pragma unroll
    for (int r = 0; r < 16; ++r) {
      const float d0 = relb - (float)((r & 3) + 8 * (r >> 2)), a0 = __builtin_fabsf(d0), a1 = __builtin_fabsf(d0 - 32.f);
      p0[r] = fmaf(a0, -kk, p0[r]); p1[r] = fmaf(a1, -kk, p1[r]);
      if (MODE == 1) { if (!(valid && a0 <= 64.f)) p0[r] = -INFINITY; if (!(valid && a1 <= 64.f)) p1[r] = -INFINITY; }
    }
  }
  float pmax = p0[0];
#pragma unroll
  for (int r = 1; r < 16; ++r) pmax = fmaxf(pmax, p0[r]);
#pragma unroll
  for (int r = 0; r < 16; ++r) pmax = fmaxf(pmax, p1[r]);
  { auto rr = __builtin_amdgcn_permlane32_swap(__float_as_uint(pmax), __float_as_uint(pmax), false, false);
    pmax = fmaxf(__uint_as_float(rr[0]), __uint_as_float(rr[1])); }
  pmax += base;
  if (__builtin_expect(__all(pmax - m_reg <= THR / SCALE), 1)) { mn = m_reg; alpha = 1.f; }
  else { mn = fmaxf(m_reg, pmax); alpha = __builtin_amdgcn_exp2f((m_reg - mn) * C); m_reg = mn; }
  const float mnC = (base - mn) * C;
#pragma unroll
  for (int r = 0; r < 16; ++r) p0[r] = fmaf(p0[r], C, mnC);
#pragma unroll
  for (int r = 0; r < 16; ++r) p1[r] = fmaf(p1[r], C, mnC);
#pragma unroll
  for (int r = 0; r < 16; ++r) p0[r] = __builtin_amdgcn_exp2f(p0[r]);
}
__device__ __forceinline__ void finishSM(f32x16& p0, f32x16& p1, float alpha, float& l_reg, bf16x8& pa0, bf16x8& pa1, bf16x8& pa2, bf16x8& pa3) {
#pragma unroll
  for (int r = 0; r < 16; ++r) p1[r] = __builtin_amdgcn_exp2f(p1[r]);
  float ps = 0;
#pragma unroll
  for (int r = 0; r < 16; ++r) ps += p0[r];
#pragma unroll
  for (int r = 0; r < 16; ++r) ps += p1[r];
  { auto rr = __builtin_amdgcn_permlane32_swap(__float_as_uint(ps), __float_as_uint(ps), false, false);
    ps = __uint_as_float(rr[0]) + __uint_as_float(rr[1]); }
  l_reg = l_reg * alpha + ps;
#define PK4(P, BASE, OUT) do { unsigned a0 = cvtpk(P[BASE + 0], P[BASE + 1]), a1 = cvtpk(P[BASE + 2], P[BASE + 3]);   \
    unsigned b0 = cvtpk(P[BASE + 4], P[BASE + 5]), b1 = cvtpk(P[BASE + 6], P[BASE + 7]);                              \
    auto r0 = __builtin_amdgcn_permlane32_swap(a0, b0, false, false); auto r1 = __builtin_amdgcn_permlane32_swap(a1, b1, false, false); \
    u32x4 w = {r0[0], r1[0], r0[1], r1[1]}; OUT = *reinterpret_cast<bf16x8*>(&w); } while (0)
  PK4(p0, 0, pa0); PK4(p0, 8, pa1); PK4(p1, 0, pa2); PK4(p1, 8, pa3);
#undef PK4
}
__device__ __forceinline__ void qkt(f32x16& p0, f32x16& p1, const bf16* Ks, const bf16x8* qr, int r32, int hi) {
  p0 = f32x16{}; p1 = f32x16{};
#pragma unroll
  for (int d0 = 0; d0 < 8; ++d0) { const int cb = (d0 * 16 + hi * 8) * 2;
    bf16x8 b0 = *reinterpret_cast<const bf16x8*>((const char*)Ks + KSWZ(r32, cb));
    bf16x8 b1 = *reinterpret_cast<const bf16x8*>((const char*)Ks + KSWZ(32 + r32, cb));
    p0 = __builtin_amdgcn_mfma_f32_32x32x16_bf16(b0, qr[d0], p0, 0, 0, 0);
    p1 = __builtin_amdgcn_mfma_f32_32x32x16_bf16(b1, qr[d0], p1, 0, 0, 0); }
}
__device__ __forceinline__ int v_st(int k, int c) { const int kk = (k & ~0xC) | ((k & 4) << 1) | ((k & 8) >> 1); return ((kk >> 3) * 4 + (c >> 5)) * 512 + ((kk & 7) * 32 + (c & 31)) * 2; }
__device__ __forceinline__ int v_rd_base(int lane) { return ((lane & 3) << 3) | (((lane >> 2) & 3) << 6) | (((lane >> 4) & 1) << 5) | (((lane >> 5) & 1) << 8); }
constexpr int v_rd_off(int d0, int ks, int half) { return d0 * 512 + ks * 4096 + half * 2048; }
template <int OFF> __device__ __forceinline__ s16x4 tr_read(int vb) {
  s16x4 r; asm volatile("ds_read_b64_tr_b16 %0, %1 offset:%2" : "=&v"(r) : "v"(vb), "i"(OFF) : "memory"); return r;
}
template <int D0> __device__ __forceinline__ void pv_one(f32x16& od, int vb, bf16x8 pa0, bf16x8 pa1, bf16x8 pa2, bf16x8 pa3) {
  const s16x4 l0 = tr_read<v_rd_off(D0, 0, 0)>(vb), h0 = tr_read<v_rd_off(D0, 0, 1)>(vb), l1 = tr_read<v_rd_off(D0, 1, 0)>(vb), h1 = tr_read<v_rd_off(D0, 1, 1)>(vb);
  const s16x4 l2 = tr_read<v_rd_off(D0, 2, 0)>(vb), h2 = tr_read<v_rd_off(D0, 2, 1)>(vb), l3 = tr_read<v_rd_off(D0, 3, 0)>(vb), h3 = tr_read<v_rd_off(D0, 3, 1)>(vb);
  asm volatile("s_waitcnt lgkmcnt(0)" ::: "memory"); SBAR();
#define PK(L, H) (bf16x8){L[0], L[1], L[2], L[3], H[0], H[1], H[2], H[3]}
  od = __builtin_amdgcn_mfma_f32_32x32x16_bf16(pa0, PK(l0, h0), od, 0, 0, 0);
  od = __builtin_amdgcn_mfma_f32_32x32x16_bf16(pa1, PK(l1, h1), od, 0, 0, 0);
  od = __builtin_amdgcn_mfma_f32_32x32x16_bf16(pa2, PK(l2, h2), od, 0, 0, 0);
  od = __builtin_amdgcn_mfma_f32_32x32x16_bf16(pa3, PK(l3, h3), od, 0, 0, 0);
#undef PK
}
__device__ __forceinline__ void pv_d0(f32x16* o, int vb, bf16x8 pa0, bf16x8 pa1, bf16x8 pa2, bf16x8 pa3) {
  pv_one<0>(o[0], vb, pa0, pa1, pa2, pa3); pv_one<1>(o[1], vb, pa0, pa1, pa2, pa3); pv_one<2>(o[2], vb, pa0, pa1, pa2, pa3); pv_one<3>(o[3], vb, pa0, pa1, pa2, pa3);
}

__device__ __forceinline__ const void* uni_ptr(const void* p) { const unsigned long long u = (unsigned long long)p;
  const unsigned lo = (unsigned)__builtin_amdgcn_readfirstlane((int)(unsigned)u), hi = (unsigned)__builtin_amdgcn_readfirstlane((int)(unsigned)(u >> 32)); return (const void*)(((unsigned long long)hi << 32) | lo); }
constexpr int PB_Q = 6, PB_ZONE = PB_Q * 1024, PB_TPITCH = 128, PB_TILE = 32 * PB_TPITCH, PB_WAVE = PB_ZONE + PB_TILE, PB_NIT = 96 * 1024;
#define PB_GAS __attribute__((address_space(1)))
#define PB_LAS __attribute__((address_space(3)))
struct Pb { int total, gw, NGW; const float* pg; long du, dd; PB_GAS unsigned char* wgu; PB_GAS unsigned char* wd; unsigned zone; };
__device__ __forceinline__ const char* pb_src(const Pb& pb, int it) {
  const int m = it >> 10, tp = it & 1023, e = m / 3, w = m % 3;
  return (const char*)pb.pg + pb.du * (long)(w == 1) + pb.dd * (long)(w == 2) + ((size_t)e * 2048 * 2048 + (size_t)((tp >> 6) * 128) * 2048 + (tp & 63) * 32) * 4;
}
__device__ __forceinline__ PB_GAS unsigned char* pb_dst(const Pb& pb, int it) {
  const int m = it >> 10, tp = it & 1023, e = m / 3, w = m % 3, k0 = (tp >> 6) * 128, n0 = (tp & 63) * 32;
  if (w == 2) return pb.wd + ((size_t)e * 2048 + n0) * 2048 + k0;
  return pb.wgu + ((size_t)e * 4096 + (size_t)(n0 >> 7) * 256 + (n0 & 127) + (w == 1 ? 128 : 0)) * 2048 + k0;
}
__device__ __forceinline__ int pb_issue(const Pb pb, int& c_issue, const char*& isrc, int lane) {
  asm volatile("s_waitcnt lgkmcnt(0)" ::: "memory");
  const int n = (pb.total - c_issue) < PB_Q ? (pb.total - c_issue) : PB_Q;
  if (n <= 0) return 0;
  const unsigned loff = (unsigned)(((lane >> 3) * 2048 + 4 * (lane & 7)) * 4);
  const unsigned z0 = (unsigned)__builtin_amdgcn_readfirstlane((int)pb.zone);
  unsigned keep; asm volatile("s_mov_b32 %0, m0" : "=s"(keep) :: "memory");
#pragma unroll
  for (int q = 0; q < PB_Q; ++q) { if (q < n) {
    if (((c_issue + q) & 15) == 0) isrc = (const char*)uni_ptr(pb_src(pb, pb.gw + ((c_issue + q) >> 4) * pb.NGW));
    asm volatile("s_mov_b32 m0, %2\n\ts_nop 0\n\tglobal_load_lds_dwordx4 %0, %1 sc1 nt" :: "v"(loff), "s"(isrc), "s"(z0 + q * 1024) : "memory");
    isrc += 65536; } }
  asm volatile("s_mov_b32 m0, %0" :: "s"(keep) : "memory");
  c_issue += n; return n;
}
__device__ __forceinline__ void pb_process(const Pb pb, int& c_proc, const int c_issue, char* lds_, int lane) {
  const int nn = lane & 31, a = lane >> 5;
  PB_LAS char* lds = (PB_LAS char*)lds_;
  PB_LAS char* tile = lds + pb.zone + PB_ZONE;
  const unsigned twr = (unsigned)(uintptr_t)(tile + nn * PB_TPITCH + 4 * a), nx = (unsigned)((nn & 7) << 4);
  const PB_LAS float* zrd = (const PB_LAS float*)(lds + pb.zone) + (4 * a) * 32 + nn;
  const int n = c_issue - c_proc;
#pragma unroll
  for (int q = 0; q < PB_Q; ++q) { if (q < n) {
    const int i = (c_proc + q) & 15;
    const PB_LAS float* z = zrd + q * 256;
    typedef float f2 __attribute__((ext_vector_type(2)));
    const f2 t01 = (f2){z[0], z[32]} * 64.f, t23 = (f2){z[64], z[96]} * 64.f;
    int w0 = __builtin_amdgcn_cvt_pk_fp8_f32(t01.x, t01.y, (int)__float_as_uint(t01.x), false); w0 = __builtin_amdgcn_cvt_pk_fp8_f32(t23.x, t23.y, w0, true);
    *(PB_LAS int*)(uintptr_t)((((unsigned)i << 3) ^ nx) + twr) = w0;
    if (i == 15) {
      PB_GAS unsigned char* dst = pb_dst(pb, pb.gw + ((c_proc + q) >> 4) * pb.NGW);
      const int lr = lane >> 3, l7 = lane & 7;
      const PB_LAS char* trd = tile + lr * PB_TPITCH + ((l7 ^ lr) << 4);
      const unsigned voff = (unsigned)(lr * 2048 + 16 * l7);
#pragma unroll
      for (int j = 0; j < 4; ++j) { const u32x4 o = *(const PB_LAS u32x4*)(trd + j * 8 * PB_TPITCH);
        __builtin_nontemporal_store(o, (PB_GAS u32x4*)(dst + (voff + (unsigned)j * 16384u))); }
    } } }
  c_proc = c_issue;
}
__device__ __forceinline__ int pb_step(const Pb pb, int& c_issue, int& c_proc, const char*& isrc, char* lds, int lane) {
  asm volatile("s_waitcnt vmcnt(4)" ::: "memory");
  pb_process(pb, c_proc, c_issue, lds, lane); return pb_issue(pb, c_issue, isrc, lane); }
__device__ __forceinline__ void pb_drain(const Pb pb, int& c_issue, int& c_proc, const char*& isrc, char* lds, int lane) {
#pragma unroll 1
  for (;;) { if (c_proc < c_issue) { asm volatile("s_waitcnt vmcnt(0)" ::: "memory"); pb_process(pb, c_proc, c_issue, lds, lane); }
    if (c_issue >= pb.total) break; (void)pb_issue(pb, c_issue, isrc, lane); }
  asm volatile("s_waitcnt vmcnt(0) lgkmcnt(0)" ::: "memory");
}

template <int D0> __device__ __forceinline__ void pv32_one(f32x16& od, int vb, bf16x8 pa0, bf16x8 pa1) {
  const s16x4 l0 = tr_read<v_rd_off(D0, 0, 0)>(vb), h0 = tr_read<v_rd_off(D0, 0, 1)>(vb), l1 = tr_read<v_rd_off(D0, 1, 0)>(vb), h1 = tr_read<v_rd_off(D0, 1, 1)>(vb);
  asm volatile("s_waitcnt lgkmcnt(0)" ::: "memory"); SBAR();
#define PK(L, H) (bf16x8){L[0], L[1], L[2], L[3], H[0], H[1], H[2], H[3]}
  od = __builtin_amdgcn_mfma_f32_32x32x16_bf16(pa0, PK(l0, h0), od, 0, 0, 0);
  od = __builtin_amdgcn_mfma_f32_32x32x16_bf16(pa1, PK(l1, h1), od, 0, 0, 0);
#undef PK
}
__device__ __forceinline__ void dilated_wave(const bf16* __restrict__ Qb, const bf16* __restrict__ Kb, const bf16* __restrict__ Vb, long ld, int j0, int L, float kk,
                                             bf16* __restrict__ Ob, long ldo, float* __restrict__ Lp, long ldl, char* ktile, char* vtile, float* scr) {
  constexpr float C = SCALE * 1.4426950408889634f;
  int lane = threadIdx.x & 63; asm volatile("" : "+v"(lane));
  const int r32 = lane & 31, hi = lane >> 5;
  bf16x8 qr[8];
  { const bf16* Qw = Qb + (long)(j0 + r32) * ld + hi * 8;
#pragma unroll
    for (int d0 = 0; d0 < 8; ++d0) qr[d0] = *reinterpret_cast<const bf16x8*>(Qw + d0 * 16); }
  float m_reg = -1e30f, l_reg = 0.f; f32x16 o[4] = {};
  const int vb0 = (int)(uintptr_t)vtile + v_rd_base(lane);
  const int sr = lane >> 4, scol = (lane & 15) * 8;
  bf16x8 kn[8], vn[8];
#define DW_LOAD(t_) do { const int kb_ = j0 - 64 + 32 * (t_); const int kbc_ = (kb_ >= 0 && kb_ < L) ? kb_ : j0;   \
    const bf16* Kw_ = Kb + (long)(kbc_ + sr) * ld + scol; const bf16* Vw_ = Vb + (long)(kbc_ + sr) * ld + scol; \
    _Pragma("unroll") for (int i_ = 0; i_ < 8; ++i_) { kn[i_] = *reinterpret_cast<const bf16x8*>(Kw_ + (long)(4 * i_) * ld); vn[i_] = *reinterpret_cast<const bf16x8*>(Vw_ + (long)(4 * i_) * ld); } } while (0)
  DW_LOAD(0);
#pragma unroll 1
  for (int t = 0; t < 5; ++t) {
    const int kb = j0 - 64 + 32 * t; const bool valid = kb >= 0 && kb < L;
#pragma unroll
    for (int i = 0; i < 8; ++i) { const int row = 4 * i + sr;
      *reinterpret_cast<bf16x8*>(ktile + row * 256 + ((scol * 2) ^ ((row & 7) << 4))) = kn[i];
      *reinterpret_cast<bf16x8*>(vtile + v_st(row, scol)) = vn[i]; }
    if (t + 1 < 5) DW_LOAD(t + 1);
    f32x16 p0 = {};
#pragma unroll
    for (int d0 = 0; d0 < 8; ++d0) { const int cbb = (d0 * 16 + hi * 8) * 2;
      const bf16x8 kf = *reinterpret_cast<const bf16x8*>(ktile + r32 * 256 + (cbb ^ ((r32 & 7) << 4)));
      p0 = __builtin_amdgcn_mfma_f32_32x32x16_bf16(kf, qr[d0], p0, 0, 0, 0); }
    const float relb = (float)(j0 + r32 - kb - 4 * hi);
#pragma unroll
    for (int r = 0; r < 16; ++r) { const float a = __builtin_fabsf(relb - (float)((r & 3) + 8 * (r >> 2))); p0[r] = fmaf(a, -kk, p0[r]); if (!(valid && a <= 64.f)) p0[r] = -INFINITY; }
    float pmax = p0[0];
#pragma unroll
    for (int r = 1; r < 16; ++r) pmax = fmaxf(pmax, p0[r]);
    { auto rr = __builtin_amdgcn_permlane32_swap(__float_as_uint(pmax), __float_as_uint(pmax), false, false); pmax = fmaxf(__uint_as_float(rr[0]), __uint_as_float(rr[1])); }
    const float mn = fmaxf(m_reg, pmax), alpha = __builtin_amdgcn_exp2f((m_reg - mn) * C), mnC = -mn * C; m_reg = mn;
    float ps = 0.f;
#pragma unroll
    for (int r = 0; r < 16; ++r) { p0[r] = __builtin_amdgcn_exp2f(fmaf(p0[r], C, mnC)); ps += p0[r]; }
    { auto rr = __builtin_amdgcn_permlane32_swap(__float_as_uint(ps), __float_as_uint(ps), false, false); ps = __uint_as_float(rr[0]) + __uint_as_float(rr[1]); }
    l_reg = l_reg * alpha + ps;
    if (__any(alpha < 1.f)) { if (hi == 0) scr[r32] = alpha; asm volatile("s_waitcnt lgkmcnt(0)" ::: "memory");
#pragma unroll
      for (int d = 0; d < 4; ++d)
#pragma unroll
        for (int r = 0; r < 16; ++r) o[d][r] *= scr[crow(r, hi)]; }
    bf16x8 pa0, pa1;
#define PK4(P, BASE, OUT) do { unsigned a0 = cvtpk(P[BASE + 0], P[BASE + 1]), a1 = cvtpk(P[BASE + 2], P[BASE + 3]);   \
    unsigned b0 = cvtpk(P[BASE + 4], P[BASE + 5]), b1 = cvtpk(P[BASE + 6], P[BASE + 7]);                              \
    auto r0 = __builtin_amdgcn_permlane32_swap(a0, b0, false, false); auto r1 = __builtin_amdgcn_permlane32_swap(a1, b1, false, false); \
    u32x4 w = {r0[0], r1[0], r0[1], r1[1]}; OUT = *reinterpret_cast<bf16x8*>(&w); } while (0)
    PK4(p0, 0, pa0); PK4(p0, 8, pa1);
#undef PK4
    SBAR();
    pv32_one<0>(o[0], vb0, pa0, pa1); pv32_one<1>(o[1], vb0, pa0, pa1); pv32_one<2>(o[2], vb0, pa0, pa1); pv32_one<3>(o[3], vb0, pa0, pa1);
  }
#undef DW_LOAD
  if (hi == 0) scr[32 + r32] = l_reg; asm volatile("s_waitcnt lgkmcnt(0)" ::: "memory");
  bf16* Ow = Ob + (long)(j0 + 4 * hi) * ldo + r32;
#pragma unroll
  for (int r = 0; r < 16; ++r) { const float rl = __builtin_amdgcn_rcpf(scr[32 + crow(r, hi)]); bf16* Or = Ow + (long)((r & 3) + 8 * (r >> 2)) * ldo;
#pragma unroll
    for (int d0 = 0; d0 < 4; ++d0) { const float y = o[d0][r] * rl; Or[d0 * 32] = (bf16)cvtpk(y, y); } }
  if (hi == 0) Lp[(long)(j0 + r32) * ldl] = m_reg * SCALE + __logf(l_reg);
}

template <int MODE>
__device__ __forceinline__ void attn_body(const bf16* __restrict__ Qb, long ldq, const bf16* __restrict__ Kh, const bf16* __restrict__ Vh, long ldk,
                                          int t0, int NT, int ntmax, int qpos0, float kk, bf16* __restrict__ Ob, long ldo, float* __restrict__ Lb, long ldl, char* lds, const Pb pb, int& pbi, int& pbp, const char*& pbs) {
  int tid = threadIdx.x; asm volatile("" : "+v"(tid));
  const int wid = tid >> 6, lane = tid & 63, r32 = lane & 31, hi = lane >> 5;
  bf16* V_lds = (bf16*)lds; bf16* K_lds = (bf16*)(lds + 2 * SHM_V);
  float* ws = (float*)(lds + 2 * SHM_V + 2 * SHM_K) + wid * 64; float* li_l = ws; float* al_l = ws + 32;
  float m_reg = -1e30f, l_reg = 0; f32x16 o[4] = {}; bf16x8 qr[8];
  const bf16* Qw = Qb + (long)(wid * QBLK + r32) * ldq + hi * 8;
#pragma unroll
  for (int d0 = 0; d0 < 8; ++d0) qr[d0] = *reinterpret_cast<const bf16x8*>(Qw + d0 * 16);
  const int sr = tid >> 4, sc = (tid & 15) * 8, vst0 = v_st(sr, sc), vst1 = v_st(32 + sr, sc);
  const int vb0 = (int)(uintptr_t)V_lds + v_rd_base(lane);
  const unsigned sob0 = 2u * (unsigned)(sr * (int)ldk + sc), sob1 = sob0 + 64u * (unsigned)ldk;
  const float qposf = (float)(qpos0 + wid * QBLK + r32 - 4 * hi);
  const int qlo = qpos0 + __builtin_amdgcn_readfirstlane(wid) * QBLK;
  struct { bf16x8 vs0, vs1, ks0, ks1; } sr_[1];
#define TCL(jt) ({ int _t = t0 + (jt); _t = _t < 0 ? 0 : (_t >= ntmax ? ntmax - 1 : _t); _t * KVBLK; })
#define TVALID(jt) ((t0 + (jt)) >= 0 && (t0 + (jt)) < ntmax)
#define RELB(jt) (qposf - (float)((t0 + (jt)) * KVBLK))
#define SIDE(jt) (qlo > (t0 + (jt)) * KVBLK + (KVBLK - 1) ? 1 : (qlo + (QBLK - 1) < (t0 + (jt)) * KVBLK ? -1 : 0))
#define SLOAD(i, jt) do { const long _k0 = (long)TCL(jt) * ldk; const bf16* _vp = (const bf16*)uni_ptr(Vh + _k0); const bf16* _kp = (const bf16*)uni_ptr(Kh + _k0); \
    asm volatile("s_nop 4\n\tglobal_load_dwordx4 %0, %4, %6\n\tglobal_load_dwordx4 %1, %5, %6\n\tglobal_load_dwordx4 %2, %4, %7\n\tglobal_load_dwordx4 %3, %5, %7" \
        : "=&v"(sr_[i].vs0), "=&v"(sr_[i].vs1), "=&v"(sr_[i].ks0), "=&v"(sr_[i].ks1) : "v"(sob0), "v"(sob1), "s"(_vp), "s"(_kp) : "memory"); } while (0)
#define SWAITN(i, n) asm volatile("s_waitcnt vmcnt(%4)" : "+v"(sr_[i].vs0), "+v"(sr_[i].vs1), "+v"(sr_[i].ks0), "+v"(sr_[i].ks1) : "i"(n) : "memory")
#define BSYNC() asm volatile("s_waitcnt lgkmcnt(0)\n\ts_barrier" ::: "memory")
#define SWRITE(b, i) do { *(bf16x8*)((char*)V_lds + (b) * SHM_V + vst0) = sr_[i].vs0;          \
    *(bf16x8*)((char*)V_lds + (b) * SHM_V + vst1) = sr_[i].vs1; const int kc = sc * 2;               \
    *(bf16x8*)((char*)K_lds + (b) * SHM_K + KSWZ(sr, kc)) = sr_[i].ks0;                       \
    *(bf16x8*)((char*)K_lds + (b) * SHM_K + KSWZ(32 + sr, kc)) = sr_[i].ks1; } while (0)
#define SWAIT() SWAITN(0, 0)
#define SWAITQ(n) asm volatile("s_cmp_eq_u32 %4, %5\n\ts_cbranch_scc1 .Lpbw%=\n\ts_waitcnt vmcnt(0)\n.Lpbw%=:\n\ts_waitcnt vmcnt(%5)" \
    : "+v"(sr_[0].vs0), "+v"(sr_[0].vs1), "+v"(sr_[0].ks0), "+v"(sr_[0].ks1) : "s"(n), "i"(PB_Q) : "memory", "scc")
#define RESC(a) do { if (__any((a) < 1.f)) { if (hi == 0) al_l[r32] = (a); asm volatile("s_waitcnt lgkmcnt(0)" ::: "memory"); \
    _Pragma("unroll") for (int d = 0; d < 4; ++d) _Pragma("unroll") for (int r = 0; r < 16; ++r) o[d][r] *= al_l[crow(r, hi)]; } } while (0)
  f32x16 pA0, pA1, pB0, pB1; float mnA, mnB, alA, alB; bf16x8 pa0, pa1, pa2, pa3; int nq = 0;
  constexpr int SE = 0, SO = 0;
  if constexpr (MODE == 1) {
    const int w2 = __builtin_amdgcn_readfirstlane(wid) >> 1;
    SLOAD(SE, 0); SWAIT(); SWRITE(0, SE); __syncthreads();
#pragma unroll 1
    for (int jt = 0; jt < NT; ++jt) {
      const int b = jt & 1;
      if (jt + 1 < NT) { SLOAD(SE, jt + 1); SBAR(); nq = pb_step(pb, pbi, pbp, pbs, lds, lane); SBAR(); }
      if (jt >= w2 && jt <= w2 + 2) {
        qkt(pA0, pA1, (bf16*)((char*)K_lds + b * SHM_K), qr, r32, hi); partialSM<MODE>(pA0, pA1, m_reg, mnA, alA, RELB(jt), kk, TVALID(jt));
        RESC(alA);
        finishSM(pA0, pA1, alA, l_reg, pa0, pa1, pa2, pa3); SBAR();
        pv_d0(o, vb0 + b * (int)SHM_V, pa0, pa1, pa2, pa3);
      }
      if (jt + 1 < NT) { SWAITQ(nq); SWRITE(b ^ 1, SE); BSYNC(); }
    }
  } else {
  SLOAD(SE, 0); SWAIT(); SWRITE(0, SE); __syncthreads();
  qkt(pA0, pA1, K_lds, qr, r32, hi); partialSM<MODE>(pA0, pA1, m_reg, mnA, alA, RELB(0), kk, TVALID(0), SIDE(0));
  SLOAD(SO, 1);
  SWAIT(); SWRITE(1, SO); __syncthreads();
  for (int j = 1; j + 1 < NT; j += 2) {
    SBAR(); qkt(pB0, pB1, (bf16*)((char*)K_lds + SHM_K), qr, r32, hi);
    finishSM(pA0, pA1, alA, l_reg, pa0, pa1, pa2, pa3); SBAR();
    SLOAD(SO, j + 1); SBAR();
    nq = pb_step(pb, pbi, pbp, pbs, lds, lane); SBAR();
    pv_d0(o, vb0, pa0, pa1, pa2, pa3); partialSM<MODE>(pB0, pB1, m_reg, mnB, alB, RELB(j), kk, TVALID(j), SIDE(j));
    BSYNC(); SWAITQ(nq); SWRITE(0, SE);
    RESC(alB); BSYNC();
    SBAR(); qkt(pA0, pA1, K_lds, qr, r32, hi);
    finishSM(pB0, pB1, alB, l_reg, pa0, pa1, pa2, pa3); SBAR();
    SLOAD(SE, j + 2); SBAR();
    nq = pb_step(pb, pbi, pbp, pbs, lds, lane); SBAR();
    pv_d0(o, vb0 + (int)SHM_V, pa0, pa1, pa2, pa3); partialSM<MODE>(pA0, pA1, m_reg, mnA, alA, RELB(j + 1), kk, TVALID(j + 1), SIDE(j + 1));
    BSYNC(); SWAITQ(nq); SWRITE(1, SO);
    RESC(alA); BSYNC();
  }
  SBAR(); qkt(pB0, pB1, (bf16*)((char*)K_lds + SHM_K), qr, r32, hi);
  finishSM(pA0, pA1, alA, l_reg, pa0, pa1, pa2, pa3); SBAR();
  pv_d0(o, vb0, pa0, pa1, pa2, pa3); partialSM<MODE>(pB0, pB1, m_reg, mnB, alB, RELB(NT - 1), kk, TVALID(NT - 1), SIDE(NT - 1));
  __syncthreads(); RESC(alB);
  finishSM(pB0, pB1, alB, l_reg, pa0, pa1, pa2, pa3); SBAR();
  pv_d0(o, vb0 + (int)SHM_V, pa0, pa1, pa2, pa3);
  }
  if (hi == 0) li_l[r32] = l_reg; asm volatile("s_waitcnt lgkmcnt(0)" ::: "memory");
  float rli[16];
#pragma unroll
  for (int r = 0; r < 16; ++r) rli[r] = __builtin_amdgcn_rcpf(li_l[crow(r, hi)]);
  int tide = tid; asm volatile("" : "+v"(tide));
  const int hie = (tide >> 5) & 1, r32e = tide & 31, wide = tide >> 6;
  bf16* Ow = Ob + (long)(wide * QBLK + 4 * hie) * ldo + r32e;
#pragma unroll
  for (int r = 0; r < 16; ++r) { bf16* Or = Ow + (long)((r & 3) + 8 * (r >> 2)) * ldo;
#pragma unroll
    for (int d0 = 0; d0 < 4; ++d0) { const float y = o[d0][r] * rli[r]; Or[d0 * 32] = (bf16)cvtpk(y, y); } }
  if (Lb != nullptr && hie == 0) Lb[(long)(wide * QBLK + r32e) * ldl] = m_reg * SCALE + __logf(l_reg);
  __syncthreads();
#undef TCL
#undef TVALID
#undef RELB
#undef SIDE
#undef SLOAD
#undef SWRITE
#undef SWAIT
#undef SWAITQ
#undef SWAITN
#undef BSYNC
#undef RESC
}

__device__ __forceinline__ int v_st256(int k, int c) { const int kk = (k & ~0xC) | ((k & 4) << 1) | ((k & 8) >> 1); return ((kk >> 3) * 8 + (c >> 5)) * 512 + ((kk & 7) * 32 + (c & 31)) * 2; }
constexpr int v_rd_off256(int d0, int ks, int half) { return d0 * 512 + ks * 8192 + half * 4096; }
template <int D0> __device__ __forceinline__ void pv32k_one(f32x16& od, int vb, bf16x8 pa0, bf16x8 pa1) {
  const s16x4 l0 = tr_read<v_rd_off256(D0, 0, 0)>(vb), h0 = tr_read<v_rd_off256(D0, 0, 1)>(vb), l1 = tr_read<v_rd_off256(D0, 1, 0)>(vb), h1 = tr_read<v_rd_off256(D0, 1, 1)>(vb);
  asm volatile("s_waitcnt lgkmcnt(0)" ::: "memory"); SBAR();
#define PK(L, H) (bf16x8){L[0], L[1], L[2], L[3], H[0], H[1], H[2], H[3]}
  od = __builtin_amdgcn_mfma_f32_32x32x16_bf16(pa0, PK(l0, h0), od, 0, 0, 0);
  od = __builtin_amdgcn_mfma_f32_32x32x16_bf16(pa1, PK(l1, h1), od, 0, 0, 0);
#undef PK
}
template <int NY> __device__ __forceinline__ int pb_step_n(const Pb pb, int& c_issue, int& c_proc, const char*& isrc, char* lds, int lane) {
  asm volatile("s_waitcnt vmcnt(%0)" :: "i"(NY) : "memory");
  pb_process(pb, c_proc, c_issue, lds, lane); return pb_issue(pb, c_issue, isrc, lane); }
constexpr int DK_V = 0, DK_K = 32768, DK_SCR = 65536;
__device__ __forceinline__ void diffk_body(const bf16* __restrict__ Qb, const bf16* __restrict__ Kh, const bf16* __restrict__ Vh, long ld, int qpos0, float kk,
                                           bf16* __restrict__ Ob, char* lds, const Pb pb, int& pbi, int& pbp, const char*& pbs) {
  constexpr float C = SCALE * 1.4426950408889634f;
  constexpr int NT = 4096 / KVBLK;
  int tid = threadIdx.x; asm volatile("" : "+v"(tid));
  const int wid = tid >> 6, lane = tid & 63, r32 = lane & 31, hi = lane >> 5;
  const int rg = __builtin_amdgcn_readfirstlane(wid);
  float* ws = (float*)(lds + DK_SCR) + wid * 64; float* li_l = ws; float* al_l = ws + 32;
  float m_reg = -1e30f, l_reg = 0; f32x16 o[8] = {}; bf16x8 qr[8];
  { const bf16* Qw = Qb + (long)(rg * 32 + r32) * ld + hi * 8;
#pragma unroll
    for (int d0 = 0; d0 < 8; ++d0) qr[d0] = *reinterpret_cast<const bf16x8*>(Qw + d0 * 16); }
#define DK_SOFFS() int t2_ = tid; asm volatile("" : "+v"(t2_)); const int sr = t2_ >> 4, sc = (t2_ & 15) * 8, l2_ = t2_ & 63, w2_ = t2_ >> 6; \
  const unsigned sob0 = 2u * (unsigned)(sr * (int)ld + sc), sob1 = sob0 + 64u * (unsigned)ld;        \
  const unsigned kof0 = (unsigned)((8 * w2_ + (l2_ >> 4)) * (int)ld * 2) + (unsigned)((((l2_ & 15) ^ (l2_ >> 4)) & 15) << 4);            \
  const unsigned kof1 = (unsigned)((8 * w2_ + 4 + (l2_ >> 4)) * (int)ld * 2) + (unsigned)((((l2_ & 15) ^ (4 + (l2_ >> 4))) & 15) << 4);
  const unsigned kdst = (unsigned)__builtin_amdgcn_readfirstlane((int)(unsigned)(uintptr_t)(lds + DK_K + 8 * wid * 256));
  const int vb = (int)(uintptr_t)(lds + DK_V) + v_rd_base(lane);
  const float qposf = (float)(qpos0 + rg * 32 + r32 - 4 * hi);
  const int qlo = qpos0 + rg * 32;
  bf16x8 vs0, vs1, vs2, vs3; int nq = 0;
#define DK_KDMA(jt, b) do { const bf16* _kp = (const bf16*)uni_ptr(Kh + (long)(jt) * KVBLK * ld); unsigned _keep; \
    asm volatile("s_nop 4\n\ts_mov_b32 %0, m0\n\ts_mov_b32 m0, %4\n\ts_nop 0\n\tglobal_load_lds_dwordx4 %1, %3\n\ts_add_u32 m0, m0, 0x400\n\ts_nop 0\n\tglobal_load_lds_dwordx4 %2, %3\n\ts_mov_b32 m0, %0" \
        : "=&s"(_keep) : "v"(kof0), "v"(kof1), "s"(_kp), "s"(kdst + (b) * 16384u) : "memory"); } while (0)
#define DK_VLOAD(jt) do { const bf16* _vp = (const bf16*)uni_ptr(Vh + (long)(jt) * KVBLK * ld); \
    asm volatile("s_nop 4\n\tglobal_load_dwordx4 %0, %4, %6\n\tglobal_load_dwordx4 %1, %5, %6\n\tglobal_load_dwordx4 %2, %4, %6 offset:256\n\tglobal_load_dwordx4 %3, %5, %6 offset:256" \
        : "=&v"(vs0), "=&v"(vs1), "=&v"(vs2), "=&v"(vs3) : "v"(sob0), "v"(sob1), "s"(_vp) : "memory"); } while (0)
#define DK_VWAIT0() asm volatile("s_waitcnt vmcnt(0)" : "+v"(vs0), "+v"(vs1), "+v"(vs2), "+v"(vs3) :: "memory")
#define DK_VWAITQ(n) asm volatile("s_cmp_eq_u32 %4, %5\n\ts_cbranch_scc1 .Ldkw%=\n\ts_waitcnt vmcnt(0)\n.Ldkw%=:\n\ts_waitcnt vmcnt(%5)" \
    : "+v"(vs0), "+v"(vs1), "+v"(vs2), "+v"(vs3) : "s"(n), "i"(PB_Q) : "memory", "scc")
#define DK_VWRITE() do { int t3_ = tid; asm volatile("" : "+v"(t3_)); char* _v = lds + DK_V + v_st256(t3_ >> 4, (t3_ & 15) * 8); *(bf16x8*)(_v) = vs0; *(bf16x8*)(_v + 16384) = vs1; *(bf16x8*)(_v + 2048) = vs2; *(bf16x8*)(_v + 18432) = vs3; } while (0)
#define DK_BSYNC() asm volatile("s_waitcnt lgkmcnt(0)\n\ts_barrier" ::: "memory")
  { DK_SOFFS(); DK_KDMA(0, 0); DK_VLOAD(0); } DK_VWAIT0(); DK_VWRITE(); __syncthreads();
#pragma unroll 1
  for (int j = 0; j < NT; ++j) {
    const char* Kb = lds + DK_K + (j & 1) * 16384;
    if (j + 1 < NT) { { DK_SOFFS(); DK_KDMA(j + 1, (j + 1) & 1); DK_VLOAD(j + 1); } SBAR(); nq = pb_step_n<6>(pb, pbi, pbp, pbs, lds, lane); SBAR(); }
    else { SBAR(); nq = pb_step_n<0>(pb, pbi, pbp, pbs, lds, lane); SBAR(); }
#pragma unroll 1
    for (int kh = 0; kh < 2; ++kh) {
    if (kh == 1) { SBAR(); nq = pb_step_n<0>(pb, pbi, pbp, pbs, lds, lane); SBAR(); }
    f32x16 p = {};
#pragma unroll
    for (int d0 = 0; d0 < 8; ++d0) { const int cb = (d0 * 16 + hi * 8) * 2;
      const bf16x8 kf = *reinterpret_cast<const bf16x8*>(Kb + (kh * 32 + r32) * 256 + (cb ^ ((r32 & 7) << 4)));
      p = __builtin_amdgcn_mfma_f32_32x32x16_bf16(kf, qr[d0], p, 0, 0, 0); }
    const float relb = qposf - (float)(j * KVBLK + 32 * kh);
    const int klo = j * KVBLK + 32 * kh;
    const int side = qlo > klo + 31 ? 1 : (qlo + 31 < klo ? -1 : 0);
    float base = 0.f;
    if (side != 0) { const float skk = side > 0 ? kk : -kk; base = -skk * relb;
#pragma unroll
      for (int r = 0; r < 16; ++r) p[r] = fmaf(skk, (float)((r & 3) + 8 * (r >> 2)), p[r]);
    } else {
#pragma unroll
      for (int r = 0; r < 16; ++r) p[r] = fmaf(__builtin_fabsf(relb - (float)((r & 3) + 8 * (r >> 2))), -kk, p[r]);
    }
    float pmax = p[0];
#pragma unroll
    for (int r = 1; r < 16; ++r) pmax = fmaxf(pmax, p[r]);
    { auto rr = __builtin_amdgcn_permlane32_swap(__float_as_uint(pmax), __float_as_uint(pmax), false, false); pmax = fmaxf(__uint_as_float(rr[0]), __uint_as_float(rr[1])); }
    pmax += base;
    float mn, alpha;
    if (__builtin_expect(__all(pmax - m_reg <= THR / SCALE), 1)) { mn = m_reg; alpha = 1.f; }
    else { mn = fmaxf(m_reg, pmax); alpha = __builtin_amdgcn_exp2f((m_reg - mn) * C); m_reg = mn; }
    const float mnC = (base - mn) * C;
    float ps = 0.f;
#pragma unroll
    for (int r = 0; r < 16; ++r) { p[r] = __builtin_amdgcn_exp2f(fmaf(p[r], C, mnC)); ps += p[r]; }
    { auto rr = __builtin_amdgcn_permlane32_swap(__float_as_uint(ps), __float_as_uint(ps), false, false); ps = __uint_as_float(rr[0]) + __uint_as_float(rr[1]); }
    l_reg = l_reg * alpha + ps;
    if (__any(alpha < 1.f)) { if (hi == 0) al_l[r32] = alpha; asm volatile("s_waitcnt lgkmcnt(0)" ::: "memory");
#pragma unroll
      for (int d = 0; d < 8; ++d)
#pragma unroll
        for (int r = 0; r < 16; ++r) o[d][r] *= al_l[crow(r, hi)]; }
    bf16x8 pa0, pa1;
#define PK4(P, BASE, OUT) do { unsigned a0 = cvtpk(P[BASE + 0], P[BASE + 1]), a1 = cvtpk(P[BASE + 2], P[BASE + 3]);   \
    unsigned b0 = cvtpk(P[BASE + 4], P[BASE + 5]), b1 = cvtpk(P[BASE + 6], P[BASE + 7]);                              \
    auto r0 = __builtin_amdgcn_permlane32_swap(a0, b0, false, false); auto r1 = __builtin_amdgcn_permlane32_swap(a1, b1, false, false); \
    u32x4 w = {r0[0], r1[0], r0[1], r1[1]}; OUT = *reinterpret_cast<bf16x8*>(&w); } while (0)
    PK4(p, 0, pa0); PK4(p, 8, pa1);
#undef PK4
    SBAR();
    pv32k_one<0>(o[0], vb + kh * 16384, pa0, pa1); pv32k_one<1>(o[1], vb + kh * 16384, pa0, pa1); pv32k_one<2>(o[2], vb + kh * 16384, pa0, pa1); pv32k_one<3>(o[3], vb + kh * 16384, pa0, pa1);
    pv32k_one<4>(o[4], vb + kh * 16384, pa0, pa1); pv32k_one<5>(o[5], vb + kh * 16384, pa0, pa1); pv32k_one<6>(o[6], vb + kh * 16384, pa0, pa1); pv32k_one<7>(o[7], vb + kh * 16384, pa0, pa1);
    }
    if (j + 1 < NT) { DK_BSYNC(); DK_VWAITQ(nq); DK_VWRITE(); DK_BSYNC(); }
  }
  if (hi == 0) li_l[r32] = l_reg; asm volatile("s_waitcnt lgkmcnt(0)" ::: "memory");
  int tide = tid; asm volatile("" : "+v"(tide));
  const int hie = (tide >> 5) & 1, r32e = tide & 31;
  bf16* Ow = Ob + (long)(rg * 32 + 4 * hie) * 1024 + r32e;
#pragma unroll
  for (int r = 0; r < 16; ++r) { const float rl = __builtin_amdgcn_rcpf(li_l[crow(r, hie)]); bf16* Or = Ow + (long)((r & 3) + 8 * (r >> 2)) * 1024;
#pragma unroll
    for (int d0 = 0; d0 < 8; ++d0) { const float y = o[d0][r] * rl; Or[d0 * 32] = (bf16)cvtpk(y, y); } }
  __syncthreads();
#undef DK_KDMA
#undef DK_SOFFS
#undef DK_VLOAD
#undef DK_VWAIT0
#undef DK_VWAITQ
#undef DK_VWRITE
#undef DK_BSYNC
}
#undef KSWZ
#undef SBAR
}
constexpr int NWAVES = 8;
#ifndef MK_SPLIT
#define MK_SPLIT 0
#endif
constexpr int N_PHASES = 12;

constexpr int DM = 2048, BATCH = 2, SEQ = 4096, T = BATCH * SEQ;
constexpr int NQKV = 10240;
constexpr int C_QA = 0, C_KA = 1024, C_VA = 2048, C_QB = 3072, C_KB = 4096, C_VB = 5120, C_GA = 6144, C_GB = 8192;
constexpr unsigned long long LBMAP = 0x4310ull;
constexpr unsigned long long LFMAP = 0x987652ull;
constexpr int NLB = 4, NLF = 6;
constexpr int NE = 32, TOPK = 4, TK = T * TOPK, TKPAD = TK + NE * 256;
constexpr float EPS = 1e-5f;
constexpr float LAMBDA_INIT = 0.2f;

constexpr size_t MiB = 1u << 20;
constexpr size_t WS_CTL = 0, CTL_ZERO_BYTES = 1 * MiB;
constexpr size_t WS_MOD = 1 * MiB;
constexpr size_t WS_RC = 1 * MiB + 512 * 1024;
constexpr size_t WS_TOPI = 2 * MiB;
constexpr size_t WS_TOPP = 2 * MiB + 256 * 1024;
constexpr size_t WS_POS = 2 * MiB + 512 * 1024;
constexpr size_t WS_TOKOF = 3 * MiB;
constexpr size_t WS_WINT = 4 * MiB;
constexpr size_t WS_WING = 4 * MiB + (size_t)6144 * 4096;
constexpr size_t WS_U8Q = 770 * MiB;
constexpr size_t WS_WAT = 44 * MiB;
constexpr size_t WS_WBT = 48 * MiB;
constexpr size_t WS_WOT = 52 * MiB;
constexpr size_t WS_U = 64 * MiB;
constexpr size_t WS_QKV = 96 * MiB;
constexpr size_t WS_OA = 256 * MiB;
constexpr size_t WS_OB = 352 * MiB;
constexpr size_t WS_LSE = 416 * MiB;
constexpr size_t WS_YA = 418 * MiB;
constexpr size_t WS_YB = 434 * MiB;
constexpr size_t WS_M1 = 450 * MiB;
constexpr size_t WS_MG = 514 * MiB;
constexpr size_t WS_H1 = 546 * MiB;
constexpr size_t WS_XS = 610 * MiB;
constexpr size_t WS_YACT = 770 * MiB;
constexpr size_t WS_YSLOT = 930 * MiB;
constexpr size_t WS_WGU = 1090 * MiB;
constexpr size_t WS_WD = 1602 * MiB;
constexpr size_t WS_END = 1858 * MiB;
constexpr int CW_TMO = 0, CW_CODE = 1;
constexpr int CW_BAR = 4096;
constexpr int CW_CNT = 8192;

constexpr int RING_OFF = 0, RING_BYTES = 131072;
constexpr int PB_OFF = 69632;
constexpr int LDSCTL_OFF = 159744, MISC_OFF = LDSCTL_OFF + 320;
constexpr int TST_OFF = LDSCTL_OFF + 1024;
constexpr int LDS_BYTES = 163840;

#define GAS __attribute__((address_space(1)))
#define LAS __attribute__((address_space(3)))
typedef unsigned short bf16;
typedef unsigned v4u __attribute__((ext_vector_type(4)));
typedef unsigned v2u __attribute__((ext_vector_type(2)));
typedef float f32x4 __attribute__((ext_vector_type(4)));
typedef float v2f __attribute__((ext_vector_type(2)));
typedef GAS unsigned gu32;
#define RLX_AGENT __ATOMIC_RELAXED, __HIP_MEMORY_SCOPE_AGENT
#define LDS_WAIT() asm volatile("s_waitcnt lgkmcnt(0)" ::: "memory")
#define VM_WAIT() asm volatile("s_waitcnt vmcnt(0)" ::: "memory")
__device__ __forceinline__ unsigned f2bf(float f) { unsigned u = __builtin_bit_cast(unsigned, f); return (u + 0x7fffu + ((u >> 16) & 1u)) >> 16; }
__device__ __forceinline__ unsigned pk2(float lo, float hi) { return f2bf(lo) | (f2bf(hi) << 16); }
__device__ __forceinline__ float bf2f(unsigned short h) { return __uint_as_float(((unsigned)h) << 16); }
__device__ __forceinline__ float wave_sum(float v) {
#pragma unroll
    for (int o = 1; o < 64; o <<= 1) v += __shfl_xor(v, o);
    return v;
}
__device__ __forceinline__ float wave_max(float v) {
#pragma unroll
    for (int o = 1; o < 64; o <<= 1) v = fmaxf(v, __shfl_xor(v, o));
    return v;
}
__device__ __forceinline__ float siluf(float x) { return x / (1.0f + __expf(-x)); }
#define XB_TMO      128
#define XB_XCNT(j)  (256  + 64 * (j))
#define XB_XSUB(j)  (1280 + 64 * (j))
#define XB_XGEN(j)  (2304 + 64 * (j))
#define XB_TOP      3328
#define XB_TOPGEN   3392
#define XCD_BAR_WORDS 3456
#define XB_SPIN_CAP (1u << 18)

__device__ __forceinline__ unsigned xb_ld(unsigned* p)              { return __hip_atomic_load(p, __ATOMIC_RELAXED, __HIP_MEMORY_SCOPE_AGENT); }
__device__ __forceinline__ unsigned xb_add(unsigned* p, unsigned v) { return __hip_atomic_fetch_add(p, v, __ATOMIC_RELAXED, __HIP_MEMORY_SCOPE_AGENT); }
__device__ __forceinline__ unsigned xb_xcc_id() { return (unsigned)__builtin_amdgcn_s_getreg((3 << 11) | 20) & 0xFu; }
#define XB_SPIN(cond, bar) do { unsigned _sp = 0; while (cond) { __builtin_amdgcn_s_sleep(1); \
    if ((++_sp & 255u) == 0u) { if (xb_ld(&(bar)[XB_TMO])) break; if (_sp > XB_SPIN_CAP) { atomicAdd(&(bar)[XB_TMO], 1u); break; } } } } while (0)

struct XcdBarrier {
    unsigned* bar; unsigned x;
    volatile LAS unsigned* st;
};

__device__ __forceinline__ XcdBarrier xcd_barrier_post(unsigned* bar, volatile LAS unsigned* st) {
    XcdBarrier b; b.bar = bar; b.x = xb_xcc_id(); b.st = st;
    if (threadIdx.x == 0) (void)xb_add(&bar[XB_XCNT(b.x)], 1u);
    return b;
}
__device__ __forceinline__ void xcd_barrier_complete(unsigned* bar, unsigned x, unsigned& nloc, unsigned& nx) {
    const unsigned G = gridDim.x * gridDim.y * gridDim.z;
    unsigned sum, cnt, mine, sp = 0u;
    for (;;) {
        sum = 0u; cnt = 0u; mine = 0u;
#pragma unroll
        for (unsigned j = 0; j < 16; ++j) { const unsigned c = xb_ld(&bar[XB_XCNT(j)]); sum += c; cnt += (c > 0u) ? 1u : 0u; mine = (j == x) ? c : mine; }
        if (sum == G) break;
        __builtin_amdgcn_s_sleep(1);
        if ((++sp & 255u) == 0u) { if (xb_ld(&bar[XB_TMO])) break; if (sp > XB_SPIN_CAP) { atomicAdd(&bar[XB_TMO], 1u); break; } }
    }
    nloc = mine > 0u ? mine : 1u; nx = cnt > 0u ? cnt : 1u;
}

__device__ __forceinline__ void xcd_barrier(const XcdBarrier& b) {
    asm volatile("s_waitcnt vmcnt(0)" ::: "memory");
    __syncthreads();
    if (threadIdx.x == 0) {
        unsigned* bar = b.bar;
        __builtin_amdgcn_s_waitcnt(0);
        unsigned nloc = b.st[0], nx = b.st[1];
        if (nloc == 0u) { xcd_barrier_complete(bar, b.x, nloc, nx); b.st[0] = nloc; b.st[1] = nx; }
        const unsigned old = xb_add(&bar[XB_XSUB(b.x)], 1u);
        const unsigned gen = old / nloc;
        if (old + 1u == (gen + 1u) * nloc) {
            __builtin_amdgcn_fence(__ATOMIC_RELEASE, "agent");
            asm volatile("s_waitcnt vmcnt(0)" ::: "memory");
            const unsigned og = xb_add(&bar[XB_TOP], 1u);
            const unsigned tg = og / nx;
            if (og + 1u == (tg + 1u) * nx) xb_add(&bar[XB_TOPGEN], 1u);
            else XB_SPIN(xb_ld(&bar[XB_TOPGEN]) == tg, bar);
            __builtin_amdgcn_fence(__ATOMIC_ACQUIRE, "agent");
            xb_add(&bar[XB_XGEN(b.x)], 1u);
            asm volatile("s_waitcnt vmcnt(0)" ::: "memory");
        } else {
            XB_SPIN(xb_ld(&bar[XB_XGEN(b.x)]) == gen, bar);
            __builtin_amdgcn_fence(__ATOMIC_ACQUIRE, "agent");
            asm volatile("s_waitcnt vmcnt(0)" ::: "memory");
        }
    }
    __syncthreads();
}
struct Args { const float* in[24]; float* out; unsigned char* ws; int ph_lo, ph_hi; };
enum { I_X = 0, I_C, I_WADA, I_BADA, I_N1G, I_WIN, I_LQ1, I_LK1, I_LQ2, I_LK2, I_SUBG, I_WOA, I_WOB, I_WO, I_N2G, I_WR, I_BR, I_WG, I_BG, I_WU, I_BU, I_WDN, I_BDN, I_FG };
struct Frame {
    LAS unsigned char* lds; char* ldsg;
    volatile LAS unsigned* MISC;
    gu32* ctl;
    int tid, lane, wave, vcu, G;
    unsigned char* ws;
};
#define WSP(T_, off) ((T_*)(F.ws + (off)))

constexpr float WSCALE = 64.0f;
__device__ __forceinline__ unsigned cvtpk_bf(float lo, float hi) { unsigned r; asm volatile("v_cvt_pk_bf16_f32 %0, %1, %2" : "=v"(r) : "v"(lo), "v"(hi)); return r; }
__device__ __forceinline__ void cvt_load(f32x4 (&v)[8], const float* __restrict__ W, int N, int k0, int n0, int lane) {
    const int lr = lane >> 3, lc = 4 * (lane & 7);
#pragma unroll
    for (int i = 0; i < 8; ++i) v[i] = __builtin_nontemporal_load((const f32x4*)(W + (size_t)(k0 + lr + 8 * i) * N + n0 + lc));
}
template <bool F8>
__device__ __forceinline__ void cvt_store(const f32x4 (&v)[8], int K, void* __restrict__ WT, int k0, long dst_row0, LAS float* scr, int lane) {
    const int lr = lane >> 3, lc = 4 * (lane & 7);
#pragma unroll
    for (int i = 0; i < 8; ++i) { LAS float* s = scr + (lr + 8 * i) * 33 + lc; s[0] = v[i].x; s[1] = v[i].y; s[2] = v[i].z; s[3] = v[i].w; }
    LDS_WAIT(); asm volatile("" ::: "memory");
    const int c = lane & 7;
#pragma unroll
    for (int j = 0; j < 4; ++j) { const int n = (lane >> 3) + 8 * j; const LAS float* s = scr + (8 * c) * 33 + n;
        if constexpr (F8) {
            int w0 = __builtin_amdgcn_cvt_pk_fp8_f32(s[0 * 33] * WSCALE, s[1 * 33] * WSCALE, 0, false); w0 = __builtin_amdgcn_cvt_pk_fp8_f32(s[2 * 33] * WSCALE, s[3 * 33] * WSCALE, w0, true);
            int w1 = __builtin_amdgcn_cvt_pk_fp8_f32(s[4 * 33] * WSCALE, s[5 * 33] * WSCALE, 0, false); w1 = __builtin_amdgcn_cvt_pk_fp8_f32(s[6 * 33] * WSCALE, s[7 * 33] * WSCALE, w1, true);
            *(v2u*)((unsigned char*)WT + (size_t)(dst_row0 + n) * K + k0 + 8 * c) = (v2u){(unsigned)w0, (unsigned)w1};
        } else {
            v4u o; o.x = cvtpk_bf(s[0 * 33], s[1 * 33]); o.y = cvtpk_bf(s[2 * 33], s[3 * 33]); o.z = cvtpk_bf(s[4 * 33], s[5 * 33]); o.w = cvtpk_bf(s[6 * 33], s[7 * 33]);
            *(v4u*)((bf16*)WT + (size_t)(dst_row0 + n) * K + k0 + 8 * c) = o; } }
    LDS_WAIT(); asm volatile("" ::: "memory");
}
__device__ __forceinline__ void cvt8_load(f32x4 (&v)[16], const float* __restrict__ W, int k0, int n0, int lane, int N = DM) {
    const float* p = W + (size_t)(k0 + (lane >> 3)) * N + n0 + 4 * (lane & 7);
#pragma unroll
    for (int i = 0; i < 16; ++i) v[i] = __builtin_nontemporal_load((const f32x4*)(p + (size_t)(8 * i) * N));
}
__device__ __forceinline__ void cvt8_store(const f32x4 (&v)[16], unsigned char* __restrict__ WT, int k0, long dst_row0, LAS float* scr, int lane) {
    const int lr = lane >> 3, lc = 4 * (lane & 7);
#pragma unroll
    for (int i = 0; i < 16; ++i) { LAS float* s = scr + (lr + 8 * i) * 33 + ((lc + 4 * (i >> 1)) & 31);
        s[0] = v[i].x; s[1] = v[i].y; s[2] = v[i].z; s[3] = v[i].w; }
    LDS_WAIT(); asm volatile("" ::: "memory");
    const int c = lane & 7;
#pragma unroll
    for (int j = 0; j < 4; ++j) { const int n = (lane >> 3) + 8 * j; const LAS float* s = scr + (16 * c) * 33 + ((n + 4 * c) & 31);
        v4u o;
#pragma unroll
        for (int h = 0; h < 4; ++h) { int w = __builtin_amdgcn_cvt_pk_fp8_f32(s[(4 * h + 0) * 33] * WSCALE, s[(4 * h + 1) * 33] * WSCALE, 0, false);
            w = __builtin_amdgcn_cvt_pk_fp8_f32(s[(4 * h + 2) * 33] * WSCALE, s[(4 * h + 3) * 33] * WSCALE, w, true); o[h] = (unsigned)w; }
        *(v4u*)(WT + (size_t)(dst_row0 + n) * DM + k0 + 16 * c) = o; }
    LDS_WAIT(); asm volatile("" ::: "memory");
}
__device__ __forceinline__ void p0_mod(Frame& F, const Args& A) {
    LAS float* red = (LAS float*)F.lds;
    LAS float* sc = red + 2048;
    if (F.vcu < 192) {
        for (int k = F.tid; k < DM; k += 512) { sc[2 * k] = siluf(A.in[I_C][k]); sc[2 * k + 1] = siluf(A.in[I_C][2048 + k]); }
    }
    __syncthreads();
    if (F.vcu < 192) {
        const int col = F.vcu * 64 + F.lane, k0 = F.wave * 256;
        const float* wp = A.in[I_WADA] + (size_t)k0 * 12288 + col; const LAS float* sp = sc + 2 * k0;
        float a0 = 0.f, a1 = 0.f;
#pragma unroll 16
        for (int k = 0; k < 256; ++k) { const float wv = __builtin_nontemporal_load(wp + (size_t)k * 12288); const v2f s2 = *(const LAS v2f*)(sp + 2 * k); a0 = fmaf(s2.x, wv, a0); a1 = fmaf(s2.y, wv, a1); }
        red[(F.wave * 2 + 0) * 64 + F.lane] = a0; red[(F.wave * 2 + 1) * 64 + F.lane] = a1;
    }
    __syncthreads();
    if (F.vcu < 192 && F.tid < 128) { const int b = F.tid >> 6, l = F.tid & 63; float s = 0.f;
#pragma unroll
        for (int w = 0; w < 8; ++w) s += red[(w * 2 + b) * 64 + l];
        const int col = F.vcu * 64 + l; WSP(float, WS_MOD)[b * 12288 + col] = s + A.in[I_BADA][col]; }
    __syncthreads();
}
__device__ __forceinline__ void p0_convert(Frame& F, const Args& A) {
    LAS float* scr = (LAS float*)(F.lds + F.wave * 16384);
    const int gw = F.vcu * NWAVES + F.wave, NGW = F.G * NWAVES;
    constexpr int I_IN = 32 * 320, I_A = 16 * 64, I_B = 16 * 64, NSMALL = I_IN + I_A + I_B;
    f32x4 v0[8];
#pragma unroll 1
    for (int it = gw; it < NSMALL; it += NGW) { int r = it; const float* W; bf16* WT; int N, K, drow = 0;
        if (r < I_IN) { W = A.in[I_WIN]; WT = WSP(bf16, WS_WINT); N = NQKV; K = DM; const int g_ = (r % 320) >> 5; int pos_ = -1;
#pragma unroll
            for (int i_ = 0; i_ < NLB; ++i_) if ((int)((LBMAP >> (4 * i_)) & 15ull) == g_) pos_ = i_;
            if (pos_ < 0) continue; drow = pos_ * 1024 - g_ * 1024; }
        else if ((r -= I_IN) < I_A) { W = A.in[I_WOA]; WT = WSP(bf16, WS_WAT); N = DM; K = 1024; }
        else { r -= I_A; W = A.in[I_WOB]; WT = WSP(bf16, WS_WBT); N = DM; K = 1024; }
        const int nnb = N / 32, k0 = (r / nnb) * 64, n0 = (r % nnb) * 32;
        cvt_load(v0, W, N, k0, n0, F.lane); cvt_store<false>(v0, K, WT, k0, n0 + drow, scr, F.lane); }
    { __syncthreads(); LAS float* scr8 = (LAS float*)(F.lds + F.wave * 16896); f32x4 va[16];
      constexpr int NF8 = 16 * NLF * 32;
#pragma unroll 1
      for (int it = gw; it < NF8 + 16 * 64; it += NGW) {
          if (it < NF8) { const int k0 = (it / (NLF * 32)) * 128, blk = it % (NLF * 32), pf = blk >> 5, g_ = (int)((LFMAP >> (4 * pf)) & 15ull);
              cvt8_load(va, A.in[I_WIN], k0, g_ * 1024 + (blk & 31) * 32, F.lane, NQKV); cvt8_store(va, WSP(unsigned char, WS_WING), k0, pf * 1024 + (blk & 31) * 32, scr8, F.lane); }
          else { const int j = it - NF8, k0 = (j >> 6) * 128, n0 = (j & 63) * 32;
              cvt8_load(va, A.in[I_WO], k0, n0, F.lane, DM); cvt8_store(va, WSP(unsigned char, WS_WOT), k0, n0, scr8, F.lane); } } }
}
__device__ __forceinline__ void p1_modulate(Frame& F, const Args& A) {
    const int gw = F.vcu * NWAVES + F.wave, NGW = F.G * NWAVES; const float* MOD = WSP(float, WS_MOD);
    if (F.vcu < 64 && F.wave == 0) { const int b = F.vcu >> 5, kq = F.vcu & 31, e = F.lane & 31, ks = F.lane >> 5; float s = 0.f;
#pragma unroll 8
        for (int i = 0; i < 32; ++i) { const int k = 64 * kq + 2 * i + ks; s = fmaf(MOD[b * 12288 + 3 * DM + k], A.in[I_WR][k * 32 + e], s); }
        s += __shfl_xor(s, 32); if (F.lane < 32) WSP(float, WS_RC)[(b * 32 + kq) * 32 + e] = s; }
    for (int m = gw; m < T; m += NGW) {
        const int b = m / SEQ; const float* xr = A.in[I_X] + (size_t)m * DM + 4 * F.lane; f32x4 v[8]; float s = 0.f;
#pragma unroll
        for (int j = 0; j < 8; ++j) { v[j] = *(const f32x4*)(xr + 256 * j); s += (v[j].x * v[j].x + v[j].y * v[j].y) + (v[j].z * v[j].z + v[j].w * v[j].w); }
        const float rstd = 1.0f / sqrtf(wave_sum(s) * (1.0f / DM) + EPS);
        bf16* ur = WSP(bf16, WS_U) + (size_t)m * DM + 4 * F.lane;
#pragma unroll
        for (int j = 0; j < 8; ++j) { const int k = 4 * F.lane + 256 * j;
            const f32x4 g = *(const f32x4*)(A.in[I_N1G] + k), sc = *(const f32x4*)(MOD + b * 12288 + 1 * DM + k), sh = *(const f32x4*)(MOD + b * 12288 + k);
            const f32x4 u = v[j] * rstd * g * (sc + 1.0f) + sh; v2u o; o.x = pk2(u.x, u.y); o.y = pk2(u.z, u.w); *(v2u*)(ur + 256 * j) = o;
            int w8 = __builtin_amdgcn_cvt_pk_fp8_f32(u.x, u.y, 0, false); w8 = __builtin_amdgcn_cvt_pk_fp8_f32(u.z, u.w, w8, true); *(int*)(WSP(unsigned char, WS_U8Q) + (size_t)m * DM + 4 * F.lane + 256 * j) = w8; }
    }
}
__device__ __forceinline__ void p3_attention(Frame& F, const Args& A) {
    const bf16* QKV = WSP(bf16, WS_QKV);
    att::Pb pb; int pbi = 0, pbp = 0; const char* pbs = nullptr; pb.gw = F.vcu * NWAVES + F.wave; pb.NGW = F.G * NWAVES;
    pb.total = pb.gw < att::PB_NIT ? ((att::PB_NIT - pb.gw + pb.NGW - 1) / pb.NGW) * 16 : 0;
    pb.pg = A.in[I_WG]; pb.du = (const char*)A.in[I_WU] - (const char*)A.in[I_WG]; pb.dd = (const char*)A.in[I_WDN] - (const char*)A.in[I_WG];
    pb.wgu = (GAS unsigned char*)WSP(unsigned char, WS_WGU); pb.wd = (GAS unsigned char*)WSP(unsigned char, WS_WD); pb.zone = (unsigned)(PB_OFF + F.wave * att::PB_WAVE);
#pragma unroll 1
    for (int i = F.vcu; i < 256; i += F.G) {
        const int c2 = i >> 4, b = c2 >> 3, h = (c2 >> 1) & 3, c = c2 & 1, qb = i & 15;
        const size_t rowb = (size_t)b * SEQ;
        const bf16* Qb = QKV + (rowb + qb * 256) * NQKV + C_QB + h * 256 + c * 128;
        const bf16* Kh = QKV + rowb * NQKV + C_KB + h * 256 + c * 128;
        const bf16* Vh = QKV + rowb * NQKV + C_VB + h * 256;
        bf16* Ob = WSP(bf16, WS_OB) + ((size_t)c * T + rowb + qb * 256) * 1024 + h * 256;
        const float slope = exp2f(-(float)(8 + h + 1) * (8.0f / 12.0f));
        att::diffk_body(Qb, Kh, Vh, NQKV, qb * 256, slope / att::SCALE, Ob, F.ldsg, pb, pbi, pbp, pbs);
    }
    att::pb_drain(pb, pbi, pbp, pbs, F.ldsg, F.lane);
    __syncthreads();
    {
        const int gw = F.vcu * NWAVES + F.wave, NGW = F.G * NWAVES;
        char* ktile = F.ldsg + F.wave * 16384; char* vtile = ktile + 8192; float* scr = (float*)(F.ldsg + 131072) + F.wave * 64;
#if defined(REP_DIL)
#pragma unroll 1
        for (int rep_ = 0; rep_ < 2; ++rep_)
#endif
#pragma unroll 1
        for (int tk = gw; tk < 3 * 2048; tk += NGW) {
            const int p = tk >> 11, r = tk & 2047, b = r >> 10, h = (r >> 7) & 7, blk = r & 127;
            const int dil = p == 0 ? 1 : (p == 1 ? 4 : 16), L = SEQ / dil, bpr = L / 32, res = blk / bpr, j0 = (blk % bpr) * 32;
            const size_t rowb = (size_t)b * SEQ + res;
            const bf16* Qb = QKV + rowb * NQKV + C_QA + h * 128; const bf16* Kb = QKV + rowb * NQKV + C_KA + h * 128; const bf16* Vb = QKV + rowb * NQKV + C_VA + h * 128;
            bf16* Ob = WSP(bf16, WS_OA) + ((size_t)p * T + rowb) * 1024 + h * 128; float* Lb = WSP(float, WS_LSE) + ((size_t)p * T + rowb) * 8 + h;
            const float slope = exp2f(-(float)(h + 1) * (8.0f / 12.0f)) * (float)dil;
            att::dilated_wave(Qb, Kb, Vb, (long)dil * NQKV, j0, L, slope / att::SCALE, Ob, (long)dil * 1024, Lb, (long)dil * 8, ktile, vtile, scr);
        }
    }
    __syncthreads();
}
__device__ __forceinline__ void p4_finalize(Frame& F, const Args& A) {
    const int gw = F.vcu * NWAVES + F.wave, NGW = F.G * NWAVES;
    float s1 = A.in[I_LQ1][F.lane] * A.in[I_LK1][F.lane] + A.in[I_LQ1][F.lane + 64] * A.in[I_LK1][F.lane + 64];
    float s2 = A.in[I_LQ2][F.lane] * A.in[I_LK2][F.lane] + A.in[I_LQ2][F.lane + 64] * A.in[I_LK2][F.lane + 64];
    s1 = wave_sum(s1); s2 = wave_sum(s2);
    const float lam = expf(s1) - expf(s2) + LAMBDA_INIT;
    const bf16* OA = WSP(bf16, WS_OA); const bf16* OB = WSP(bf16, WS_OB); const float* LS = WSP(float, WS_LSE);
    for (int m = gw; m < T; m += NGW) {
        { const int h = F.lane >> 3; const float l0 = LS[((size_t)0 * T + m) * 8 + h], l1 = LS[((size_t)1 * T + m) * 8 + h], l2 = LS[((size_t)2 * T + m) * 8 + h];
          const float mx = fmaxf(l0, fmaxf(l1, l2)); float w0 = __expf(l0 - mx), w1 = __expf(l1 - mx), w2 = __expf(l2 - mx); const float inv = 1.0f / (w0 + w1 + w2); w0 *= inv; w1 *= inv; w2 *= inv;
          const size_t o = (size_t)m * 1024 + 16 * F.lane; unsigned pk[8];
#pragma unroll
          for (int q = 0; q < 2; ++q) { const v4u a0 = *(const v4u*)(OA + o + 8 * q), a1 = *(const v4u*)(OA + (size_t)T * 1024 + o + 8 * q), a2 = *(const v4u*)(OA + (size_t)2 * T * 1024 + o + 8 * q);
#pragma unroll
              for (int e = 0; e < 4; ++e) { const float ylo = w0 * __uint_as_float(a0[e] << 16) + w1 * __uint_as_float(a1[e] << 16) + w2 * __uint_as_float(a2[e] << 16);
                  const float yhi = w0 * __uint_as_float(a0[e] & 0xffff0000u) + w1 * __uint_as_float(a1[e] & 0xffff0000u) + w2 * __uint_as_float(a2[e] & 0xffff0000u); pk[4 * q + e] = pk2(ylo, yhi); } }
          bf16* ya = WSP(bf16, WS_YA) + o; *(v4u*)ya = (v4u){pk[0], pk[1], pk[2], pk[3]}; *(v4u*)(ya + 8) = (v4u){pk[4], pk[5], pk[6], pk[7]}; }
#pragma unroll
        for (int h = 0; h < 4; ++h) { const size_t o = (size_t)m * 1024 + h * 256 + 4 * F.lane;
            const v2u b0 = *(const v2u*)(OB + o), b1 = *(const v2u*)(OB + (size_t)T * 1024 + o);
            const f32x4 v = (f32x4){__uint_as_float(b0.x << 16), __uint_as_float(b0.x & 0xffff0000u), __uint_as_float(b0.y << 16), __uint_as_float(b0.y & 0xffff0000u)}
                          - (f32x4){__uint_as_float(b1.x << 16), __uint_as_float(b1.x & 0xffff0000u), __uint_as_float(b1.y << 16), __uint_as_float(b1.y & 0xffff0000u)} * lam;
            const float ss = wave_sum((v.x * v.x + v.y * v.y) + (v.z * v.z + v.w * v.w)); const float rstd = 1.0f / sqrtf(ss * (1.0f / 256.0f) + EPS);
            const f32x4 g = *(const f32x4*)(A.in[I_SUBG] + 4 * F.lane); const f32x4 y = v * rstd * g * (1.0f - LAMBDA_INIT);
            v2u w; w.x = pk2(y.x, y.y); w.y = pk2(y.z, y.w); *(v2u*)(WSP(bf16, WS_YB) + o) = w; }
    }
}
typedef float f32x16r __attribute__((ext_vector_type(16)));
__device__ __forceinline__ void p7_router(Frame& F, const Args& A, bool commit = true) {
    LAS float* gainL = (LAS float*)F.lds;
    LAS float* shiftL = gainL + 2048;
    LAS float* part = shiftL + 2048;
    LAS float* ssp = part + 8 * 32 * 32;
    LAS float* logitL = ssp + 512;
    LAS float* rstdL = logitL + 32 * 33;
    LAS int* lcnt = (LAS int*)(rstdL + 32);
    LAS int* lbase = lcnt + 32;
    const float* H1 = WSP(float, WS_H1); const float* MODp = WSP(float, WS_MOD); const float* RC = WSP(float, WS_RC);
    for (int blk = F.vcu; blk < T / 32; blk += F.G) {
        const int t0 = blk * 32, bb = t0 / SEQ; const float* mod = MODp + bb * 12288;
        for (int k = F.tid; k < DM; k += 512) { gainL[k] = A.in[I_N2G][k] * (1.0f + mod[4 * DM + k]); shiftL[k] = mod[3 * DM + k]; }
        if (F.tid < 32) lcnt[F.tid] = 0;
        __syncthreads();
        {
            const int i = F.lane & 31, kk = F.lane >> 5, kb = F.wave * 256 + kk * 128;
            const float* hp = H1 + (size_t)(t0 + i) * DM + kb; const float* wp = A.in[I_WR] + (size_t)kb * 32 + i; const LAS float* gp = gainL + kb;
            f32x16r acc = {}; float ss = 0.f;
#pragma unroll 4
            for (int s0 = 0; s0 < 128; s0 += 4) {
                const f32x4 hv = *(const f32x4*)(hp + s0); const f32x4 g4 = *(const LAS f32x4*)(gp + s0);
                const float b0 = wp[(s0 + 0) * 32], b1 = wp[(s0 + 1) * 32], b2 = wp[(s0 + 2) * 32], b3 = wp[(s0 + 3) * 32];
                ss += (hv.x * hv.x + hv.y * hv.y) + (hv.z * hv.z + hv.w * hv.w);
                acc = __builtin_amdgcn_mfma_f32_32x32x2f32(hv.x * g4.x, b0, acc, 0, 0, 0);
                acc = __builtin_amdgcn_mfma_f32_32x32x2f32(hv.y * g4.y, b1, acc, 0, 0, 0);
                acc = __builtin_amdgcn_mfma_f32_32x32x2f32(hv.z * g4.z, b2, acc, 0, 0, 0);
                acc = __builtin_amdgcn_mfma_f32_32x32x2f32(hv.w * g4.w, b3, acc, 0, 0, 0);
            }
#pragma unroll
            for (int r = 0; r < 16; ++r) part[(F.wave * 32 + (r & 3) + 8 * (r >> 2) + 4 * kk) * 32 + i] = acc[r];
            ssp[F.wave * 64 + F.lane] = ss;
        }
        __syncthreads();
        { const int token = F.tid & 31, eg = F.tid >> 5; float s2 = 0.f;
#pragma unroll
          for (int w = 0; w < 8; ++w) s2 += ssp[w * 64 + token] + ssp[w * 64 + 32 + token];
          const float rstd = 1.0f / sqrtf(s2 * (1.0f / DM) + EPS);
#pragma unroll
          for (int q = 0; q < 2; ++q) { const int e = eg * 2 + q; float raw = 0.f;
#pragma unroll
              for (int w = 0; w < 8; ++w) raw += part[(w * 32 + token) * 32 + e];
              float rc = A.in[I_BR][e];
#pragma unroll 8
              for (int kq = 0; kq < 32; ++kq) rc += RC[(bb * 32 + kq) * 32 + e];
              logitL[token * 33 + e] = rstd * raw + rc; }
          if (eg == 0) rstdL[token] = rstd; }
        __syncthreads();
        int se[4] = {0, 0, 0, 0}, lp[4] = {0, 0, 0, 0}; float pv[4] = {0.f, 0.f, 0.f, 0.f};
        if (F.tid < 32) {
            float sv[4];
#pragma unroll
            for (int k = 0; k < 4; ++k) { float best = -INFINITY; int bi = 0;
                for (int e = 0; e < 32; ++e) { const float v = logitL[F.tid * 33 + e]; if (v > best) { best = v; bi = e; } }
                sv[k] = best; se[k] = bi; logitL[F.tid * 33 + bi] = -INFINITY; }
            float sum = 0.f;
#pragma unroll
            for (int k = 0; k < 4; ++k) { pv[k] = expf(sv[k] - sv[0]); sum += pv[k]; }
            const float inv = 1.0f / sum;
#pragma unroll
            for (int k = 0; k < 4; ++k) { pv[k] *= inv; lp[k] = __hip_atomic_fetch_add(lcnt + se[k], 1, __ATOMIC_RELAXED, __HIP_MEMORY_SCOPE_WORKGROUP); }
        }
        __syncthreads();
        if (F.tid < 32 && commit) lbase[F.tid] = (int)__hip_atomic_fetch_add((unsigned*)(F.ctl + CW_CNT + 64 * F.tid), (unsigned)lcnt[F.tid], RLX_AGENT);
        __syncthreads();
        if (F.tid < 32 && commit) { const int m = t0 + F.tid;
#pragma unroll
            for (int k = 0; k < 4; ++k) { const int pos = lbase[se[k]] + lp[k]; WSP(int, WS_TOPI)[m * 4 + k] = se[k]; WSP(float, WS_TOPP)[m * 4 + k] = pv[k]; WSP(int, WS_POS)[m * 4 + k] = pos;
                WSP(int, WS_TOKOF)[se[k] * 8192 + pos] = m; } }
        for (int i = 0; i < 4; ++i) { const int token = F.wave * 4 + i, m = t0 + token; const float rstd = rstdL[token];
            const float* hr = H1 + (size_t)m * DM + 4 * F.lane; unsigned char* ur = WSP(unsigned char, WS_U) + (size_t)m * DM + 4 * F.lane;
#pragma unroll
            for (int j = 0; j < 8; ++j) { const f32x4 h = *(const f32x4*)(hr + 256 * j), g = *(const LAS f32x4*)(gainL + 4 * F.lane + 256 * j), s = *(const LAS f32x4*)(shiftL + 4 * F.lane + 256 * j);
                const f32x4 u = h * rstd * g + s; int w8 = __builtin_amdgcn_cvt_pk_fp8_f32(u.x, u.y, 0, false); w8 = __builtin_amdgcn_cvt_pk_fp8_f32(u.z, u.w, w8, true); *(int*)(ur + 256 * j) = w8; } }
        __syncthreads();
    }
}
__device__ __forceinline__ void build_tile_table(Frame& F) {
    LAS int* ts = (LAS int*)(F.lds + TST_OFF);
    if (F.tid < 64) {
        const int e = F.tid & 31; const int c = (int)__hip_atomic_load((unsigned*)(F.ctl + CW_CNT + 64 * e), RLX_AGENT); const int tl = (c + 255) >> 8; int x = tl;
#pragma unroll
        for (int o = 1; o < 32; o <<= 1) { const int y = __shfl_up(x, o, 32); if (e >= o) x += y; }
        if (F.tid < 32) { ts[e] = x - tl; ts[40 + e] = c; if (e == 31) ts[32] = x; } }
    __syncthreads();
}
__device__ __forceinline__ void p11_final(Frame& F, const Args& A) {
    build_tile_table(F);
    const LAS int* ts = (const LAS int*)(F.lds + TST_OFF);
    const int gw = F.vcu * NWAVES + F.wave, NGW = F.G * NWAVES; const float* MODp = WSP(float, WS_MOD);
    for (int m = gw; m < T; m += NGW) {
        const int bb = m / SEQ; const bf16* yr[4]; float p[4];
#pragma unroll
        for (int k = 0; k < 4; ++k) { const int e = WSP(int, WS_TOPI)[m * 4 + k], pos = WSP(int, WS_POS)[m * 4 + k]; p[k] = WSP(float, WS_TOPP)[m * 4 + k];
            yr[k] = WSP(bf16, WS_YSLOT) + ((size_t)ts[e] * 256 + pos) * DM + 4 * F.lane; }
        const float* hr = WSP(float, WS_H1) + (size_t)m * DM + 4 * F.lane; f32x4 v[8]; float s = 0.f;
#pragma unroll
        for (int j = 0; j < 8; ++j) { f32x4 a = {0.f, 0.f, 0.f, 0.f};
#pragma unroll
            for (int k = 0; k < 4; ++k) { const v2u w = *(const v2u*)(yr[k] + 256 * j); const f32x4 y = {__uint_as_float(w.x << 16), __uint_as_float(w.x & 0xffff0000u), __uint_as_float(w.y << 16), __uint_as_float(w.y & 0xffff0000u)}; a += y * p[k]; }
            const f32x4 g2 = *(const f32x4*)(MODp + bb * 12288 + 5 * DM + 4 * F.lane + 256 * j);
            v[j] = *(const f32x4*)(hr + 256 * j) + g2 * a; s += (v[j].x * v[j].x + v[j].y * v[j].y) + (v[j].z * v[j].z + v[j].w * v[j].w); }
        const float rstd = 1.0f / sqrtf(wave_sum(s) * (1.0f / DM) + EPS);
        float* orow = A.out + (size_t)m * DM + 4 * F.lane;
#pragma unroll
        for (int j = 0; j < 8; ++j) { const f32x4 g = *(const f32x4*)(A.in[I_FG] + 4 * F.lane + 256 * j); *(f32x4*)(orow + 256 * j) = v[j] * rstd * g; }
    }
}

__global__ void __launch_bounds__(NWAVES * 64, 2) fwd(Args args) {
    extern __shared__ __attribute__((aligned(16))) unsigned char lds[];
    Frame F;
    F.lds = (LAS unsigned char*)lds; F.ldsg = (char*)lds;
    F.MISC = (volatile LAS unsigned*)(F.lds + MISC_OFF);
    F.tid = threadIdx.x; F.lane = F.tid & 63; F.wave = __builtin_amdgcn_readfirstlane(F.tid >> 6);
    F.G = gridDim.x; { const int bx = blockIdx.x; F.vcu = (F.G % 8 == 0) ? (bx % 8) * (F.G / 8) + bx / 8 : bx; }
    F.ws = args.ws; F.ctl = (gu32*)(args.ws + WS_CTL);
    for (int u = F.tid; u < (LDS_BYTES - LDSCTL_OFF) / 4; u += NWAVES * 64) ((LAS unsigned*)(F.lds + LDSCTL_OFF))[u] = 0u;
    __syncthreads();
#if MK_SPLIT
#define GRID_BAR() do { } while (0)
#else
    XcdBarrier bar = xcd_barrier_post((unsigned*)(F.ctl + CW_BAR), F.MISC + 8);
#define GRID_BAR() xcd_barrier(bar)
#endif
    const int lo = args.ph_lo, hi = args.ph_hi;
#define IN(k) (lo <= (k) && (k) < hi)
#define SEAM(k) do { if (IN(k) && IN((k) + 1)) GRID_BAR(); } while (0)
    const Args& A = args;
    constexpr bool AL = true, SP = true;

#ifndef REP_PHASE
#define REP_PHASE -1
#endif
#define REPN(k) ((REP_PHASE == (k)) ? 2 : 1)
    if (IN(0)) { for (int rep = 0; rep < REPN(0); ++rep) p0_mod(F, A); p0_convert(F, A); } SEAM(0);
    if (IN(1)) { for (int rep = 0; rep < REPN(1); ++rep) p1_modulate(F, A); } SEAM(1);
    if (IN(2)) {
        { pg8::Gemm g{WSP(bf16, WS_U), WSP(bf16, WS_WINT), T, NLB * 1024, DM}; pg8::StaticOrder S; S.init(T, NLB * 1024, F.G, (int)blockIdx.x);
          pg8::EpiQKV E{WSP(bf16, WS_QKV), NQKV, LBMAP, 1.0f};
          pg8::gemm_phase<pg8::EpiQKV, pg8::StaticOrder, AL, SP>(F.lds + RING_OFF, g, S, E); }
        VM_WAIT(); __syncthreads();
        { pg8::Gemm g{WSP(bf16, WS_U8Q), WSP(bf16, WS_WING), T, NLF * 1024, DM / 2}; pg8::StaticOrder S; S.init(T, NLF * 1024, F.G, (int)blockIdx.x);
          pg8::EpiQKV E{WSP(bf16, WS_QKV), NQKV, LFMAP, 1.0f / WSCALE};
          pg8::gemm_phase<pg8::EpiQKV, pg8::StaticOrder, AL, SP, true>(F.lds + RING_OFF, g, S, E); }
    } SEAM(2);
    if (IN(3)) { for (int rep = 0; rep < REPN(3); ++rep) p3_attention(F, A); } SEAM(3);
    if (IN(4)) { for (int rep = 0; rep < REPN(4); ++rep) p4_finalize(F, A); } SEAM(4);
    if (IN(5)) for (int rep = 0; rep < REPN(5); ++rep) {
        { pg8::Gemm g{WSP(bf16, WS_YA), WSP(bf16, WS_WAT), T, DM, 1024}; pg8::StaticOrder S; S.init(T, DM, F.G, (int)blockIdx.x);
          pg8::EpiM1 E{WSP(bf16, WS_M1), WSP(bf16, WS_QKV) + C_GA, NQKV};
          pg8::gemm_phase<pg8::EpiM1, pg8::StaticOrder, AL, SP>(F.lds + RING_OFF, g, S, E); }
        VM_WAIT(); __syncthreads();
        { pg8::Gemm g{WSP(bf16, WS_YB), WSP(bf16, WS_WBT), T, DM, 1024}; pg8::StaticOrder S; S.init(T, DM, F.G, (int)blockIdx.x);
          pg8::EpiMerged E{WSP(bf16, WS_M1), WSP(bf16, WS_QKV) + C_GB, NQKV, WSP(unsigned char, WS_MG)};
          pg8::gemm_phase<pg8::EpiMerged, pg8::StaticOrder, AL, SP>(F.lds + RING_OFF, g, S, E); }
    } SEAM(5);
    if (IN(6)) for (int rep = 0; rep < REPN(6); ++rep) {
        pg8::Gemm g{WSP(bf16, WS_MG), WSP(bf16, WS_WOT), T, DM, DM / 2}; pg8::StaticOrder S; S.init(T, DM, F.G, (int)blockIdx.x);
        pg8::EpiH1 E{A.in[I_X], WSP(float, WS_H1), WSP(float, WS_MOD) + 2 * DM, 12288, SEQ / 256, 1.0f / (16.0f * WSCALE)};
        pg8::gemm_phase<pg8::EpiH1, pg8::StaticOrder, AL, SP, true>(F.lds + RING_OFF, g, S, E);
    } SEAM(6);
    if (IN(7)) { for (int rep = 0; rep < REPN(7); ++rep) p7_router(F, A, rep == 0); } if (IN(7) && IN(9)) GRID_BAR();
    if (IN(9)) for (int rep = 0; rep < REPN(9); ++rep) {
        build_tile_table(F);
        pg8::Gemm g{WSP(bf16, WS_U), WSP(bf16, WS_WGU), TKPAD, NE * 4096, DM / 2}; pg8::MoeOrder S; S.init((const LAS int*)(F.lds + TST_OFF), 16, F.G, (int)blockIdx.x, WSP(int, WS_TOKOF));
        pg8::EpiSwiGLU E{WSP(unsigned char, WS_YACT), A.in[I_BG], A.in[I_BU], 1.0f / WSCALE};
        pg8::gemm_phase<pg8::EpiSwiGLU, pg8::MoeOrder, AL, SP, true, true>(F.lds + RING_OFF, g, S, E);
    } SEAM(9);
    if (IN(10)) for (int rep = 0; rep < REPN(10); ++rep) {
        build_tile_table(F);
        pg8::Gemm g{WSP(bf16, WS_YACT), WSP(bf16, WS_WD), TKPAD, NE * DM, DM / 2}; pg8::MoeOrder S; S.init((const LAS int*)(F.lds + TST_OFF), 8, F.G, (int)blockIdx.x);
        pg8::EpiBf16B E{WSP(bf16, WS_YSLOT), DM, A.in[I_BDN], 8, 1.0f / WSCALE};
        pg8::gemm_phase<pg8::EpiBf16B, pg8::MoeOrder, AL, SP, true>(F.lds + RING_OFF, g, S, E);
    } SEAM(10);
    if (IN(11)) { for (int rep = 0; rep < REPN(11); ++rep) p11_final(F, A); }
#undef IN
#undef SEAM
}
extern "C" void kernel_launch(void* const* d_in, const int* in_sizes, int n_in, void* d_out, int out_size, void* d_ws, size_t ws_size, hipStream_t stream) {
    static int grid = 0;
    if (grid == 0) {
        if (n_in != 24 || in_sizes[0] != T * DM || out_size != T * DM || ws_size < WS_END) { fprintf(stderr, "kernel_launch: shape mismatch (n_in %d, in0 %d, out %d, ws %zu < %zu); nothing launched\n", n_in, n_in > 0 ? in_sizes[0] : -1, out_size, ws_size, (size_t)WS_END); grid = -1; return; }
        int dev = 0, cus = 0, per_cu = 0;
        if (hipGetDevice(&dev) != hipSuccess || hipDeviceGetAttribute(&cus, hipDeviceAttributeMultiprocessorCount, dev) != hipSuccess) { grid = -1; return; }
        if (hipFuncSetAttribute((const void*)fwd, hipFuncAttributeMaxDynamicSharedMemorySize, LDS_BYTES) != hipSuccess) { fprintf(stderr, "kernel_launch: hipFuncSetAttribute failed\n"); grid = -1; return; }
        if (hipOccupancyMaxActiveBlocksPerMultiprocessor(&per_cu, (const void*)fwd, NWAVES * 64, LDS_BYTES) != hipSuccess || per_cu < 1)
            fprintf(stderr, "kernel_launch: note: occupancy query reports %d workgroups per CU\n", per_cu);
        (void)hipGetLastError();
        grid = cus;
    }
    if (grid < 0) return;
    if (hipMemsetAsync((char*)d_ws + WS_CTL, 0, CTL_ZERO_BYTES, stream) != hipSuccess) return;
    Args a; memset(&a, 0, sizeof(a));
    for (int i = 0; i < 24; ++i) a.in[i] = (const float*)d_in[i];
    a.out = (float*)d_out; a.ws = (unsigned char*)d_ws;
#if MK_SPLIT
    for (int ph = 0; ph < N_PHASES; ++ph) { a.ph_lo = ph; a.ph_hi = ph + 1; hipLaunchKernelGGL(fwd, dim3(grid), dim3(NWAVES * 64), LDS_BYTES, stream, a); }
#else
    a.ph_lo = 0; a.ph_hi = N_PHASES; hipLaunchKernelGGL(fwd, dim3(grid), dim3(NWAVES * 64), LDS_BYTES, stream, a);
#endif
    const hipError_t le = hipPeekAtLastError();
    if (le != hipSuccess) fprintf(stderr, "kernel_launch: launch failed: %s\n", hipGetErrorName(le));
}
```

```cpp
#include <hip/hip_runtime.h>
#include <cstdio>
#include <cstdint>
#include <cstring>
#include <cmath>
namespace pg8 {
#define PG8_LAS __attribute__((address_space(3)))
typedef unsigned short bf16_t;
typedef short bf16x8 __attribute__((ext_vector_type(8)));
typedef float f32x4 __attribute__((ext_vector_type(4)));
typedef unsigned u32x4 __attribute__((ext_vector_type(4)));
constexpr int BM = 256, BK = 64, HALF = 128, HTB = HALF * BK * 2  , STAGE_BYTES = 8 * HTB, NXCD = 8, WGM = 8;

__host__ __device__ __forceinline__ int lds_byte(int r, int c) { const int st = (r >> 4) * 2 + (c >> 5), rr = r & 15, cc = c & 31, ob = rr * 64 + cc * 2; return st * 1024 + (ob ^ (((ob >> 9) & 1) << 5)); }
__host__ __device__ __forceinline__ void stage_rc(int b, int& R, int& C) { const int st = b / 1024, sb = b % 1024, swz = sb ^ (((sb >> 9) & 1) << 5); R = (st >> 1) * 16 + swz / 64; C = (st & 1) * 32 + (swz % 64) / 2; }
__host__ __device__ __forceinline__ int perm32(int rho) { const int n = rho >> 4, i = rho & 15; return 8 * (i >> 2) + 4 * n + (i & 3); }

struct Unit { int pm, pn; };
struct Gemm { const bf16_t* A; const bf16_t* Bt; int M, N, K; };

struct StaticOrder {
    int nM, nN, nwg, G, c;
    __host__ __device__ void init(int M, int N, int G_, int c_) { nM = M / BM; nN = N / BM; nwg = nM * nN; G = G_; c = c_; }
    __host__ __device__ bool next(int i, Unit& u) const {
        const long L = (long)i * G + c; if (L >= nwg) return false;
        int wgid = (int)L; { const int q = nwg / NXCD, r = nwg % NXCD, xcd = wgid % NXCD, off = wgid / NXCD; wgid = (xcd < r ? xcd * (q + 1) : r * (q + 1) + (xcd - r) * q) + off; }
        const int nig = WGM * nN, gid = wgid / nig, fm = gid * WGM, gsz = (nM - fm) < WGM ? (nM - fm) : WGM;
        u.pm = fm + ((wgid % nig) % gsz); u.pn = (wgid % nig) / gsz; return true;
    }
    __device__ __forceinline__ void a_ready(const Unit&) const {}
    __device__ __forceinline__ void done(const Unit&) const {}
    __device__ __forceinline__ int arow(const Unit&, int R) const { return R; }
};

__device__ __forceinline__ unsigned cvt_pk_bf16(float lo, float hi) { unsigned r; asm volatile("v_cvt_pk_bf16_f32 %0, %1, %2" : "=v"(r) : "v"(lo), "v"(hi)); return r; }

typedef int v4i_t __attribute__((ext_vector_type(4)));
typedef int v8i_t __attribute__((ext_vector_type(8)));
template <class Epi, class Sched, bool ALIGN_EPI = false, bool SP2 = false, bool F8 = false, bool GATHER = false>
__device__ __forceinline__ void gemm_phase(PG8_LAS unsigned char* lds, const Gemm g, const Sched& S, const Epi& E) {
    int tid = threadIdx.x; asm volatile("" : "+v"(tid));
    const int wid = __builtin_amdgcn_readfirstlane(tid >> 6), lane = tid & 63, wr = wid >> 2, wc = wid & 3, fr = lane & 15, fq = lane >> 4;
    const int K = g.K, nt = K / BK;
    unsigned voffA[2], voffB[2];
#pragma unroll
    for (int i = 0; i < 2; ++i) { int R, C; stage_rc(tid * 16 + i * 8192, R, C); const int Rb = Epi::PERM ? ((R & ~31) + perm32(R & 31)) : R;
        voffA[i] = (unsigned)(R * K + C) * 2u; voffB[i] = (unsigned)(Rb * K + C) * 2u; }
    static_assert(!GATHER || SP2, "the gather form is written for the two-super-phase loop");
    unsigned vo[2][2], nvo[2][2];
#define PG8_SETVO(dst, u) do { _Pragma("unroll") for (int _h = 0; _h < 2; ++_h) _Pragma("unroll") for (int _i = 0; _i < 2; ++_i) { \
        if constexpr (GATHER) { int R_, C_; stage_rc(tid * 16 + _i * 8192, R_, C_); dst[_h][_i] = (unsigned)(S.arow(u, R_ + HALF * _h) * K + C_) * 2u; } \
        else dst[_h][_i] = voffA[_i] + (unsigned)_h * (unsigned)(HALF * K * 2); } } while (0)
    const size_t kstep = (size_t)(BK * 2);
    const size_t hstep = (size_t)HALF * K * 2;
    const size_t tstep = 2 * hstep;
    const unsigned ldsw = (unsigned)wid * 1024u;
    const int aoff = lds_byte(wr * 64 + fr, fq * 8), boff = lds_byte(wc * 32 + fr, fq * 8);
#define PG8_SA(b, h) (((b) * 2 + (h)) * HTB)
#define PG8_SB(b, h) ((4 + (b) * 2 + (h)) * HTB)
#define PG8_STAGE(bufoff, gbase, voff) do { _Pragma("unroll") for (int _i = 0; _i < 2; ++_i) \
        __builtin_amdgcn_global_load_lds((const unsigned*)((const char*)(gbase) + (voff)[_i]), (PG8_LAS unsigned*)(lds + (bufoff) + ldsw + _i * 8192), 16, 0, 0); } while (0)
#define PG8_LDA(dst, b, h) do { _Pragma("unroll") for (int m = 0; m < 4; ++m) _Pragma("unroll") for (int k = 0; k < 2; ++k) dst[m][k] = *(const PG8_LAS bf16x8*)(lds + PG8_SA(b, h) + aoff + m * 2048 + k * 1024); } while (0)
#define PG8_LDB(dst, b, h) do { _Pragma("unroll") for (int n = 0; n < 2; ++n) _Pragma("unroll") for (int k = 0; k < 2; ++k) dst[n][k] = *(const PG8_LAS bf16x8*)(lds + PG8_SB(b, h) + boff + n * 2048 + k * 1024); } while (0)
#define PG8_MMA(ai, bj, At, Bt) do { __builtin_amdgcn_s_setprio(1); _Pragma("unroll") for (int m = 0; m < 4; ++m) _Pragma("unroll") for (int n = 0; n < 2; ++n) { \
        if constexpr (F8) { const v8i_t _b = __builtin_shufflevector(__builtin_bit_cast(v4i_t, Bt[n][0]), __builtin_bit_cast(v4i_t, Bt[n][1]), 0, 1, 2, 3, 4, 5, 6, 7); \
            const v8i_t _a = __builtin_shufflevector(__builtin_bit_cast(v4i_t, At[m][0]), __builtin_bit_cast(v4i_t, At[m][1]), 0, 1, 2, 3, 4, 5, 6, 7); \
            asm volatile("v_mfma_scale_f32_16x16x128_f8f6f4 %0, %1, %2, %0, %3, %3 op_sel_hi:[0,0,0]" : "+v"(acc[ai][bj][m][n]) : "v"(_b), "v"(_a), "v"(f8scale)); } \
        else { _Pragma("unroll") for (int k = 0; k < 2; ++k) acc[ai][bj][m][n] = __builtin_amdgcn_mfma_f32_16x16x32_bf16(Bt[n][k], At[m][k], acc[ai][bj][m][n], 0, 0, 0); } } \
        __builtin_amdgcn_s_setprio(0); } while (0)
#define PG8_WAIT_V(n) asm volatile("s_waitcnt vmcnt(" #n ")" ::: "memory")
#define PG8_WAIT_L(n) asm volatile("s_waitcnt lgkmcnt(" #n ")" ::: "memory")
#define PG8_BAR __builtin_amdgcn_s_barrier()
#define PG8_SCHED __builtin_amdgcn_sched_barrier(0)
    Unit cur, nxt; int ui = 0;
    if (!S.next(0, cur)) return;
    const int f8scale = 0x7f7f7f7f;
    f32x4 acc[2][2][4][2];
#pragma unroll
    for (int a = 0; a < 2; ++a)
#pragma unroll
        for (int b = 0; b < 2; ++b)
#pragma unroll
            for (int m = 0; m < 4; ++m)
#pragma unroll
                for (int n = 0; n < 2; ++n) acc[a][b][m][n] = (f32x4){0.f, 0.f, 0.f, 0.f};
    bf16x8 At[4][2], B0[2][2], B1[2][2];
    const char* cA = (const char*)g.A + (GATHER ? (size_t)0 : (size_t)cur.pm * tstep); const char* cB = (const char*)g.Bt + (size_t)cur.pn * tstep;
    PG8_SETVO(vo, cur);
    S.a_ready(cur);
    if constexpr (SP2) {
        PG8_STAGE(PG8_SB(0, 0), cB, voffB); PG8_STAGE(PG8_SB(0, 1), cB + hstep, voffB); PG8_STAGE(PG8_SA(0, 0), cA, vo[0]); PG8_STAGE(PG8_SA(0, 1), cA, vo[1]);
        if (wr == 1) PG8_BAR;
        PG8_WAIT_V(2); PG8_BAR;
        PG8_STAGE(PG8_SB(1, 0), cB + kstep, voffB); PG8_STAGE(PG8_SA(1, 0), cA + kstep, vo[0]); PG8_STAGE(PG8_SB(1, 1), cB + hstep + kstep, voffB);
        PG8_WAIT_V(6); PG8_BAR;
    } else {
        PG8_STAGE(PG8_SB(0, 0), cB, voffB); PG8_STAGE(PG8_SA(0, 0), cA, vo[0]); PG8_STAGE(PG8_SB(0, 1), cB + hstep, voffB); PG8_STAGE(PG8_SA(0, 1), cA, vo[1]);
        if (wr == 1) PG8_BAR;
        PG8_WAIT_V(4); PG8_BAR;
        PG8_STAGE(PG8_SB(1, 0), cB + kstep, voffB); PG8_STAGE(PG8_SA(1, 0), cA + kstep, vo[0]); PG8_STAGE(PG8_SB(1, 1), cB + hstep + kstep, voffB);
        PG8_WAIT_V(6); PG8_BAR;
    }
    for (;;) {
        const bool has_next = S.next(ui + 1, nxt);
        const char* nA = (has_next && !GATHER) ? (const char*)g.A + (size_t)nxt.pm * tstep : cA; const char* nB = has_next ? (const char*)g.Bt + (size_t)nxt.pn * tstep : cB;
        if (has_next) { PG8_SETVO(nvo, nxt); } else {
#pragma unroll
            for (int _h = 0; _h < 2; ++_h)
#pragma unroll
                for (int _i = 0; _i < 2; ++_i) nvo[_h][_i] = vo[_h][_i]; }
        for (int t = 0; t < nt; t += 2) {
            const bool last = (t == nt - 2);
            const char* a1 = cA + (size_t)(t + 1) * kstep;
            const char* a2 = last ? nA : cA + (size_t)(t + 2) * kstep; const char* b2 = last ? nB : cB + (size_t)(t + 2) * kstep;
            const char* a3 = a2 + kstep; const char* b3 = b2 + kstep;
            unsigned s0[2], s1[2];
#pragma unroll
            for (int _i = 0; _i < 2; ++_i) { s0[_i] = last ? nvo[0][_i] : vo[0][_i]; s1[_i] = last ? nvo[1][_i] : vo[1][_i]; }
            if (last && has_next) S.a_ready(nxt);
            if constexpr (SP2) {
            PG8_LDB(B0, 0, 0); PG8_LDB(B1, 0, 1); PG8_SCHED; PG8_LDA(At, 0, 0); PG8_STAGE(PG8_SA(1, 1), a1, vo[1]);
            PG8_WAIT_V(8); PG8_WAIT_L(0); PG8_BAR; PG8_MMA(0, 0, At, B0); PG8_MMA(0, 1, At, B1); PG8_BAR; PG8_SCHED;
            PG8_LDA(At, 0, 1); PG8_STAGE(PG8_SB(0, 0), b2, voffB); PG8_STAGE(PG8_SB(0, 1), b2 + hstep, voffB); PG8_STAGE(PG8_SA(0, 0), a2, s0);
            PG8_WAIT_V(8); PG8_WAIT_L(0); PG8_BAR; PG8_MMA(1, 0, At, B0); PG8_MMA(1, 1, At, B1); PG8_BAR; PG8_SCHED;
            PG8_LDB(B0, 1, 0); PG8_LDB(B1, 1, 1); PG8_SCHED; PG8_LDA(At, 1, 0); PG8_STAGE(PG8_SA(0, 1), a2, s1);
            PG8_WAIT_V(8); PG8_WAIT_L(0); PG8_BAR; PG8_MMA(0, 0, At, B0); PG8_MMA(0, 1, At, B1); PG8_BAR; PG8_SCHED;
            PG8_LDA(At, 1, 1); PG8_STAGE(PG8_SB(1, 0), b3, voffB); PG8_STAGE(PG8_SB(1, 1), b3 + hstep, voffB); PG8_STAGE(PG8_SA(1, 0), a3, s0);
            PG8_WAIT_V(8); PG8_WAIT_L(0); PG8_BAR; PG8_MMA(1, 0, At, B0); PG8_MMA(1, 1, At, B1); PG8_BAR; PG8_SCHED;
            } else {
            PG8_LDB(B0, 0, 0); PG8_SCHED; PG8_LDA(At, 0, 0); PG8_STAGE(PG8_SA(1, 1), a1, vo[1]);
            PG8_WAIT_L(8); PG8_BAR; PG8_WAIT_L(0); PG8_MMA(0, 0, At, B0); PG8_BAR; PG8_SCHED;
            PG8_LDB(B1, 0, 1); PG8_STAGE(PG8_SB(0, 0), b2, voffB);
            PG8_BAR; PG8_WAIT_L(0); PG8_MMA(0, 1, At, B1); PG8_BAR;
            PG8_LDA(At, 0, 1); PG8_STAGE(PG8_SA(0, 0), a2, s0);
            PG8_BAR; PG8_WAIT_L(0); PG8_MMA(1, 0, At, B0); PG8_BAR; PG8_SCHED;
            PG8_STAGE(PG8_SB(0, 1), b2 + hstep, voffB);
            PG8_WAIT_V(6); PG8_BAR; PG8_MMA(1, 1, At, B1); PG8_BAR;
            PG8_LDB(B0, 1, 0); PG8_SCHED; PG8_LDA(At, 1, 0); PG8_STAGE(PG8_SA(0, 1), a2, s1);
            PG8_WAIT_L(8); PG8_BAR; PG8_WAIT_L(0); PG8_MMA(0, 0, At, B0); PG8_BAR; PG8_SCHED;
            PG8_LDB(B1, 1, 1); PG8_STAGE(PG8_SB(1, 0), b3, voffB);
            PG8_BAR; PG8_WAIT_L(0); PG8_MMA(0, 1, At, B1); PG8_BAR;
            PG8_LDA(At, 1, 1); PG8_STAGE(PG8_SA(1, 0), a3, s0);
            PG8_BAR; PG8_WAIT_L(0); PG8_MMA(1, 0, At, B0); PG8_BAR; PG8_SCHED;
            PG8_STAGE(PG8_SB(1, 1), b3 + hstep, voffB);
            PG8_WAIT_V(6); PG8_BAR; PG8_MMA(1, 1, At, B1); PG8_BAR;
            }
        }
        if constexpr (F8) asm volatile("s_nop 15\n\ts_nop 7" ::: "memory");
        if constexpr (ALIGN_EPI) { if (wr == 0) PG8_BAR; }
        if constexpr (!Epi::AFTER_DRAIN) { E(acc, cur, wr, wc, fr, fq); S.done(cur); }
        if (!has_next) break;
#pragma unroll
        for (int a = 0; a < 2; ++a)
#pragma unroll
            for (int b = 0; b < 2; ++b)
#pragma unroll
                for (int m = 0; m < 4; ++m)
#pragma unroll
                    for (int n = 0; n < 2; ++n) acc[a][b][m][n] = (f32x4){0.f, 0.f, 0.f, 0.f};
        cur = nxt; cA = nA; cB = nB; ++ui;
#pragma unroll
        for (int _h = 0; _h < 2; ++_h)
#pragma unroll
            for (int _i = 0; _i < 2; ++_i) vo[_h][_i] = nvo[_h][_i];
        if constexpr (ALIGN_EPI) { if (wr == 1) PG8_BAR; }
    }
    PG8_WAIT_V(0);
    if constexpr (!ALIGN_EPI) { if (wr == 0) PG8_BAR; }
    PG8_BAR;
    if constexpr (Epi::AFTER_DRAIN) { E.fused(acc, cur, wr, wc, fr, fq, lds, wid, lane); S.done(cur); }
#undef PG8_SA
#undef PG8_SETVO
#undef PG8_SB
#undef PG8_STAGE
#undef PG8_LDA
#undef PG8_LDB
#undef PG8_MMA
#undef PG8_WAIT_V
#undef PG8_WAIT_L
#undef PG8_BAR
#undef PG8_SCHED
}
}
namespace pg8 {
typedef float f32x2e __attribute__((ext_vector_type(2)));
__device__ __forceinline__ float bf_lo(unsigned w) { return __uint_as_float(w << 16); }
__device__ __forceinline__ float bf_hi(unsigned w) { return __uint_as_float(w & 0xffff0000u); }
__device__ __forceinline__ float sigmoidf_fast(float x) { return __builtin_amdgcn_rcpf(1.0f + __expf(-x)); }

struct EpiBf16B {
    static constexpr bool PERM = true, AFTER_DRAIN = false;
    bf16_t* O; int ldc; const float* bias; int ntile_mod; float scale;
    __device__ __forceinline__ void operator()(const f32x4 (&acc)[2][2][4][2], const Unit& u, int wr, int wc, int fr, int fq) const {
        const int row0 = u.pm * BM + wr * 64 + fr; const int colt = (u.pn % ntile_mod) * BM;
        const int col0 = colt + wc * 32 + 8 * fq, bcol0 = u.pn * BM + wc * 32 + 8 * fq;
        f32x4 bv[2][2];
#pragma unroll
        for (int bj = 0; bj < 2; ++bj)
#pragma unroll
            for (int n = 0; n < 2; ++n) bv[bj][n] = bias ? *(const f32x4*)(bias + bcol0 + bj * HALF + 4 * n) : (f32x4){0.f, 0.f, 0.f, 0.f};
#pragma unroll
        for (int ai = 0; ai < 2; ++ai)
#pragma unroll
            for (int m = 0; m < 4; ++m) { bf16_t* rowp = O + (size_t)(row0 + ai * HALF + m * 16) * ldc + col0;
#pragma unroll
                for (int bj = 0; bj < 2; ++bj) { const f32x4 v0 = acc[ai][bj][m][0] * scale + bv[bj][0], v1 = acc[ai][bj][m][1] * scale + bv[bj][1];
                    u32x4 w; w.x = cvt_pk_bf16(v0[0], v0[1]); w.y = cvt_pk_bf16(v0[2], v0[3]); w.z = cvt_pk_bf16(v1[0], v1[1]); w.w = cvt_pk_bf16(v1[2], v1[3]);
                    *(u32x4*)(rowp + bj * HALF) = w; } }
    }
};
struct EpiQKV {
    static constexpr bool PERM = true, AFTER_DRAIN = false;
    bf16_t* O; int ldc; unsigned long long gmap; float scale;
    __device__ __forceinline__ void operator()(const f32x4 (&acc)[2][2][4][2], const Unit& u, int wr, int wc, int fr, int fq) const {
        const int og = (int)((gmap >> (4 * (u.pn >> 2))) & 15ull); const bool sg = og >= 6;
        const int row0 = u.pm * BM + wr * 64 + fr; const int col0 = (og * 4 + (u.pn & 3)) * BM + wc * 32 + 8 * fq;
#pragma unroll
        for (int ai = 0; ai < 2; ++ai)
#pragma unroll
            for (int m = 0; m < 4; ++m) { bf16_t* rowp = O + (size_t)(row0 + ai * HALF + m * 16) * ldc + col0;
#pragma unroll
                for (int bj = 0; bj < 2; ++bj) { f32x4 v0 = acc[ai][bj][m][0] * scale, v1 = acc[ai][bj][m][1] * scale;
                    if (sg) {
#pragma unroll
                        for (int i = 0; i < 4; ++i) { v0[i] = sigmoidf_fast(v0[i]); v1[i] = sigmoidf_fast(v1[i]); } }
                    u32x4 w; w.x = cvt_pk_bf16(v0[0], v0[1]); w.y = cvt_pk_bf16(v0[2], v0[3]); w.z = cvt_pk_bf16(v1[0], v1[1]); w.w = cvt_pk_bf16(v1[2], v1[3]);
                    *(u32x4*)(rowp + bj * HALF) = w; } }
    }
};
struct EpiM1 {
    static constexpr bool PERM = true, AFTER_DRAIN = false;
    bf16_t* M1; const bf16_t* G; int ldg;
    __device__ __forceinline__ void operator()(const f32x4 (&acc)[2][2][4][2], const Unit& u, int wr, int wc, int fr, int fq) const {
        const int row0 = u.pm * BM + wr * 64 + fr; const int col0 = u.pn * BM + wc * 32 + 8 * fq;
#pragma unroll
        for (int ai = 0; ai < 2; ++ai)
#pragma unroll
            for (int m = 0; m < 4; ++m) { const size_t row = (size_t)(row0 + ai * HALF + m * 16);
#pragma unroll
                for (int bj = 0; bj < 2; ++bj) { const int col = col0 + bj * HALF; const u32x4 g = *(const u32x4*)(G + row * ldg + col);
                    const f32x4 a0 = acc[ai][bj][m][0], a1 = acc[ai][bj][m][1];
                    const f32x4 o0 = {a0[0] * bf_lo(g.x), a0[1] * bf_hi(g.x), a0[2] * bf_lo(g.y), a0[3] * bf_hi(g.y)};
                    const f32x4 o1 = {a1[0] * bf_lo(g.z), a1[1] * bf_hi(g.z), a1[2] * bf_lo(g.w), a1[3] * bf_hi(g.w)};
                    u32x4 w; w.x = cvt_pk_bf16(o0[0], o0[1]); w.y = cvt_pk_bf16(o0[2], o0[3]); w.z = cvt_pk_bf16(o1[0], o1[1]); w.w = cvt_pk_bf16(o1[2], o1[3]);
                    *(u32x4*)(M1 + row * 2048 + col) = w; } }
    }
};
struct EpiMerged {
    static constexpr bool PERM = true, AFTER_DRAIN = false;
    const bf16_t* M1; const bf16_t* G; int ldg; unsigned char* MG;
    __device__ __forceinline__ void operator()(const f32x4 (&acc)[2][2][4][2], const Unit& u, int wr, int wc, int fr, int fq) const {
        const int row0 = u.pm * BM + wr * 64 + fr; const int col0 = u.pn * BM + wc * 32 + 8 * fq;
#pragma unroll
        for (int ai = 0; ai < 2; ++ai)
#pragma unroll
            for (int m = 0; m < 4; ++m) { const size_t row = (size_t)(row0 + ai * HALF + m * 16);
#pragma unroll
                for (int bj = 0; bj < 2; ++bj) { const int col = col0 + bj * HALF; const u32x4 g = *(const u32x4*)(G + row * ldg + col);
                    const u32x4 mw = *(const u32x4*)(M1 + row * 2048 + col);
                    const f32x4 m0 = {bf_lo(mw.x), bf_hi(mw.x), bf_lo(mw.y), bf_hi(mw.y)}, m1 = {bf_lo(mw.z), bf_hi(mw.z), bf_lo(mw.w), bf_hi(mw.w)};
                    const f32x4 a0 = acc[ai][bj][m][0], a1 = acc[ai][bj][m][1];
                    const f32x4 o0 = {m0[0] + a0[0] * bf_lo(g.x), m0[1] + a0[1] * bf_hi(g.x), m0[2] + a0[2] * bf_lo(g.y), m0[3] + a0[3] * bf_hi(g.y)};
                    const f32x4 o1 = {m1[0] + a1[0] * bf_lo(g.z), m1[1] + a1[1] * bf_hi(g.z), m1[2] + a1[2] * bf_lo(g.w), m1[3] + a1[3] * bf_hi(g.w)};
                    int w0 = __builtin_amdgcn_cvt_pk_fp8_f32(o0[0] * 16.f, o0[1] * 16.f, 0, false); w0 = __builtin_amdgcn_cvt_pk_fp8_f32(o0[2] * 16.f, o0[3] * 16.f, w0, true);
                    int w1 = __builtin_amdgcn_cvt_pk_fp8_f32(o1[0] * 16.f, o1[1] * 16.f, 0, false); w1 = __builtin_amdgcn_cvt_pk_fp8_f32(o1[2] * 16.f, o1[3] * 16.f, w1, true);
                    typedef int v2i_m __attribute__((ext_vector_type(2))); *(v2i_m*)(MG + row * 2048 + col) = (v2i_m){w0, w1}; } }
    }
};
struct EpiH1 {
    static constexpr bool PERM = false, AFTER_DRAIN = false;
    const float* X; float* H1; const float* g1; int g1_stride; int tiles_per_batch; float wscale;
    __device__ __forceinline__ void operator()(const f32x4 (&acc)[2][2][4][2], const Unit& u, int wr, int wc, int fr, int fq) const {
        const int row0 = u.pm * BM + wr * 64 + fr; const int col0 = u.pn * BM + wc * 32 + 4 * fq; const float* gb = g1 + (size_t)(u.pm / tiles_per_batch) * g1_stride;
        f32x4 gv[2][2];
#pragma unroll
        for (int bj = 0; bj < 2; ++bj)
#pragma unroll
            for (int n = 0; n < 2; ++n) gv[bj][n] = *(const f32x4*)(gb + col0 + bj * HALF + n * 16);
#pragma unroll
        for (int ai = 0; ai < 2; ++ai)
#pragma unroll
            for (int m = 0; m < 4; ++m) { const size_t off = (size_t)(row0 + ai * HALF + m * 16) * 2048 + col0;
#pragma unroll
                for (int bj = 0; bj < 2; ++bj)
#pragma unroll
                    for (int n = 0; n < 2; ++n) { const f32x4 xv = *(const f32x4*)(X + off + bj * HALF + n * 16);
                        *(f32x4*)(H1 + off + bj * HALF + n * 16) = xv + gv[bj][n] * (acc[ai][bj][m][n] * wscale); } }
    }
};
struct EpiSwiGLU {
    static constexpr bool PERM = true, AFTER_DRAIN = false;
    unsigned char* Y; const float* bg; const float* bu; float wscale;
    __device__ __forceinline__ void operator()(const f32x4 (&acc)[2][2][4][2], const Unit& u, int wr, int wc, int fr, int fq) const {
        const int e = u.pn >> 4, pnl = u.pn & 15; const int row0 = u.pm * BM + wr * 64 + fr; const int col0 = pnl * HALF + wc * 32 + 8 * fq;
        f32x4 bgv[2], buv[2];
#pragma unroll
        for (int n = 0; n < 2; ++n) { bgv[n] = *(const f32x4*)(bg + (size_t)e * 2048 + col0 + 4 * n); buv[n] = *(const f32x4*)(bu + (size_t)e * 2048 + col0 + 4 * n); }
#pragma unroll
        for (int ai = 0; ai < 2; ++ai)
#pragma unroll
            for (int m = 0; m < 4; ++m) { unsigned char* rowp = Y + (size_t)(row0 + ai * HALF + m * 16) * 2048 + col0; f32x4 y[2];
#pragma unroll
                for (int n = 0; n < 2; ++n) { const f32x4 g4 = acc[ai][0][m][n] * wscale + bgv[n], u4 = acc[ai][1][m][n] * wscale + buv[n];
                    f32x4 gc, uc, ex;
#pragma unroll
                    for (int i = 0; i < 4; ++i) { gc[i] = fminf(g4[i], 7.0f); uc[i] = __builtin_amdgcn_fmed3f(u4[i], -7.0f, 7.0f); }
                    const f32x4 t = gc * (-1.702f * 1.4426950408889634f);
#pragma unroll
                    for (int i = 0; i < 4; ++i) ex[i] = __builtin_amdgcn_rcpf(1.0f + __builtin_amdgcn_exp2f(t[i]));
                    y[n] = (uc + 1.0f) * (gc * ex); }
                int w0 = __builtin_amdgcn_cvt_pk_fp8_f32(y[0][0], y[0][1], 0, false); w0 = __builtin_amdgcn_cvt_pk_fp8_f32(y[0][2], y[0][3], w0, true);
                int w1 = __builtin_amdgcn_cvt_pk_fp8_f32(y[1][0], y[1][1], 0, false); w1 = __builtin_amdgcn_cvt_pk_fp8_f32(y[1][2], y[1][3], w1, true);
                typedef int v2i_t __attribute__((ext_vector_type(2))); *(v2i_t*)rowp = (v2i_t){w0, w1}; }
    }
};
struct MoeOrder {
    const PG8_LAS int* tstart; int npn, lo, hi, rank, W; const int* tokof;
    __device__ __forceinline__ int arow(const Unit& u, int R) const { const int e = u.pn / npn, slot = (u.pm - tstart[e]) * 256 + R;
        return slot < tstart[40 + e] ? tokof[e * 8192 + slot] : 0; }
    __device__ __forceinline__ void init(const PG8_LAS int* ts, int npn_, int G, int c, const int* tk = nullptr) { tstart = ts; npn = npn_; tokof = tk; const int U = ts[32] * npn_; const int x = c % NXCD; rank = c / NXCD; W = G / NXCD;
        lo = (int)(((long)U * x) / NXCD); hi = (int)(((long)U * (x + 1)) / NXCD); }
    __device__ __forceinline__ bool next(int i, Unit& u) const {
        const int q = lo + rank + W * i; if (q >= hi) return false;
        const int lk = (int)(threadIdx.x & 31u);
        const int e = __builtin_popcountll(__ballot(tstart[lk] * npn <= q) & 0xffffffffull) - 1;
        const int ts = tstart[e], te = tstart[e + 1] - ts, qq = q - ts * npn;
        u.pm = ts + qq % te; u.pn = e * npn + qq / te; return true;
    }
    __device__ __forceinline__ void a_ready(const Unit&) const {}
    __device__ __forceinline__ void done(const Unit&) const {}
};
}
namespace att {
using bf16x8 = __attribute__((ext_vector_type(8))) short;
using s16x4  = __attribute__((ext_vector_type(4))) short;
using f32x16 = __attribute__((ext_vector_type(16))) float;
using u32x4  = __attribute__((ext_vector_type(4))) unsigned;
using f32x4v = __attribute__((ext_vector_type(4))) float;
typedef unsigned short bf16;
constexpr int   D = 128, NW = 8, QBLK = 32, KVBLK = 64;
constexpr float SCALE = 0.088388347648318440f;
constexpr float THR = 8.f;
constexpr size_t SHM_V = KVBLK * D * 2, SHM_K = KVBLK * D * 2, SHM_ATTN = 2 * SHM_V + 2 * SHM_K + NW * 64 * 4;
#define KSWZ(row, colB) ((row) * 256 + ((colB) ^ (((row) & 7) << 4)))
#define SBAR() __builtin_amdgcn_sched_barrier(0)
__device__ __forceinline__ int crow(int r, int hi) { return (r & 3) + 8 * (r >> 2) + 4 * hi; }
__device__ __forceinline__ unsigned cvtpk(float lo, float hi) { unsigned r; asm volatile("v_cvt_pk_bf16_f32 %0, %1, %2" : "=v"(r) : "v"(lo), "v"(hi)); return r; }

template <int MODE>
__device__ __forceinline__ void partialSM(f32x16& p0, f32x16& p1, float& m_reg, float& mn, float& alpha, float relb, float kk, bool valid, int side = 0) {
  constexpr float C = SCALE * 1.4426950408889634f;
  float base = 0.f;
  if (MODE == 0 && side != 0) {
    const float skk = side > 0 ? kk : -kk; base = -skk * relb;
#pragma unroll
    for (int r = 0; r < 16; ++r) { p0[r] = fmaf(skk, (float)((r & 3) + 8 * (r >> 2)), p0[r]); p1[r] = fmaf(skk, (float)((r & 3) + 8 * (r >> 2) + 32), p1[r]); }
  } else {
#pragma unroll
    for (int r = 0; r < 16; ++r) {
      const float d0 = relb - (float)((r & 3) + 8 * (r >> 2)), a0 = __builtin_fabsf(d0), a1 = __builtin_fabsf(d0 - 32.f);
      p0[r] = fmaf(a0, -kk, p0[r]); p1[r] = fmaf(a1, -kk, p1[r]);
      if (MODE == 1) { if (!(valid && a0 <= 64.f)) p0[r] = -INFINITY; if (!(valid && a1 <= 64.f)) p1[r] = -INFINITY; }
    }
  }
  float pmax = p0[0];
#pragma unroll
  for (int r = 1; r < 16; ++r) pmax = fmaxf(pmax, p0[r]);
#pragma unroll
  for (int r = 0; r < 16; ++r) pmax = fmaxf(pmax, p1[r]);
  { auto rr = __builtin_amdgcn_permlane32_swap(__float_as_uint(pmax), __float_as_uint(pmax), false, false);
    pmax = fmaxf(__uint_as_float(rr[0]), __uint_as_float(rr[1])); }
  pmax += base;
  if (__builtin_expect(__all(pmax - m_reg <= THR / SCALE), 1)) { mn = m_reg; alpha = 1.f; }
  else { mn = fmaxf(m_reg, pmax); alpha = __builtin_amdgcn_exp2f((m_reg - mn) * C); m_reg = mn; }
  const float mnC = (base - mn) * C;
#pragma unroll
  for (int r = 0; r < 16; ++r) p0[r] = fmaf(p0[r], C, mnC);
#pragma unroll
  for (int r = 0; r < 16; ++r) p1[r] = fmaf(p1[r], C, mnC);
#pragma unroll
  for (int r = 0; r < 16; ++r) p0[r] = __builtin_amdgcn_exp2f(p0[r]);
}
__device__ __forceinline__ void finishSM(f32x16& p0, f32x16& p1, float alpha, float& l_reg, bf16x8& pa0, bf16x8& pa1, bf16x8& pa2, bf16x8& pa3) {
#pragma unroll
  for (int r = 0; r < 16; ++r) p1[r] = __builtin_amdgcn_exp2f(p1[r]);
  float ps = 0;
#pragma unroll
  for (int r = 0; r < 16; ++r) ps += p0[r];
#pragma unroll
  for (int r = 0; r < 16; ++r) ps += p1[r];
  { auto rr = __builtin_amdgcn_permlane32_swap(__float_as_uint(ps), __float_as_uint(ps), false, false);
    ps = __uint_as_float(rr[0]) + __uint_as_float(rr[1]); }
  l_reg = l_reg * alpha + ps;
#define PK4(P, BASE, OUT) do { unsigned a0 = cvtpk(P[BASE + 0], P[BASE + 1]), a1 = cvtpk(P[BASE + 2], P[BASE + 3]);   \
    unsigned b0 = cvtpk(P[BASE + 4], P[BASE + 5]), b1 = cvtpk(P[BASE + 6], P[BASE + 7]);                              \
    auto r0 = __builtin_amdgcn_permlane32_swap(a0, b0, false, false); auto r1 = __builtin_amdgcn_permlane32_swap(a1, b1, false, false); \
    u32x4 w = {r0[0], r1[0], r0[1], r1[1]}; OUT = *reinterpret_cast<bf16x8*>(&w); } while (0)
  PK4(p0, 0, pa0); PK4(p0, 8, pa1); PK4(p1, 0, pa2); PK4(p1, 8, pa3);
#undef PK4
}
__device__ __forceinline__ void qkt(f32x16& p0, f32x16& p1, const bf16* Ks, const bf16x8* qr, int r32, int hi) {
  p0 = f32x16{}; p1 = f32x16{};
#pragma unroll
  for (int d0 = 0; d0 < 8; ++d0) { const int cb = (d0 * 16 + hi * 8) * 2;
    bf16x8 b0 = *reinterpret_cast<const bf16x8*>((const char*)Ks + KSWZ(r32, cb));
    bf16x8 b1 = *reinterpret_cast<const bf16x8*>((const char*)Ks + KSWZ(32 + r32, cb));
    p0 = __builtin_amdgcn_mfma_f32_32x32x16_bf16(b0, qr[d0], p0, 0, 0, 0);
    p1 = __builtin_amdgcn_mfma_f32_32x32x16_bf16(b1, qr[d0], p1, 0, 0, 0); }
}
__device__ __forceinline__ int v_st(int k, int c) { const int kk = (k & ~0xC) | ((k & 4) << 1) | ((k & 8) >> 1); return ((kk >> 3) * 4 + (c >> 5)) * 512 + ((kk & 7) * 32 + (c & 31)) * 2; }
__device__ __forceinline__ int v_rd_base(int lane) { return ((lane & 3) << 3) | (((lane >> 2) & 3) << 6) | (((lane >> 4) & 1) << 5) | (((lane >> 5) & 1) << 8); }
constexpr int v_rd_off(int d0, int ks, int half) { return d0 * 512 + ks * 4096 + half * 2048; }
template <int OFF> __device__ __forceinline__ s16x4 tr_read(int vb) {
  s16x4 r; asm volatile("ds_read_b64_tr_b16 %0, %1 offset:%2" : "=&v"(r) : "v"(vb), "i"(OFF) : "memory"); return r;
}
template <int D0> __device__ __forceinline__ void pv_one(f32x16& od, int vb, bf16x8 pa0, bf16x8 pa1, bf16x8 pa2, bf16x8 pa3) {
  const s16x4 l0 = tr_read<v_rd_off(D0, 0, 0)>(vb), h0 = tr_read<v_rd_off(D0, 0, 1)>(vb), l1 = tr_read<v_rd_off(D0, 1, 0)>(vb), h1 = tr_read<v_rd_off(D0, 1, 1)>(vb);
  const s16x4 l2 = tr_read<v_rd_off(D0, 2, 0)>(vb), h2 = tr_read<v_rd_off(D0, 2, 1)>(vb), l3 = tr_read<v_rd_off(D0, 3, 0)>(vb), h3 = tr_read<v_rd_off(D0, 3, 1)>(vb);
  asm volatile("s_waitcnt lgkmcnt(0)" ::: "memory"); SBAR();
#define PK(L, H) (bf16x8){L[0], L[1], L[2], L[3], H[0], H[1], H[2], H[3]}
  od = __builtin_amdgcn_mfma_f32_32x32x16_bf16(pa0, PK(l0, h0), od, 0, 0, 0);
  od = __builtin_amdgcn_mfma_f32_32x32x16_bf16(pa1, PK(l1, h1), od, 0, 0, 0);
  od = __builtin_amdgcn_mfma_f32_32x32x16_bf16(pa2, PK(l2, h2), od, 0, 0, 0);
  od = __builtin_amdgcn_mfma_f32_32x32x16_bf16(pa3, PK(l3, h3), od, 0, 0, 0);
#undef PK
}
__device__ __forceinline__ void pv_d0(f32x16* o, int vb, bf16x8 pa0, bf16x8 pa1, bf16x8 pa2, bf16x8 pa3) {
  pv_one<0>(o[0], vb, pa0, pa1, pa2, pa3); pv_one<1>(o[1], vb, pa0, pa1, pa2, pa3); pv_one<2>(o[2], vb, pa0, pa1, pa2, pa3); pv_one<3>(o[3], vb, pa0, pa1, pa2, pa3);
}

__device__ __forceinline__ const void* uni_ptr(const void* p) { const unsigned long long u = (unsigned long long)p;
  const unsigned lo = (unsigned)__builtin_amdgcn_readfirstlane((int)(unsigned)u), hi = (unsigned)__builtin_amdgcn_readfirstlane((int)(unsigned)(u >> 32)); return (const void*)(((unsigned long long)hi << 32) | lo); }
constexpr int PB_Q = 6, PB_ZONE = PB_Q * 1024, PB_TPITCH = 128, PB_TILE = 32 * PB_TPITCH, PB_WAVE = PB_ZONE + PB_TILE, PB_NIT = 96 * 1024;
#define PB_GAS __attribute__((address_space(1)))
#define PB_LAS __attribute__((address_space(3)))
struct Pb { int total, gw, NGW; const float* pg; long du, dd; PB_GAS unsigned char* wgu; PB_GAS unsigned char* wd; unsigned zone; };
__device__ __forceinline__ const char* pb_src(const Pb& pb, int it) {
  const int m = it >> 10, tp = it & 1023, e = m / 3, w = m % 3;
  return (const char*)pb.pg + pb.du * (long)(w == 1) + pb.dd * (long)(w == 2) + ((size_t)e * 2048 * 2048 + (size_t)((tp >> 6) * 128) * 2048 + (tp & 63) * 32) * 4;
}
__device__ __forceinline__ PB_GAS unsigned char* pb_dst(const Pb& pb, int it) {
  const int m = it >> 10, tp = it & 1023, e = m / 3, w = m % 3, k0 = (tp >> 6) * 128, n0 = (tp & 63) * 32;
  if (w == 2) return pb.wd + ((size_t)e * 2048 + n0) * 2048 + k0;
  return pb.wgu + ((size_t)e * 4096 + (size_t)(n0 >> 7) * 256 + (n0 & 127) + (w == 1 ? 128 : 0)) * 2048 + k0;
}
__device__ __forceinline__ int pb_issue(const Pb pb, int& c_issue, const char*& isrc, int lane) {
  asm volatile("s_waitcnt lgkmcnt(0)" ::: "memory");
  const int n = (pb.total - c_issue) < PB_Q ? (pb.total - c_issue) : PB_Q;
  if (n <= 0) return 0;
  const unsigned loff = (unsigned)(((lane >> 3) * 2048 + 4 * (lane & 7)) * 4);
  const unsigned z0 = (unsigned)__builtin_amdgcn_readfirstlane((int)pb.zone);
  unsigned keep; asm volatile("s_mov_b32 %0, m0" : "=s"(keep) :: "memory");
#pragma unroll
  for (int q = 0; q < PB_Q; ++q) { if (q < n) {
    if (((c_issue + q) & 15) == 0) isrc = (const char*)uni_ptr(pb_src(pb, pb.gw + ((c_issue + q) >> 4) * pb.NGW));
    asm volatile("s_mov_b32 m0, %2\n\ts_nop 0\n\tglobal_load_lds_dwordx4 %0, %1 sc1 nt" :: "v"(loff), "s"(isrc), "s"(z0 + q * 1024) : "memory");
    isrc += 65536; } }
  asm volatile("s_mov_b32 m0, %0" :: "s"(keep) : "memory");
  c_issue += n; return n;
}
__device__ __forceinline__ void pb_process(const Pb pb, int& c_proc, const int c_issue, char* lds_, int lane) {
  const int nn = lane & 31, a = lane >> 5;
  PB_LAS char* lds = (PB_LAS char*)lds_;
  PB_LAS char* tile = lds + pb.zone + PB_ZONE;
  const unsigned twr = (unsigned)(uintptr_t)(tile + nn * PB_TPITCH + 4 * a), nx = (unsigned)((nn & 7) << 4);
  const PB_LAS float* zrd = (const PB_LAS float*)(lds + pb.zone) + (4 * a) * 32 + nn;
  const int n = c_issue - c_proc;
#pragma unroll
  for (int q = 0; q < PB_Q; ++q) { if (q < n) {
    const int i = (c_proc + q) & 15;
    const PB_LAS float* z = zrd + q * 256;
    typedef float f2 __attribute__((ext_vector_type(2)));
    const f2 t01 = (f2){z[0], z[32]} * 64.f, t23 = (f2){z[64], z[96]} * 64.f;
    int w0 = __builtin_amdgcn_cvt_pk_fp8_f32(t01.x, t01.y, (int)__float_as_uint(t01.x), false); w0 = __builtin_amdgcn_cvt_pk_fp8_f32(t23.x, t23.y, w0, true);
    *(PB_LAS int*)(uintptr_t)((((unsigned)i << 3) ^ nx) + twr) = w0;
    if (i == 15) {
      PB_GAS unsigned char* dst = pb_dst(pb, pb.gw + ((c_proc + q) >> 4) * pb.NGW);
      const int lr = lane >> 3, l7 = lane & 7;
      const PB_LAS char* trd = tile + lr * PB_TPITCH + ((l7 ^ lr) << 4);
      const unsigned voff = (unsigned)(lr * 2048 + 16 * l7);
#pragma unroll
      for (int j = 0; j < 4; ++j) { const u32x4 o = *(const PB_LAS u32x4*)(trd + j * 8 * PB_TPITCH);
        __builtin_nontemporal_store(o, (PB_GAS u32x4*)(dst + (voff + (unsigned)j * 16384u))); }
    } } }
  c_proc = c_issue;
}
__device__ __forceinline__ int pb_step(const Pb pb, int& c_issue, int& c_proc, const char*& isrc, char* lds, int lane) {
  asm volatile("s_waitcnt vmcnt(4)" ::: "memory");
  pb_process(pb, c_proc, c_issue, lds, lane); return pb_issue(pb, c_issue, isrc, lane); }
__device__ __forceinline__ void pb_drain(const Pb pb, int& c_issue, int& c_proc, const char*& isrc, char* lds, int lane) {
#pragma unroll 1
  for (;;) { if (c_proc < c_issue) { asm volatile("s_waitcnt vmcnt(0)" ::: "memory"); pb_process(pb, c_proc, c_issue, lds, lane); }
    if (c_issue >= pb.total) break; (void)pb_issue(pb, c_issue, isrc, lane); }
  asm volatile("s_waitcnt vmcnt(0) lgkmcnt(0)" ::: "memory");
}

template <int D0> __device__ __forceinline__ void pv32_one(f32x16& od, int vb, bf16x8 pa0, bf16x8 pa1) {
  const s16x4 l0 = tr_read<v_rd_off(D0, 0, 0)>(vb), h0 = tr_read<v_rd_off(D0, 0, 1)>(vb), l1 = tr_read<v_rd_off(D0, 1, 0)>(vb), h1 = tr_read<v_rd_off(D0, 1, 1)>(vb);
  asm volatile("s_waitcnt lgkmcnt(0)" ::: "memory"); SBAR();
#define PK(L, H) (bf16x8){L[0], L[1], L[2], L[3], H[0], H[1], H[2], H[3]}
  od = __builtin_amdgcn_mfma_f32_32x32x16_bf16(pa0, PK(l0, h0), od, 0, 0, 0);
  od = __builtin_amdgcn_mfma_f32_32x32x16_bf16(pa1, PK(l1, h1), od, 0, 0, 0);
#undef PK
}
__device__ __forceinline__ void dilated_wave(const bf16* __restrict__ Qb, const bf16* __restrict__ Kb, const bf16* __restrict__ Vb, long ld, int j0, int L, float kk,
                                             bf16* __restrict__ Ob, long ldo, float* __restrict__ Lp, long ldl, char* ktile, char* vtile, float* scr) {
  constexpr float C = SCALE * 1.4426950408889634f;
  int lane = threadIdx.x & 63; asm volatile("" : "+v"(lane));
  const int r32 = lane & 31, hi = lane >> 5;
  bf16x8 qr[8];
  { const bf16* Qw = Qb + (long)(j0 + r32) * ld + hi * 8;
#pragma unroll
    for (int d0 = 0; d0 < 8; ++d0) qr[d0] = *reinterpret_cast<const bf16x8*>(Qw + d0 * 16); }
  float m_reg = -1e30f, l_reg = 0.f; f32x16 o[4] = {};
  const int vb0 = (int)(uintptr_t)vtile + v_rd_base(lane);
  const int sr = lane >> 4, scol = (lane & 15) * 8;
  bf16x8 kn[8], vn[8];
#define DW_LOAD(t_) do { const int kb_ = j0 - 64 + 32 * (t_); const int kbc_ = (kb_ >= 0 && kb_ < L) ? kb_ : j0;   \
    const bf16* Kw_ = Kb + (long)(kbc_ + sr) * ld + scol; const bf16* Vw_ = Vb + (long)(kbc_ + sr) * ld + scol; \
    _Pragma("unroll") for (int i_ = 0; i_ < 8; ++i_) { kn[i_] = *reinterpret_cast<const bf16x8*>(Kw_ + (long)(4 * i_) * ld); vn[i_] = *reinterpret_cast<const bf16x8*>(Vw_ + (long)(4 * i_) * ld); } } while (0)
  DW_LOAD(0);
#pragma unroll 1
  for (int t = 0; t < 5; ++t) {
    const int kb = j0 - 64 + 32 * t; const bool valid = kb >= 0 && kb < L;
#pragma unroll
    for (int i = 0; i < 8; ++i) { const int row = 4 * i + sr;
      *reinterpret_cast<bf16x8*>(ktile + row * 256 + ((scol * 2) ^ ((row & 7) << 4))) = kn[i];
      *reinterpret_cast<bf16x8*>(vtile + v_st(row, scol)) = vn[i]; }
    if (t + 1 < 5) DW_LOAD(t + 1);
    f32x16 p0 = {};
#pragma unroll
    for (int d0 = 0; d0 < 8; ++d0) { const int cbb = (d0 * 16 + hi * 8) * 2;
      const bf16x8 kf = *reinterpret_cast<const bf16x8*>(ktile + r32 * 256 + (cbb ^ ((r32 & 7) << 4)));
      p0 = __builtin_amdgcn_mfma_f32_32x32x16_bf16(kf, qr[d0], p0, 0, 0, 0); }
    const float relb = (float)(j0 + r32 - kb - 4 * hi);
#pragma unroll
    for (int r = 0; r < 16; ++r) { const float a = __builtin_fabsf(relb - (float)((r & 3) + 8 * (r >> 2))); p0[r] = fmaf(a, -kk, p0[r]); if (!(valid && a <= 64.f)) p0[r] = -INFINITY; }
    float pmax = p0[0];
#pragma unroll
    for (int r = 1; r < 16; ++r) pmax = fmaxf(pmax, p0[r]);
    { auto rr = __builtin_amdgcn_permlane32_swap(__float_as_uint(pmax), __float_as_uint(pmax), false, false); pmax = fmaxf(__uint_as_float(rr[0]), __uint_as_float(rr[1])); }
    const float mn = fmaxf(m_reg, pmax), alpha = __builtin_amdgcn_exp2f((m_reg - mn) * C), mnC = -mn * C; m_reg = mn;
    float ps = 0.f;
#pragma unroll
    for (int r = 0; r < 16; ++r) { p0[r] = __builtin_amdgcn_exp2f(fmaf(p0[r], C, mnC)); ps += p0[r]; }
    { auto rr = __builtin_amdgcn_permlane32_swap(__float_as_uint(ps), __float_as_uint(ps), false, false); ps = __uint_as_float(rr[0]) + __uint_as_float(rr[1]); }
    l_reg = l_reg * alpha + ps;
    if (__any(alpha < 1.f)) { if (hi == 0) scr[r32] = alpha; asm volatile("s_waitcnt lgkmcnt(0)" ::: "memory");
#pragma unroll
      for (int d = 0; d < 4; ++d)
#pragma unroll
        for (int r = 0; r < 16; ++r) o[d][r] *= scr[crow(r, hi)]; }
    bf16x8 pa0, pa1;
#define PK4(P, BASE, OUT) do { unsigned a0 = cvtpk(P[BASE + 0], P[BASE + 1]), a1 = cvtpk(P[BASE + 2], P[BASE + 3]);   \
    unsigned b0 = cvtpk(P[BASE + 4], P[BASE + 5]), b1 = cvtpk(P[BASE + 6], P[BASE + 7]);                              \
    auto r0 = __builtin_amdgcn_permlane32_swap(a0, b0, false, false); auto r1 = __builtin_amdgcn_permlane32_swap(a1, b1, false, false); \
    u32x4 w = {r0[0], r1[0], r0[1], r1[1]}; OUT = *reinterpret_cast<bf16x8*>(&w); } while (0)
    PK4(p0, 0, pa0); PK4(p0, 8, pa1);
#undef PK4
    SBAR();
    pv32_one<0>(o[0], vb0, pa0, pa1); pv32_one<1>(o[1], vb0, pa0, pa1); pv32_one<2>(o[2], vb0, pa0, pa1); pv32_one<3>(o[3], vb0, pa0, pa1);
  }
#undef DW_LOAD
  if (hi == 0) scr[32 + r32] = l_reg; asm volatile("s_waitcnt lgkmcnt(0)" ::: "memory");
  bf16* Ow = Ob + (long)(j0 + 4 * hi) * ldo + r32;
#pragma unroll
  for (int r = 0; r < 16; ++r) { const float rl = __builtin_amdgcn_rcpf(scr[32 + crow(r, hi)]); bf16* Or = Ow + (long)((r & 3) + 8 * (r >> 2)) * ldo;
#pragma unroll
    for (int d0 = 0; d0 < 4; ++d0) { const float y = o[d0][r] * rl; Or[d0 * 32] = (bf16)cvtpk(y, y); } }
  if (hi == 0) Lp[(long)(j0 + r32) * ldl] = m_reg * SCALE + __logf(l_reg);
}

template <int MODE>
__device__ __forceinline__ void attn_body(const bf16* __restrict__ Qb, long ldq, const bf16* __restrict__ Kh, const bf16* __restrict__ Vh, long ldk,
                                          int t0, int NT, int ntmax, int qpos0, float kk, bf16* __restrict__ Ob, long ldo, float* __restrict__ Lb, long ldl, char* lds, const Pb pb, int& pbi, int& pbp, const char*& pbs) {
  int tid = threadIdx.x; asm volatile("" : "+v"(tid));
  const int wid = tid >> 6, lane = tid & 63, r32 = lane & 31, hi = lane >> 5;
  bf16* V_lds = (bf16*)lds; bf16* K_lds = (bf16*)(lds + 2 * SHM_V);
  float* ws = (float*)(lds + 2 * SHM_V + 2 * SHM_K) + wid * 64; float* li_l = ws; float* al_l = ws + 32;
  float m_reg = -1e30f, l_reg = 0; f32x16 o[4] = {}; bf16x8 qr[8];
  const bf16* Qw = Qb + (long)(wid * QBLK + r32) * ldq + hi * 8;
#pragma unroll
  for (int d0 = 0; d0 < 8; ++d0) qr[d0] = *reinterpret_cast<const bf16x8*>(Qw + d0 * 16);
  const int sr = tid >> 4, sc = (tid & 15) * 8, vst0 = v_st(sr, sc), vst1 = v_st(32 + sr, sc);
  const int vb0 = (int)(uintptr_t)V_lds + v_rd_base(lane);
  const unsigned sob0 = 2u * (unsigned)(sr * (int)ldk + sc), sob1 = sob0 + 64u * (unsigned)ldk;
  const float qposf = (float)(qpos0 + wid * QBLK + r32 - 4 * hi);
  const int qlo = qpos0 + __builtin_amdgcn_readfirstlane(wid) * QBLK;
  struct { bf16x8 vs0, vs1, ks0, ks1; } sr_[1];
#define TCL(jt) ({ int _t = t0 + (jt); _t = _t < 0 ? 0 : (_t >= ntmax ? ntmax - 1 : _t); _t * KVBLK; })
#define TVALID(jt) ((t0 + (jt)) >= 0 && (t0 + (jt)) < ntmax)
#define RELB(jt) (qposf - (float)((t0 + (jt)) * KVBLK))
#define SIDE(jt) (qlo > (t0 + (jt)) * KVBLK + (KVBLK - 1) ? 1 : (qlo + (QBLK - 1) < (t0 + (jt)) * KVBLK ? -1 : 0))
#define SLOAD(i, jt) do { const long _k0 = (long)TCL(jt) * ldk; const bf16* _vp = (const bf16*)uni_ptr(Vh + _k0); const bf16* _kp = (const bf16*)uni_ptr(Kh + _k0); \
    asm volatile("s_nop 4\n\tglobal_load_dwordx4 %0, %4, %6\n\tglobal_load_dwordx4 %1, %5, %6\n\tglobal_load_dwordx4 %2, %4, %7\n\tglobal_load_dwordx4 %3, %5, %7" \
        : "=&v"(sr_[i].vs0), "=&v"(sr_[i].vs1), "=&v"(sr_[i].ks0), "=&v"(sr_[i].ks1) : "v"(sob0), "v"(sob1), "s"(_vp), "s"(_kp) : "memory"); } while (0)
#define SWAITN(i, n) asm volatile("s_waitcnt vmcnt(%4)" : "+v"(sr_[i].vs0), "+v"(sr_[i].vs1), "+v"(sr_[i].ks0), "+v"(sr_[i].ks1) : "i"(n) : "memory")
#define BSYNC() asm volatile("s_waitcnt lgkmcnt(0)\n\ts_barrier" ::: "memory")
#define SWRITE(b, i) do { *(bf16x8*)((char*)V_lds + (b) * SHM_V + vst0) = sr_[i].vs0;          \
    *(bf16x8*)((char*)V_lds + (b) * SHM_V + vst1) = sr_[i].vs1; const int kc = sc * 2;               \
    *(bf16x8*)((char*)K_lds + (b) * SHM_K + KSWZ(sr, kc)) = sr_[i].ks0;                       \
    *(bf16x8*)((char*)K_lds + (b) * SHM_K + KSWZ(32 + sr, kc)) = sr_[i].ks1; } while (0)
#define SWAIT() SWAITN(0, 0)
#define SWAITQ(n) asm volatile("s_cmp_eq_u32 %4, %5\n\ts_cbranch_scc1 .Lpbw%=\n\ts_waitcnt vmcnt(0)\n.Lpbw%=:\n\ts_waitcnt vmcnt(%5)" \
    : "+v"(sr_[0].vs0), "+v"(sr_[0].vs1), "+v"(sr_[0].ks0), "+v"(sr_[0].ks1) : "s"(n), "i"(PB_Q) : "memory", "scc")
#define RESC(a) do { if (__any((a) < 1.f)) { if (hi == 0) al_l[r32] = (a); asm volatile("s_waitcnt lgkmcnt(0)" ::: "memory"); \
    _Pragma("unroll") for (int d = 0; d < 4; ++d) _Pragma("unroll") for (int r = 0; r < 16; ++r) o[d][r] *= al_l[crow(r, hi)]; } } while (0)
  f32x16 pA0, pA1, pB0, pB1; float mnA, mnB, alA, alB; bf16x8 pa0, pa1, pa2, pa3; int nq = 0;
  constexpr int SE = 0, SO = 0;
  if constexpr (MODE == 1) {
    const int w2 = __builtin_amdgcn_readfirstlane(wid) >> 1;
    SLOAD(SE, 0); SWAIT(); SWRITE(0, SE); __syncthreads();
#pragma unroll 1
    for (int jt = 0; jt < NT; ++jt) {
      const int b = jt & 1;
      if (jt + 1 < NT) { SLOAD(SE, jt + 1); SBAR(); nq = pb_step(pb, pbi, pbp, pbs, lds, lane); SBAR(); }
      if (jt >= w2 && jt <= w2 + 2) {
        qkt(pA0, pA1, (bf16*)((char*)K_lds + b * SHM_K), qr, r32, hi); partialSM<MODE>(pA0, pA1, m_reg, mnA, alA, RELB(jt), kk, TVALID(jt));
        RESC(alA);
        finishSM(pA0, pA1, alA, l_reg, pa0, pa1, pa2, pa3); SBAR();
        pv_d0(o, vb0 + b * (int)SHM_V, pa0, pa1, pa2, pa3);
      }
      if (jt + 1 < NT) { SWAITQ(nq); SWRITE(b ^ 1, SE); BSYNC(); }
    }
  } else {
  SLOAD(SE, 0); SWAIT(); SWRITE(0, SE); __syncthreads();
  qkt(pA0, pA1, K_lds, qr, r32, hi); partialSM<MODE>(pA0, pA1, m_reg, mnA, alA, RELB(0), kk, TVALID(0), SIDE(0));
  SLOAD(SO, 1);
  SWAIT(); SWRITE(1, SO); __syncthreads();
  for (int j = 1; j + 1 < NT; j += 2) {
    SBAR(); qkt(pB0, pB1, (bf16*)((char*)K_lds + SHM_K), qr, r32, hi);
    finishSM(pA0, pA1, alA, l_reg, pa0, pa1, pa2, pa3); SBAR();
    SLOAD(SO, j + 1); SBAR();
    nq = pb_step(pb, pbi, pbp, pbs, lds, lane); SBAR();
    pv_d0(o, vb0, pa0, pa1, pa2, pa3); partialSM<MODE>(pB0, pB1, m_reg, mnB, alB, RELB(j), kk, TVALID(j), SIDE(j));
    BSYNC(); SWAITQ(nq); SWRITE(0, SE);
    RESC(alB); BSYNC();
    SBAR(); qkt(pA0, pA1, K_lds, qr, r32, hi);
    finishSM(pB0, pB1, alB, l_reg, pa0, pa1, pa2, pa3); SBAR();
    SLOAD(SE, j + 2); SBAR();
    nq = pb_step(pb, pbi, pbp, pbs, lds, lane); SBAR();
    pv_d0(o, vb0 + (int)SHM_V, pa0, pa1, pa2, pa3); partialSM<MODE>(pA0, pA1, m_reg, mnA, alA, RELB(j + 1), kk, TVALID(j + 1), SIDE(j + 1));
    BSYNC(); SWAITQ(nq); SWRITE(1, SO);
    RESC(alA); BSYNC();
  }
  SBAR(); qkt(pB0, pB1, (bf16*)((char*)K_lds + SHM_K), qr, r32, hi);
  finishSM(pA0, pA1, alA, l_reg, pa0, pa1, pa2, pa3); SBAR();
  pv_d0(o, vb0, pa0, pa1, pa2, pa3); partialSM<MODE>(pB0, pB1, m_reg, mnB, alB, RELB(NT - 1), kk, TVALID(NT - 1), SIDE(NT - 1));
  __syncthreads(); RESC(alB);
  finishSM(pB0, pB1, alB, l_reg, pa0, pa1, pa2, pa3); SBAR();
  pv_d0(o, vb0 + (int)SHM_V, pa0, pa1, pa2, pa3);
  }
  if (hi == 0) li_l[r32] = l_reg; asm volatile("s_waitcnt lgkmcnt(0)" ::: "memory");
  float rli[16];
#pragma unroll
  for (int r = 0; r < 16; ++r) rli[r] = __builtin_amdgcn_rcpf(li_l[crow(r, hi)]);
  int tide = tid; asm volatile("" : "+v"(tide));
  const int hie = (tide >> 5) & 1, r32e = tide & 31, wide = tide >> 6;
  bf16* Ow = Ob + (long)(wide * QBLK + 4 * hie) * ldo + r32e;
#pragma unroll
  for (int r = 0; r < 16; ++r) { bf16* Or = Ow + (long)((r & 3) + 8 * (r >> 2)) * ldo;
#pragma unroll
    for (int d0 = 0; d0 < 4; ++d0) { const float y = o[d0][r] * rli[r]; Or[d0 * 32] = (bf16)cvtpk(y, y); } }
  if (Lb != nullptr && hie == 0) Lb[(long)(wide * QBLK + r32e) * ldl] = m_reg * SCALE + __logf(l_reg);
  __syncthreads();
#undef TCL
#undef TVALID
#undef RELB
#undef SIDE
#undef SLOAD
#undef SWRITE
#undef SWAIT
#undef SWAITQ
#undef SWAITN
#undef BSYNC
#undef RESC
}

__device__ __forceinline__ int v_st256(int k, int c) { const int kk = (k & ~0xC) | ((k & 4) << 1) | ((k & 8) >> 1); return ((kk >> 3) * 8 + (c >> 5)) * 512 + ((kk & 7) * 32 + (c & 31)) * 2; }
constexpr int v_rd_off256(int d0, int ks, int half) { return d0 * 512 + ks * 8192 + half * 4096; }
template <int D0> __device__ __forceinline__ void pv32k_one(f32x16& od, int vb, bf16x8 pa0, bf16x8 pa1) {
  const s16x4 l0 = tr_read<v_rd_off256(D0, 0, 0)>(vb), h0 = tr_read<v_rd_off256(D0, 0, 1)>(vb), l1 = tr_read<v_rd_off256(D0, 1, 0)>(vb), h1 = tr_read<v_rd_off256(D0, 1, 1)>(vb);
  asm volatile("s_waitcnt lgkmcnt(0)" ::: "memory"); SBAR();
#define PK(L, H) (bf16x8){L[0], L[1], L[2], L[3], H[0], H[1], H[2], H[3]}
  od = __builtin_amdgcn_mfma_f32_32x32x16_bf16(pa0, PK(l0, h0), od, 0, 0, 0);
  od = __builtin_amdgcn_mfma_f32_32x32x16_bf16(pa1, PK(l1, h1), od, 0, 0, 0);
#undef PK
}
template <int NY> __device__ __forceinline__ int pb_step_n(const Pb pb, int& c_issue, int& c_proc, const char*& isrc, char* lds, int lane) {
  asm volatile("s_waitcnt vmcnt(%0)" :: "i"(NY) : "memory");
  pb_process(pb, c_proc, c_issue, lds, lane); return pb_issue(pb, c_issue, isrc, lane); }
constexpr int DK_V = 0, DK_K = 32768, DK_SCR = 65536;
__device__ __forceinline__ void diffk_body(const bf16* __restrict__ Qb, const bf16* __restrict__ Kh, const bf16* __restrict__ Vh, long ld, int qpos0, float kk,
                                           bf16* __restrict__ Ob, char* lds, const Pb pb, int& pbi, int& pbp, const char*& pbs) {
  constexpr float C = SCALE * 1.4426950408889634f;
  constexpr int NT = 4096 / KVBLK;
  int tid = threadIdx.x; asm volatile("" : "+v"(tid));
  const int wid = tid >> 6, lane = tid & 63, r32 = lane & 31, hi = lane >> 5;
  const int rg = __builtin_amdgcn_readfirstlane(wid);
  float* ws = (float*)(lds + DK_SCR) + wid * 64; float* li_l = ws; float* al_l = ws + 32;
  float m_reg = -1e30f, l_reg = 0; f32x16 o[8] = {}; bf16x8 qr[8];
  { const bf16* Qw = Qb + (long)(rg * 32 + r32) * ld + hi * 8;
#pragma unroll
    for (int d0 = 0; d0 < 8; ++d0) qr[d0] = *reinterpret_cast<const bf16x8*>(Qw + d0 * 16); }
#define DK_SOFFS() int t2_ = tid; asm volatile("" : "+v"(t2_)); const int sr = t2_ >> 4, sc = (t2_ & 15) * 8, l2_ = t2_ & 63, w2_ = t2_ >> 6; \
  const unsigned sob0 = 2u * (unsigned)(sr * (int)ld + sc), sob1 = sob0 + 64u * (unsigned)ld;        \
  const unsigned kof0 = (unsigned)((8 * w2_ + (l2_ >> 4)) * (int)ld * 2) + (unsigned)((((l2_ & 15) ^ (l2_ >> 4)) & 15) << 4);            \
  const unsigned kof1 = (unsigned)((8 * w2_ + 4 + (l2_ >> 4)) * (int)ld * 2) + (unsigned)((((l2_ & 15) ^ (4 + (l2_ >> 4))) & 15) << 4);
  const unsigned kdst = (unsigned)__builtin_amdgcn_readfirstlane((int)(unsigned)(uintptr_t)(lds + DK_K + 8 * wid * 256));
  const int vb = (int)(uintptr_t)(lds + DK_V) + v_rd_base(lane);
  const float qposf = (float)(qpos0 + rg * 32 + r32 - 4 * hi);
  const int qlo = qpos0 + rg * 32;
  bf16x8 vs0, vs1, vs2, vs3; int nq = 0;
#define DK_KDMA(jt, b) do { const bf16* _kp = (const bf16*)uni_ptr(Kh + (long)(jt) * KVBLK * ld); unsigned _keep; \
    asm volatile("s_nop 4\n\ts_mov_b32 %0, m0\n\ts_mov_b32 m0, %4\n\ts_nop 0\n\tglobal_load_lds_dwordx4 %1, %3\n\ts_add_u32 m0, m0, 0x400\n\ts_nop 0\n\tglobal_load_lds_dwordx4 %2, %3\n\ts_mov_b32 m0, %0" \
        : "=&s"(_keep) : "v"(kof0), "v"(kof1), "s"(_kp), "s"(kdst + (b) * 16384u) : "memory"); } while (0)
#define DK_VLOAD(jt) do { const bf16* _vp = (const bf16*)uni_ptr(Vh + (long)(jt) * KVBLK * ld); \
    asm volatile("s_nop 4\n\tglobal_load_dwordx4 %0, %4, %6\n\tglobal_load_dwordx4 %1, %5, %6\n\tglobal_load_dwordx4 %2, %4, %6 offset:256\n\tglobal_load_dwordx4 %3, %5, %6 offset:256" \
        : "=&v"(vs0), "=&v"(vs1), "=&v"(vs2), "=&v"(vs3) : "v"(sob0), "v"(sob1), "s"(_vp) : "memory"); } while (0)
#define DK_VWAIT0() asm volatile("s_waitcnt vmcnt(0)" : "+v"(vs0), "+v"(vs1), "+v"(vs2), "+v"(vs3) :: "memory")
#define DK_VWAITQ(n) asm volatile("s_cmp_eq_u32 %4, %5\n\ts_cbranch_scc1 .Ldkw%=\n\ts_waitcnt vmcnt(0)\n.Ldkw%=:\n\ts_waitcnt vmcnt(%5)" \
    : "+v"(vs0), "+v"(vs1), "+v"(vs2), "+v"(vs3) : "s"(n), "i"(PB_Q) : "memory", "scc")
#define DK_VWRITE() do { int t3_ = tid; asm volatile("" : "+v"(t3_)); char* _v = lds + DK_V + v_st256(t3_ >> 4, (t3_ & 15) * 8); *(bf16x8*)(_v) = vs0; *(bf16x8*)(_v + 16384) = vs1; *(bf16x8*)(_v + 2048) = vs2; *(bf16x8*)(_v + 18432) = vs3; } while (0)
#define DK_BSYNC() asm volatile("s_waitcnt lgkmcnt(0)\n\ts_barrier" ::: "memory")
  { DK_SOFFS(); DK_KDMA(0, 0); DK_VLOAD(0); } DK_VWAIT0(); DK_VWRITE(); __syncthreads();
#pragma unroll 1
  for (int j = 0; j < NT; ++j) {
    const char* Kb = lds + DK_K + (j & 1) * 16384;
    if (j + 1 < NT) { { DK_SOFFS(); DK_KDMA(j + 1, (j + 1) & 1); DK_VLOAD(j + 1); } SBAR(); nq = pb_step_n<6>(pb, pbi, pbp, pbs, lds, lane); SBAR(); }
    else { SBAR(); nq = pb_step_n<0>(pb, pbi, pbp, pbs, lds, lane); SBAR(); }
#pragma unroll 1
    for (int kh = 0; kh < 2; ++kh) {
    if (kh == 1) { SBAR(); nq = pb_step_n<0>(pb, pbi, pbp, pbs, lds, lane); SBAR(); }
    f32x16 p = {};
#pragma unroll
    for (int d0 = 0; d0 < 8; ++d0) { const int cb = (d0 * 16 + hi * 8) * 2;
      const bf16x8 kf = *reinterpret_cast<const bf16x8*>(Kb + (kh * 32 + r32) * 256 + (cb ^ ((r32 & 7) << 4)));
      p = __builtin_amdgcn_mfma_f32_32x32x16_bf16(kf, qr[d0], p, 0, 0, 0); }
    const float relb = qposf - (float)(j * KVBLK + 32 * kh);
    const int klo = j * KVBLK + 32 * kh;
    const int side = qlo > klo + 31 ? 1 : (qlo + 31 < klo ? -1 : 0);
    float base = 0.f;
    if (side != 0) { const float skk = side > 0 ? kk : -kk; base = -skk * relb;
#pragma unroll
      for (int r = 0; r < 16; ++r) p[r] = fmaf(skk, (float)((r & 3) + 8 * (r >> 2)), p[r]);
    } else {
#pragma unroll
      for (int r = 0; r < 16; ++r) p[r] = fmaf(__builtin_fabsf(relb - (float)((r & 3) + 8 * (r >> 2))), -kk, p[r]);
    }
    float pmax = p[0];
#pragma unroll
    for (int r = 1; r < 16; ++r) pmax = fmaxf(pmax, p[r]);
    { auto rr = __builtin_amdgcn_permlane32_swap(__float_as_uint(pmax), __float_as_uint(pmax), false, false); pmax = fmaxf(__uint_as_float(rr[0]), __uint_as_float(rr[1])); }
    pmax += base;
    float mn, alpha;
    if (__builtin_expect(__all(pmax - m_reg <= THR / SCALE), 1)) { mn = m_reg; alpha = 1.f; }
    else { mn = fmaxf(m_reg, pmax); alpha = __builtin_amdgcn_exp2f((m_reg - mn) * C); m_reg = mn; }
    const float mnC = (base - mn) * C;
    float ps = 0.f;
#pragma unroll
    for (int r = 0; r < 16; ++r) { p[r] = __builtin_amdgcn_exp2f(fmaf(p[r], C, mnC)); ps += p[r]; }
    { auto rr = __builtin_amdgcn_permlane32_swap(__float_as_uint(ps), __float_as_uint(ps), false, false); ps = __uint_as_float(rr[0]) + __uint_as_float(rr[1]); }
    l_reg = l_reg * alpha + ps;
    if (__any(alpha < 1.f)) { if (hi == 0) al_l[r32] = alpha; asm volatile("s_waitcnt lgkmcnt(0)" ::: "memory");
#pragma unroll
      for (int d = 0; d < 8; ++d)
#pragma unroll
        for (int r = 0; r < 16; ++r) o[d][r] *= al_l[crow(r, hi)]; }
    bf16x8 pa0, pa1;
#define PK4(P, BASE, OUT) do { unsigned a0 = cvtpk(P[BASE + 0], P[BASE + 1]), a1 = cvtpk(P[BASE + 2], P[BASE + 3]);   \
    unsigned b0 = cvtpk(P[BASE + 4], P[BASE + 5]), b1 = cvtpk(P[BASE + 6], P[BASE + 7]);                              \
    auto r0 = __builtin_amdgcn_permlane32_swap(a0, b0, false, false); auto r1 = __builtin_amdgcn_permlane32_swap(a1, b1, false, false); \
    u32x4 w = {r0[0], r1[0], r0[1], r1[1]}; OUT = *reinterpret_cast<bf16x8*>(&w); } while (0)
    PK4(p, 0, pa0); PK4(p, 8, pa1);
#undef PK4
    SBAR();
    pv32k_one<0>(o[0], vb + kh * 16384, pa0, pa1); pv32k_one<1>(o[1], vb + kh * 16384, pa0, pa1); pv32k_one<2>(o[2], vb + kh * 16384, pa0, pa1); pv32k_one<3>(o[3], vb + kh * 16384, pa0, pa1);
    pv32k_one<4>(o[4], vb + kh * 16384, pa0, pa1); pv32k_one<5>(o[5], vb + kh * 16384, pa0, pa1); pv32k_one<6>(o[6], vb + kh * 16384, pa0, pa1); pv32k_one<7>(o[7], vb + kh * 16384, pa0, pa1);
    }
    if (j + 1 < NT) { DK_BSYNC(); DK_VWAITQ(nq); DK_VWRITE(); DK_BSYNC(); }
  }
  if (hi == 0) li_l[r32] = l_reg; asm volatile("s_waitcnt lgkmcnt(0)" ::: "memory");
  int tide = tid; asm volatile("" : "+v"(tide));
  const int hie = (tide >> 5) & 1, r32e = tide & 31;
  bf16* Ow = Ob + (long)(rg * 32 + 4 * hie) * 1024 + r32e;
#pragma unroll
  for (int r = 0; r < 16; ++r) { const float rl = __builtin_amdgcn_rcpf(li_l[crow(r, hie)]); bf16* Or = Ow + (long)((r & 3) + 8 * (r >> 2)) * 1024;
#pragma unroll
    for (int d0 = 0; d0 < 8; ++d0) { const float y = o[d0][r] * rl; Or[d0 * 32] = (bf16)cvtpk(y, y); } }
  __syncthreads();
#undef DK_KDMA
#undef DK_SOFFS
#undef DK_VLOAD
#undef DK_VWAIT0
#undef DK_VWAITQ
#undef DK_VWRITE
#undef DK_BSYNC
}
#undef KSWZ
#undef SBAR
}
constexpr int NWAVES = 8;
#ifndef MK_SPLIT
#define MK_SPLIT 0
#endif
constexpr int N_PHASES = 12;

constexpr int DM = 2048, BATCH = 2, SEQ = 4096, T = BATCH * SEQ;
constexpr int NQKV = 10240;
constexpr int C_QA = 0, C_KA = 1024, C_VA = 2048, C_QB = 3072, C_KB = 4096, C_VB = 5120, C_GA = 6144, C_GB = 8192;
constexpr unsigned long long LBMAP = 0x52ull;
constexpr unsigned long long LFMAP = 0x98764310ull;
constexpr int NLB = 2, NLF = 8;
constexpr int NE = 32, TOPK = 4, TK = T * TOPK, TKPAD = TK + NE * 256;
constexpr float EPS = 1e-5f;
constexpr float LAMBDA_INIT = 0.2f;

constexpr size_t MiB = 1u << 20;
constexpr size_t WS_CTL = 0, CTL_ZERO_BYTES = 1 * MiB;
constexpr size_t WS_MOD = 1 * MiB;
constexpr size_t WS_RC = 1 * MiB + 512 * 1024;
constexpr size_t WS_TOPI = 2 * MiB;
constexpr size_t WS_TOPP = 2 * MiB + 256 * 1024;
constexpr size_t WS_POS = 2 * MiB + 512 * 1024;
constexpr size_t WS_TOKOF = 3 * MiB;
constexpr size_t WS_WINT = 4 * MiB;
constexpr size_t WS_WING = 4 * MiB + (size_t)6144 * 4096;
constexpr size_t WS_U8Q = 770 * MiB;
constexpr size_t WS_WAT = 44 * MiB;
constexpr size_t WS_WBT = 48 * MiB;
constexpr size_t WS_WOT = 52 * MiB;
constexpr size_t WS_U = 64 * MiB;
constexpr size_t WS_QKV = 96 * MiB;
constexpr size_t WS_OA = 256 * MiB;
constexpr size_t WS_OB = 352 * MiB;
constexpr size_t WS_LSE = 416 * MiB;
constexpr size_t WS_YA = 418 * MiB;
constexpr size_t WS_YB = 434 * MiB;
constexpr size_t WS_M1 = 450 * MiB;
constexpr size_t WS_MG = 514 * MiB;
constexpr size_t WS_H1 = 546 * MiB;
constexpr size_t WS_XS = 610 * MiB;
constexpr size_t WS_YACT = 770 * MiB;
constexpr size_t WS_YSLOT = 930 * MiB;
constexpr size_t WS_WGU = 1090 * MiB;
constexpr size_t WS_WD = 1602 * MiB;
constexpr size_t WS_END = 1858 * MiB;
constexpr int CW_TMO = 0, CW_CODE = 1;
constexpr int CW_BAR = 4096;
constexpr int CW_CNT = 8192;

constexpr int RING_OFF = 0, RING_BYTES = 131072;
constexpr int PB_OFF = 69632;
constexpr int LDSCTL_OFF = 159744, MISC_OFF = LDSCTL_OFF + 320;
constexpr int TST_OFF = LDSCTL_OFF + 1024;
constexpr int LDS_BYTES = 163840;

#define GAS __attribute__((address_space(1)))
#define LAS __attribute__((address_space(3)))
typedef unsigned short bf16;
typedef unsigned v4u __attribute__((ext_vector_type(4)));
typedef unsigned v2u __attribute__((ext_vector_type(2)));
typedef float f32x4 __attribute__((ext_vector_type(4)));
typedef float v2f __attribute__((ext_vector_type(2)));
typedef GAS unsigned gu32;
#define RLX_AGENT __ATOMIC_RELAXED, __HIP_MEMORY_SCOPE_AGENT
#define LDS_WAIT() asm volatile("s_waitcnt lgkmcnt(0)" ::: "memory")
#define VM_WAIT() asm volatile("s_waitcnt vmcnt(0)" ::: "memory")
__device__ __forceinline__ unsigned f2bf(float f) { unsigned u = __builtin_bit_cast(unsigned, f); return (u + 0x7fffu + ((u >> 16) & 1u)) >> 16; }
__device__ __forceinline__ unsigned pk2(float lo, float hi) { return f2bf(lo) | (f2bf(hi) << 16); }
__device__ __forceinline__ float bf2f(unsigned short h) { return __uint_as_float(((unsigned)h) << 16); }
__device__ __forceinline__ float wave_sum(float v) {
#pragma unroll
    for (int o = 1; o < 64; o <<= 1) v += __shfl_xor(v, o);
    return v;
}
__device__ __forceinline__ float wave_max(float v) {
#pragma unroll
    for (int o = 1; o < 64; o <<= 1) v = fmaxf(v, __shfl_xor(v, o));
    return v;
}
__device__ __forceinline__ float siluf(float x) { return x / (1.0f + __expf(-x)); }
#define XB_TMO      128
#define XB_XCNT(j)  (256  + 64 * (j))
#define XB_XSUB(j)  (1280 + 64 * (j))
#define XB_XGEN(j)  (2304 + 64 * (j))
#define XB_TOP      3328
#define XB_TOPGEN   3392
#define XCD_BAR_WORDS 3456
#define XB_SPIN_CAP (1u << 18)

__device__ __forceinline__ unsigned xb_ld(unsigned* p)              { return __hip_atomic_load(p, __ATOMIC_RELAXED, __HIP_MEMORY_SCOPE_AGENT); }
__device__ __forceinline__ unsigned xb_add(unsigned* p, unsigned v) { return __hip_atomic_fetch_add(p, v, __ATOMIC_RELAXED, __HIP_MEMORY_SCOPE_AGENT); }
__device__ __forceinline__ unsigned xb_xcc_id() { return (unsigned)__builtin_amdgcn_s_getreg((3 << 11) | 20) & 0xFu; }
#define XB_SPIN(cond, bar) do { unsigned _sp = 0; while (cond) { __builtin_amdgcn_s_sleep(1); \
    if ((++_sp & 255u) == 0u) { if (xb_ld(&(bar)[XB_TMO])) break; if (_sp > XB_SPIN_CAP) { atomicAdd(&(bar)[XB_TMO], 1u); break; } } } } while (0)

struct XcdBarrier {
    unsigned* bar; unsigned x;
    volatile LAS unsigned* st;
};

__device__ __forceinline__ XcdBarrier xcd_barrier_post(unsigned* bar, volatile LAS unsigned* st) {
    XcdBarrier b; b.bar = bar; b.x = xb_xcc_id(); b.st = st;
    if (threadIdx.x == 0) (void)xb_add(&bar[XB_XCNT(b.x)], 1u);
    return b;
}
__device__ __forceinline__ void xcd_barrier_complete(unsigned* bar, unsigned x, unsigned& nloc, unsigned& nx) {
    const unsigned G = gridDim.x * gridDim.y * gridDim.z;
    unsigned sum, cnt, mine, sp = 0u;
    for (;;) {
        sum = 0u; cnt = 0u; mine = 0u;
#pragma unroll
        for (unsigned j = 0; j < 16; ++j) { const unsigned c = xb_ld(&bar[XB_XCNT(j)]); sum += c; cnt += (c > 0u) ? 1u : 0u; mine = (j == x) ? c : mine; }
        if (sum == G) break;
        __builtin_amdgcn_s_sleep(1);
        if ((++sp & 255u) == 0u) { if (xb_ld(&bar[XB_TMO])) break; if (sp > XB_SPIN_CAP) { atomicAdd(&bar[XB_TMO], 1u); break; } }
    }
    nloc = mine > 0u ? mine : 1u; nx = cnt > 0u ? cnt : 1u;
}

__device__ __forceinline__ void xcd_barrier(const XcdBarrier& b) {
    asm volatile("s_waitcnt vmcnt(0)" ::: "memory");
    __syncthreads();
    if (threadIdx.x == 0) {
        unsigned* bar = b.bar;
        __builtin_amdgcn_s_waitcnt(0);
        unsigned nloc = b.st[0], nx = b.st[1];
        if (nloc == 0u) { xcd_barrier_complete(bar, b.x, nloc, nx); b.st[0] = nloc; b.st[1] = nx; }
        const unsigned old = xb_add(&bar[XB_XSUB(b.x)], 1u);
        const unsigned gen = old / nloc;
        if (old + 1u == (gen + 1u) * nloc) {
            __builtin_amdgcn_fence(__ATOMIC_RELEASE, "agent");
            asm volatile("s_waitcnt vmcnt(0)" ::: "memory");
            const unsigned og = xb_add(&bar[XB_TOP], 1u);
            const unsigned tg = og / nx;
            if (og + 1u == (tg + 1u) * nx) xb_add(&bar[XB_TOPGEN], 1u);
            else XB_SPIN(xb_ld(&bar[XB_TOPGEN]) == tg, bar);
            __builtin_amdgcn_fence(__ATOMIC_ACQUIRE, "agent");
            xb_add(&bar[XB_XGEN(b.x)], 1u);
            asm volatile("s_waitcnt vmcnt(0)" ::: "memory");
        } else {
            XB_SPIN(xb_ld(&bar[XB_XGEN(b.x)]) == gen, bar);
            __builtin_amdgcn_fence(__ATOMIC_ACQUIRE, "agent");
            asm volatile("s_waitcnt vmcnt(0)" ::: "memory");
        }
    }
    __syncthreads();
}
struct Args { const float* in[24]; float* out; unsigned char* ws; int ph_lo, ph_hi; };
enum { I_X = 0, I_C, I_WADA, I_BADA, I_N1G, I_WIN, I_LQ1, I_LK1, I_LQ2, I_LK2, I_SUBG, I_WOA, I_WOB, I_WO, I_N2G, I_WR, I_BR, I_WG, I_BG, I_WU, I_BU, I_WDN, I_BDN, I_FG };
struct Frame {
    LAS unsigned char* lds; char* ldsg;
    volatile LAS unsigned* MISC;
    gu32* ctl;
    int tid, lane, wave, vcu, G;
    unsigned char* ws;
};
#define WSP(T_, off) ((T_*)(F.ws + (off)))

constexpr float WSCALE = 64.0f;
__device__ __forceinline__ unsigned cvtpk_bf(float lo, float hi) { unsigned r; asm volatile("v_cvt_pk_bf16_f32 %0, %1, %2" : "=v"(r) : "v"(lo), "v"(hi)); return r; }
__device__ __forceinline__ void cvt_load(f32x4 (&v)[8], const float* __restrict__ W, int N, int k0, int n0, int lane) {
    const int lr = lane >> 3, lc = 4 * (lane & 7);
#pragma unroll
    for (int i = 0; i < 8; ++i) v[i] = __builtin_nontemporal_load((const f32x4*)(W + (size_t)(k0 + lr + 8 * i) * N + n0 + lc));
}
template <bool F8>
__device__ __forceinline__ void cvt_store(const f32x4 (&v)[8], int K, void* __restrict__ WT, int k0, long dst_row0, LAS float* scr, int lane) {
    const int lr = lane >> 3, lc = 4 * (lane & 7);
#pragma unroll
    for (int i = 0; i < 8; ++i) { LAS float* s = scr + (lr + 8 * i) * 33 + lc; s[0] = v[i].x; s[1] = v[i].y; s[2] = v[i].z; s[3] = v[i].w; }
    LDS_WAIT(); asm volatile("" ::: "memory");
    const int c = lane & 7;
#pragma unroll
    for (int j = 0; j < 4; ++j) { const int n = (lane >> 3) + 8 * j; const LAS float* s = scr + (8 * c) * 33 + n;
        if constexpr (F8) {
            int w0 = __builtin_amdgcn_cvt_pk_fp8_f32(s[0 * 33] * WSCALE, s[1 * 33] * WSCALE, 0, false); w0 = __builtin_amdgcn_cvt_pk_fp8_f32(s[2 * 33] * WSCALE, s[3 * 33] * WSCALE, w0, true);
            int w1 = __builtin_amdgcn_cvt_pk_fp8_f32(s[4 * 33] * WSCALE, s[5 * 33] * WSCALE, 0, false); w1 = __builtin_amdgcn_cvt_pk_fp8_f32(s[6 * 33] * WSCALE, s[7 * 33] * WSCALE, w1, true);
            *(v2u*)((unsigned char*)WT + (size_t)(dst_row0 + n) * K + k0 + 8 * c) = (v2u){(unsigned)w0, (unsigned)w1};
        } else {
            v4u o; o.x = cvtpk_bf(s[0 * 33], s[1 * 33]); o.y = cvtpk_bf(s[2 * 33], s[3 * 33]); o.z = cvtpk_bf(s[4 * 33], s[5 * 33]); o.w = cvtpk_bf(s[6 * 33], s[7 * 33]);
            *(v4u*)((bf16*)WT + (size_t)(dst_row0 + n) * K + k0 + 8 * c) = o; } }
    LDS_WAIT(); asm volatile("" ::: "memory");
}
__device__ __forceinline__ void cvt8_load(f32x4 (&v)[16], const float* __restrict__ W, int k0, int n0, int lane, int N = DM) {
    const float* p = W + (size_t)(k0 + (lane >> 3)) * N + n0 + 4 * (lane & 7);
#pragma unroll
    for (int i = 0; i < 16; ++i) v[i] = __builtin_nontemporal_load((const f32x4*)(p + (size_t)(8 * i) * N));
}
__device__ __forceinline__ void cvt8_store(const f32x4 (&v)[16], unsigned char* __restrict__ WT, int k0, long dst_row0, LAS float* scr, int lane) {
    const int lr = lane >> 3, lc = 4 * (lane & 7);
#pragma unroll
    for (int i = 0; i < 16; ++i) { LAS float* s = scr + (lr + 8 * i) * 33 + ((lc + 4 * (i >> 1)) & 31);
        s[0] = v[i].x; s[1] = v[i].y; s[2] = v[i].z; s[3] = v[i].w; }
    LDS_WAIT(); asm volatile("" ::: "memory");
    const int c = lane & 7;
#pragma unroll
    for (int j = 0; j < 4; ++j) { const int n = (lane >> 3) + 8 * j; const LAS float* s = scr + (16 * c) * 33 + ((n + 4 * c) & 31);
        v4u o;
#pragma unroll
        for (int h = 0; h < 4; ++h) { int w = __builtin_amdgcn_cvt_pk_fp8_f32(s[(4 * h + 0) * 33] * WSCALE, s[(4 * h + 1) * 33] * WSCALE, 0, false);
            w = __builtin_amdgcn_cvt_pk_fp8_f32(s[(4 * h + 2) * 33] * WSCALE, s[(4 * h + 3) * 33] * WSCALE, w, true); o[h] = (unsigned)w; }
        *(v4u*)(WT + (size_t)(dst_row0 + n) * DM + k0 + 16 * c) = o; }
    LDS_WAIT(); asm volatile("" ::: "memory");
}
__device__ __forceinline__ void p0_mod(Frame& F, const Args& A) {
    LAS float* red = (LAS float*)F.lds;
    LAS float* sc = red + 2048;
    if (F.vcu < 192) {
        for (int k = F.tid; k < DM; k += 512) { sc[2 * k] = siluf(A.in[I_C][k]); sc[2 * k + 1] = siluf(A.in[I_C][2048 + k]); }
    }
    __syncthreads();
    if (F.vcu < 192) {
        const int col = F.vcu * 64 + F.lane, k0 = F.wave * 256;
        const float* wp = A.in[I_WADA] + (size_t)k0 * 12288 + col; const LAS float* sp = sc + 2 * k0;
        float a0 = 0.f, a1 = 0.f;
#pragma unroll 16
        for (int k = 0; k < 256; ++k) { const float wv = __builtin_nontemporal_load(wp + (size_t)k * 12288); const v2f s2 = *(const LAS v2f*)(sp + 2 * k); a0 = fmaf(s2.x, wv, a0); a1 = fmaf(s2.y, wv, a1); }
        red[(F.wave * 2 + 0) * 64 + F.lane] = a0; red[(F.wave * 2 + 1) * 64 + F.lane] = a1;
    }
    __syncthreads();
    if (F.vcu < 192 && F.tid < 128) { const int b = F.tid >> 6, l = F.tid & 63; float s = 0.f;
#pragma unroll
        for (int w = 0; w < 8; ++w) s += red[(w * 2 + b) * 64 + l];
        const int col = F.vcu * 64 + l; WSP(float, WS_MOD)[b * 12288 + col] = s + A.in[I_BADA][col]; }
    __syncthreads();
}
__device__ __forceinline__ void p0_convert(Frame& F, const Args& A) {
    LAS float* scr = (LAS float*)(F.lds + F.wave * 16384);
    const int gw = F.vcu * NWAVES + F.wave, NGW = F.G * NWAVES;
    constexpr int I_IN = 32 * 320, I_A = 16 * 64, I_B = 16 * 64, NSMALL = I_IN + I_A + I_B;
    f32x4 v0[8];
#pragma unroll 1
    for (int it = gw; it < NSMALL; it += NGW) { int r = it; const float* W; bf16* WT; int N, K, drow = 0;
        if (r < I_IN) { W = A.in[I_WIN]; WT = WSP(bf16, WS_WINT); N = NQKV; K = DM; const int g_ = (r % 320) >> 5; int pos_ = -1;
#pragma unroll
            for (int i_ = 0; i_ < NLB; ++i_) if ((int)((LBMAP >> (4 * i_)) & 15ull) == g_) pos_ = i_;
            if (pos_ < 0) continue; drow = pos_ * 1024 - g_ * 1024; }
        else if ((r -= I_IN) < I_A) { W = A.in[I_WOA]; WT = WSP(bf16, WS_WAT); N = DM; K = 1024; }
        else { r -= I_A; W = A.in[I_WOB]; WT = WSP(bf16, WS_WBT); N = DM; K = 1024; }
        const int nnb = N / 32, k0 = (r / nnb) * 64, n0 = (r % nnb) * 32;
        cvt_load(v0, W, N, k0, n0, F.lane); cvt_store<false>(v0, K, WT, k0, n0 + drow, scr, F.lane); }
    { __syncthreads(); LAS float* scr8 = (LAS float*)(F.lds + F.wave * 16896); f32x4 va[16];
      constexpr int NF8 = 16 * NLF * 32;
#pragma unroll 1
      for (int it = gw; it < NF8 + 16 * 64; it += NGW) {
          if (it < NF8) { const int k0 = (it / (NLF * 32)) * 128, blk = it % (NLF * 32), pf = blk >> 5, g_ = (int)((LFMAP >> (4 * pf)) & 15ull);
              cvt8_load(va, A.in[I_WIN], k0, g_ * 1024 + (blk & 31) * 32, F.lane, NQKV); cvt8_store(va, WSP(unsigned char, WS_WING), k0, pf * 1024 + (blk & 31) * 32, scr8, F.lane); }
          else { const int j = it - NF8, k0 = (j >> 6) * 128, n0 = (j & 63) * 32;
              cvt8_load(va, A.in[I_WO], k0, n0, F.lane, DM); cvt8_store(va, WSP(unsigned char, WS_WOT), k0, n0, scr8, F.lane); } } }
}
__device__ __forceinline__ void p1_modulate(Frame& F, const Args& A) {
    const int gw = F.vcu * NWAVES + F.wave, NGW = F.G * NWAVES; const float* MOD = WSP(float, WS_MOD);
    if (F.vcu < 64 && F.wave == 0) { const int b = F.vcu >> 5, kq = F.vcu & 31, e = F.lane & 31, ks = F.lane >> 5; float s = 0.f;
#pragma unroll 8
        for (int i = 0; i < 32; ++i) { const int k = 64 * kq + 2 * i + ks; s = fmaf(MOD[b * 12288 + 3 * DM + k], A.in[I_WR][k * 32 + e], s); }
        s += __shfl_xor(s, 32); if (F.lane < 32) WSP(float, WS_RC)[(b * 32 + kq) * 32 + e] = s; }
    for (int m = gw; m < T; m += NGW) {
        const int b = m / SEQ; const float* xr = A.in[I_X] + (size_t)m * DM + 4 * F.lane; f32x4 v[8]; float s = 0.f;
#pragma unroll
        for (int j = 0; j < 8; ++j) { v[j] = *(const f32x4*)(xr + 256 * j); s += (v[j].x * v[j].x + v[j].y * v[j].y) + (v[j].z * v[j].z + v[j].w * v[j].w); }
        const float rstd = 1.0f / sqrtf(wave_sum(s) * (1.0f / DM) + EPS);
        bf16* ur = WSP(bf16, WS_U) + (size_t)m * DM + 4 * F.lane;
#pragma unroll
        for (int j = 0; j < 8; ++j) { const int k = 4 * F.lane + 256 * j;
            const f32x4 g = *(const f32x4*)(A.in[I_N1G] + k), sc = *(const f32x4*)(MOD + b * 12288 + 1 * DM + k), sh = *(const f32x4*)(MOD + b * 12288 + k);
            const f32x4 u = v[j] * rstd * g * (sc + 1.0f) + sh; v2u o; o.x = pk2(u.x, u.y); o.y = pk2(u.z, u.w); *(v2u*)(ur + 256 * j) = o;
            int w8 = __builtin_amdgcn_cvt_pk_fp8_f32(u.x, u.y, 0, false); w8 = __builtin_amdgcn_cvt_pk_fp8_f32(u.z, u.w, w8, true); *(int*)(WSP(unsigned char, WS_U8Q) + (size_t)m * DM + 4 * F.lane + 256 * j) = w8; }
    }
}
__device__ __forceinline__ void p3_attention(Frame& F, const Args& A) {
    const bf16* QKV = WSP(bf16, WS_QKV);
    att::Pb pb; int pbi = 0, pbp = 0; const char* pbs = nullptr; pb.gw = F.vcu * NWAVES + F.wave; pb.NGW = F.G * NWAVES;
    pb.total = pb.gw < att::PB_NIT ? ((att::PB_NIT - pb.gw + pb.NGW - 1) / pb.NGW) * 16 : 0;
    pb.pg = A.in[I_WG]; pb.du = (const char*)A.in[I_WU] - (const char*)A.in[I_WG]; pb.dd = (const char*)A.in[I_WDN] - (const char*)A.in[I_WG];
    pb.wgu = (GAS unsigned char*)WSP(unsigned char, WS_WGU); pb.wd = (GAS unsigned char*)WSP(unsigned char, WS_WD); pb.zone = (unsigned)(PB_OFF + F.wave * att::PB_WAVE);
#pragma unroll 1
    for (int i = F.vcu; i < 256; i += F.G) {
        const int c2 = i >> 4, b = c2 >> 3, h = (c2 >> 1) & 3, c = c2 & 1, qb = i & 15;
        const size_t rowb = (size_t)b * SEQ;
        const bf16* Qb = QKV + (rowb + qb * 256) * NQKV + C_QB + h * 256 + c * 128;
        const bf16* Kh = QKV + rowb * NQKV + C_KB + h * 256 + c * 128;
        const bf16* Vh = QKV + rowb * NQKV + C_VB + h * 256;
        bf16* Ob = WSP(bf16, WS_OB) + ((size_t)c * T + rowb + qb * 256) * 1024 + h * 256;
        const float slope = exp2f(-(float)(8 + h + 1) * (8.0f / 12.0f));
        att::diffk_body(Qb, Kh, Vh, NQKV, qb * 256, slope / att::SCALE, Ob, F.ldsg, pb, pbi, pbp, pbs);
    }
    att::pb_drain(pb, pbi, pbp, pbs, F.ldsg, F.lane);
    __syncthreads();
    {
        const int gw = F.vcu * NWAVES + F.wave, NGW = F.G * NWAVES;
        char* ktile = F.ldsg + F.wave * 16384; char* vtile = ktile + 8192; float* scr = (float*)(F.ldsg + 131072) + F.wave * 64;
#if defined(REP_DIL)
#pragma unroll 1
        for (int rep_ = 0; rep_ < 2; ++rep_)
#endif
#pragma unroll 1
        for (int tk = gw; tk < 3 * 2048; tk += NGW) {
            const int p = tk >> 11, r = tk & 2047, b = r >> 10, h = (r >> 7) & 7, blk = r & 127;
            const int dil = p == 0 ? 1 : (p == 1 ? 4 : 16), L = SEQ / dil, bpr = L / 32, res = blk / bpr, j0 = (blk % bpr) * 32;
            const size_t rowb = (size_t)b * SEQ + res;
            const bf16* Qb = QKV + rowb * NQKV + C_QA + h * 128; const bf16* Kb = QKV + rowb * NQKV + C_KA + h * 128; const bf16* Vb = QKV + rowb * NQKV + C_VA + h * 128;
            bf16* Ob = WSP(bf16, WS_OA) + ((size_t)p * T + rowb) * 1024 + h * 128; float* Lb = WSP(float, WS_LSE) + ((size_t)p * T + rowb) * 8 + h;
            const float slope = exp2f(-(float)(h + 1) * (8.0f / 12.0f)) * (float)dil;
            att::dilated_wave(Qb, Kb, Vb, (long)dil * NQKV, j0, L, slope / att::SCALE, Ob, (long)dil * 1024, Lb, (long)dil * 8, ktile, vtile, scr);
        }
    }
    __syncthreads();
}
__device__ __forceinline__ void p4_finalize(Frame& F, const Args& A) {
    const int gw = F.vcu * NWAVES + F.wave, NGW = F.G * NWAVES;
    float s1 = A.in[I_LQ1][F.lane] * A.in[I_LK1][F.lane] + A.in[I_LQ1][F.lane + 64] * A.in[I_LK1][F.lane + 64];
    float s2 = A.in[I_LQ2][F.lane] * A.in[I_LK2][F.lane] + A.in[I_LQ2][F.lane + 64] * A.in[I_LK2][F.lane + 64];
    s1 = wave_sum(s1); s2 = wave_sum(s2);
    const float lam = expf(s1) - expf(s2) + LAMBDA_INIT;
    const bf16* OA = WSP(bf16, WS_OA); const bf16* OB = WSP(bf16, WS_OB); const float* LS = WSP(float, WS_LSE);
    for (int m = gw; m < T; m += NGW) {
        { const int h = F.lane >> 3; const float l0 = LS[((size_t)0 * T + m) * 8 + h], l1 = LS[((size_t)1 * T + m) * 8 + h], l2 = LS[((size_t)2 * T + m) * 8 + h];
          const float mx = fmaxf(l0, fmaxf(l1, l2)); float w0 = __expf(l0 - mx), w1 = __expf(l1 - mx), w2 = __expf(l2 - mx); const float inv = 1.0f / (w0 + w1 + w2); w0 *= inv; w1 *= inv; w2 *= inv;
          const size_t o = (size_t)m * 1024 + 16 * F.lane; unsigned pk[8];
#pragma unroll
          for (int q = 0; q < 2; ++q) { const v4u a0 = *(const v4u*)(OA + o + 8 * q), a1 = *(const v4u*)(OA + (size_t)T * 1024 + o + 8 * q), a2 = *(const v4u*)(OA + (size_t)2 * T * 1024 + o + 8 * q);
#pragma unroll
              for (int e = 0; e < 4; ++e) { const float ylo = w0 * __uint_as_float(a0[e] << 16) + w1 * __uint_as_float(a1[e] << 16) + w2 * __uint_as_float(a2[e] << 16);
                  const float yhi = w0 * __uint_as_float(a0[e] & 0xffff0000u) + w1 * __uint_as_float(a1[e] & 0xffff0000u) + w2 * __uint_as_float(a2[e] & 0xffff0000u); pk[4 * q + e] = pk2(ylo, yhi); } }
          bf16* ya = WSP(bf16, WS_YA) + o; *(v4u*)ya = (v4u){pk[0], pk[1], pk[2], pk[3]}; *(v4u*)(ya + 8) = (v4u){pk[4], pk[5], pk[6], pk[7]}; }
#pragma unroll
        for (int h = 0; h < 4; ++h) { const size_t o = (size_t)m * 1024 + h * 256 + 4 * F.lane;
            const v2u b0 = *(const v2u*)(OB + o), b1 = *(const v2u*)(OB + (size_t)T * 1024 + o);
            const f32x4 v = (f32x4){__uint_as_float(b0.x << 16), __uint_as_float(b0.x & 0xffff0000u), __uint_as_float(b0.y << 16), __uint_as_float(b0.y & 0xffff0000u)}
                          - (f32x4){__uint_as_float(b1.x << 16), __uint_as_float(b1.x & 0xffff0000u), __uint_as_float(b1.y << 16), __uint_as_float(b1.y & 0xffff0000u)} * lam;
            const float ss = wave_sum((v.x * v.x + v.y * v.y) + (v.z * v.z + v.w * v.w)); const float rstd = 1.0f / sqrtf(ss * (1.0f / 256.0f) + EPS);
            const f32x4 g = *(const f32x4*)(A.in[I_SUBG] + 4 * F.lane); const f32x4 y = v * rstd * g * (1.0f - LAMBDA_INIT);
            v2u w; w.x = pk2(y.x, y.y); w.y = pk2(y.z, y.w); *(v2u*)(WSP(bf16, WS_YB) + o) = w; }
    }
}
typedef float f32x16r __attribute__((ext_vector_type(16)));
__device__ __forceinline__ void p7_router(Frame& F, const Args& A, bool commit = true) {
    LAS float* gainL = (LAS float*)F.lds;
    LAS float* shiftL = gainL + 2048;
    LAS float* part = shiftL + 2048;
    LAS float* ssp = part + 8 * 32 * 32;
    LAS float* logitL = ssp + 512;
    LAS float* rstdL = logitL + 32 * 33;
    LAS int* lcnt = (LAS int*)(rstdL + 32);
    LAS int* lbase = lcnt + 32;
    const float* H1 = WSP(float, WS_H1); const float* MODp = WSP(float, WS_MOD); const float* RC = WSP(float, WS_RC);
    for (int blk = F.vcu; blk < T / 32; blk += F.G) {
        const int t0 = blk * 32, bb = t0 / SEQ; const float* mod = MODp + bb * 12288;
        for (int k = F.tid; k < DM; k += 512) { gainL[k] = A.in[I_N2G][k] * (1.0f + mod[4 * DM + k]); shiftL[k] = mod[3 * DM + k]; }
        if (F.tid < 32) lcnt[F.tid] = 0;
        __syncthreads();
        {
            const int i = F.lane & 31, kk = F.lane >> 5, kb = F.wave * 256 + kk * 128;
            const float* hp = H1 + (size_t)(t0 + i) * DM + kb; const float* wp = A.in[I_WR] + (size_t)kb * 32 + i; const LAS float* gp = gainL + kb;
            f32x16r acc = {}; float ss = 0.f;
#pragma unroll 4
            for (int s0 = 0; s0 < 128; s0 += 4) {
                const f32x4 hv = *(const f32x4*)(hp + s0); const f32x4 g4 = *(const LAS f32x4*)(gp + s0);
                const float b0 = wp[(s0 + 0) * 32], b1 = wp[(s0 + 1) * 32], b2 = wp[(s0 + 2) * 32], b3 = wp[(s0 + 3) * 32];
                ss += (hv.x * hv.x + hv.y * hv.y) + (hv.z * hv.z + hv.w * hv.w);
                acc = __builtin_amdgcn_mfma_f32_32x32x2f32(hv.x * g4.x, b0, acc, 0, 0, 0);
                acc = __builtin_amdgcn_mfma_f32_32x32x2f32(hv.y * g4.y, b1, acc, 0, 0, 0);
                acc = __builtin_amdgcn_mfma_f32_32x32x2f32(hv.z * g4.z, b2, acc, 0, 0, 0);
                acc = __builtin_amdgcn_mfma_f32_32x32x2f32(hv.w * g4.w, b3, acc, 0, 0, 0);
            }
#pragma unroll
            for (int r = 0; r < 16; ++r) part[(F.wave * 32 + (r & 3) + 8 * (r >> 2) + 4 * kk) * 32 + i] = acc[r];
            ssp[F.wave * 64 + F.lane] = ss;
        }
        __syncthreads();
        { const int token = F.tid & 31, eg = F.tid >> 5; float s2 = 0.f;
#pragma unroll
          for (int w = 0; w < 8; ++w) s2 += ssp[w * 64 + token] + ssp[w * 64 + 32 + token];
          const float rstd = 1.0f / sqrtf(s2 * (1.0f / DM) + EPS);
#pragma unroll
          for (int q = 0; q < 2; ++q) { const int e = eg * 2 + q; float raw = 0.f;
#pragma unroll
              for (int w = 0; w < 8; ++w) raw += part[(w * 32 + token) * 32 + e];
              float rc = A.in[I_BR][e];
#pragma unroll 8
              for (int kq = 0; kq < 32; ++kq) rc += RC[(bb * 32 + kq) * 32 + e];
              logitL[token * 33 + e] = rstd * raw + rc; }
          if (eg == 0) rstdL[token] = rstd; }
        __syncthreads();
        int se[4] = {0, 0, 0, 0}, lp[4] = {0, 0, 0, 0}; float pv[4] = {0.f, 0.f, 0.f, 0.f};
        if (F.tid < 32) {
            float sv[4];
#pragma unroll
            for (int k = 0; k < 4; ++k) { float best = -INFINITY; int bi = 0;
                for (int e = 0; e < 32; ++e) { const float v = logitL[F.tid * 33 + e]; if (v > best) { best = v; bi = e; } }
                sv[k] = best; se[k] = bi; logitL[F.tid * 33 + bi] = -INFINITY; }
            float sum = 0.f;
#pragma unroll
            for (int k = 0; k < 4; ++k) { pv[k] = expf(sv[k] - sv[0]); sum += pv[k]; }
            const float inv = 1.0f / sum;
#pragma unroll
            for (int k = 0; k < 4; ++k) { pv[k] *= inv; lp[k] = __hip_atomic_fetch_add(lcnt + se[k], 1, __ATOMIC_RELAXED, __HIP_MEMORY_SCOPE_WORKGROUP); }
        }
        __syncthreads();
        if (F.tid < 32 && commit) lbase[F.tid] = (int)__hip_atomic_fetch_add((unsigned*)(F.ctl + CW_CNT + 64 * F.tid), (unsigned)lcnt[F.tid], RLX_AGENT);
        __syncthreads();
        if (F.tid < 32 && commit) { const int m = t0 + F.tid;
#pragma unroll
            for (int k = 0; k < 4; ++k) { const int pos = lbase[se[k]] + lp[k]; WSP(int, WS_TOPI)[m * 4 + k] = se[k]; WSP(float, WS_TOPP)[m * 4 + k] = pv[k]; WSP(int, WS_POS)[m * 4 + k] = pos;
                WSP(int, WS_TOKOF)[se[k] * 8192 + pos] = m; } }
        for (int i = 0; i < 4; ++i) { const int token = F.wave * 4 + i, m = t0 + token; const float rstd = rstdL[token];
            const float* hr = H1 + (size_t)m * DM + 4 * F.lane; unsigned char* ur = WSP(unsigned char, WS_U) + (size_t)m * DM + 4 * F.lane;
#pragma unroll
            for (int j = 0; j < 8; ++j) { const f32x4 h = *(const f32x4*)(hr + 256 * j), g = *(const LAS f32x4*)(gainL + 4 * F.lane + 256 * j), s = *(const LAS f32x4*)(shiftL + 4 * F.lane + 256 * j);
                const f32x4 u = h * rstd * g + s; int w8 = __builtin_amdgcn_cvt_pk_fp8_f32(u.x, u.y, 0, false); w8 = __builtin_amdgcn_cvt_pk_fp8_f32(u.z, u.w, w8, true); *(int*)(ur + 256 * j) = w8; } }
        __syncthreads();
    }
}
__device__ __forceinline__ void build_tile_table(Frame& F) {
    LAS int* ts = (LAS int*)(F.lds + TST_OFF);
    if (F.tid < 64) {
        const int e = F.tid & 31; const int c = (int)__hip_atomic_load((unsigned*)(F.ctl + CW_CNT + 64 * e), RLX_AGENT); const int tl = (c + 255) >> 8; int x = tl;
#pragma unroll
        for (int o = 1; o < 32; o <<= 1) { const int y = __shfl_up(x, o, 32); if (e >= o) x += y; }
        if (F.tid < 32) { ts[e] = x - tl; ts[40 + e] = c; if (e == 31) ts[32] = x; } }
    __syncthreads();
}
__device__ __forceinline__ void p11_final(Frame& F, const Args& A) {
    build_tile_table(F);
    const LAS int* ts = (const LAS int*)(F.lds + TST_OFF);
    const int gw = F.vcu * NWAVES + F.wave, NGW = F.G * NWAVES; const float* MODp = WSP(float, WS_MOD);
    for (int m = gw; m < T; m += NGW) {
        const int bb = m / SEQ; const bf16* yr[4]; float p[4];
#pragma unroll
        for (int k = 0; k < 4; ++k) { const int e = WSP(int, WS_TOPI)[m * 4 + k], pos = WSP(int, WS_POS)[m * 4 + k]; p[k] = WSP(float, WS_TOPP)[m * 4 + k];
            yr[k] = WSP(bf16, WS_YSLOT) + ((size_t)ts[e] * 256 + pos) * DM + 4 * F.lane; }
        const float* hr = WSP(float, WS_H1) + (size_t)m * DM + 4 * F.lane; f32x4 v[8]; float s = 0.f;
#pragma unroll
        for (int j = 0; j < 8; ++j) { f32x4 a = {0.f, 0.f, 0.f, 0.f};
#pragma unroll
            for (int k = 0; k < 4; ++k) { const v2u w = *(const v2u*)(yr[k] + 256 * j); const f32x4 y = {__uint_as_float(w.x << 16), __uint_as_float(w.x & 0xffff0000u), __uint_as_float(w.y << 16), __uint_as_float(w.y & 0xffff0000u)}; a += y * p[k]; }
            const f32x4 g2 = *(const f32x4*)(MODp + bb * 12288 + 5 * DM + 4 * F.lane + 256 * j);
            v[j] = *(const f32x4*)(hr + 256 * j) + g2 * a; s += (v[j].x * v[j].x + v[j].y * v[j].y) + (v[j].z * v[j].z + v[j].w * v[j].w); }
        const float rstd = 1.0f / sqrtf(wave_sum(s) * (1.0f / DM) + EPS);
        float* orow = A.out + (size_t)m * DM + 4 * F.lane;
#pragma unroll
        for (int j = 0; j < 8; ++j) { const f32x4 g = *(const f32x4*)(A.in[I_FG] + 4 * F.lane + 256 * j); *(f32x4*)(orow + 256 * j) = v[j] * rstd * g; }
    }
}

__global__ void __launch_bounds__(NWAVES * 64, 2) fwd(Args args) {
    extern __shared__ __attribute__((aligned(16))) unsigned char lds[];
    Frame F;
    F.lds = (LAS unsigned char*)lds; F.ldsg = (char*)lds;
    F.MISC = (volatile LAS unsigned*)(F.lds + MISC_OFF);
    F.tid = threadIdx.x; F.lane = F.tid & 63; F.wave = __builtin_amdgcn_readfirstlane(F.tid >> 6);
    F.G = gridDim.x; { const int bx = blockIdx.x; F.vcu = (F.G % 8 == 0) ? (bx % 8) * (F.G / 8) + bx / 8 : bx; }
    F.ws = args.ws; F.ctl = (gu32*)(args.ws + WS_CTL);
    for (int u = F.tid; u < (LDS_BYTES - LDSCTL_OFF) / 4; u += NWAVES * 64) ((LAS unsigned*)(F.lds + LDSCTL_OFF))[u] = 0u;
    __syncthreads();
#if MK_SPLIT
#define GRID_BAR() do { } while (0)
#else
    XcdBarrier bar = xcd_barrier_post((unsigned*)(F.ctl + CW_BAR), F.MISC + 8);
#define GRID_BAR() xcd_barrier(bar)
#endif
    const int lo = args.ph_lo, hi = args.ph_hi;
#define IN(k) (lo <= (k) && (k) < hi)
#define SEAM(k) do { if (IN(k) && IN((k) + 1)) GRID_BAR(); } while (0)
    const Args& A = args;
    constexpr bool AL = true, SP = true;

#ifndef REP_PHASE
#define REP_PHASE -1
#endif
#define REPN(k) ((REP_PHASE == (k)) ? 2 : 1)
    if (IN(0)) { for (int rep = 0; rep < REPN(0); ++rep) p0_mod(F, A); p0_convert(F, A); } SEAM(0);
    if (IN(1)) { for (int rep = 0; rep < REPN(1); ++rep) p1_modulate(F, A); } SEAM(1);
    if (IN(2)) {
        { pg8::Gemm g{WSP(bf16, WS_U), WSP(bf16, WS_WINT), T, NLB * 1024, DM}; pg8::StaticOrder S; S.init(T, NLB * 1024, F.G, (int)blockIdx.x);
          pg8::EpiQKV E{WSP(bf16, WS_QKV), NQKV, LBMAP, 1.0f};
          pg8::gemm_phase<pg8::EpiQKV, pg8::StaticOrder, AL, SP>(F.lds + RING_OFF, g, S, E); }
        VM_WAIT(); __syncthreads();
        { pg8::Gemm g{WSP(bf16, WS_U8Q), WSP(bf16, WS_WING), T, NLF * 1024, DM / 2}; pg8::StaticOrder S; S.init(T, NLF * 1024, F.G, (int)blockIdx.x);
          pg8::EpiQKV E{WSP(bf16, WS_QKV), NQKV, LFMAP, 1.0f / WSCALE};
          pg8::gemm_phase<pg8::EpiQKV, pg8::StaticOrder, AL, SP, true>(F.lds + RING_OFF, g, S, E); }
    } SEAM(2);
    if (IN(3)) { for (int rep = 0; rep < REPN(3); ++rep) p3_attention(F, A); } SEAM(3);
    if (IN(4)) { for (int rep = 0; rep < REPN(4); ++rep) p4_finalize(F, A); } SEAM(4);
    if (IN(5)) for (int rep = 0; rep < REPN(5); ++rep) {
        { pg8::Gemm g{WSP(bf16, WS_YA), WSP(bf16, WS_WAT), T, DM, 1024}; pg8::StaticOrder S; S.init(T, DM, F.G, (int)blockIdx.x);
          pg8::EpiM1 E{WSP(bf16, WS_M1), WSP(bf16, WS_QKV) + C_GA, NQKV};
          pg8::gemm_phase<pg8::EpiM1, pg8::StaticOrder, AL, SP>(F.lds + RING_OFF, g, S, E); }
        VM_WAIT(); __syncthreads();
        { pg8::Gemm g{WSP(bf16, WS_YB), WSP(bf16, WS_WBT), T, DM, 1024}; pg8::StaticOrder S; S.init(T, DM, F.G, (int)blockIdx.x);
          pg8::EpiMerged E{WSP(bf16, WS_M1), WSP(bf16, WS_QKV) + C_GB, NQKV, WSP(unsigned char, WS_MG)};
          pg8::gemm_phase<pg8::EpiMerged, pg8::StaticOrder, AL, SP>(F.lds + RING_OFF, g, S, E); }
    } SEAM(5);
    if (IN(6)) for (int rep = 0; rep < REPN(6); ++rep) {
        pg8::Gemm g{WSP(bf16, WS_MG), WSP(bf16, WS_WOT), T, DM, DM / 2}; pg8::StaticOrder S; S.init(T, DM, F.G, (int)blockIdx.x);
        pg8::EpiH1 E{A.in[I_X], WSP(float, WS_H1), WSP(float, WS_MOD) + 2 * DM, 12288, SEQ / 256, 1.0f / (16.0f * WSCALE)};
        pg8::gemm_phase<pg8::EpiH1, pg8::StaticOrder, AL, SP, true>(F.lds + RING_OFF, g, S, E);
    } SEAM(6);
    if (IN(7)) { for (int rep = 0; rep < REPN(7); ++rep) p7_router(F, A, rep == 0); } if (IN(7) && IN(9)) GRID_BAR();
    if (IN(9)) for (int rep = 0; rep < REPN(9); ++rep) {
        build_tile_table(F);
        pg8::Gemm g{WSP(bf16, WS_U), WSP(bf16, WS_WGU), TKPAD, NE * 4096, DM / 2}; pg8::MoeOrder S; S.init((const LAS int*)(F.lds + TST_OFF), 16, F.G, (int)blockIdx.x, WSP(int, WS_TOKOF));
        pg8::EpiSwiGLU E{WSP(unsigned char, WS_YACT), A.in[I_BG], A.in[I_BU], 1.0f / WSCALE};
        pg8::gemm_phase<pg8::EpiSwiGLU, pg8::MoeOrder, AL, SP, true, true>(F.lds + RING_OFF, g, S, E);
    } SEAM(9);
    if (IN(10)) for (int rep = 0; rep < REPN(10); ++rep) {
        build_tile_table(F);
        pg8::Gemm g{WSP(bf16, WS_YACT), WSP(bf16, WS_WD), TKPAD, NE * DM, DM / 2}; pg8::MoeOrder S; S.init((const LAS int*)(F.lds + TST_OFF), 8, F.G, (int)blockIdx.x);
        pg8::EpiBf16B E{WSP(bf16, WS_YSLOT), DM, A.in[I_BDN], 8, 1.0f / WSCALE};
        pg8::gemm_phase<pg8::EpiBf16B, pg8::MoeOrder, AL, SP, true>(F.lds + RING_OFF, g, S, E);
    } SEAM(10);
    if (IN(11)) { for (int rep = 0; rep < REPN(11); ++rep) p11_final(F, A); }
#undef IN
#undef SEAM
}
extern "C" void kernel_launch(void* const* d_in, const int* in_sizes, int n_in, void* d_out, int out_size, void* d_ws, size_t ws_size, hipStream_t stream) {
    static int grid = 0;
    if (grid == 0) {
        if (n_in != 24 || in_sizes[0] != T * DM || out_size != T * DM || ws_size < WS_END) { fprintf(stderr, "kernel_launch: shape mismatch (n_in %d, in0 %d, out %d, ws %zu < %zu); nothing launched\n", n_in, n_in > 0 ? in_sizes[0] : -1, out_size, ws_size, (size_t)WS_END); grid = -1; return; }
        int dev = 0, cus = 0, per_cu = 0;
        if (hipGetDevice(&dev) != hipSuccess || hipDeviceGetAttribute(&cus, hipDeviceAttributeMultiprocessorCount, dev) != hipSuccess) { grid = -1; return; }
        if (hipFuncSetAttribute((const void*)fwd, hipFuncAttributeMaxDynamicSharedMemorySize, LDS_BYTES) != hipSuccess) { fprintf(stderr, "kernel_launch: hipFuncSetAttribute failed\n"); grid = -1; return; }
        if (hipOccupancyMaxActiveBlocksPerMultiprocessor(&per_cu, (const void*)fwd, NWAVES * 64, LDS_BYTES) != hipSuccess || per_cu < 1)
            fprintf(stderr, "kernel_launch: note: occupancy query reports %d workgroups per CU\n", per_cu);
        (void)hipGetLastError();
        grid = cus;
    }
    if (grid < 0) return;
    if (hipMemsetAsync((char*)d_ws + WS_CTL, 0, CTL_ZERO_BYTES, stream) != hipSuccess) return;
    Args a; memset(&a, 0, sizeof(a));
    for (int i = 0; i < 24; ++i) a.in[i] = (const float*)d_in[i];
    a.out = (float*)d_out; a.ws = (unsigned char*)d_ws;
#if MK_SPLIT
    for (int ph = 0; ph < N_PHASES; ++ph) { a.ph_lo = ph; a.ph_hi = ph + 1; hipLaunchKernelGGL(fwd, dim3(grid), dim3(NWAVES * 64), LDS_BYTES, stream, a); }
#else
    a.ph_lo = 0; a.ph_hi = N_PHASES; hipLaunchKernelGGL(fwd, dim3(grid), dim3(NWAVES * 64), LDS_BYTES, stream, a);
#endif
    const hipError_t le = hipPeekAtLastError();
    if (le != hipSuccess) fprintf(stderr, "kernel_launch: launch failed: %s\n", hipGetErrorName(le));
}
```

```cpp
#include <hip/hip_runtime.h>
#include <cstdio>
#include <cstdint>
#include <cstring>
#include <cmath>
namespace pg8 {
#define PG8_LAS __attribute__((address_space(3)))
typedef unsigned short bf16_t;
typedef short bf16x8 __attribute__((ext_vector_type(8)));
typedef float f32x4 __attribute__((ext_vector_type(4)));
typedef unsigned u32x4 __attribute__((ext_vector_type(4)));
constexpr int BM = 256, BK = 64, HALF = 128, HTB = HALF * BK * 2  , STAGE_BYTES = 8 * HTB, NXCD = 8, WGM = 8;

__host__ __device__ __forceinline__ int lds_byte(int r, int c) { const int st = (r >> 4) * 2 + (c >> 5), rr = r & 15, cc = c & 31, ob = rr * 64 + cc * 2; return st * 1024 + (ob ^ (((ob >> 9) & 1) << 5)); }
__host__ __device__ __forceinline__ void stage_rc(int b, int& R, int& C) { const int st = b / 1024, sb = b % 1024, swz = sb ^ (((sb >> 9) & 1) << 5); R = (st >> 1) * 16 + swz / 64; C = (st & 1) * 32 + (swz % 64) / 2; }
__host__ __device__ __forceinline__ int perm32(int rho) { const int n = rho >> 4, i = rho & 15; return 8 * (i >> 2) + 4 * n + (i & 3); }

struct Unit { int pm, pn; };
struct Gemm { const bf16_t* A; const bf16_t* Bt; int M, N, K; };

struct StaticOrder {
    int nM, nN, nwg, G, c;
    __host__ __device__ void init(int M, int N, int G_, int c_) { nM = M / BM; nN = N / BM; nwg = nM * nN; G = G_; c = c_; }
    __host__ __device__ bool next(int i, Unit& u) const {
        const long L = (long)i * G + c; if (L >= nwg) return false;
        int wgid = (int)L; { const int q = nwg / NXCD, r = nwg % NXCD, xcd = wgid % NXCD, off = wgid / NXCD; wgid = (xcd < r ? xcd * (q + 1) : r * (q + 1) + (xcd - r) * q) + off; }
        const int nig = WGM * nN, gid = wgid / nig, fm = gid * WGM, gsz = (nM - fm) < WGM ? (nM - fm) : WGM;
        u.pm = fm + ((wgid % nig) % gsz); u.pn = (wgid % nig) / gsz; return true;
    }
    __device__ __forceinline__ void a_ready(const Unit&) const {}
    __device__ __forceinline__ void done(const Unit&) const {}
    __device__ __forceinline__ int arow(const Unit&, int R) const { return R; }
};

__device__ __forceinline__ unsigned cvt_pk_bf16(float lo, float hi) { unsigned r; asm volatile("v_cvt_pk_bf16_f32 %0, %1, %2" : "=v"(r) : "v"(lo), "v"(hi)); return r; }

typedef int v4i_t __attribute__((ext_vector_type(4)));
typedef int v8i_t __attribute__((ext_vector_type(8)));
template <class Epi, class Sched, bool ALIGN_EPI = false, bool SP2 = false, bool F8 = false, bool GATHER = false>
__device__ __forceinline__ void gemm_phase(PG8_LAS unsigned char* lds, const Gemm g, const Sched& S, const Epi& E) {
    int tid = threadIdx.x; asm volatile("" : "+v"(tid));
    const int wid = __builtin_amdgcn_readfirstlane(tid >> 6), lane = tid & 63, wr = wid >> 2, wc = wid & 3, fr = lane & 15, fq = lane >> 4;
    const int K = g.K, nt = K / BK;
    unsigned voffA[2], voffB[2];
#pragma unroll
    for (int i = 0; i < 2; ++i) { int R, C; stage_rc(tid * 16 + i * 8192, R, C); const int Rb = Epi::PERM ? ((R & ~31) + perm32(R & 31)) : R;
        voffA[i] = (unsigned)(R * K + C) * 2u; voffB[i] = (unsigned)(Rb * K + C) * 2u; }
    static_assert(!GATHER || SP2, "the gather form is written for the two-super-phase loop");
    unsigned vo[2][2], nvo[2][2];
#define PG8_SETVO(dst, u) do { _Pragma("unroll") for (int _h = 0; _h < 2; ++_h) _Pragma("unroll") for (int _i = 0; _i < 2; ++_i) { \
        if constexpr (GATHER) { int R_, C_; stage_rc(tid * 16 + _i * 8192, R_, C_); dst[_h][_i] = (unsigned)(S.arow(u, R_ + HALF * _h) * K + C_) * 2u; } \
        else dst[_h][_i] = voffA[_i] + (unsigned)_h * (unsigned)(HALF * K * 2); } } while (0)
    const size_t kstep = (size_t)(BK * 2);
    const size_t hstep = (size_t)HALF * K * 2;
    const size_t tstep = 2 * hstep;
    const unsigned ldsw = (unsigned)wid * 1024u;
    const int aoff = lds_byte(wr * 64 + fr, fq * 8), boff = lds_byte(wc * 32 + fr, fq * 8);
#define PG8_SA(b, h) (((b) * 2 + (h)) * HTB)
#define PG8_SB(b, h) ((4 + (b) * 2 + (h)) * HTB)
#define PG8_STAGE(bufoff, gbase, voff) do { _Pragma("unroll") for (int _i = 0; _i < 2; ++_i) \
        __builtin_amdgcn_global_load_lds((const unsigned*)((const char*)(gbase) + (voff)[_i]), (PG8_LAS unsigned*)(lds + (bufoff) + ldsw + _i * 8192), 16, 0, 0); } while (0)
#define PG8_LDA(dst, b, h) do { _Pragma("unroll") for (int m = 0; m < 4; ++m) _Pragma("unroll") for (int k = 0; k < 2; ++k) dst[m][k] = *(const PG8_LAS bf16x8*)(lds + PG8_SA(b, h) + aoff + m * 2048 + k * 1024); } while (0)
#define PG8_LDB(dst, b, h) do { _Pragma("unroll") for (int n = 0; n < 2; ++n) _Pragma("unroll") for (int k = 0; k < 2; ++k) dst[n][k] = *(const PG8_LAS bf16x8*)(lds + PG8_SB(b, h) + boff + n * 2048 + k * 1024); } while (0)
#define PG8_MMA(ai, bj, At, Bt) do { __builtin_amdgcn_s_setprio(1); _Pragma("unroll") for (int m = 0; m < 4; ++m) _Pragma("unroll") for (int n = 0; n < 2; ++n) { \
        if constexpr (F8) { const v8i_t _b = __builtin_shufflevector(__builtin_bit_cast(v4i_t, Bt[n][0]), __builtin_bit_cast(v4i_t, Bt[n][1]), 0, 1, 2, 3, 4, 5, 6, 7); \
            const v8i_t _a = __builtin_shufflevector(__builtin_bit_cast(v4i_t, At[m][0]), __builtin_bit_cast(v4i_t, At[m][1]), 0, 1, 2, 3, 4, 5, 6, 7); \
            asm volatile("v_mfma_scale_f32_16x16x128_f8f6f4 %0, %1, %2, %0, %3, %3 op_sel_hi:[0,0,0]" : "+v"(acc[ai][bj][m][n]) : "v"(_b), "v"(_a), "v"(f8scale)); } \
        else { _Pragma("unroll") for (int k = 0; k < 2; ++k) acc[ai][bj][m][n] = __builtin_amdgcn_mfma_f32_16x16x32_bf16(Bt[n][k], At[m][k], acc[ai][bj][m][n], 0, 0, 0); } } \
        __builtin_amdgcn_s_setprio(0); } while (0)
#define PG8_WAIT_V(n) asm volatile("s_waitcnt vmcnt(" #n ")" ::: "memory")
#define PG8_WAIT_L(n) asm volatile("s_waitcnt lgkmcnt(" #n ")" ::: "memory")
#define PG8_BAR __builtin_amdgcn_s_barrier()
#define PG8_SCHED __builtin_amdgcn_sched_barrier(0)
    Unit cur, nxt; int ui = 0;
    if (!S.next(0, cur)) return;
    const int f8scale = 0x7f7f7f7f;
    f32x4 acc[2][2][4][2];
#pragma unroll
    for (int a = 0; a < 2; ++a)
#pragma unroll
        for (int b = 0; b < 2; ++b)
#pragma unroll
            for (int m = 0; m < 4; ++m)
#pragma unroll
                for (int n = 0; n < 2; ++n) acc[a][b][m][n] = (f32x4){0.f, 0.f, 0.f, 0.f};
    bf16x8 At[4][2], B0[2][2], B1[2][2];
    const char* cA = (const char*)g.A + (GATHER ? (size_t)0 : (size_t)cur.pm * tstep); const char* cB = (const char*)g.Bt + (size_t)cur.pn * tstep;
    PG8_SETVO(vo, cur);
    S.a_ready(cur);
    if constexpr (SP2) {
        PG8_STAGE(PG8_SB(0, 0), cB, voffB); PG8_STAGE(PG8_SB(0, 1), cB + hstep, voffB); PG8_STAGE(PG8_SA(0, 0), cA, vo[0]); PG8_STAGE(PG8_SA(0, 1), cA, vo[1]);
        if (wr == 1) PG8_BAR;
        PG8_WAIT_V(2); PG8_BAR;
        PG8_STAGE(PG8_SB(1, 0), cB + kstep, voffB); PG8_STAGE(PG8_SA(1, 0), cA + kstep, vo[0]); PG8_STAGE(PG8_SB(1, 1), cB + hstep + kstep, voffB);
        PG8_WAIT_V(6); PG8_BAR;
    } else {
        PG8_STAGE(PG8_SB(0, 0), cB, voffB); PG8_STAGE(PG8_SA(0, 0), cA, vo[0]); PG8_STAGE(PG8_SB(0, 1), cB + hstep, voffB); PG8_STAGE(PG8_SA(0, 1), cA, vo[1]);
        if (wr == 1) PG8_BAR;
        PG8_WAIT_V(4); PG8_BAR;
        PG8_STAGE(PG8_SB(1, 0), cB + kstep, voffB); PG8_STAGE(PG8_SA(1, 0), cA + kstep, vo[0]); PG8_STAGE(PG8_SB(1, 1), cB + hstep + kstep, voffB);
        PG8_WAIT_V(6); PG8_BAR;
    }
    for (;;) {
        const bool has_next = S.next(ui + 1, nxt);
        const char* nA = (has_next && !GATHER) ? (const char*)g.A + (size_t)nxt.pm * tstep : cA; const char* nB = has_next ? (const char*)g.Bt + (size_t)nxt.pn * tstep : cB;
        if (has_next) { PG8_SETVO(nvo, nxt); } else {
#pragma unroll
            for (int _h = 0; _h < 2; ++_h)
#pragma unroll
                for (int _i = 0; _i < 2; ++_i) nvo[_h][_i] = vo[_h][_i]; }
        for (int t = 0; t < nt; t += 2) {
            const bool last = (t == nt - 2);
            const char* a1 = cA + (size_t)(t + 1) * kstep;
            const char* a2 = last ? nA : cA + (size_t)(t + 2) * kstep; const char* b2 = last ? nB : cB + (size_t)(t + 2) * kstep;
            const char* a3 = a2 + kstep; const char* b3 = b2 + kstep;
            unsigned s0[2], s1[2];
#pragma unroll
            for (int _i = 0; _i < 2; ++_i) { s0[_i] = last ? nvo[0][_i] : vo[0][_i]; s1[_i] = last ? nvo[1][_i] : vo[1][_i]; }
            if (last && has_next) S.a_ready(nxt);
            if constexpr (SP2) {
            PG8_LDB(B0, 0, 0); PG8_LDB(B1, 0, 1); PG8_SCHED; PG8_LDA(At, 0, 0); PG8_STAGE(PG8_SA(1, 1), a1, vo[1]);
            PG8_WAIT_V(8); PG8_WAIT_L(0); PG8_BAR; PG8_MMA(0, 0, At, B0); PG8_MMA(0, 1, At, B1); PG8_BAR; PG8_SCHED;
            PG8_LDA(At, 0, 1); PG8_STAGE(PG8_SB(0, 0), b2, voffB); PG8_STAGE(PG8_SB(0, 1), b2 + hstep, voffB); PG8_STAGE(PG8_SA(0, 0), a2, s0);
            PG8_WAIT_V(8); PG8_WAIT_L(0); PG8_BAR; PG8_MMA(1, 0, At, B0); PG8_MMA(1, 1, At, B1); PG8_BAR; PG8_SCHED;
            PG8_LDB(B0, 1, 0); PG8_LDB(B1, 1, 1); PG8_SCHED; PG8_LDA(At, 1, 0); PG8_STAGE(PG8_SA(0, 1), a2, s1);
            PG8_WAIT_V(8); PG8_WAIT_L(0); PG8_BAR; PG8_MMA(0, 0, At, B0); PG8_MMA(0, 1, At, B1); PG8_BAR; PG8_SCHED;
            PG8_LDA(At, 1, 1); PG8_STAGE(PG8_SB(1, 0), b3, voffB); PG8_STAGE(PG8_SB(1, 1), b3 + hstep, voffB); PG8_STAGE(PG8_SA(1, 0), a3, s0);
            PG8_WAIT_V(8); PG8_WAIT_L(0); PG8_BAR; PG8_MMA(1, 0, At, B0); PG8_MMA(1, 1, At, B1); PG8_BAR; PG8_SCHED;
            } else {
            PG8_LDB(B0, 0, 0); PG8_SCHED; PG8_LDA(At, 0, 0); PG8_STAGE(PG8_SA(1, 1), a1, vo[1]);
            PG8_WAIT_L(8); PG8_BAR; PG8_WAIT_L(0); PG8_MMA(0, 0, At, B0); PG8_BAR; PG8_SCHED;
            PG8_LDB(B1, 0, 1); PG8_STAGE(PG8_SB(0, 0), b2, voffB);
            PG8_BAR; PG8_WAIT_L(0); PG8_MMA(0, 1, At, B1); PG8_BAR;
            PG8_LDA(At, 0, 1); PG8_STAGE(PG8_SA(0, 0), a2, s0);
            PG8_BAR; PG8_WAIT_L(0); PG8_MMA(1, 0, At, B0); PG8_BAR; PG8_SCHED;
            PG8_STAGE(PG8_SB(0, 1), b2 + hstep, voffB);
            PG8_WAIT_V(6); PG8_BAR; PG8_MMA(1, 1, At, B1); PG8_BAR;
            PG8_LDB(B0, 1, 0); PG8_SCHED; PG8_LDA(At, 1, 0); PG8_STAGE(PG8_SA(0, 1), a2, s1);
            PG8_WAIT_L(8); PG8_BAR; PG8_WAIT_L(0); PG8_MMA(0, 0, At, B0); PG8_BAR; PG8_SCHED;
            PG8_LDB(B1, 1, 1); PG8_STAGE(PG8_SB(1, 0), b3, voffB);
            PG8_BAR; PG8_WAIT_L(0); PG8_MMA(0, 1, At, B1); PG8_BAR;
            PG8_LDA(At, 1, 1); PG8_STAGE(PG8_SA(1, 0), a3, s0);
            PG8_BAR; PG8_WAIT_L(0); PG8_MMA(1, 0, At, B0); PG8_BAR; PG8_SCHED;
            PG8_STAGE(PG8_SB(1, 1), b3 + hstep, voffB);
            PG8_WAIT_V(6); PG8_BAR; PG8_MMA(1, 1, At, B1); PG8_BAR;
            }
        }
        if constexpr (F8) asm volatile("s_nop 15\n\ts_nop 7" ::: "memory");
        if constexpr (ALIGN_EPI) { if (wr == 0) PG8_BAR; }
        if constexpr (!Epi::AFTER_DRAIN) { E(acc, cur, wr, wc, fr, fq); S.done(cur); }
        if (!has_next) break;
#pragma unroll
        for (int a = 0; a < 2; ++a)
#pragma unroll
            for (int b = 0; b < 2; ++b)
#pragma unroll
                for (int m = 0; m < 4; ++m)
#pragma unroll
                    for (int n = 0; n < 2; ++n) acc[a][b][m][n] = (f32x4){0.f, 0.f, 0.f, 0.f};
        cur = nxt; cA = nA; cB = nB; ++ui;
#pragma unroll
        for (int _h = 0; _h < 2; ++_h)
#pragma unroll
            for (int _i = 0; _i < 2; ++_i) vo[_h][_i] = nvo[_h][_i];
        if constexpr (ALIGN_EPI) { if (wr == 1) PG8_BAR; }
    }
    PG8_WAIT_V(0);
    if constexpr (!ALIGN_EPI) { if (wr == 0) PG8_BAR; }
    PG8_BAR;
    if constexpr (Epi::AFTER_DRAIN) { E.fused(acc, cur, wr, wc, fr, fq, lds, wid, lane); S.done(cur); }
#undef PG8_SA
#undef PG8_SETVO
#undef PG8_SB
#undef PG8_STAGE
#undef PG8_LDA
#undef PG8_LDB
#undef PG8_MMA
#undef PG8_WAIT_V
#undef PG8_WAIT_L
#undef PG8_BAR
#undef PG8_SCHED
}
}
namespace pg8 {
typedef float f32x2e __attribute__((ext_vector_type(2)));
__device__ __forceinline__ float bf_lo(unsigned w) { return __uint_as_float(w << 16); }
__device__ __forceinline__ float bf_hi(unsigned w) { return __uint_as_float(w & 0xffff0000u); }
__device__ __forceinline__ float sigmoidf_fast(float x) { return __builtin_amdgcn_rcpf(1.0f + __expf(-x)); }

struct EpiBf16B {
    static constexpr bool PERM = true, AFTER_DRAIN = false;
    bf16_t* O; int ldc; const float* bias; int ntile_mod; float scale;
    __device__ __forceinline__ void operator()(const f32x4 (&acc)[2][2][4][2], const Unit& u, int wr, int wc, int fr, int fq) const {
        const int row0 = u.pm * BM + wr * 64 + fr; const int colt = (u.pn % ntile_mod) * BM;
        const int col0 = colt + wc * 32 + 8 * fq, bcol0 = u.pn * BM + wc * 32 + 8 * fq;
        f32x4 bv[2][2];
#pragma unroll
        for (int bj = 0; bj < 2; ++bj)
#pragma unroll
            for (int n = 0; n < 2; ++n) bv[bj][n] = bias ? *(const f32x4*)(bias + bcol0 + bj * HALF + 4 * n) : (f32x4){0.f, 0.f, 0.f, 0.f};
#pragma unroll
        for (int ai = 0; ai < 2; ++ai)
#pragma unroll
            for (int m = 0; m < 4; ++m) { bf16_t* rowp = O + (size_t)(row0 + ai * HALF + m * 16) * ldc + col0;
#pragma unroll
                for (int bj = 0; bj < 2; ++bj) { const f32x4 v0 = acc[ai][bj][m][0] * scale + bv[bj][0], v1 = acc[ai][bj][m][1] * scale + bv[bj][1];
                    u32x4 w; w.x = cvt_pk_bf16(v0[0], v0[1]); w.y = cvt_pk_bf16(v0[2], v0[3]); w.z = cvt_pk_bf16(v1[0], v1[1]); w.w = cvt_pk_bf16(v1[2], v1[3]);
                    *(u32x4*)(rowp + bj * HALF) = w; } }
    }
};
struct EpiQKV {
    static constexpr bool PERM = true, AFTER_DRAIN = false;
    bf16_t* O; int ldc; unsigned long long gmap; float scale;
    __device__ __forceinline__ void operator()(const f32x4 (&acc)[2][2][4][2], const Unit& u, int wr, int wc, int fr, int fq) const {
        const int og = (int)((gmap >> (4 * (u.pn >> 2))) & 15ull); const bool sg = og >= 6;
        const int row0 = u.pm * BM + wr * 64 + fr; const int col0 = (og * 4 + (u.pn & 3)) * BM + wc * 32 + 8 * fq;
#pragma unroll
        for (int ai = 0; ai < 2; ++ai)
#pragma unroll
            for (int m = 0; m < 4; ++m) { bf16_t* rowp = O + (size_t)(row0 + ai * HALF + m * 16) * ldc + col0;
#pragma unroll
                for (int bj = 0; bj < 2; ++bj) { f32x4 v0 = acc[ai][bj][m][0] * scale, v1 = acc[ai][bj][m][1] * scale;
                    if (sg) {
#pragma unroll
                        for (int i = 0; i < 4; ++i) { v0[i] = sigmoidf_fast(v0[i]); v1[i] = sigmoidf_fast(v1[i]); } }
                    u32x4 w; w.x = cvt_pk_bf16(v0[0], v0[1]); w.y = cvt_pk_bf16(v0[2], v0[3]); w.z = cvt_pk_bf16(v1[0], v1[1]); w.w = cvt_pk_bf16(v1[2], v1[3]);
                    *(u32x4*)(rowp + bj * HALF) = w; } }
    }
};
struct EpiM1 {
    static constexpr bool PERM = true, AFTER_DRAIN = false;
    bf16_t* M1; const bf16_t* G; int ldg;
    __device__ __forceinline__ void operator()(const f32x4 (&acc)[2][2][4][2], const Unit& u, int wr, int wc, int fr, int fq) const {
        const int row0 = u.pm * BM + wr * 64 + fr; const int col0 = u.pn * BM + wc * 32 + 8 * fq;
#pragma unroll
        for (int ai = 0; ai < 2; ++ai)
#pragma unroll
            for (int m = 0; m < 4; ++m) { const size_t row = (size_t)(row0 + ai * HALF + m * 16);
#pragma unroll
                for (int bj = 0; bj < 2; ++bj) { const int col = col0 + bj * HALF; const u32x4 g = *(const u32x4*)(G + row * ldg + col);
                    const f32x4 a0 = acc[ai][bj][m][0], a1 = acc[ai][bj][m][1];
                    const f32x4 o0 = {a0[0] * bf_lo(g.x), a0[1] * bf_hi(g.x), a0[2] * bf_lo(g.y), a0[3] * bf_hi(g.y)};
                    const f32x4 o1 = {a1[0] * bf_lo(g.z), a1[1] * bf_hi(g.z), a1[2] * bf_lo(g.w), a1[3] * bf_hi(g.w)};
                    u32x4 w; w.x = cvt_pk_bf16(o0[0], o0[1]); w.y = cvt_pk_bf16(o0[2], o0[3]); w.z = cvt_pk_bf16(o1[0], o1[1]); w.w = cvt_pk_bf16(o1[2], o1[3]);
                    *(u32x4*)(M1 + row * 2048 + col) = w; } }
    }
};
struct EpiMerged {
    static constexpr bool PERM = true, AFTER_DRAIN = false;
    const bf16_t* M1; const bf16_t* G; int ldg; unsigned char* MG;
    __device__ __forceinline__ void operator()(const f32x4 (&acc)[2][2][4][2], const Unit& u, int wr, int wc, int fr, int fq) const {
        const int row0 = u.pm * BM + wr * 64 + fr; const int col0 = u.pn * BM + wc * 32 + 8 * fq;
#pragma unroll
        for (int ai = 0; ai < 2; ++ai)
#pragma unroll
            for (int m = 0; m < 4; ++m) { const size_t row = (size_t)(row0 + ai * HALF + m * 16);
#pragma unroll
                for (int bj = 0; bj < 2; ++bj) { const int col = col0 + bj * HALF; const u32x4 g = *(const u32x4*)(G + row * ldg + col);
                    const u32x4 mw = *(const u32x4*)(M1 + row * 2048 + col);
                    const f32x4 m0 = {bf_lo(mw.x), bf_hi(mw.x), bf_lo(mw.y), bf_hi(mw.y)}, m1 = {bf_lo(mw.z), bf_hi(mw.z), bf_lo(mw.w), bf_hi(mw.w)};
                    const f32x4 a0 = acc[ai][bj][m][0], a1 = acc[ai][bj][m][1];
                    const f32x4 o0 = {m0[0] + a0[0] * bf_lo(g.x), m0[1] + a0[1] * bf_hi(g.x), m0[2] + a0[2] * bf_lo(g.y), m0[3] + a0[3] * bf_hi(g.y)};
                    const f32x4 o1 = {m1[0] + a1[0] * bf_lo(g.z), m1[1] + a1[1] * bf_hi(g.z), m1[2] + a1[2] * bf_lo(g.w), m1[3] + a1[3] * bf_hi(g.w)};
                    int w0 = __builtin_amdgcn_cvt_pk_fp8_f32(o0[0] * 16.f, o0[1] * 16.f, 0, false); w0 = __builtin_amdgcn_cvt_pk_fp8_f32(o0[2] * 16.f, o0[3] * 16.f, w0, true);
                    int w1 = __builtin_amdgcn_cvt_pk_fp8_f32(o1[0] * 16.f, o1[1] * 16.f, 0, false); w1 = __builtin_amdgcn_cvt_pk_fp8_f32(o1[2] * 16.f, o1[3] * 16.f, w1, true);
                    typedef int v2i_m __attribute__((ext_vector_type(2))); *(v2i_m*)(MG + row * 2048 + col) = (v2i_m){w0, w1}; } }
    }
};
struct EpiMergedB {
    static constexpr bool PERM = true, AFTER_DRAIN = false;
    const bf16_t* M1; const bf16_t* G; int ldg; bf16_t* MG;
    __device__ __forceinline__ void operator()(const f32x4 (&acc)[2][2][4][2], const Unit& u, int wr, int wc, int fr, int fq) const {
        const int row0 = u.pm * BM + wr * 64 + fr; const int col0 = u.pn * BM + wc * 32 + 8 * fq;
#pragma unroll
        for (int ai = 0; ai < 2; ++ai)
#pragma unroll
            for (int m = 0; m < 4; ++m) { const size_t row = (size_t)(row0 + ai * HALF + m * 16);
#pragma unroll
                for (int bj = 0; bj < 2; ++bj) { const int col = col0 + bj * HALF; const u32x4 g = *(const u32x4*)(G + row * ldg + col);
                    const u32x4 mw = *(const u32x4*)(M1 + row * 2048 + col);
                    const f32x4 m0 = {bf_lo(mw.x), bf_hi(mw.x), bf_lo(mw.y), bf_hi(mw.y)}, m1 = {bf_lo(mw.z), bf_hi(mw.z), bf_lo(mw.w), bf_hi(mw.w)};
                    const f32x4 a0 = acc[ai][bj][m][0], a1 = acc[ai][bj][m][1];
                    const f32x4 o0 = {m0[0] + a0[0] * bf_lo(g.x), m0[1] + a0[1] * bf_hi(g.x), m0[2] + a0[2] * bf_lo(g.y), m0[3] + a0[3] * bf_hi(g.y)};
                    const f32x4 o1 = {m1[0] + a1[0] * bf_lo(g.z), m1[1] + a1[1] * bf_hi(g.z), m1[2] + a1[2] * bf_lo(g.w), m1[3] + a1[3] * bf_hi(g.w)};
                    u32x4 w; w.x = cvt_pk_bf16(o0[0], o0[1]); w.y = cvt_pk_bf16(o0[2], o0[3]); w.z = cvt_pk_bf16(o1[0], o1[1]); w.w = cvt_pk_bf16(o1[2], o1[3]);
                    *(u32x4*)(MG + row * 2048 + col) = w; } }
    }
};
struct EpiH1 {
    static constexpr bool PERM = false, AFTER_DRAIN = false;
    const float* X; float* H1; const float* g1; int g1_stride; int tiles_per_batch; float wscale;
    __device__ __forceinline__ void operator()(const f32x4 (&acc)[2][2][4][2], const Unit& u, int wr, int wc, int fr, int fq) const {
        const int row0 = u.pm * BM + wr * 64 + fr; const int col0 = u.pn * BM + wc * 32 + 4 * fq; const float* gb = g1 + (size_t)(u.pm / tiles_per_batch) * g1_stride;
        f32x4 gv[2][2];
#pragma unroll
        for (int bj = 0; bj < 2; ++bj)
#pragma unroll
            for (int n = 0; n < 2; ++n) gv[bj][n] = *(const f32x4*)(gb + col0 + bj * HALF + n * 16);
#pragma unroll
        for (int ai = 0; ai < 2; ++ai)
#pragma unroll
            for (int m = 0; m < 4; ++m) { const size_t off = (size_t)(row0 + ai * HALF + m * 16) * 2048 + col0;
#pragma unroll
                for (int bj = 0; bj < 2; ++bj)
#pragma unroll
                    for (int n = 0; n < 2; ++n) { const f32x4 xv = *(const f32x4*)(X + off + bj * HALF + n * 16);
                        *(f32x4*)(H1 + off + bj * HALF + n * 16) = xv + gv[bj][n] * (acc[ai][bj][m][n] * wscale); } }
    }
};
struct EpiSwiGLU {
    static constexpr bool PERM = true, AFTER_DRAIN = false;
    unsigned char* Y; const float* bg; const float* bu; float wscale;
    __device__ __forceinline__ void operator()(const f32x4 (&acc)[2][2][4][2], const Unit& u, int wr, int wc, int fr, int fq) const {
        const int e = u.pn >> 4, pnl = u.pn & 15; const int row0 = u.pm * BM + wr * 64 + fr; const int col0 = pnl * HALF + wc * 32 + 8 * fq;
        f32x4 bgv[2], buv[2];
#pragma unroll
        for (int n = 0; n < 2; ++n) { bgv[n] = *(const f32x4*)(bg + (size_t)e * 2048 + col0 + 4 * n); buv[n] = *(const f32x4*)(bu + (size_t)e * 2048 + col0 + 4 * n); }
#pragma unroll
        for (int ai = 0; ai < 2; ++ai)
#pragma unroll
            for (int m = 0; m < 4; ++m) { unsigned char* rowp = Y + (size_t)(row0 + ai * HALF + m * 16) * 2048 + col0; f32x4 y[2];
#pragma unroll
                for (int n = 0; n < 2; ++n) { const f32x4 g4 = acc[ai][0][m][n] * wscale + bgv[n], u4 = acc[ai][1][m][n] * wscale + buv[n];
                    f32x4 gc, uc, ex;
#pragma unroll
                    for (int i = 0; i < 4; ++i) { gc[i] = fminf(g4[i], 7.0f); uc[i] = __builtin_amdgcn_fmed3f(u4[i], -7.0f, 7.0f); }
                    const f32x4 t = gc * (-1.702f * 1.4426950408889634f);
#pragma unroll
                    for (int i = 0; i < 4; ++i) ex[i] = __builtin_amdgcn_rcpf(1.0f + __builtin_amdgcn_exp2f(t[i]));
                    y[n] = (uc + 1.0f) * (gc * ex); }
                int w0 = __builtin_amdgcn_cvt_pk_fp8_f32(y[0][0], y[0][1], 0, false); w0 = __builtin_amdgcn_cvt_pk_fp8_f32(y[0][2], y[0][3], w0, true);
                int w1 = __builtin_amdgcn_cvt_pk_fp8_f32(y[1][0], y[1][1], 0, false); w1 = __builtin_amdgcn_cvt_pk_fp8_f32(y[1][2], y[1][3], w1, true);
                typedef int v2i_t __attribute__((ext_vector_type(2))); *(v2i_t*)rowp = (v2i_t){w0, w1}; }
    }
};
struct MoeOrder {
    const PG8_LAS int* tstart; int npn, lo, hi, rank, W; const int* tokof;
    __device__ __forceinline__ int arow(const Unit& u, int R) const { const int e = u.pn / npn, slot = (u.pm - tstart[e]) * 256 + R;
        return slot < tstart[40 + e] ? tokof[e * 8192 + slot] : 0; }
    __device__ __forceinline__ void init(const PG8_LAS int* ts, int npn_, int G, int c, const int* tk = nullptr) { tstart = ts; npn = npn_; tokof = tk; const int U = ts[32] * npn_; const int x = c % NXCD; rank = c / NXCD; W = G / NXCD;
        lo = (int)(((long)U * x) / NXCD); hi = (int)(((long)U * (x + 1)) / NXCD); }
    __device__ __forceinline__ bool next(int i, Unit& u) const {
        const int q = lo + rank + W * i; if (q >= hi) return false;
        const int lk = (int)(threadIdx.x & 31u);
        const int e = __builtin_popcountll(__ballot(tstart[lk] * npn <= q) & 0xffffffffull) - 1;
        const int ts = tstart[e], te = tstart[e + 1] - ts, qq = q - ts * npn;
        u.pm = ts + qq % te; u.pn = e * npn + qq / te; return true;
    }
    __device__ __forceinline__ void a_ready(const Unit&) const {}
    __device__ __forceinline__ void done(const Unit&) const {}
};
}
namespace att {
using bf16x8 = __attribute__((ext_vector_type(8))) short;
using s16x4  = __attribute__((ext_vector_type(4))) short;
using f32x16 = __attribute__((ext_vector_type(16))) float;
using u32x4  = __attribute__((ext_vector_type(4))) unsigned;
using f32x4v = __attribute__((ext_vector_type(4))) float;
typedef unsigned short bf16;
constexpr int   D = 128, NW = 8, QBLK = 32, KVBLK = 64;
constexpr float SCALE = 0.088388347648318440f;
constexpr float THR = 8.f;
constexpr size_t SHM_V = KVBLK * D * 2, SHM_K = KVBLK * D * 2, SHM_ATTN = 2 * SHM_V + 2 * SHM_K + NW * 64 * 4;
#define KSWZ(row, colB) ((row) * 256 + ((colB) ^ (((row) & 7) << 4)))
#define SBAR() __builtin_amdgcn_sched_barrier(0)
__device__ __forceinline__ int crow(int r, int hi) { return (r & 3) + 8 * (r >> 2) + 4 * hi; }
__device__ __forceinline__ unsigned cvtpk(float lo, float hi) { unsigned r; asm volatile("v_cvt_pk_bf16_f32 %0, %1, %2" : "=v"(r) : "v"(lo), "v"(hi)); return r; }

template <int MODE>
__device__ __forceinline__ void partialSM(f32x16& p0, f32x16& p1, float& m_reg, float& mn, float& alpha, float relb, float kk, bool valid, int side = 0) {
  constexpr float C = SCALE * 1.4426950408889634f;
  float base = 0.f;
  if (MODE == 0 && side != 0) {
    const float skk = side > 0 ? kk : -kk; base = -skk * relb;
#pragma unroll
    for (int r = 0; r < 16; ++r) { p0[r] = fmaf(skk, (float)((r & 3) + 8 * (r >> 2)), p0[r]); p1[r] = fmaf(skk, (float)((r & 3) + 8 * (r >> 2) + 32), p1[r]); }
  } else {
#pragma unroll
    for (int r = 0; r < 16; ++r) {
      const float d0 = relb - (float)((r & 3) + 8 * (r >> 2)), a0 = __builtin_fabsf(d0), a1 = __builtin_fabsf(d0 - 32.f);
      p0[r] = fmaf(a0, -kk, p0[r]); p1[r] = fmaf(a1, -kk, p1[r]);
      if (MODE == 1) { if (!(valid && a0 <= 64.f)) p0[r] = -INFINITY; if (!(valid && a1 <= 64.f)) p1[r] = -INFINITY; }
    }
  }
  float pmax = p0[0];
#pragma unroll
  for (int r = 1; r < 16; ++r) pmax = fmaxf(pmax, p0[r]);
#pragma unroll
  for (int r = 0; r < 16; ++r) pmax = fmaxf(pmax, p1[r]);
  { auto rr = __builtin_amdgcn_permlane32_swap(__float_as_uint(pmax), __float_as_uint(pmax), false, false);
    pmax = fmaxf(__uint_as_float(rr[0]), __uint_as_float(rr[1])); }
  pmax += base;
  if (__builtin_expect(__all(pmax - m_reg <= THR / SCALE), 1)) { mn = m_reg; alpha = 1.f; }
  else { mn = fmaxf(m_reg, pmax); alpha = __builtin_amdgcn_exp2f((m_reg - mn) * C); m_reg = mn; }
  const float mnC = (base - mn) * C;
#pragma unroll
  for (int r = 0; r < 16; ++r) p0[r] = fmaf(p0[r], C, mnC);
#pragma unroll
  for (int r = 0; r < 16; ++r) p1[r] = fmaf(p1[r], C, mnC);
#pragma unroll
  for (int r = 0; r < 16; ++r) p0[r] = __builtin_amdgcn_exp2f(p0[r]);
}
__device__ __forceinline__ void finishSM(f32x16& p0, f32x16& p1, float alpha, float& l_reg, bf16x8& pa0, bf16x8& pa1, bf16x8& pa2, bf16x8& pa3) {
#pragma unroll
  for (int r = 0; r < 16; ++r) p1[r] = __builtin_amdgcn_exp2f(p1[r]);
  float ps = 0;
#pragma unroll
  for (int r = 0; r < 16; ++r) ps += p0[r];
#pragma unroll
  for (int r = 0; r < 16; ++r) ps += p1[r];
  { auto rr = __builtin_amdgcn_permlane32_swap(__float_as_uint(ps), __float_as_uint(ps), false, false);
    ps = __uint_as_float(rr[0]) + __uint_as_float(rr[1]); }
  l_reg = l_reg * alpha + ps;
#define PK4(P, BASE, OUT) do { unsigned a0 = cvtpk(P[BASE + 0], P[BASE + 1]), a1 = cvtpk(P[BASE + 2], P[BASE + 3]);   \
    unsigned b0 = cvtpk(P[BASE + 4], P[BASE + 5]), b1 = cvtpk(P[BASE + 6], P[BASE + 7]);                              \
    auto r0 = __builtin_amdgcn_permlane32_swap(a0, b0, false, false); auto r1 = __builtin_amdgcn_permlane32_swap(a1, b1, false, false); \
    u32x4 w = {r0[0], r1[0], r0[1], r1[1]}; OUT = *reinterpret_cast<bf16x8*>(&w); } while (0)
  PK4(p0, 0, pa0); PK4(p0, 8, pa1); PK4(p1, 0, pa2); PK4(p1, 8, pa3);
#undef PK4
}
__device__ __forceinline__ void qkt(f32x16& p0, f32x16& p1, const bf16* Ks, const bf16x8* qr, int r32, int hi) {
  p0 = f32x16{}; p1 = f32x16{};
#pragma unroll
  for (int d0 = 0; d0 < 8; ++d0) { const int cb = (d0 * 16 + hi * 8) * 2;
    bf16x8 b0 = *reinterpret_cast<const bf16x8*>((const char*)Ks + KSWZ(r32, cb));
    bf16x8 b1 = *reinterpret_cast<const bf16x8*>((const char*)Ks + KSWZ(32 + r32, cb));
    p0 = __builtin_amdgcn_mfma_f32_32x32x16_bf16(b0, qr[d0], p0, 0, 0, 0);
    p1 = __builtin_amdgcn_mfma_f32_32x32x16_bf16(b1, qr[d0], p1, 0, 0, 0); }
}
__device__ __forceinline__ int v_st(int k, int c) { const int kk = (k & ~0xC) | ((k & 4) << 1) | ((k & 8) >> 1); return ((kk >> 3) * 4 + (c >> 5)) * 512 + ((kk & 7) * 32 + (c & 31)) * 2; }
__device__ __forceinline__ int v_rd_base(int lane) { return ((lane & 3) << 3) | (((lane >> 2) & 3) << 6) | (((lane >> 4) & 1) << 5) | (((lane >> 5) & 1) << 8); }
constexpr int v_rd_off(int d0, int ks, int half) { return d0 * 512 + ks * 4096 + half * 2048; }
template <int OFF> __device__ __forceinline__ s16x4 tr_read(int vb) {
  s16x4 r; asm volatile("ds_read_b64_tr_b16 %0, %1 offset:%2" : "=&v"(r) : "v"(vb), "i"(OFF) : "memory"); return r;
}
template <int D0> __device__ __forceinline__ void pv_one(f32x16& od, int vb, bf16x8 pa0, bf16x8 pa1, bf16x8 pa2, bf16x8 pa3) {
  const s16x4 l0 = tr_read<v_rd_off(D0, 0, 0)>(vb), h0 = tr_read<v_rd_off(D0, 0, 1)>(vb), l1 = tr_read<v_rd_off(D0, 1, 0)>(vb), h1 = tr_read<v_rd_off(D0, 1, 1)>(vb);
  const s16x4 l2 = tr_read<v_rd_off(D0, 2, 0)>(vb), h2 = tr_read<v_rd_off(D0, 2, 1)>(vb), l3 = tr_read<v_rd_off(D0, 3, 0)>(vb), h3 = tr_read<v_rd_off(D0, 3, 1)>(vb);
  asm volatile("s_waitcnt lgkmcnt(0)" ::: "memory"); SBAR();
#define PK(L, H) (bf16x8){L[0], L[1], L[2], L[3], H[0], H[1], H[2], H[3]}
  od = __builtin_amdgcn_mfma_f32_32x32x16_bf16(pa0, PK(l0, h0), od, 0, 0, 0);
  od = __builtin_amdgcn_mfma_f32_32x32x16_bf16(pa1, PK(l1, h1), od, 0, 0, 0);
  od = __builtin_amdgcn_mfma_f32_32x32x16_bf16(pa2, PK(l2, h2), od, 0, 0, 0);
  od = __builtin_amdgcn_mfma_f32_32x32x16_bf16(pa3, PK(l3, h3), od, 0, 0, 0);
#undef PK
}
__device__ __forceinline__ void pv_d0(f32x16* o, int vb, bf16x8 pa0, bf16x8 pa1, bf16x8 pa2, bf16x8 pa3) {
  pv_one<0>(o[0], vb, pa0, pa1, pa2, pa3); pv_one<1>(o[1], vb, pa0, pa1, pa2, pa3); pv_one<2>(o[2], vb, pa0, pa1, pa2, pa3); pv_one<3>(o[3], vb, pa0, pa1, pa2, pa3);
}

__device__ __forceinline__ const void* uni_ptr(const void* p) { const unsigned long long u = (unsigned long long)p;
  const unsigned lo = (unsigned)__builtin_amdgcn_readfirstlane((int)(unsigned)u), hi = (unsigned)__builtin_amdgcn_readfirstlane((int)(unsigned)(u >> 32)); return (const void*)(((unsigned long long)hi << 32) | lo); }
constexpr int PB_Q = 6, PB_ZONE = PB_Q * 1024, PB_TPITCH = 128, PB_TILE = 32 * PB_TPITCH, PB_WAVE = PB_ZONE + PB_TILE, PB_NIT = 96 * 1024;
#define PB_GAS __attribute__((address_space(1)))
#define PB_LAS __attribute__((address_space(3)))
struct Pb { int total, gw, NGW; const float* pg; long du, dd; PB_GAS unsigned char* wgu; PB_GAS unsigned char* wd; unsigned zone; };
__device__ __forceinline__ const char* pb_src(const Pb& pb, int it) {
  const int m = it >> 10, tp = it & 1023, e = m / 3, w = m % 3;
  return (const char*)pb.pg + pb.du * (long)(w == 1) + pb.dd * (long)(w == 2) + ((size_t)e * 2048 * 2048 + (size_t)((tp >> 6) * 128) * 2048 + (tp & 63) * 32) * 4;
}
__device__ __forceinline__ PB_GAS unsigned char* pb_dst(const Pb& pb, int it) {
  const int m = it >> 10, tp = it & 1023, e = m / 3, w = m % 3, k0 = (tp >> 6) * 128, n0 = (tp & 63) * 32;
  if (w == 2) return pb.wd + ((size_t)e * 2048 + n0) * 2048 + k0;
  return pb.wgu + ((size_t)e * 4096 + (size_t)(n0 >> 7) * 256 + (n0 & 127) + (w == 1 ? 128 : 0)) * 2048 + k0;
}
__device__ __forceinline__ int pb_issue(const Pb pb, int& c_issue, const char*& isrc, int lane) {
  asm volatile("s_waitcnt lgkmcnt(0)" ::: "memory");
  const int n = (pb.total - c_issue) < PB_Q ? (pb.total - c_issue) : PB_Q;
  if (n <= 0) return 0;
  const unsigned loff = (unsigned)(((lane >> 3) * 2048 + 4 * (lane & 7)) * 4);
  const unsigned z0 = (unsigned)__builtin_amdgcn_readfirstlane((int)pb.zone);
  unsigned keep; asm volatile("s_mov_b32 %0, m0" : "=s"(keep) :: "memory");
#pragma unroll
  for (int q = 0; q < PB_Q; ++q) { if (q < n) {
    if (((c_issue + q) & 15) == 0) isrc = (const char*)uni_ptr(pb_src(pb, pb.gw + ((c_issue + q) >> 4) * pb.NGW));
    asm volatile("s_mov_b32 m0, %2\n\ts_nop 0\n\tglobal_load_lds_dwordx4 %0, %1 sc1 nt" :: "v"(loff), "s"(isrc), "s"(z0 + q * 1024) : "memory");
    isrc += 65536; } }
  asm volatile("s_mov_b32 m0, %0" :: "s"(keep) : "memory");
  c_issue += n; return n;
}
__device__ __forceinline__ void pb_process(const Pb pb, int& c_proc, const int c_issue, char* lds_, int lane) {
  const int nn = lane & 31, a = lane >> 5;
  PB_LAS char* lds = (PB_LAS char*)lds_;
  PB_LAS char* tile = lds + pb.zone + PB_ZONE;
  const unsigned twr = (unsigned)(uintptr_t)(tile + nn * PB_TPITCH + 4 * a), nx = (unsigned)((nn & 7) << 4);
  const PB_LAS float* zrd = (const PB_LAS float*)(lds + pb.zone) + (4 * a) * 32 + nn;
  const int n = c_issue - c_proc;
#pragma unroll
  for (int q = 0; q < PB_Q; ++q) { if (q < n) {
    const int i = (c_proc + q) & 15;
    const PB_LAS float* z = zrd + q * 256;
    typedef float f2 __attribute__((ext_vector_type(2)));
    const f2 t01 = (f2){z[0], z[32]} * 64.f, t23 = (f2){z[64], z[96]} * 64.f;
    int w0 = __builtin_amdgcn_cvt_pk_fp8_f32(t01.x, t01.y, (int)__float_as_uint(t01.x), false); w0 = __builtin_amdgcn_cvt_pk_fp8_f32(t23.x, t23.y, w0, true);
    *(PB_LAS int*)(uintptr_t)((((unsigned)i << 3) ^ nx) + twr) = w0;
    if (i == 15) {
      PB_GAS unsigned char* dst = pb_dst(pb, pb.gw + ((c_proc + q) >> 4) * pb.NGW);
      const int lr = lane >> 3, l7 = lane & 7;
      const PB_LAS char* trd = tile + lr * PB_TPITCH + ((l7 ^ lr) << 4);
      const unsigned voff = (unsigned)(lr * 2048 + 16 * l7);
#pragma unroll
      for (int j = 0; j < 4; ++j) { const u32x4 o = *(const PB_LAS u32x4*)(trd + j * 8 * PB_TPITCH);
        __builtin_nontemporal_store(o, (PB_GAS u32x4*)(dst + (voff + (unsigned)j * 16384u))); }
    } } }
  c_proc = c_issue;
}
__device__ __forceinline__ int pb_step(const Pb pb, int& c_issue, int& c_proc, const char*& isrc, char* lds, int lane) {
  asm volatile("s_waitcnt vmcnt(4)" ::: "memory");
  pb_process(pb, c_proc, c_issue, lds, lane); return pb_issue(pb, c_issue, isrc, lane); }
__device__ __forceinline__ void pb_drain(const Pb pb, int& c_issue, int& c_proc, const char*& isrc, char* lds, int lane) {
#pragma unroll 1
  for (;;) { if (c_proc < c_issue) { asm volatile("s_waitcnt vmcnt(0)" ::: "memory"); pb_process(pb, c_proc, c_issue, lds, lane); }
    if (c_issue >= pb.total) break; (void)pb_issue(pb, c_issue, isrc, lane); }
  asm volatile("s_waitcnt vmcnt(0) lgkmcnt(0)" ::: "memory");
}

template <int D0> __device__ __forceinline__ void pv32_one(f32x16& od, int vb, bf16x8 pa0, bf16x8 pa1) {
  const s16x4 l0 = tr_read<v_rd_off(D0, 0, 0)>(vb), h0 = tr_read<v_rd_off(D0, 0, 1)>(vb), l1 = tr_read<v_rd_off(D0, 1, 0)>(vb), h1 = tr_read<v_rd_off(D0, 1, 1)>(vb);
  asm volatile("s_waitcnt lgkmcnt(0)" ::: "memory"); SBAR();
#define PK(L, H) (bf16x8){L[0], L[1], L[2], L[3], H[0], H[1], H[2], H[3]}
  od = __builtin_amdgcn_mfma_f32_32x32x16_bf16(pa0, PK(l0, h0), od, 0, 0, 0);
  od = __builtin_amdgcn_mfma_f32_32x32x16_bf16(pa1, PK(l1, h1), od, 0, 0, 0);
#undef PK
}
__device__ __forceinline__ void dilated_wave(const bf16* __restrict__ Qb, const bf16* __restrict__ Kb, const bf16* __restrict__ Vb, long ld, int j0, int L, float kk,
                                             bf16* __restrict__ Ob, long ldo, float* __restrict__ Lp, long ldl, char* ktile, char* vtile, float* scr) {
  constexpr float C = SCALE * 1.4426950408889634f;
  int lane = threadIdx.x & 63; asm volatile("" : "+v"(lane));
  const int r32 = lane & 31, hi = lane >> 5;
  bf16x8 qr[8];
  { const bf16* Qw = Qb + (long)(j0 + r32) * ld + hi * 8;
#pragma unroll
    for (int d0 = 0; d0 < 8; ++d0) qr[d0] = *reinterpret_cast<const bf16x8*>(Qw + d0 * 16); }
  float m_reg = -1e30f, l_reg = 0.f; f32x16 o[4] = {};
  const int vb0 = (int)(uintptr_t)vtile + v_rd_base(lane);
  const int sr = lane >> 4, scol = (lane & 15) * 8;
  bf16x8 kn[8], vn[8];
#define DW_LOAD(t_) do { const int kb_ = j0 - 64 + 32 * (t_); const int kbc_ = (kb_ >= 0 && kb_ < L) ? kb_ : j0;   \
    const bf16* Kw_ = Kb + (long)(kbc_ + sr) * ld + scol; const bf16* Vw_ = Vb + (long)(kbc_ + sr) * ld + scol; \
    _Pragma("unroll") for (int i_ = 0; i_ < 8; ++i_) { kn[i_] = *reinterpret_cast<const bf16x8*>(Kw_ + (long)(4 * i_) * ld); vn[i_] = *reinterpret_cast<const bf16x8*>(Vw_ + (long)(4 * i_) * ld); } } while (0)
  DW_LOAD(0);
#pragma unroll 1
  for (int t = 0; t < 5; ++t) {
    const int kb = j0 - 64 + 32 * t; const bool valid = kb >= 0 && kb < L;
#pragma unroll
    for (int i = 0; i < 8; ++i) { const int row = 4 * i + sr;
      *reinterpret_cast<bf16x8*>(ktile + row * 256 + ((scol * 2) ^ ((row & 7) << 4))) = kn[i];
      *reinterpret_cast<bf16x8*>(vtile + v_st(row, scol)) = vn[i]; }
    if (t + 1 < 5) DW_LOAD(t + 1);
    f32x16 p0 = {};
#pragma unroll
    for (int d0 = 0; d0 < 8; ++d0) { const int cbb = (d0 * 16 + hi * 8) * 2;
      const bf16x8 kf = *reinterpret_cast<const bf16x8*>(ktile + r32 * 256 + (cbb ^ ((r32 & 7) << 4)));
      p0 = __builtin_amdgcn_mfma_f32_32x32x16_bf16(kf, qr[d0], p0, 0, 0, 0); }
    const float relb = (float)(j0 + r32 - kb - 4 * hi);
#pragma unroll
    for (int r = 0; r < 16; ++r) { const float a = __builtin_fabsf(relb - (float)((r & 3) + 8 * (r >> 2))); p0[r] = fmaf(a, -kk, p0[r]); if (!(valid && a <= 64.f)) p0[r] = -INFINITY; }
    float pmax = p0[0];
#pragma unroll
    for (int r = 1; r < 16; ++r) pmax = fmaxf(pmax, p0[r]);
    { auto rr = __builtin_amdgcn_permlane32_swap(__float_as_uint(pmax), __float_as_uint(pmax), false, false); pmax = fmaxf(__uint_as_float(rr[0]), __uint_as_float(rr[1])); }
    const float mn = fmaxf(m_reg, pmax), alpha = __builtin_amdgcn_exp2f((m_reg - mn) * C), mnC = -mn * C; m_reg = mn;
    float ps = 0.f;
#pragma unroll
    for (int r = 0; r < 16; ++r) { p0[r] = __builtin_amdgcn_exp2f(fmaf(p0[r], C, mnC)); ps += p0[r]; }
    { auto rr = __builtin_amdgcn_permlane32_swap(__float_as_uint(ps), __float_as_uint(ps), false, false); ps = __uint_as_float(rr[0]) + __uint_as_float(rr[1]); }
    l_reg = l_reg * alpha + ps;
    if (__any(alpha < 1.f)) { if (hi == 0) scr[r32] = alpha; asm volatile("s_waitcnt lgkmcnt(0)" ::: "memory");
#pragma unroll
      for (int d = 0; d < 4; ++d)
#pragma unroll
        for (int r = 0; r < 16; ++r) o[d][r] *= scr[crow(r, hi)]; }
    bf16x8 pa0, pa1;
#define PK4(P, BASE, OUT) do { unsigned a0 = cvtpk(P[BASE + 0], P[BASE + 1]), a1 = cvtpk(P[BASE + 2], P[BASE + 3]);   \
    unsigned b0 = cvtpk(P[BASE + 4], P[BASE + 5]), b1 = cvtpk(P[BASE + 6], P[BASE + 7]);                              \
    auto r0 = __builtin_amdgcn_permlane32_swap(a0, b0, false, false); auto r1 = __builtin_amdgcn_permlane32_swap(a1, b1, false, false); \
    u32x4 w = {r0[0], r1[0], r0[1], r1[1]}; OUT = *reinterpret_cast<bf16x8*>(&w); } while (0)
    PK4(p0, 0, pa0); PK4(p0, 8, pa1);
#undef PK4
    SBAR();
    pv32_one<0>(o[0], vb0, pa0, pa1); pv32_one<1>(o[1], vb0, pa0, pa1); pv32_one<2>(o[2], vb0, pa0, pa1); pv32_one<3>(o[3], vb0, pa0, pa1);
  }
#undef DW_LOAD
  if (hi == 0) scr[32 + r32] = l_reg; asm volatile("s_waitcnt lgkmcnt(0)" ::: "memory");
  bf16* Ow = Ob + (long)(j0 + 4 * hi) * ldo + r32;
#pragma unroll
  for (int r = 0; r < 16; ++r) { const float rl = __builtin_amdgcn_rcpf(scr[32 + crow(r, hi)]); bf16* Or = Ow + (long)((r & 3) + 8 * (r >> 2)) * ldo;
#pragma unroll
    for (int d0 = 0; d0 < 4; ++d0) { const float y = o[d0][r] * rl; Or[d0 * 32] = (bf16)cvtpk(y, y); } }
  if (hi == 0) Lp[(long)(j0 + r32) * ldl] = m_reg * SCALE + __logf(l_reg);
}

template <int MODE>
__device__ __forceinline__ void attn_body(const bf16* __restrict__ Qb, long ldq, const bf16* __restrict__ Kh, const bf16* __restrict__ Vh, long ldk,
                                          int t0, int NT, int ntmax, int qpos0, float kk, bf16* __restrict__ Ob, long ldo, float* __restrict__ Lb, long ldl, char* lds, const Pb pb, int& pbi, int& pbp, const char*& pbs) {
  int tid = threadIdx.x; asm volatile("" : "+v"(tid));
  const int wid = tid >> 6, lane = tid & 63, r32 = lane & 31, hi = lane >> 5;
  bf16* V_lds = (bf16*)lds; bf16* K_lds = (bf16*)(lds + 2 * SHM_V);
  float* ws = (float*)(lds + 2 * SHM_V + 2 * SHM_K) + wid * 64; float* li_l = ws; float* al_l = ws + 32;
  float m_reg = -1e30f, l_reg = 0; f32x16 o[4] = {}; bf16x8 qr[8];
  const bf16* Qw = Qb + (long)(wid * QBLK + r32) * ldq + hi * 8;
#pragma unroll
  for (int d0 = 0; d0 < 8; ++d0) qr[d0] = *reinterpret_cast<const bf16x8*>(Qw + d0 * 16);
  const int sr = tid >> 4, sc = (tid & 15) * 8, vst0 = v_st(sr, sc), vst1 = v_st(32 + sr, sc);
  const int vb0 = (int)(uintptr_t)V_lds + v_rd_base(lane);
  const unsigned sob0 = 2u * (unsigned)(sr * (int)ldk + sc), sob1 = sob0 + 64u * (unsigned)ldk;
  const float qposf = (float)(qpos0 + wid * QBLK + r32 - 4 * hi);
  const int qlo = qpos0 + __builtin_amdgcn_readfirstlane(wid) * QBLK;
  struct { bf16x8 vs0, vs1, ks0, ks1; } sr_[1];
#define TCL(jt) ({ int _t = t0 + (jt); _t = _t < 0 ? 0 : (_t >= ntmax ? ntmax - 1 : _t); _t * KVBLK; })
#define TVALID(jt) ((t0 + (jt)) >= 0 && (t0 + (jt)) < ntmax)
#define RELB(jt) (qposf - (float)((t0 + (jt)) * KVBLK))
#define SIDE(jt) (qlo > (t0 + (jt)) * KVBLK + (KVBLK - 1) ? 1 : (qlo + (QBLK - 1) < (t0 + (jt)) * KVBLK ? -1 : 0))
#define SLOAD(i, jt) do { const long _k0 = (long)TCL(jt) * ldk; const bf16* _vp = (const bf16*)uni_ptr(Vh + _k0); const bf16* _kp = (const bf16*)uni_ptr(Kh + _k0); \
    asm volatile("s_nop 4\n\tglobal_load_dwordx4 %0, %4, %6\n\tglobal_load_dwordx4 %1, %5, %6\n\tglobal_load_dwordx4 %2, %4, %7\n\tglobal_load_dwordx4 %3, %5, %7" \
        : "=&v"(sr_[i].vs0), "=&v"(sr_[i].vs1), "=&v"(sr_[i].ks0), "=&v"(sr_[i].ks1) : "v"(sob0), "v"(sob1), "s"(_vp), "s"(_kp) : "memory"); } while (0)
#define SWAITN(i, n) asm volatile("s_waitcnt vmcnt(%4)" : "+v"(sr_[i].vs0), "+v"(sr_[i].vs1), "+v"(sr_[i].ks0), "+v"(sr_[i].ks1) : "i"(n) : "memory")
#define BSYNC() asm volatile("s_waitcnt lgkmcnt(0)\n\ts_barrier" ::: "memory")
#define SWRITE(b, i) do { *(bf16x8*)((char*)V_lds + (b) * SHM_V + vst0) = sr_[i].vs0;          \
    *(bf16x8*)((char*)V_lds + (b) * SHM_V + vst1) = sr_[i].vs1; const int kc = sc * 2;               \
    *(bf16x8*)((char*)K_lds + (b) * SHM_K + KSWZ(sr, kc)) = sr_[i].ks0;                       \
    *(bf16x8*)((char*)K_lds + (b) * SHM_K + KSWZ(32 + sr, kc)) = sr_[i].ks1; } while (0)
#define SWAIT() SWAITN(0, 0)
#define SWAITQ(n) asm volatile("s_cmp_eq_u32 %4, %5\n\ts_cbranch_scc1 .Lpbw%=\n\ts_waitcnt vmcnt(0)\n.Lpbw%=:\n\ts_waitcnt vmcnt(%5)" \
    : "+v"(sr_[0].vs0), "+v"(sr_[0].vs1), "+v"(sr_[0].ks0), "+v"(sr_[0].ks1) : "s"(n), "i"(PB_Q) : "memory", "scc")
#define RESC(a) do { if (__any((a) < 1.f)) { if (hi == 0) al_l[r32] = (a); asm volatile("s_waitcnt lgkmcnt(0)" ::: "memory"); \
    _Pragma("unroll") for (int d = 0; d < 4; ++d) _Pragma("unroll") for (int r = 0; r < 16; ++r) o[d][r] *= al_l[crow(r, hi)]; } } while (0)
  f32x16 pA0, pA1, pB0, pB1; float mnA, mnB, alA, alB; bf16x8 pa0, pa1, pa2, pa3; int nq = 0;
  constexpr int SE = 0, SO = 0;
  if constexpr (MODE == 1) {
    const int w2 = __builtin_amdgcn_readfirstlane(wid) >> 1;
    SLOAD(SE, 0); SWAIT(); SWRITE(0, SE); __syncthreads();
#pragma unroll 1
    for (int jt = 0; jt < NT; ++jt) {
      const int b = jt & 1;
      if (jt + 1 < NT) { SLOAD(SE, jt + 1); SBAR(); nq = pb_step(pb, pbi, pbp, pbs, lds, lane); SBAR(); }
      if (jt >= w2 && jt <= w2 + 2) {
        qkt(pA0, pA1, (bf16*)((char*)K_lds + b * SHM_K), qr, r32, hi); partialSM<MODE>(pA0, pA1, m_reg, mnA, alA, RELB(jt), kk, TVALID(jt));
        RESC(alA);
        finishSM(pA0, pA1, alA, l_reg, pa0, pa1, pa2, pa3); SBAR();
        pv_d0(o, vb0 + b * (int)SHM_V, pa0, pa1, pa2, pa3);
      }
      if (jt + 1 < NT) { SWAITQ(nq); SWRITE(b ^ 1, SE); BSYNC(); }
    }
  } else {
  SLOAD(SE, 0); SWAIT(); SWRITE(0, SE); __syncthreads();
  qkt(pA0, pA1, K_lds, qr, r32, hi); partialSM<MODE>(pA0, pA1, m_reg, mnA, alA, RELB(0), kk, TVALID(0), SIDE(0));
  SLOAD(SO, 1);
  SWAIT(); SWRITE(1, SO); __syncthreads();
  for (int j = 1; j + 1 < NT; j += 2) {
    SBAR(); qkt(pB0, pB1, (bf16*)((char*)K_lds + SHM_K), qr, r32, hi);
    finishSM(pA0, pA1, alA, l_reg, pa0, pa1, pa2, pa3); SBAR();
    SLOAD(SO, j + 1); SBAR();
    nq = pb_step(pb, pbi, pbp, pbs, lds, lane); SBAR();
    pv_d0(o, vb0, pa0, pa1, pa2, pa3); partialSM<MODE>(pB0, pB1, m_reg, mnB, alB, RELB(j), kk, TVALID(j), SIDE(j));
    BSYNC(); SWAITQ(nq); SWRITE(0, SE);
    RESC(alB); BSYNC();
    SBAR(); qkt(pA0, pA1, K_lds, qr, r32, hi);
    finishSM(pB0, pB1, alB, l_reg, pa0, pa1, pa2, pa3); SBAR();
    SLOAD(SE, j + 2); SBAR();
    nq = pb_step(pb, pbi, pbp, pbs, lds, lane); SBAR();
    pv_d0(o, vb0 + (int)SHM_V, pa0, pa1, pa2, pa3); partialSM<MODE>(pA0, pA1, m_reg, mnA, alA, RELB(j + 1), kk, TVALID(j + 1), SIDE(j + 1));
    BSYNC(); SWAITQ(nq); SWRITE(1, SO);
    RESC(alA); BSYNC();
  }
  SBAR(); qkt(pB0, pB1, (bf16*)((char*)K_lds + SHM_K), qr, r32, hi);
  finishSM(pA0, pA1, alA, l_reg, pa0, pa1, pa2, pa3); SBAR();
  pv_d0(o, vb0, pa0, pa1, pa2, pa3); partialSM<MODE>(pB0, pB1, m_reg, mnB, alB, RELB(NT - 1), kk, TVALID(NT - 1), SIDE(NT - 1));
  __syncthreads(); RESC(alB);
  finishSM(pB0, pB1, alB, l_reg, pa0, pa1, pa2, pa3); SBAR();
  pv_d0(o, vb0 + (int)SHM_V, pa0, pa1, pa2, pa3);
  }
  if (hi == 0) li_l[r32] = l_reg; asm volatile("s_waitcnt lgkmcnt(0)" ::: "memory");
  float rli[16];
#pragma unroll
  for (int r = 0; r < 16; ++r) rli[r] = __builtin_amdgcn_rcpf(li_l[crow(r, hi)]);
  int tide = tid; asm volatile("" : "+v"(tide));
  const int hie = (tide >> 5) & 1, r32e = tide & 31, wide = tide >> 6;
  bf16* Ow = Ob + (long)(wide * QBLK + 4 * hie) * ldo + r32e;
#pragma unroll
  for (int r = 0; r < 16; ++r) { bf16* Or = Ow + (long)((r & 3) + 8 * (r >> 2)) * ldo;
#pragma unroll
    for (int d0 = 0; d0 < 4; ++d0) { const float y = o[d0][r] * rli[r]; Or[d0 * 32] = (bf16)cvtpk(y, y); } }
  if (Lb != nullptr && hie == 0) Lb[(long)(wide * QBLK + r32e) * ldl] = m_reg * SCALE + __logf(l_reg);
  __syncthreads();
#undef TCL
#undef TVALID
#undef RELB
#undef SIDE
#undef SLOAD
#undef SWRITE
#undef SWAIT
#undef SWAITQ
#undef SWAITN
#undef BSYNC
#undef RESC
}

__device__ __forceinline__ int v_st256(int k, int c) { const int kk = (k & ~0xC) | ((k & 4) << 1) | ((k & 8) >> 1); return ((kk >> 3) * 8 + (c >> 5)) * 512 + ((kk & 7) * 32 + (c & 31)) * 2; }
constexpr int v_rd_off256(int d0, int ks, int half) { return d0 * 512 + ks * 8192 + half * 4096; }
template <int D0> __device__ __forceinline__ void pv32k_one(f32x16& od, int vb, bf16x8 pa0, bf16x8 pa1) {
  const s16x4 l0 = tr_read<v_rd_off256(D0, 0, 0)>(vb), h0 = tr_read<v_rd_off256(D0, 0, 1)>(vb), l1 = tr_read<v_rd_off256(D0, 1, 0)>(vb), h1 = tr_read<v_rd_off256(D0, 1, 1)>(vb);
  asm volatile("s_waitcnt lgkmcnt(0)" ::: "memory"); SBAR();
#define PK(L, H) (bf16x8){L[0], L[1], L[2], L[3], H[0], H[1], H[2], H[3]}
  od = __builtin_amdgcn_mfma_f32_32x32x16_bf16(pa0, PK(l0, h0), od, 0, 0, 0);
  od = __builtin_amdgcn_mfma_f32_32x32x16_bf16(pa1, PK(l1, h1), od, 0, 0, 0);
#undef PK
}
template <int NY> __device__ __forceinline__ int pb_step_n(const Pb pb, int& c_issue, int& c_proc, const char*& isrc, char* lds, int lane) {
  asm volatile("s_waitcnt vmcnt(%0)" :: "i"(NY) : "memory");
  pb_process(pb, c_proc, c_issue, lds, lane); return pb_issue(pb, c_issue, isrc, lane); }
constexpr int DK_V = 0, DK_K = 32768, DK_SCR = 65536;
__device__ __forceinline__ void diffk_body(const bf16* __restrict__ Qb, const bf16* __restrict__ Kh, const bf16* __restrict__ Vh, long ld, int qpos0, float kk,
                                           bf16* __restrict__ Ob, char* lds, const Pb pb, int& pbi, int& pbp, const char*& pbs) {
  constexpr float C = SCALE * 1.4426950408889634f;
  constexpr int NT = 4096 / KVBLK;
  int tid = threadIdx.x; asm volatile("" : "+v"(tid));
  const int wid = tid >> 6, lane = tid & 63, r32 = lane & 31, hi = lane >> 5;
  const int rg = __builtin_amdgcn_readfirstlane(wid);
  float* ws = (float*)(lds + DK_SCR) + wid * 64; float* li_l = ws; float* al_l = ws + 32;
  float m_reg = -1e30f, l_reg = 0; f32x16 o[8] = {}; bf16x8 qr[8];
  { const bf16* Qw = Qb + (long)(rg * 32 + r32) * ld + hi * 8;
#pragma unroll
    for (int d0 = 0; d0 < 8; ++d0) qr[d0] = *reinterpret_cast<const bf16x8*>(Qw + d0 * 16); }
#define DK_SOFFS() int t2_ = tid; asm volatile("" : "+v"(t2_)); const int sr = t2_ >> 4, sc = (t2_ & 15) * 8, l2_ = t2_ & 63, w2_ = t2_ >> 6; \
  const unsigned sob0 = 2u * (unsigned)(sr * (int)ld + sc), sob1 = sob0 + 64u * (unsigned)ld;        \
  const unsigned kof0 = (unsigned)((8 * w2_ + (l2_ >> 4)) * (int)ld * 2) + (unsigned)((((l2_ & 15) ^ (l2_ >> 4)) & 15) << 4);            \
  const unsigned kof1 = (unsigned)((8 * w2_ + 4 + (l2_ >> 4)) * (int)ld * 2) + (unsigned)((((l2_ & 15) ^ (4 + (l2_ >> 4))) & 15) << 4);
  const unsigned kdst = (unsigned)__builtin_amdgcn_readfirstlane((int)(unsigned)(uintptr_t)(lds + DK_K + 8 * wid * 256));
  const int vb = (int)(uintptr_t)(lds + DK_V) + v_rd_base(lane);
  const float qposf = (float)(qpos0 + rg * 32 + r32 - 4 * hi);
  const int qlo = qpos0 + rg * 32;
  bf16x8 vs0, vs1, vs2, vs3; int nq = 0;
#define DK_KDMA(jt, b) do { const bf16* _kp = (const bf16*)uni_ptr(Kh + (long)(jt) * KVBLK * ld); unsigned _keep; \
    asm volatile("s_nop 4\n\ts_mov_b32 %0, m0\n\ts_mov_b32 m0, %4\n\ts_nop 0\n\tglobal_load_lds_dwordx4 %1, %3\n\ts_add_u32 m0, m0, 0x400\n\ts_nop 0\n\tglobal_load_lds_dwordx4 %2, %3\n\ts_mov_b32 m0, %0" \
        : "=&s"(_keep) : "v"(kof0), "v"(kof1), "s"(_kp), "s"(kdst + (b) * 16384u) : "memory"); } while (0)
#define DK_VLOAD(jt) do { const bf16* _vp = (const bf16*)uni_ptr(Vh + (long)(jt) * KVBLK * ld); \
    asm volatile("s_nop 4\n\tglobal_load_dwordx4 %0, %4, %6\n\tglobal_load_dwordx4 %1, %5, %6\n\tglobal_load_dwordx4 %2, %4, %6 offset:256\n\tglobal_load_dwordx4 %3, %5, %6 offset:256" \
        : "=&v"(vs0), "=&v"(vs1), "=&v"(vs2), "=&v"(vs3) : "v"(sob0), "v"(sob1), "s"(_vp) : "memory"); } while (0)
#define DK_VWAIT0() asm volatile("s_waitcnt vmcnt(0)" : "+v"(vs0), "+v"(vs1), "+v"(vs2), "+v"(vs3) :: "memory")
#define DK_VWAITQ(n) asm volatile("s_cmp_eq_u32 %4, %5\n\ts_cbranch_scc1 .Ldkw%=\n\ts_waitcnt vmcnt(0)\n.Ldkw%=:\n\ts_waitcnt vmcnt(%5)" \
    : "+v"(vs0), "+v"(vs1), "+v"(vs2), "+v"(vs3) : "s"(n), "i"(PB_Q) : "memory", "scc")
#define DK_VWRITE() do { int t3_ = tid; asm volatile("" : "+v"(t3_)); char* _v = lds + DK_V + v_st256(t3_ >> 4, (t3_ & 15) * 8); *(bf16x8*)(_v) = vs0; *(bf16x8*)(_v + 16384) = vs1; *(bf16x8*)(_v + 2048) = vs2; *(bf16x8*)(_v + 18432) = vs3; } while (0)
#define DK_BSYNC() asm volatile("s_waitcnt lgkmcnt(0)\n\ts_barrier" ::: "memory")
  { DK_SOFFS(); DK_KDMA(0, 0); DK_VLOAD(0); } DK_VWAIT0(); DK_VWRITE(); __syncthreads();
#pragma unroll 1
  for (int j = 0; j < NT; ++j) {
    const char* Kb = lds + DK_K + (j & 1) * 16384;
    if (j + 1 < NT) { { DK_SOFFS(); DK_KDMA(j + 1, (j + 1) & 1); DK_VLOAD(j + 1); } SBAR(); nq = pb_step_n<6>(pb, pbi, pbp, pbs, lds, lane); SBAR(); }
    else { SBAR(); nq = pb_step_n<0>(pb, pbi, pbp, pbs, lds, lane); SBAR(); }
#pragma unroll 1
    for (int kh = 0; kh < 2; ++kh) {
    if (kh == 1) { SBAR(); nq = pb_step_n<0>(pb, pbi, pbp, pbs, lds, lane); SBAR(); }
    f32x16 p = {};
#pragma unroll
    for (int d0 = 0; d0 < 8; ++d0) { const int cb = (d0 * 16 + hi * 8) * 2;
      const bf16x8 kf = *reinterpret_cast<const bf16x8*>(Kb + (kh * 32 + r32) * 256 + (cb ^ ((r32 & 7) << 4)));
      p = __builtin_amdgcn_mfma_f32_32x32x16_bf16(kf, qr[d0], p, 0, 0, 0); }
    const float relb = qposf - (float)(j * KVBLK + 32 * kh);
    const int klo = j * KVBLK + 32 * kh;
    const int side = qlo > klo + 31 ? 1 : (qlo + 31 < klo ? -1 : 0);
    float base = 0.f;
    if (side != 0) { const float skk = side > 0 ? kk : -kk; base = -skk * relb;
#pragma unroll
      for (int r = 0; r < 16; ++r) p[r] = fmaf(skk, (float)((r & 3) + 8 * (r >> 2)), p[r]);
    } else {
#pragma unroll
      for (int r = 0; r < 16; ++r) p[r] = fmaf(__builtin_fabsf(relb - (float)((r & 3) + 8 * (r >> 2))), -kk, p[r]);
    }
    float pmax = p[0];
#pragma unroll
    for (int r = 1; r < 16; ++r) pmax = fmaxf(pmax, p[r]);
    { auto rr = __builtin_amdgcn_permlane32_swap(__float_as_uint(pmax), __float_as_uint(pmax), false, false); pmax = fmaxf(__uint_as_float(rr[0]), __uint_as_float(rr[1])); }
    pmax += base;
    float mn, alpha;
    if (__builtin_expect(__all(pmax - m_reg <= THR / SCALE), 1)) { mn = m_reg; alpha = 1.f; }
    else { mn = fmaxf(m_reg, pmax); alpha = __builtin_amdgcn_exp2f((m_reg - mn) * C); m_reg = mn; }
    const float mnC = (base - mn) * C;
    float ps = 0.f;
#pragma unroll
    for (int r = 0; r < 16; ++r) { p[r] = __builtin_amdgcn_exp2f(fmaf(p[r], C, mnC)); ps += p[r]; }
    { auto rr = __builtin_amdgcn_permlane32_swap(__float_as_uint(ps), __float_as_uint(ps), false, false); ps = __uint_as_float(rr[0]) + __uint_as_float(rr[1]); }
    l_reg = l_reg * alpha + ps;
    if (__any(alpha < 1.f)) { if (hi == 0) al_l[r32] = alpha; asm volatile("s_waitcnt lgkmcnt(0)" ::: "memory");
#pragma unroll
      for (int d = 0; d < 8; ++d)
#pragma unroll
        for (int r = 0; r < 16; ++r) o[d][r] *= al_l[crow(r, hi)]; }
    bf16x8 pa0, pa1;
#define PK4(P, BASE, OUT) do { unsigned a0 = cvtpk(P[BASE + 0], P[BASE + 1]), a1 = cvtpk(P[BASE + 2], P[BASE + 3]);   \
    unsigned b0 = cvtpk(P[BASE + 4], P[BASE + 5]), b1 = cvtpk(P[BASE + 6], P[BASE + 7]);                              \
    auto r0 = __builtin_amdgcn_permlane32_swap(a0, b0, false, false); auto r1 = __builtin_amdgcn_permlane32_swap(a1, b1, false, false); \
    u32x4 w = {r0[0], r1[0], r0[1], r1[1]}; OUT = *reinterpret_cast<bf16x8*>(&w); } while (0)
    PK4(p, 0, pa0); PK4(p, 8, pa1);
#undef PK4
    SBAR();
    pv32k_one<0>(o[0], vb + kh * 16384, pa0, pa1); pv32k_one<1>(o[1], vb + kh * 16384, pa0, pa1); pv32k_one<2>(o[2], vb + kh * 16384, pa0, pa1); pv32k_one<3>(o[3], vb + kh * 16384, pa0, pa1);
    pv32k_one<4>(o[4], vb + kh * 16384, pa0, pa1); pv32k_one<5>(o[5], vb + kh * 16384, pa0, pa1); pv32k_one<6>(o[6], vb + kh * 16384, pa0, pa1); pv32k_one<7>(o[7], vb + kh * 16384, pa0, pa1);
    }
    if (j + 1 < NT) { DK_BSYNC(); DK_VWAITQ(nq); DK_VWRITE(); DK_BSYNC(); }
  }
  if (hi == 0) li_l[r32] = l_reg; asm volatile("s_waitcnt lgkmcnt(0)" ::: "memory");
  int tide = tid; asm volatile("" : "+v"(tide));
  const int hie = (tide >> 5) & 1, r32e = tide & 31;
  bf16* Ow = Ob + (long)(rg * 32 + 4 * hie) * 1024 + r32e;
#pragma unroll
  for (int r = 0; r < 16; ++r) { const float rl = __builtin_amdgcn_rcpf(li_l[crow(r, hie)]); bf16* Or = Ow + (long)((r & 3) + 8 * (r >> 2)) * 1024;
#pragma unroll
    for (int d0 = 0; d0 < 8; ++d0) { const float y = o[d0][r] * rl; Or[d0 * 32] = (bf16)cvtpk(y, y); } }
  __syncthreads();
#undef DK_KDMA
#undef DK_SOFFS
#undef DK_VLOAD
#undef DK_VWAIT0
#undef DK_VWAITQ
#undef DK_VWRITE
#undef DK_BSYNC
}
#undef KSWZ
#undef SBAR
}
constexpr int NWAVES = 8;
#ifndef MK_SPLIT
#define MK_SPLIT 0
#endif
constexpr int N_PHASES = 12;

constexpr int DM = 2048, BATCH = 2, SEQ = 4096, T = BATCH * SEQ;
constexpr int NQKV = 10240;
constexpr int C_QA = 0, C_KA = 1024, C_VA = 2048, C_QB = 3072, C_KB = 4096, C_VB = 5120, C_GA = 6144, C_GB = 8192;
constexpr unsigned long long LBMAP = 0x0ull;
constexpr unsigned long long LFMAP = 0x9876543210ull;
constexpr int NLB = 0, NLF = 10;
constexpr bool P6_F8 = true;
constexpr int NE = 32, TOPK = 4, TK = T * TOPK, TKPAD = TK + NE * 256;
constexpr float EPS = 1e-5f;
constexpr float LAMBDA_INIT = 0.2f;

constexpr size_t MiB = 1u << 20;
constexpr size_t WS_CTL = 0, CTL_ZERO_BYTES = 1 * MiB;
constexpr size_t WS_MOD = 1 * MiB;
constexpr size_t WS_RC = 1 * MiB + 512 * 1024;
constexpr size_t WS_TOPI = 2 * MiB;
constexpr size_t WS_TOPP = 2 * MiB + 256 * 1024;
constexpr size_t WS_POS = 2 * MiB + 512 * 1024;
constexpr size_t WS_TOKOF = 3 * MiB;
constexpr size_t WS_WINT = 4 * MiB;
constexpr size_t WS_WING = 4 * MiB;
constexpr size_t WS_U8Q = 770 * MiB;
constexpr size_t WS_WAT = 44 * MiB;
constexpr size_t WS_WBT = 48 * MiB;
constexpr size_t WS_WOT = 52 * MiB;
constexpr size_t WS_U = 64 * MiB;
constexpr size_t WS_QKV = 96 * MiB;
constexpr size_t WS_OA = 256 * MiB;
constexpr size_t WS_OB = 352 * MiB;
constexpr size_t WS_LSE = 416 * MiB;
constexpr size_t WS_YA = 418 * MiB;
constexpr size_t WS_YB = 434 * MiB;
constexpr size_t WS_M1 = 450 * MiB;
constexpr size_t WS_MG = 514 * MiB;
constexpr size_t WS_H1 = 546 * MiB;
constexpr size_t WS_XS = 610 * MiB;
constexpr size_t WS_YACT = 770 * MiB;
constexpr size_t WS_YSLOT = 930 * MiB;
constexpr size_t WS_WGU = 1090 * MiB;
constexpr size_t WS_WD = 1602 * MiB;
constexpr size_t WS_END = 1858 * MiB;
constexpr int CW_TMO = 0, CW_CODE = 1;
constexpr int CW_BAR = 4096;
constexpr int CW_CNT = 8192;

constexpr int RING_OFF = 0, RING_BYTES = 131072;
constexpr int PB_OFF = 69632;
constexpr int LDSCTL_OFF = 159744, MISC_OFF = LDSCTL_OFF + 320;
constexpr int TST_OFF = LDSCTL_OFF + 1024;
constexpr int LDS_BYTES = 163840;

#define GAS __attribute__((address_space(1)))
#define LAS __attribute__((address_space(3)))
typedef unsigned short bf16;
typedef unsigned v4u __attribute__((ext_vector_type(4)));
typedef unsigned v2u __attribute__((ext_vector_type(2)));
typedef float f32x4 __attribute__((ext_vector_type(4)));
typedef float v2f __attribute__((ext_vector_type(2)));
typedef GAS unsigned gu32;
#define RLX_AGENT __ATOMIC_RELAXED, __HIP_MEMORY_SCOPE_AGENT
#define LDS_WAIT() asm volatile("s_waitcnt lgkmcnt(0)" ::: "memory")
#define VM_WAIT() asm volatile("s_waitcnt vmcnt(0)" ::: "memory")
__device__ __forceinline__ unsigned f2bf(float f) { unsigned u = __builtin_bit_cast(unsigned, f); return (u + 0x7fffu + ((u >> 16) & 1u)) >> 16; }
__device__ __forceinline__ unsigned pk2(float lo, float hi) { return f2bf(lo) | (f2bf(hi) << 16); }
__device__ __forceinline__ float bf2f(unsigned short h) { return __uint_as_float(((unsigned)h) << 16); }
__device__ __forceinline__ float wave_sum(float v) {
#pragma unroll
    for (int o = 1; o < 64; o <<= 1) v += __shfl_xor(v, o);
    return v;
}
__device__ __forceinline__ float wave_max(float v) {
#pragma unroll
    for (int o = 1; o < 64; o <<= 1) v = fmaxf(v, __shfl_xor(v, o));
    return v;
}
__device__ __forceinline__ float siluf(float x) { return x / (1.0f + __expf(-x)); }
#define XB_TMO      128
#define XB_XCNT(j)  (256  + 64 * (j))
#define XB_XSUB(j)  (1280 + 64 * (j))
#define XB_XGEN(j)  (2304 + 64 * (j))
#define XB_TOP      3328
#define XB_TOPGEN   3392
#define XCD_BAR_WORDS 3456
#define XB_SPIN_CAP (1u << 18)

__device__ __forceinline__ unsigned xb_ld(unsigned* p)              { return __hip_atomic_load(p, __ATOMIC_RELAXED, __HIP_MEMORY_SCOPE_AGENT); }
__device__ __forceinline__ unsigned xb_add(unsigned* p, unsigned v) { return __hip_atomic_fetch_add(p, v, __ATOMIC_RELAXED, __HIP_MEMORY_SCOPE_AGENT); }
__device__ __forceinline__ unsigned xb_xcc_id() { return (unsigned)__builtin_amdgcn_s_getreg((3 << 11) | 20) & 0xFu; }
#define XB_SPIN(cond, bar) do { unsigned _sp = 0; while (cond) { __builtin_amdgcn_s_sleep(1); \
    if ((++_sp & 255u) == 0u) { if (xb_ld(&(bar)[XB_TMO])) break; if (_sp > XB_SPIN_CAP) { atomicAdd(&(bar)[XB_TMO], 1u); break; } } } } while (0)

struct XcdBarrier {
    unsigned* bar; unsigned x;
    volatile LAS unsigned* st;
};

__device__ __forceinline__ XcdBarrier xcd_barrier_post(unsigned* bar, volatile LAS unsigned* st) {
    XcdBarrier b; b.bar = bar; b.x = xb_xcc_id(); b.st = st;
    if (threadIdx.x == 0) (void)xb_add(&bar[XB_XCNT(b.x)], 1u);
    return b;
}
__device__ __forceinline__ void xcd_barrier_complete(unsigned* bar, unsigned x, unsigned& nloc, unsigned& nx) {
    const unsigned G = gridDim.x * gridDim.y * gridDim.z;
    unsigned sum, cnt, mine, sp = 0u;
    for (;;) {
        sum = 0u; cnt = 0u; mine = 0u;
#pragma unroll
        for (unsigned j = 0; j < 16; ++j) { const unsigned c = xb_ld(&bar[XB_XCNT(j)]); sum += c; cnt += (c > 0u) ? 1u : 0u; mine = (j == x) ? c : mine; }
        if (sum == G) break;
        __builtin_amdgcn_s_sleep(1);
        if ((++sp & 255u) == 0u) { if (xb_ld(&bar[XB_TMO])) break; if (sp > XB_SPIN_CAP) { atomicAdd(&bar[XB_TMO], 1u); break; } }
    }
    nloc = mine > 0u ? mine : 1u; nx = cnt > 0u ? cnt : 1u;
}

__device__ __forceinline__ void xcd_barrier(const XcdBarrier& b) {
    asm volatile("s_waitcnt vmcnt(0)" ::: "memory");
    __syncthreads();
    if (threadIdx.x == 0) {
        unsigned* bar = b.bar;
        __builtin_amdgcn_s_waitcnt(0);
        unsigned nloc = b.st[0], nx = b.st[1];
        if (nloc == 0u) { xcd_barrier_complete(bar, b.x, nloc, nx); b.st[0] = nloc; b.st[1] = nx; }
        const unsigned old = xb_add(&bar[XB_XSUB(b.x)], 1u);
        const unsigned gen = old / nloc;
        if (old + 1u == (gen + 1u) * nloc) {
            __builtin_amdgcn_fence(__ATOMIC_RELEASE, "agent");
            asm volatile("s_waitcnt vmcnt(0)" ::: "memory");
            const unsigned og = xb_add(&bar[XB_TOP], 1u);
            const unsigned tg = og / nx;
            if (og + 1u == (tg + 1u) * nx) xb_add(&bar[XB_TOPGEN], 1u);
            else XB_SPIN(xb_ld(&bar[XB_TOPGEN]) == tg, bar);
            __builtin_amdgcn_fence(__ATOMIC_ACQUIRE, "agent");
            xb_add(&bar[XB_XGEN(b.x)], 1u);
            asm volatile("s_waitcnt vmcnt(0)" ::: "memory");
        } else {
            XB_SPIN(xb_ld(&bar[XB_XGEN(b.x)]) == gen, bar);
            __builtin_amdgcn_fence(__ATOMIC_ACQUIRE, "agent");
            asm volatile("s_waitcnt vmcnt(0)" ::: "memory");
        }
    }
    __syncthreads();
}
struct Args { const float* in[24]; float* out; unsigned char* ws; int ph_lo, ph_hi; };
enum { I_X = 0, I_C, I_WADA, I_BADA, I_N1G, I_WIN, I_LQ1, I_LK1, I_LQ2, I_LK2, I_SUBG, I_WOA, I_WOB, I_WO, I_N2G, I_WR, I_BR, I_WG, I_BG, I_WU, I_BU, I_WDN, I_BDN, I_FG };
struct Frame {
    LAS unsigned char* lds; char* ldsg;
    volatile LAS unsigned* MISC;
    gu32* ctl;
    int tid, lane, wave, vcu, G;
    unsigned char* ws;
};
#define WSP(T_, off) ((T_*)(F.ws + (off)))

constexpr float WSCALE = 64.0f;
__device__ __forceinline__ unsigned cvtpk_bf(float lo, float hi) { unsigned r; asm volatile("v_cvt_pk_bf16_f32 %0, %1, %2" : "=v"(r) : "v"(lo), "v"(hi)); return r; }
__device__ __forceinline__ void cvt_load(f32x4 (&v)[8], const float* __restrict__ W, int N, int k0, int n0, int lane) {
    const int lr = lane >> 3, lc = 4 * (lane & 7);
#pragma unroll
    for (int i = 0; i < 8; ++i) v[i] = __builtin_nontemporal_load((const f32x4*)(W + (size_t)(k0 + lr + 8 * i) * N + n0 + lc));
}
template <bool F8>
__device__ __forceinline__ void cvt_store(const f32x4 (&v)[8], int K, void* __restrict__ WT, int k0, long dst_row0, LAS float* scr, int lane) {
    const int lr = lane >> 3, lc = 4 * (lane & 7);
#pragma unroll
    for (int i = 0; i < 8; ++i) { LAS float* s = scr + (lr + 8 * i) * 33 + lc; s[0] = v[i].x; s[1] = v[i].y; s[2] = v[i].z; s[3] = v[i].w; }
    LDS_WAIT(); asm volatile("" ::: "memory");
    const int c = lane & 7;
#pragma unroll
    for (int j = 0; j < 4; ++j) { const int n = (lane >> 3) + 8 * j; const LAS float* s = scr + (8 * c) * 33 + n;
        if constexpr (F8) {
            int w0 = __builtin_amdgcn_cvt_pk_fp8_f32(s[0 * 33] * WSCALE, s[1 * 33] * WSCALE, 0, false); w0 = __builtin_amdgcn_cvt_pk_fp8_f32(s[2 * 33] * WSCALE, s[3 * 33] * WSCALE, w0, true);
            int w1 = __builtin_amdgcn_cvt_pk_fp8_f32(s[4 * 33] * WSCALE, s[5 * 33] * WSCALE, 0, false); w1 = __builtin_amdgcn_cvt_pk_fp8_f32(s[6 * 33] * WSCALE, s[7 * 33] * WSCALE, w1, true);
            *(v2u*)((unsigned char*)WT + (size_t)(dst_row0 + n) * K + k0 + 8 * c) = (v2u){(unsigned)w0, (unsigned)w1};
        } else {
            v4u o; o.x = cvtpk_bf(s[0 * 33], s[1 * 33]); o.y = cvtpk_bf(s[2 * 33], s[3 * 33]); o.z = cvtpk_bf(s[4 * 33], s[5 * 33]); o.w = cvtpk_bf(s[6 * 33], s[7 * 33]);
            *(v4u*)((bf16*)WT + (size_t)(dst_row0 + n) * K + k0 + 8 * c) = o; } }
    LDS_WAIT(); asm volatile("" ::: "memory");
}
__device__ __forceinline__ void cvt8_load(f32x4 (&v)[16], const float* __restrict__ W, int k0, int n0, int lane, int N = DM) {
    const float* p = W + (size_t)(k0 + (lane >> 3)) * N + n0 + 4 * (lane & 7);
#pragma unroll
    for (int i = 0; i < 16; ++i) v[i] = __builtin_nontemporal_load((const f32x4*)(p + (size_t)(8 * i) * N));
}
__device__ __forceinline__ void cvt8_store(const f32x4 (&v)[16], unsigned char* __restrict__ WT, int k0, long dst_row0, LAS float* scr, int lane) {
    const int lr = lane >> 3, lc = 4 * (lane & 7);
#pragma unroll
    for (int i = 0; i < 16; ++i) { LAS float* s = scr + (lr + 8 * i) * 33 + ((lc + 4 * (i >> 1)) & 31);
        s[0] = v[i].x; s[1] = v[i].y; s[2] = v[i].z; s[3] = v[i].w; }
    LDS_WAIT(); asm volatile("" ::: "memory");
    const int c = lane & 7;
#pragma unroll
    for (int j = 0; j < 4; ++j) { const int n = (lane >> 3) + 8 * j; const LAS float* s = scr + (16 * c) * 33 + ((n + 4 * c) & 31);
        v4u o;
#pragma unroll
        for (int h = 0; h < 4; ++h) { int w = __builtin_amdgcn_cvt_pk_fp8_f32(s[(4 * h + 0) * 33] * WSCALE, s[(4 * h + 1) * 33] * WSCALE, 0, false);
            w = __builtin_amdgcn_cvt_pk_fp8_f32(s[(4 * h + 2) * 33] * WSCALE, s[(4 * h + 3) * 33] * WSCALE, w, true); o[h] = (unsigned)w; }
        *(v4u*)(WT + (size_t)(dst_row0 + n) * DM + k0 + 16 * c) = o; }
    LDS_WAIT(); asm volatile("" ::: "memory");
}
__device__ __forceinline__ void p0_mod(Frame& F, const Args& A) {
    LAS float* red = (LAS float*)F.lds;
    LAS float* sc = red + 2048;
    if (F.vcu < 192) {
        for (int k = F.tid; k < DM; k += 512) { sc[2 * k] = siluf(A.in[I_C][k]); sc[2 * k + 1] = siluf(A.in[I_C][2048 + k]); }
    }
    __syncthreads();
    if (F.vcu < 192) {
        const int col = F.vcu * 64 + F.lane, k0 = F.wave * 256;
        const float* wp = A.in[I_WADA] + (size_t)k0 * 12288 + col; const LAS float* sp = sc + 2 * k0;
        float a0 = 0.f, a1 = 0.f;
#pragma unroll 16
        for (int k = 0; k < 256; ++k) { const float wv = __builtin_nontemporal_load(wp + (size_t)k * 12288); const v2f s2 = *(const LAS v2f*)(sp + 2 * k); a0 = fmaf(s2.x, wv, a0); a1 = fmaf(s2.y, wv, a1); }
        red[(F.wave * 2 + 0) * 64 + F.lane] = a0; red[(F.wave * 2 + 1) * 64 + F.lane] = a1;
    }
    __syncthreads();
    if (F.vcu < 192 && F.tid < 128) { const int b = F.tid >> 6, l = F.tid & 63; float s = 0.f;
#pragma unroll
        for (int w = 0; w < 8; ++w) s += red[(w * 2 + b) * 64 + l];
        const int col = F.vcu * 64 + l; WSP(float, WS_MOD)[b * 12288 + col] = s + A.in[I_BADA][col]; }
    __syncthreads();
}
__device__ __forceinline__ void p0_convert(Frame& F, const Args& A) {
    LAS float* scr = (LAS float*)(F.lds + F.wave * 16384);
    const int gw = F.vcu * NWAVES + F.wave, NGW = F.G * NWAVES;
    constexpr int I_IN = 32 * 320, I_A = 16 * 64, I_B = 16 * 64, I_O = P6_F8 ? 0 : 32 * 64, NSMALL = I_IN + I_A + I_B + I_O;
    f32x4 v0[8];
#pragma unroll 1
    for (int it = gw; it < NSMALL; it += NGW) { int r = it; const float* W; bf16* WT; int N, K, drow = 0;
        if (r < I_IN) { W = A.in[I_WIN]; WT = WSP(bf16, WS_WINT); N = NQKV; K = DM; const int g_ = (r % 320) >> 5; int pos_ = -1;
#pragma unroll
            for (int i_ = 0; i_ < NLB; ++i_) if ((int)((LBMAP >> (4 * i_)) & 15ull) == g_) pos_ = i_;
            if (pos_ < 0) continue; drow = pos_ * 1024 - g_ * 1024; }
        else if ((r -= I_IN) < I_A) { W = A.in[I_WOA]; WT = WSP(bf16, WS_WAT); N = DM; K = 1024; }
        else if ((r -= I_A) < I_B) { W = A.in[I_WOB]; WT = WSP(bf16, WS_WBT); N = DM; K = 1024; }
        else { r -= I_B; W = A.in[I_WO]; WT = WSP(bf16, WS_WOT); N = DM; K = DM; }
        const int nnb = N / 32, k0 = (r / nnb) * 64, n0 = (r % nnb) * 32;
        cvt_load(v0, W, N, k0, n0, F.lane); cvt_store<false>(v0, K, WT, k0, n0 + drow, scr, F.lane); }
    { __syncthreads(); LAS float* scr8 = (LAS float*)(F.lds + F.wave * 16896); f32x4 va[16];
      constexpr int NF8 = 16 * NLF * 32;
#pragma unroll 1
      for (int it = gw; it < NF8 + (P6_F8 ? 16 * 64 : 0); it += NGW) {
          if (it < NF8) { const int k0 = (it / (NLF * 32)) * 128, blk = it % (NLF * 32), pf = blk >> 5, g_ = (int)((LFMAP >> (4 * pf)) & 15ull);
              cvt8_load(va, A.in[I_WIN], k0, g_ * 1024 + (blk & 31) * 32, F.lane, NQKV); cvt8_store(va, WSP(unsigned char, WS_WING), k0, pf * 1024 + (blk & 31) * 32, scr8, F.lane); }
          else { const int j = it - NF8, k0 = (j >> 6) * 128, n0 = (j & 63) * 32;
              cvt8_load(va, A.in[I_WO], k0, n0, F.lane, DM); cvt8_store(va, WSP(unsigned char, WS_WOT), k0, n0, scr8, F.lane); } } }
}
__device__ __forceinline__ void p1_modulate(Frame& F, const Args& A) {
    const int gw = F.vcu * NWAVES + F.wave, NGW = F.G * NWAVES; const float* MOD = WSP(float, WS_MOD);
    if (F.vcu < 64 && F.wave == 0) { const int b = F.vcu >> 5, kq = F.vcu & 31, e = F.lane & 31, ks = F.lane >> 5; float s = 0.f;
#pragma unroll 8
        for (int i = 0; i < 32; ++i) { const int k = 64 * kq + 2 * i + ks; s = fmaf(MOD[b * 12288 + 3 * DM + k], A.in[I_WR][k * 32 + e], s); }
        s += __shfl_xor(s, 32); if (F.lane < 32) WSP(float, WS_RC)[(b * 32 + kq) * 32 + e] = s; }
    for (int m = gw; m < T; m += NGW) {
        const int b = m / SEQ; const float* xr = A.in[I_X] + (size_t)m * DM + 4 * F.lane; f32x4 v[8]; float s = 0.f;
#pragma unroll
        for (int j = 0; j < 8; ++j) { v[j] = *(const f32x4*)(xr + 256 * j); s += (v[j].x * v[j].x + v[j].y * v[j].y) + (v[j].z * v[j].z + v[j].w * v[j].w); }
        const float rstd = 1.0f / sqrtf(wave_sum(s) * (1.0f / DM) + EPS);
        bf16* ur = WSP(bf16, WS_U) + (size_t)m * DM + 4 * F.lane;
#pragma unroll
        for (int j = 0; j < 8; ++j) { const int k = 4 * F.lane + 256 * j;
            const f32x4 g = *(const f32x4*)(A.in[I_N1G] + k), sc = *(const f32x4*)(MOD + b * 12288 + 1 * DM + k), sh = *(const f32x4*)(MOD + b * 12288 + k);
            const f32x4 u = v[j] * rstd * g * (sc + 1.0f) + sh; if constexpr (NLB > 0) { v2u o; o.x = pk2(u.x, u.y); o.y = pk2(u.z, u.w); *(v2u*)(ur + 256 * j) = o; }
            int w8 = __builtin_amdgcn_cvt_pk_fp8_f32(u.x, u.y, 0, false); w8 = __builtin_amdgcn_cvt_pk_fp8_f32(u.z, u.w, w8, true); *(int*)(WSP(unsigned char, WS_U8Q) + (size_t)m * DM + 4 * F.lane + 256 * j) = w8; }
    }
}
__device__ __forceinline__ void p3_attention(Frame& F, const Args& A) {
    const bf16* QKV = WSP(bf16, WS_QKV);
    att::Pb pb; int pbi = 0, pbp = 0; const char* pbs = nullptr; pb.gw = F.vcu * NWAVES + F.wave; pb.NGW = F.G * NWAVES;
    pb.total = pb.gw < att::PB_NIT ? ((att::PB_NIT - pb.gw + pb.NGW - 1) / pb.NGW) * 16 : 0;
    pb.pg = A.in[I_WG]; pb.du = (const char*)A.in[I_WU] - (const char*)A.in[I_WG]; pb.dd = (const char*)A.in[I_WDN] - (const char*)A.in[I_WG];
    pb.wgu = (GAS unsigned char*)WSP(unsigned char, WS_WGU); pb.wd = (GAS unsigned char*)WSP(unsigned char, WS_WD); pb.zone = (unsigned)(PB_OFF + F.wave * att::PB_WAVE);
#pragma unroll 1
    for (int i = F.vcu; i < 256; i += F.G) {
        const int c2 = i >> 4, b = c2 >> 3, h = (c2 >> 1) & 3, c = c2 & 1, qb = i & 15;
        const size_t rowb = (size_t)b * SEQ;
        const bf16* Qb = QKV + (rowb + qb * 256) * NQKV + C_QB + h * 256 + c * 128;
        const bf16* Kh = QKV + rowb * NQKV + C_KB + h * 256 + c * 128;
        const bf16* Vh = QKV + rowb * NQKV + C_VB + h * 256;
        bf16* Ob = WSP(bf16, WS_OB) + ((size_t)c * T + rowb + qb * 256) * 1024 + h * 256;
        const float slope = exp2f(-(float)(8 + h + 1) * (8.0f / 12.0f));
        att::diffk_body(Qb, Kh, Vh, NQKV, qb * 256, slope / att::SCALE, Ob, F.ldsg, pb, pbi, pbp, pbs);
    }
    att::pb_drain(pb, pbi, pbp, pbs, F.ldsg, F.lane);
    __syncthreads();
    {
        const int gw = F.vcu * NWAVES + F.wave, NGW = F.G * NWAVES;
        char* ktile = F.ldsg + F.wave * 16384; char* vtile = ktile + 8192; float* scr = (float*)(F.ldsg + 131072) + F.wave * 64;
#if defined(REP_DIL)
#pragma unroll 1
        for (int rep_ = 0; rep_ < 2; ++rep_)
#endif
#pragma unroll 1
        for (int tk = gw; tk < 3 * 2048; tk += NGW) {
            const int p = tk >> 11, r = tk & 2047, b = r >> 10, h = (r >> 7) & 7, blk = r & 127;
            const int dil = p == 0 ? 1 : (p == 1 ? 4 : 16), L = SEQ / dil, bpr = L / 32, res = blk / bpr, j0 = (blk % bpr) * 32;
            const size_t rowb = (size_t)b * SEQ + res;
            const bf16* Qb = QKV + rowb * NQKV + C_QA + h * 128; const bf16* Kb = QKV + rowb * NQKV + C_KA + h * 128; const bf16* Vb = QKV + rowb * NQKV + C_VA + h * 128;
            bf16* Ob = WSP(bf16, WS_OA) + ((size_t)p * T + rowb) * 1024 + h * 128; float* Lb = WSP(float, WS_LSE) + ((size_t)p * T + rowb) * 8 + h;
            const float slope = exp2f(-(float)(h + 1) * (8.0f / 12.0f)) * (float)dil;
            att::dilated_wave(Qb, Kb, Vb, (long)dil * NQKV, j0, L, slope / att::SCALE, Ob, (long)dil * 1024, Lb, (long)dil * 8, ktile, vtile, scr);
        }
    }
    __syncthreads();
}
__device__ __forceinline__ void p4_finalize(Frame& F, const Args& A) {
    const int gw = F.vcu * NWAVES + F.wave, NGW = F.G * NWAVES;
    float s1 = A.in[I_LQ1][F.lane] * A.in[I_LK1][F.lane] + A.in[I_LQ1][F.lane + 64] * A.in[I_LK1][F.lane + 64];
    float s2 = A.in[I_LQ2][F.lane] * A.in[I_LK2][F.lane] + A.in[I_LQ2][F.lane + 64] * A.in[I_LK2][F.lane + 64];
    s1 = wave_sum(s1); s2 = wave_sum(s2);
    const float lam = expf(s1) - expf(s2) + LAMBDA_INIT;
    const bf16* OA = WSP(bf16, WS_OA); const bf16* OB = WSP(bf16, WS_OB); const float* LS = WSP(float, WS_LSE);
    for (int m = gw; m < T; m += NGW) {
        { const int h = F.lane >> 3; const float l0 = LS[((size_t)0 * T + m) * 8 + h], l1 = LS[((size_t)1 * T + m) * 8 + h], l2 = LS[((size_t)2 * T + m) * 8 + h];
          const float mx = fmaxf(l0, fmaxf(l1, l2)); float w0 = __expf(l0 - mx), w1 = __expf(l1 - mx), w2 = __expf(l2 - mx); const float inv = 1.0f / (w0 + w1 + w2); w0 *= inv; w1 *= inv; w2 *= inv;
          const size_t o = (size_t)m * 1024 + 16 * F.lane; unsigned pk[8];
#pragma unroll
          for (int q = 0; q < 2; ++q) { const v4u a0 = *(const v4u*)(OA + o + 8 * q), a1 = *(const v4u*)(OA + (size_t)T * 1024 + o + 8 * q), a2 = *(const v4u*)(OA + (size_t)2 * T * 1024 + o + 8 * q);
#pragma unroll
              for (int e = 0; e < 4; ++e) { const float ylo = w0 * __uint_as_float(a0[e] << 16) + w1 * __uint_as_float(a1[e] << 16) + w2 * __uint_as_float(a2[e] << 16);
                  const float yhi = w0 * __uint_as_float(a0[e] & 0xffff0000u) + w1 * __uint_as_float(a1[e] & 0xffff0000u) + w2 * __uint_as_float(a2[e] & 0xffff0000u); pk[4 * q + e] = pk2(ylo, yhi); } }
          bf16* ya = WSP(bf16, WS_YA) + o; *(v4u*)ya = (v4u){pk[0], pk[1], pk[2], pk[3]}; *(v4u*)(ya + 8) = (v4u){pk[4], pk[5], pk[6], pk[7]}; }
#pragma unroll
        for (int h = 0; h < 4; ++h) { const size_t o = (size_t)m * 1024 + h * 256 + 4 * F.lane;
            const v2u b0 = *(const v2u*)(OB + o), b1 = *(const v2u*)(OB + (size_t)T * 1024 + o);
            const f32x4 v = (f32x4){__uint_as_float(b0.x << 16), __uint_as_float(b0.x & 0xffff0000u), __uint_as_float(b0.y << 16), __uint_as_float(b0.y & 0xffff0000u)}
                          - (f32x4){__uint_as_float(b1.x << 16), __uint_as_float(b1.x & 0xffff0000u), __uint_as_float(b1.y << 16), __uint_as_float(b1.y & 0xffff0000u)} * lam;
            const float ss = wave_sum((v.x * v.x + v.y * v.y) + (v.z * v.z + v.w * v.w)); const float rstd = 1.0f / sqrtf(ss * (1.0f / 256.0f) + EPS);
            const f32x4 g = *(const f32x4*)(A.in[I_SUBG] + 4 * F.lane); const f32x4 y = v * rstd * g * (1.0f - LAMBDA_INIT);
            v2u w; w.x = pk2(y.x, y.y); w.y = pk2(y.z, y.w); *(v2u*)(WSP(bf16, WS_YB) + o) = w; }
    }
}
typedef float f32x16r __attribute__((ext_vector_type(16)));
__device__ __forceinline__ void p7_router(Frame& F, const Args& A, bool commit = true) {
    LAS float* gainL = (LAS float*)F.lds;
    LAS float* shiftL = gainL + 2048;
    LAS float* part = shiftL + 2048;
    LAS float* ssp = part + 8 * 32 * 32;
    LAS float* logitL = ssp + 512;
    LAS float* rstdL = logitL + 32 * 33;
    LAS int* lcnt = (LAS int*)(rstdL + 32);
    LAS int* lbase = lcnt + 32;
    const float* H1 = WSP(float, WS_H1); const float* MODp = WSP(float, WS_MOD); const float* RC = WSP(float, WS_RC);
    for (int blk = F.vcu; blk < T / 32; blk += F.G) {
        const int t0 = blk * 32, bb = t0 / SEQ; const float* mod = MODp + bb * 12288;
        for (int k = F.tid; k < DM; k += 512) { gainL[k] = A.in[I_N2G][k] * (1.0f + mod[4 * DM + k]); shiftL[k] = mod[3 * DM + k]; }
        if (F.tid < 32) lcnt[F.tid] = 0;
        __syncthreads();
        {
            const int i = F.lane & 31, kk = F.lane >> 5, kb = F.wave * 256 + kk * 128;
            const float* hp = H1 + (size_t)(t0 + i) * DM + kb; const float* wp = A.in[I_WR] + (size_t)kb * 32 + i; const LAS float* gp = gainL + kb;
            f32x16r acc = {}; float ss = 0.f;
#pragma unroll 4
            for (int s0 = 0; s0 < 128; s0 += 4) {
                const f32x4 hv = *(const f32x4*)(hp + s0); const f32x4 g4 = *(const LAS f32x4*)(gp + s0);
                const float b0 = wp[(s0 + 0) * 32], b1 = wp[(s0 + 1) * 32], b2 = wp[(s0 + 2) * 32], b3 = wp[(s0 + 3) * 32];
                ss += (hv.x * hv.x + hv.y * hv.y) + (hv.z * hv.z + hv.w * hv.w);
                acc = __builtin_amdgcn_mfma_f32_32x32x2f32(hv.x * g4.x, b0, acc, 0, 0, 0);
                acc = __builtin_amdgcn_mfma_f32_32x32x2f32(hv.y * g4.y, b1, acc, 0, 0, 0);
                acc = __builtin_amdgcn_mfma_f32_32x32x2f32(hv.z * g4.z, b2, acc, 0, 0, 0);
                acc = __builtin_amdgcn_mfma_f32_32x32x2f32(hv.w * g4.w, b3, acc, 0, 0, 0);
            }
#pragma unroll
            for (int r = 0; r < 16; ++r) part[(F.wave * 32 + (r & 3) + 8 * (r >> 2) + 4 * kk) * 32 + i] = acc[r];
            ssp[F.wave * 64 + F.lane] = ss;
        }
        __syncthreads();
        { const int token = F.tid & 31, eg = F.tid >> 5; float s2 = 0.f;
#pragma unroll
          for (int w = 0; w < 8; ++w) s2 += ssp[w * 64 + token] + ssp[w * 64 + 32 + token];
          const float rstd = 1.0f / sqrtf(s2 * (1.0f / DM) + EPS);
#pragma unroll
          for (int q = 0; q < 2; ++q) { const int e = eg * 2 + q; float raw = 0.f;
#pragma unroll
              for (int w = 0; w < 8; ++w) raw += part[(w * 32 + token) * 32 + e];
              float rc = A.in[I_BR][e];
#pragma unroll 8
              for (int kq = 0; kq < 32; ++kq) rc += RC[(bb * 32 + kq) * 32 + e];
              logitL[token * 33 + e] = rstd * raw + rc; }
          if (eg == 0) rstdL[token] = rstd; }
        __syncthreads();
        int se[4] = {0, 0, 0, 0}, lp[4] = {0, 0, 0, 0}; float pv[4] = {0.f, 0.f, 0.f, 0.f};
        if (F.tid < 32) {
            float sv[4];
#pragma unroll
            for (int k = 0; k < 4; ++k) { float best = -INFINITY; int bi = 0;
                for (int e = 0; e < 32; ++e) { const float v = logitL[F.tid * 33 + e]; if (v > best) { best = v; bi = e; } }
                sv[k] = best; se[k] = bi; logitL[F.tid * 33 + bi] = -INFINITY; }
            float sum = 0.f;
#pragma unroll
            for (int k = 0; k < 4; ++k) { pv[k] = expf(sv[k] - sv[0]); sum += pv[k]; }
            const float inv = 1.0f / sum;
#pragma unroll
            for (int k = 0; k < 4; ++k) { pv[k] *= inv; lp[k] = __hip_atomic_fetch_add(lcnt + se[k], 1, __ATOMIC_RELAXED, __HIP_MEMORY_SCOPE_WORKGROUP); }
        }
        __syncthreads();
        if (F.tid < 32 && commit) lbase[F.tid] = (int)__hip_atomic_fetch_add((unsigned*)(F.ctl + CW_CNT + 64 * F.tid), (unsigned)lcnt[F.tid], RLX_AGENT);
        __syncthreads();
        if (F.tid < 32 && commit) { const int m = t0 + F.tid;
#pragma unroll
            for (int k = 0; k < 4; ++k) { const int pos = lbase[se[k]] + lp[k]; WSP(int, WS_TOPI)[m * 4 + k] = se[k]; WSP(float, WS_TOPP)[m * 4 + k] = pv[k]; WSP(int, WS_POS)[m * 4 + k] = pos;
                WSP(int, WS_TOKOF)[se[k] * 8192 + pos] = m; } }
        for (int i = 0; i < 4; ++i) { const int token = F.wave * 4 + i, m = t0 + token; const float rstd = rstdL[token];
            const float* hr = H1 + (size_t)m * DM + 4 * F.lane; unsigned char* ur = WSP(unsigned char, WS_U) + (size_t)m * DM + 4 * F.lane;
#pragma unroll
            for (int j = 0; j < 8; ++j) { const f32x4 h = *(const f32x4*)(hr + 256 * j), g = *(const LAS f32x4*)(gainL + 4 * F.lane + 256 * j), s = *(const LAS f32x4*)(shiftL + 4 * F.lane + 256 * j);
                const f32x4 u = h * rstd * g + s; int w8 = __builtin_amdgcn_cvt_pk_fp8_f32(u.x, u.y, 0, false); w8 = __builtin_amdgcn_cvt_pk_fp8_f32(u.z, u.w, w8, true); *(int*)(ur + 256 * j) = w8; } }
        __syncthreads();
    }
}
__device__ __forceinline__ void build_tile_table(Frame& F) {
    LAS int* ts = (LAS int*)(F.lds + TST_OFF);
    if (F.tid < 64) {
        const int e = F.tid & 31; const int c = (int)__hip_atomic_load((unsigned*)(F.ctl + CW_CNT + 64 * e), RLX_AGENT); const int tl = (c + 255) >> 8; int x = tl;
#pragma unroll
        for (int o = 1; o < 32; o <<= 1) { const int y = __shfl_up(x, o, 32); if (e >= o) x += y; }
        if (F.tid < 32) { ts[e] = x - tl; ts[40 + e] = c; if (e == 31) ts[32] = x; } }
    __syncthreads();
}
__device__ __forceinline__ void p11_final(Frame& F, const Args& A) {
    build_tile_table(F);
    const LAS int* ts = (const LAS int*)(F.lds + TST_OFF);
    const int gw = F.vcu * NWAVES + F.wave, NGW = F.G * NWAVES; const float* MODp = WSP(float, WS_MOD);
    for (int m = gw; m < T; m += NGW) {
        const int bb = m / SEQ; const bf16* yr[4]; float p[4];
#pragma unroll
        for (int k = 0; k < 4; ++k) { const int e = WSP(int, WS_TOPI)[m * 4 + k], pos = WSP(int, WS_POS)[m * 4 + k]; p[k] = WSP(float, WS_TOPP)[m * 4 + k];
            yr[k] = WSP(bf16, WS_YSLOT) + ((size_t)ts[e] * 256 + pos) * DM + 4 * F.lane; }
        const float* hr = WSP(float, WS_H1) + (size_t)m * DM + 4 * F.lane; f32x4 v[8]; float s = 0.f;
#pragma unroll
        for (int j = 0; j < 8; ++j) { f32x4 a = {0.f, 0.f, 0.f, 0.f};
#pragma unroll
            for (int k = 0; k < 4; ++k) { const v2u w = *(const v2u*)(yr[k] + 256 * j); const f32x4 y = {__uint_as_float(w.x << 16), __uint_as_float(w.x & 0xffff0000u), __uint_as_float(w.y << 16), __uint_as_float(w.y & 0xffff0000u)}; a += y * p[k]; }
            const f32x4 g2 = *(const f32x4*)(MODp + bb * 12288 + 5 * DM + 4 * F.lane + 256 * j);
            v[j] = *(const f32x4*)(hr + 256 * j) + g2 * a; s += (v[j].x * v[j].x + v[j].y * v[j].y) + (v[j].z * v[j].z + v[j].w * v[j].w); }
        const float rstd = 1.0f / sqrtf(wave_sum(s) * (1.0f / DM) + EPS);
        float* orow = A.out + (size_t)m * DM + 4 * F.lane;
#pragma unroll
        for (int j = 0; j < 8; ++j) { const f32x4 g = *(const f32x4*)(A.in[I_FG] + 4 * F.lane + 256 * j); *(f32x4*)(orow + 256 * j) = v[j] * rstd * g; }
    }
}

__global__ void __launch_bounds__(NWAVES * 64, 2) fwd(Args args) {
    extern __shared__ __attribute__((aligned(16))) unsigned char lds[];
    Frame F;
    F.lds = (LAS unsigned char*)lds; F.ldsg = (char*)lds;
    F.MISC = (volatile LAS unsigned*)(F.lds + MISC_OFF);
    F.tid = threadIdx.x; F.lane = F.tid & 63; F.wave = __builtin_amdgcn_readfirstlane(F.tid >> 6);
    F.G = gridDim.x; { const int bx = blockIdx.x; F.vcu = (F.G % 8 == 0) ? (bx % 8) * (F.G / 8) + bx / 8 : bx; }
    F.ws = args.ws; F.ctl = (gu32*)(args.ws + WS_CTL);
    for (int u = F.tid; u < (LDS_BYTES - LDSCTL_OFF) / 4; u += NWAVES * 64) ((LAS unsigned*)(F.lds + LDSCTL_OFF))[u] = 0u;
    __syncthreads();
#if MK_SPLIT
#define GRID_BAR() do { } while (0)
#else
    XcdBarrier bar = xcd_barrier_post((unsigned*)(F.ctl + CW_BAR), F.MISC + 8);
#define GRID_BAR() xcd_barrier(bar)
#endif
    const int lo = args.ph_lo, hi = args.ph_hi;
#define IN(k) (lo <= (k) && (k) < hi)
#define SEAM(k) do { if (IN(k) && IN((k) + 1)) GRID_BAR(); } while (0)
    const Args& A = args;
    constexpr bool AL = true, SP = true;

#ifndef REP_PHASE
#define REP_PHASE -1
#endif
#define REPN(k) ((REP_PHASE == (k)) ? 2 : 1)
    if (IN(0)) { for (int rep = 0; rep < REPN(0); ++rep) p0_mod(F, A); p0_convert(F, A); } SEAM(0);
    if (IN(1)) { for (int rep = 0; rep < REPN(1); ++rep) p1_modulate(F, A); } SEAM(1);
    if (IN(2)) {
        if constexpr (NLB > 0) { pg8::Gemm g{WSP(bf16, WS_U), WSP(bf16, WS_WINT), T, NLB * 1024, DM}; pg8::StaticOrder S; S.init(T, NLB * 1024, F.G, (int)blockIdx.x);
          pg8::EpiQKV E{WSP(bf16, WS_QKV), NQKV, LBMAP, 1.0f};
          pg8::gemm_phase<pg8::EpiQKV, pg8::StaticOrder, AL, SP>(F.lds + RING_OFF, g, S, E);
          VM_WAIT(); __syncthreads(); }
        { pg8::Gemm g{WSP(bf16, WS_U8Q), WSP(bf16, WS_WING), T, NLF * 1024, DM / 2}; pg8::StaticOrder S; S.init(T, NLF * 1024, F.G, (int)blockIdx.x);
          pg8::EpiQKV E{WSP(bf16, WS_QKV), NQKV, LFMAP, 1.0f / WSCALE};
          pg8::gemm_phase<pg8::EpiQKV, pg8::StaticOrder, AL, SP, true>(F.lds + RING_OFF, g, S, E); }
    } SEAM(2);
    if (IN(3)) { for (int rep = 0; rep < REPN(3); ++rep) p3_attention(F, A); } SEAM(3);
    if (IN(4)) { for (int rep = 0; rep < REPN(4); ++rep) p4_finalize(F, A); } SEAM(4);
    if (IN(5)) for (int rep = 0; rep < REPN(5); ++rep) {
        { pg8::Gemm g{WSP(bf16, WS_YA), WSP(bf16, WS_WAT), T, DM, 1024}; pg8::StaticOrder S; S.init(T, DM, F.G, (int)blockIdx.x);
          pg8::EpiM1 E{WSP(bf16, WS_M1), WSP(bf16, WS_QKV) + C_GA, NQKV};
          pg8::gemm_phase<pg8::EpiM1, pg8::StaticOrder, AL, SP>(F.lds + RING_OFF, g, S, E); }
        VM_WAIT(); __syncthreads();
        { pg8::Gemm g{WSP(bf16, WS_YB), WSP(bf16, WS_WBT), T, DM, 1024}; pg8::StaticOrder S; S.init(T, DM, F.G, (int)blockIdx.x);
          if constexpr (P6_F8) { pg8::EpiMerged E{WSP(bf16, WS_M1), WSP(bf16, WS_QKV) + C_GB, NQKV, WSP(unsigned char, WS_MG)};
            pg8::gemm_phase<pg8::EpiMerged, pg8::StaticOrder, AL, SP>(F.lds + RING_OFF, g, S, E); }
          else { pg8::EpiMergedB E{WSP(bf16, WS_M1), WSP(bf16, WS_QKV) + C_GB, NQKV, WSP(bf16, WS_MG)};
            pg8::gemm_phase<pg8::EpiMergedB, pg8::StaticOrder, AL, SP>(F.lds + RING_OFF, g, S, E); } }
    } SEAM(5);
    if (IN(6)) for (int rep = 0; rep < REPN(6); ++rep) {
        pg8::Gemm g{WSP(bf16, WS_MG), WSP(bf16, WS_WOT), T, DM, P6_F8 ? DM / 2 : DM}; pg8::StaticOrder S; S.init(T, DM, F.G, (int)blockIdx.x);
        pg8::EpiH1 E{A.in[I_X], WSP(float, WS_H1), WSP(float, WS_MOD) + 2 * DM, 12288, SEQ / 256, P6_F8 ? 1.0f / (16.0f * WSCALE) : 1.0f};
        pg8::gemm_phase<pg8::EpiH1, pg8::StaticOrder, AL, SP, P6_F8>(F.lds + RING_OFF, g, S, E);
    } SEAM(6);
    if (IN(7)) { for (int rep = 0; rep < REPN(7); ++rep) p7_router(F, A, rep == 0); } if (IN(7) && IN(9)) GRID_BAR();
    if (IN(9)) for (int rep = 0; rep < REPN(9); ++rep) {
        build_tile_table(F);
        pg8::Gemm g{WSP(bf16, WS_U), WSP(bf16, WS_WGU), TKPAD, NE * 4096, DM / 2}; pg8::MoeOrder S; S.init((const LAS int*)(F.lds + TST_OFF), 16, F.G, (int)blockIdx.x, WSP(int, WS_TOKOF));
        pg8::EpiSwiGLU E{WSP(unsigned char, WS_YACT), A.in[I_BG], A.in[I_BU], 1.0f / WSCALE};
        pg8::gemm_phase<pg8::EpiSwiGLU, pg8::MoeOrder, AL, SP, true, true>(F.lds + RING_OFF, g, S, E);
    } SEAM(9);
    if (IN(10)) for (int rep = 0; rep < REPN(10); ++rep) {
        build_tile_table(F);
        pg8::Gemm g{WSP(bf16, WS_YACT), WSP(bf16, WS_WD), TKPAD, NE * DM, DM / 2}; pg8::MoeOrder S; S.init((const LAS int*)(F.lds + TST_OFF), 8, F.G, (int)blockIdx.x);
        pg8::EpiBf16B E{WSP(bf16, WS_YSLOT), DM, A.in[I_BDN], 8, 1.0f / WSCALE};
        pg8::gemm_phase<pg8::EpiBf16B, pg8::MoeOrder, AL, SP, true>(F.lds + RING_OFF, g, S, E);
    } SEAM(10);
    if (IN(11)) { for (int rep = 0; rep < REPN(11); ++rep) p11_final(F, A); }
#undef IN
#undef SEAM
}
extern "C" void kernel_launch(void* const* d_in, const int* in_sizes, int n_in, void* d_out, int out_size, void* d_ws, size_t ws_size, hipStream_t stream) {
    static int grid = 0;
    if (grid == 0) {
        if (n_in != 24 || in_sizes[0] != T * DM || out_size != T * DM || ws_size < WS_END) { fprintf(stderr, "kernel_launch: shape mismatch (n_in %d, in0 %d, out %d, ws %zu < %zu); nothing launched\n", n_in, n_in > 0 ? in_sizes[0] : -1, out_size, ws_size, (size_t)WS_END); grid = -1; return; }
        int dev = 0, cus = 0, per_cu = 0;
        if (hipGetDevice(&dev) != hipSuccess || hipDeviceGetAttribute(&cus, hipDeviceAttributeMultiprocessorCount, dev) != hipSuccess) { grid = -1; return; }
        if (hipFuncSetAttribute((const void*)fwd, hipFuncAttributeMaxDynamicSharedMemorySize, LDS_BYTES) != hipSuccess) { fprintf(stderr, "kernel_launch: hipFuncSetAttribute failed\n"); grid = -1; return; }
        if (hipOccupancyMaxActiveBlocksPerMultiprocessor(&per_cu, (const void*)fwd, NWAVES * 64, LDS_BYTES) != hipSuccess || per_cu < 1)
            fprintf(stderr, "kernel_launch: note: occupancy query reports %d workgroups per CU\n", per_cu);
        (void)hipGetLastError();
        grid = cus;
    }
    if (grid < 0) return;
    if (hipMemsetAsync((char*)d_ws + WS_CTL, 0, CTL_ZERO_BYTES, stream) != hipSuccess) return;
    Args a; memset(&a, 0, sizeof(a));
    for (int i = 0; i < 24; ++i) a.in[i] = (const float*)d_in[i];
    a.out = (float*)d_out; a.ws = (unsigned char*)d_ws;
#if MK_SPLIT
    for (int ph = 0; ph < N_PHASES; ++ph) { a.ph_lo = ph; a.ph_hi = ph + 1; hipLaunchKernelGGL(fwd, dim3(grid), dim3(NWAVES * 64), LDS_BYTES, stream, a); }
#else
    a.ph_lo = 0; a.ph_hi = N_PHASES; hipLaunchKernelGGL(fwd, dim3(grid), dim3(NWAVES * 64), LDS_BYTES, stream, a);
#endif
    const hipError_t le = hipPeekAtLastError();
    if (le != hipSuccess) fprintf(stderr, "kernel_launch: launch failed: %s\n", hipGetErrorName(le));
}
```

```cpp
#include <hip/hip_runtime.h>
#include <cstdio>
#include <cstdint>
#include <cstring>
#include <cmath>
namespace pg8 {
#define PG8_LAS __attribute__((address_space(3)))
typedef unsigned short bf16_t;
typedef short bf16x8 __attribute__((ext_vector_type(8)));
typedef float f32x4 __attribute__((ext_vector_type(4)));
typedef unsigned u32x4 __attribute__((ext_vector_type(4)));
constexpr int BM = 256, BK = 64, HALF = 128, HTB = HALF * BK * 2  , STAGE_BYTES = 8 * HTB, NXCD = 8, WGM = 8;

__host__ __device__ __forceinline__ int lds_byte(int r, int c) { const int st = (r >> 4) * 2 + (c >> 5), rr = r & 15, cc = c & 31, ob = rr * 64 + cc * 2; return st * 1024 + (ob ^ (((ob >> 9) & 1) << 5)); }
__host__ __device__ __forceinline__ void stage_rc(int b, int& R, int& C) { const int st = b / 1024, sb = b % 1024, swz = sb ^ (((sb >> 9) & 1) << 5); R = (st >> 1) * 16 + swz / 64; C = (st & 1) * 32 + (swz % 64) / 2; }
__host__ __device__ __forceinline__ int perm32(int rho) { const int n = rho >> 4, i = rho & 15; return 8 * (i >> 2) + 4 * n + (i & 3); }

struct Unit { int pm, pn; };
struct Gemm { const bf16_t* A; const bf16_t* Bt; int M, N, K; };

struct StaticOrder {
    int nM, nN, nwg, G, c;
    __host__ __device__ void init(int M, int N, int G_, int c_) { nM = M / BM; nN = N / BM; nwg = nM * nN; G = G_; c = c_; }
    __host__ __device__ bool next(int i, Unit& u) const {
        const long L = (long)i * G + c; if (L >= nwg) return false;
        int wgid = (int)L; { const int q = nwg / NXCD, r = nwg % NXCD, xcd = wgid % NXCD, off = wgid / NXCD; wgid = (xcd < r ? xcd * (q + 1) : r * (q + 1) + (xcd - r) * q) + off; }
        const int nig = WGM * nN, gid = wgid / nig, fm = gid * WGM, gsz = (nM - fm) < WGM ? (nM - fm) : WGM;
        u.pm = fm + ((wgid % nig) % gsz); u.pn = (wgid % nig) / gsz; return true;
    }
    __device__ __forceinline__ void a_ready(const Unit&) const {}
    __device__ __forceinline__ void done(const Unit&) const {}
    __device__ __forceinline__ int arow(const Unit&, int R) const { return R; }
};

__device__ __forceinline__ unsigned cvt_pk_bf16(float lo, float hi) { unsigned r; asm volatile("v_cvt_pk_bf16_f32 %0, %1, %2" : "=v"(r) : "v"(lo), "v"(hi)); return r; }

typedef int v4i_t __attribute__((ext_vector_type(4)));
typedef int v8i_t __attribute__((ext_vector_type(8)));
template <class Epi, class Sched, bool ALIGN_EPI = false, bool SP2 = false, bool F8 = false, bool GATHER = false>
__device__ __forceinline__ void gemm_phase(PG8_LAS unsigned char* lds, const Gemm g, const Sched& S, const Epi& E) {
    int tid = threadIdx.x; asm volatile("" : "+v"(tid));
    const int wid = __builtin_amdgcn_readfirstlane(tid >> 6), lane = tid & 63, wr = wid >> 2, wc = wid & 3, fr = lane & 15, fq = lane >> 4;
    const int K = g.K, nt = K / BK;
    unsigned voffA[2], voffB[2];
#pragma unroll
    for (int i = 0; i < 2; ++i) { int R, C; stage_rc(tid * 16 + i * 8192, R, C); const int Rb = Epi::PERM ? ((R & ~31) + perm32(R & 31)) : R;
        voffA[i] = (unsigned)(R * K + C) * 2u; voffB[i] = (unsigned)(Rb * K + C) * 2u; }
    static_assert(!GATHER || SP2, "the gather form is written for the two-super-phase loop");
    unsigned vo[2][2], nvo[2][2];
#define PG8_SETVO(dst, u) do { _Pragma("unroll") for (int _h = 0; _h < 2; ++_h) _Pragma("unroll") for (int _i = 0; _i < 2; ++_i) { \
        if constexpr (GATHER) { int R_, C_; stage_rc(tid * 16 + _i * 8192, R_, C_); dst[_h][_i] = (unsigned)(S.arow(u, R_ + HALF * _h) * K + C_) * 2u; } \
        else dst[_h][_i] = voffA[_i] + (unsigned)_h * (unsigned)(HALF * K * 2); } } while (0)
    const size_t kstep = (size_t)(BK * 2);
    const size_t hstep = (size_t)HALF * K * 2;
    const size_t tstep = 2 * hstep;
    const unsigned ldsw = (unsigned)wid * 1024u;
    const int aoff = lds_byte(wr * 64 + fr, fq * 8), boff = lds_byte(wc * 32 + fr, fq * 8);
#define PG8_SA(b, h) (((b) * 2 + (h)) * HTB)
#define PG8_SB(b, h) ((4 + (b) * 2 + (h)) * HTB)
#define PG8_STAGE(bufoff, gbase, voff) do { _Pragma("unroll") for (int _i = 0; _i < 2; ++_i) \
        __builtin_amdgcn_global_load_lds((const unsigned*)((const char*)(gbase) + (voff)[_i]), (PG8_LAS unsigned*)(lds + (bufoff) + ldsw + _i * 8192), 16, 0, 0); } while (0)
#define PG8_LDA(dst, b, h) do { _Pragma("unroll") for (int m = 0; m < 4; ++m) _Pragma("unroll") for (int k = 0; k < 2; ++k) dst[m][k] = *(const PG8_LAS bf16x8*)(lds + PG8_SA(b, h) + aoff + m * 2048 + k * 1024); } while (0)
#define PG8_LDB(dst, b, h) do { _Pragma("unroll") for (int n = 0; n < 2; ++n) _Pragma("unroll") for (int k = 0; k < 2; ++k) dst[n][k] = *(const PG8_LAS bf16x8*)(lds + PG8_SB(b, h) + boff + n * 2048 + k * 1024); } while (0)
#define PG8_MMA(ai, bj, At, Bt) do { __builtin_amdgcn_s_setprio(1); _Pragma("unroll") for (int m = 0; m < 4; ++m) _Pragma("unroll") for (int n = 0; n < 2; ++n) { \
        if constexpr (F8) { const v8i_t _b = __builtin_shufflevector(__builtin_bit_cast(v4i_t, Bt[n][0]), __builtin_bit_cast(v4i_t, Bt[n][1]), 0, 1, 2, 3, 4, 5, 6, 7); \
            const v8i_t _a = __builtin_shufflevector(__builtin_bit_cast(v4i_t, At[m][0]), __builtin_bit_cast(v4i_t, At[m][1]), 0, 1, 2, 3, 4, 5, 6, 7); \
            asm volatile("v_mfma_scale_f32_16x16x128_f8f6f4 %0, %1, %2, %0, %3, %3 op_sel_hi:[0,0,0]" : "+v"(acc[ai][bj][m][n]) : "v"(_b), "v"(_a), "v"(f8scale)); } \
        else { _Pragma("unroll") for (int k = 0; k < 2; ++k) acc[ai][bj][m][n] = __builtin_amdgcn_mfma_f32_16x16x32_bf16(Bt[n][k], At[m][k], acc[ai][bj][m][n], 0, 0, 0); } } \
        __builtin_amdgcn_s_setprio(0); } while (0)
#define PG8_WAIT_V(n) asm volatile("s_waitcnt vmcnt(" #n ")" ::: "memory")
#define PG8_WAIT_L(n) asm volatile("s_waitcnt lgkmcnt(" #n ")" ::: "memory")
#define PG8_BAR __builtin_amdgcn_s_barrier()
#define PG8_SCHED __builtin_amdgcn_sched_barrier(0)
    Unit cur, nxt; int ui = 0;
    if (!S.next(0, cur)) return;
    const int f8scale = 0x7f7f7f7f;
    f32x4 acc[2][2][4][2];
#pragma unroll
    for (int a = 0; a < 2; ++a)
#pragma unroll
        for (int b = 0; b < 2; ++b)
#pragma unroll
            for (int m = 0; m < 4; ++m)
#pragma unroll
                for (int n = 0; n < 2; ++n) acc[a][b][m][n] = (f32x4){0.f, 0.f, 0.f, 0.f};
    bf16x8 At[4][2], B0[2][2], B1[2][2];
    const char* cA = (const char*)g.A + (GATHER ? (size_t)0 : (size_t)cur.pm * tstep); const char* cB = (const char*)g.Bt + (size_t)cur.pn * tstep;
    PG8_SETVO(vo, cur);
    S.a_ready(cur);
    if constexpr (SP2) {
        PG8_STAGE(PG8_SB(0, 0), cB, voffB); PG8_STAGE(PG8_SB(0, 1), cB + hstep, voffB); PG8_STAGE(PG8_SA(0, 0), cA, vo[0]); PG8_STAGE(PG8_SA(0, 1), cA, vo[1]);
        if (wr == 1) PG8_BAR;
        PG8_WAIT_V(2); PG8_BAR;
        PG8_STAGE(PG8_SB(1, 0), cB + kstep, voffB); PG8_STAGE(PG8_SA(1, 0), cA + kstep, vo[0]); PG8_STAGE(PG8_SB(1, 1), cB + hstep + kstep, voffB);
        PG8_WAIT_V(6); PG8_BAR;
    } else {
        PG8_STAGE(PG8_SB(0, 0), cB, voffB); PG8_STAGE(PG8_SA(0, 0), cA, vo[0]); PG8_STAGE(PG8_SB(0, 1), cB + hstep, voffB); PG8_STAGE(PG8_SA(0, 1), cA, vo[1]);
        if (wr == 1) PG8_BAR;
        PG8_WAIT_V(4); PG8_BAR;
        PG8_STAGE(PG8_SB(1, 0), cB + kstep, voffB); PG8_STAGE(PG8_SA(1, 0), cA + kstep, vo[0]); PG8_STAGE(PG8_SB(1, 1), cB + hstep + kstep, voffB);
        PG8_WAIT_V(6); PG8_BAR;
    }
    for (;;) {
        const bool has_next = S.next(ui + 1, nxt);
        const char* nA = (has_next && !GATHER) ? (const char*)g.A + (size_t)nxt.pm * tstep : cA; const char* nB = has_next ? (const char*)g.Bt + (size_t)nxt.pn * tstep : cB;
        if (has_next) { PG8_SETVO(nvo, nxt); } else {
#pragma unroll
            for (int _h = 0; _h < 2; ++_h)
#pragma unroll
                for (int _i = 0; _i < 2; ++_i) nvo[_h][_i] = vo[_h][_i]; }
        for (int t = 0; t < nt; t += 2) {
            const bool last = (t == nt - 2);
            const char* a1 = cA + (size_t)(t + 1) * kstep;
            const char* a2 = last ? nA : cA + (size_t)(t + 2) * kstep; const char* b2 = last ? nB : cB + (size_t)(t + 2) * kstep;
            const char* a3 = a2 + kstep; const char* b3 = b2 + kstep;
            unsigned s0[2], s1[2];
#pragma unroll
            for (int _i = 0; _i < 2; ++_i) { s0[_i] = last ? nvo[0][_i] : vo[0][_i]; s1[_i] = last ? nvo[1][_i] : vo[1][_i]; }
            if (last && has_next) S.a_ready(nxt);
            if constexpr (SP2) {
            PG8_LDB(B0, 0, 0); PG8_LDB(B1, 0, 1); PG8_SCHED; PG8_LDA(At, 0, 0); PG8_STAGE(PG8_SA(1, 1), a1, vo[1]);
            PG8_WAIT_V(8); PG8_WAIT_L(0); PG8_BAR; PG8_MMA(0, 0, At, B0); PG8_MMA(0, 1, At, B1); PG8_BAR; PG8_SCHED;
            PG8_LDA(At, 0, 1); PG8_STAGE(PG8_SB(0, 0), b2, voffB); PG8_STAGE(PG8_SB(0, 1), b2 + hstep, voffB); PG8_STAGE(PG8_SA(0, 0), a2, s0);
            PG8_WAIT_V(8); PG8_WAIT_L(0); PG8_BAR; PG8_MMA(1, 0, At, B0); PG8_MMA(1, 1, At, B1); PG8_BAR; PG8_SCHED;
            PG8_LDB(B0, 1, 0); PG8_LDB(B1, 1, 1); PG8_SCHED; PG8_LDA(At, 1, 0); PG8_STAGE(PG8_SA(0, 1), a2, s1);
            PG8_WAIT_V(8); PG8_WAIT_L(0); PG8_BAR; PG8_MMA(0, 0, At, B0); PG8_MMA(0, 1, At, B1); PG8_BAR; PG8_SCHED;
            PG8_LDA(At, 1, 1); PG8_STAGE(PG8_SB(1, 0), b3, voffB); PG8_STAGE(PG8_SB(1, 1), b3 + hstep, voffB); PG8_STAGE(PG8_SA(1, 0), a3, s0);
            PG8_WAIT_V(8); PG8_WAIT_L(0); PG8_BAR; PG8_MMA(1, 0, At, B0); PG8_MMA(1, 1, At, B1); PG8_BAR; PG8_SCHED;
            } else {
            PG8_LDB(B0, 0, 0); PG8_SCHED; PG8_LDA(At, 0, 0); PG8_STAGE(PG8_SA(1, 1), a1, vo[1]);
            PG8_WAIT_L(8); PG8_BAR; PG8_WAIT_L(0); PG8_MMA(0, 0, At, B0); PG8_BAR; PG8_SCHED;
            PG8_LDB(B1, 0, 1); PG8_STAGE(PG8_SB(0, 0), b2, voffB);
            PG8_BAR; PG8_WAIT_L(0); PG8_MMA(0, 1, At, B1); PG8_BAR;
            PG8_LDA(At, 0, 1); PG8_STAGE(PG8_SA(0, 0), a2, s0);
            PG8_BAR; PG8_WAIT_L(0); PG8_MMA(1, 0, At, B0); PG8_BAR; PG8_SCHED;
            PG8_STAGE(PG8_SB(0, 1), b2 + hstep, voffB);
            PG8_WAIT_V(6); PG8_BAR; PG8_MMA(1, 1, At, B1); PG8_BAR;
            PG8_LDB(B0, 1, 0); PG8_SCHED; PG8_LDA(At, 1, 0); PG8_STAGE(PG8_SA(0, 1), a2, s1);
            PG8_WAIT_L(8); PG8_BAR; PG8_WAIT_L(0); PG8_MMA(0, 0, At, B0); PG8_BAR; PG8_SCHED;
            PG8_LDB(B1, 1, 1); PG8_STAGE(PG8_SB(1, 0), b3, voffB);
            PG8_BAR; PG8_WAIT_L(0); PG8_MMA(0, 1, At, B1); PG8_BAR;
            PG8_LDA(At, 1, 1); PG8_STAGE(PG8_SA(1, 0), a3, s0);
            PG8_BAR; PG8_WAIT_L(0); PG8_MMA(1, 0, At, B0); PG8_BAR; PG8_SCHED;
            PG8_STAGE(PG8_SB(1, 1), b3 + hstep, voffB);
            PG8_WAIT_V(6); PG8_BAR; PG8_MMA(1, 1, At, B1); PG8_BAR;
            }
        }
        if constexpr (F8) asm volatile("s_nop 15\n\ts_nop 7" ::: "memory");
        if constexpr (ALIGN_EPI) { if (wr == 0) PG8_BAR; }
        if constexpr (!Epi::AFTER_DRAIN) { E(acc, cur, wr, wc, fr, fq); S.done(cur); }
        if (!has_next) break;
#pragma unroll
        for (int a = 0; a < 2; ++a)
#pragma unroll
            for (int b = 0; b < 2; ++b)
#pragma unroll
                for (int m = 0; m < 4; ++m)
#pragma unroll
                    for (int n = 0; n < 2; ++n) acc[a][b][m][n] = (f32x4){0.f, 0.f, 0.f, 0.f};
        cur = nxt; cA = nA; cB = nB; ++ui;
#pragma unroll
        for (int _h = 0; _h < 2; ++_h)
#pragma unroll
            for (int _i = 0; _i < 2; ++_i) vo[_h][_i] = nvo[_h][_i];
        if constexpr (ALIGN_EPI) { if (wr == 1) PG8_BAR; }
    }
    PG8_WAIT_V(0);
    if constexpr (!ALIGN_EPI) { if (wr == 0) PG8_BAR; }
    PG8_BAR;
    if constexpr (Epi::AFTER_DRAIN) { E.fused(acc, cur, wr, wc, fr, fq, lds, wid, lane); S.done(cur); }
#undef PG8_SA
#undef PG8_SETVO
#undef PG8_SB
#undef PG8_STAGE
#undef PG8_LDA
#undef PG8_LDB
#undef PG8_MMA
#undef PG8_WAIT_V
#undef PG8_WAIT_L
#undef PG8_BAR
#undef PG8_SCHED
}
}
namespace pg8 {
typedef float f32x2e __attribute__((ext_vector_type(2)));
__device__ __forceinline__ float bf_lo(unsigned w) { return __uint_as_float(w << 16); }
__device__ __forceinline__ float bf_hi(unsigned w) { return __uint_as_float(w & 0xffff0000u); }
__device__ __forceinline__ float sigmoidf_fast(float x) { return __builtin_amdgcn_rcpf(1.0f + __expf(-x)); }

struct EpiBf16B {
    static constexpr bool PERM = true, AFTER_DRAIN = false;
    bf16_t* O; int ldc; const float* bias; int ntile_mod; float scale;
    __device__ __forceinline__ void operator()(const f32x4 (&acc)[2][2][4][2], const Unit& u, int wr, int wc, int fr, int fq) const {
        const int row0 = u.pm * BM + wr * 64 + fr; const int colt = (u.pn % ntile_mod) * BM;
        const int col0 = colt + wc * 32 + 8 * fq, bcol0 = u.pn * BM + wc * 32 + 8 * fq;
        f32x4 bv[2][2];
#pragma unroll
        for (int bj = 0; bj < 2; ++bj)
#pragma unroll
            for (int n = 0; n < 2; ++n) bv[bj][n] = bias ? *(const f32x4*)(bias + bcol0 + bj * HALF + 4 * n) : (f32x4){0.f, 0.f, 0.f, 0.f};
#pragma unroll
        for (int ai = 0; ai < 2; ++ai)
#pragma unroll
            for (int m = 0; m < 4; ++m) { bf16_t* rowp = O + (size_t)(row0 + ai * HALF + m * 16) * ldc + col0;
#pragma unroll
                for (int bj = 0; bj < 2; ++bj) { const f32x4 v0 = acc[ai][bj][m][0] * scale + bv[bj][0], v1 = acc[ai][bj][m][1] * scale + bv[bj][1];
                    u32x4 w; w.x = cvt_pk_bf16(v0[0], v0[1]); w.y = cvt_pk_bf16(v0[2], v0[3]); w.z = cvt_pk_bf16(v1[0], v1[1]); w.w = cvt_pk_bf16(v1[2], v1[3]);
                    *(u32x4*)(rowp + bj * HALF) = w; } }
    }
};
struct EpiQKV {
    static constexpr bool PERM = true, AFTER_DRAIN = false;
    bf16_t* O; int ldc; unsigned long long gmap; float scale;
    static constexpr long Q8_FROM_O = (610L - 96L) * 1048576L;
    __device__ __forceinline__ void operator()(const f32x4 (&acc)[2][2][4][2], const Unit& u, int wr, int wc, int fr, int fq) const {
        const int og = (int)((gmap >> (4 * (u.pn >> 2))) & 15ull); const bool sg = og >= 6;
        const int row0 = u.pm * BM + wr * 64 + fr; const int col0 = (og * 4 + (u.pn & 3)) * BM + wc * 32 + 8 * fq;
#pragma unroll
        for (int ai = 0; ai < 2; ++ai)
#pragma unroll
            for (int m = 0; m < 4; ++m) { bf16_t* rowp = O + (size_t)(row0 + ai * HALF + m * 16) * ldc + col0;
#pragma unroll
                for (int bj = 0; bj < 2; ++bj) { f32x4 v0 = acc[ai][bj][m][0] * scale, v1 = acc[ai][bj][m][1] * scale;
                    if (og == 3 || og == 4) {
                        int w0 = __builtin_amdgcn_cvt_pk_fp8_f32(v0[0] * 8.f, v0[1] * 8.f, 0, false); w0 = __builtin_amdgcn_cvt_pk_fp8_f32(v0[2] * 8.f, v0[3] * 8.f, w0, true);
                        int w1 = __builtin_amdgcn_cvt_pk_fp8_f32(v1[0] * 8.f, v1[1] * 8.f, 0, false); w1 = __builtin_amdgcn_cvt_pk_fp8_f32(v1[2] * 8.f, v1[3] * 8.f, w1, true);
                        typedef int v2i_q __attribute__((ext_vector_type(2)));
                        *(v2i_q*)((unsigned char*)O + Q8_FROM_O + (size_t)(row0 + ai * HALF + m * 16) * 2048 + (og - 3) * 1024 + (u.pn & 3) * BM + wc * 32 + 8 * fq + bj * HALF) = (v2i_q){w0, w1};
                        continue; }
                    if (sg) {
#pragma unroll
                        for (int i = 0; i < 4; ++i) { v0[i] = sigmoidf_fast(v0[i]); v1[i] = sigmoidf_fast(v1[i]); } }
                    u32x4 w; w.x = cvt_pk_bf16(v0[0], v0[1]); w.y = cvt_pk_bf16(v0[2], v0[3]); w.z = cvt_pk_bf16(v1[0], v1[1]); w.w = cvt_pk_bf16(v1[2], v1[3]);
                    *(u32x4*)(rowp + bj * HALF) = w; } }
    }
};
struct EpiM1 {
    static constexpr bool PERM = true, AFTER_DRAIN = false;
    bf16_t* M1; const bf16_t* G; int ldg;
    __device__ __forceinline__ void operator()(const f32x4 (&acc)[2][2][4][2], const Unit& u, int wr, int wc, int fr, int fq) const {
        const int row0 = u.pm * BM + wr * 64 + fr; const int col0 = u.pn * BM + wc * 32 + 8 * fq;
#pragma unroll
        for (int ai = 0; ai < 2; ++ai)
#pragma unroll
            for (int m = 0; m < 4; ++m) { const size_t row = (size_t)(row0 + ai * HALF + m * 16);
#pragma unroll
                for (int bj = 0; bj < 2; ++bj) { const int col = col0 + bj * HALF; const u32x4 g = *(const u32x4*)(G + row * ldg + col);
                    const f32x4 a0 = acc[ai][bj][m][0], a1 = acc[ai][bj][m][1];
                    const f32x4 o0 = {a0[0] * bf_lo(g.x), a0[1] * bf_hi(g.x), a0[2] * bf_lo(g.y), a0[3] * bf_hi(g.y)};
                    const f32x4 o1 = {a1[0] * bf_lo(g.z), a1[1] * bf_hi(g.z), a1[2] * bf_lo(g.w), a1[3] * bf_hi(g.w)};
                    u32x4 w; w.x = cvt_pk_bf16(o0[0], o0[1]); w.y = cvt_pk_bf16(o0[2], o0[3]); w.z = cvt_pk_bf16(o1[0], o1[1]); w.w = cvt_pk_bf16(o1[2], o1[3]);
                    *(u32x4*)(M1 + row * 2048 + col) = w; } }
    }
};
struct EpiMerged {
    static constexpr bool PERM = true, AFTER_DRAIN = false;
    const bf16_t* M1; const bf16_t* G; int ldg; unsigned char* MG;
    __device__ __forceinline__ void operator()(const f32x4 (&acc)[2][2][4][2], const Unit& u, int wr, int wc, int fr, int fq) const {
        const int row0 = u.pm * BM + wr * 64 + fr; const int col0 = u.pn * BM + wc * 32 + 8 * fq;
#pragma unroll
        for (int ai = 0; ai < 2; ++ai)
#pragma unroll
            for (int m = 0; m < 4; ++m) { const size_t row = (size_t)(row0 + ai * HALF + m * 16);
#pragma unroll
                for (int bj = 0; bj < 2; ++bj) { const int col = col0 + bj * HALF; const u32x4 g = *(const u32x4*)(G + row * ldg + col);
                    const u32x4 mw = *(const u32x4*)(M1 + row * 2048 + col);
                    const f32x4 m0 = {bf_lo(mw.x), bf_hi(mw.x), bf_lo(mw.y), bf_hi(mw.y)}, m1 = {bf_lo(mw.z), bf_hi(mw.z), bf_lo(mw.w), bf_hi(mw.w)};
                    const f32x4 a0 = acc[ai][bj][m][0], a1 = acc[ai][bj][m][1];
                    const f32x4 o0 = {m0[0] + a0[0] * bf_lo(g.x), m0[1] + a0[1] * bf_hi(g.x), m0[2] + a0[2] * bf_lo(g.y), m0[3] + a0[3] * bf_hi(g.y)};
                    const f32x4 o1 = {m1[0] + a1[0] * bf_lo(g.z), m1[1] + a1[1] * bf_hi(g.z), m1[2] + a1[2] * bf_lo(g.w), m1[3] + a1[3] * bf_hi(g.w)};
                    int w0 = __builtin_amdgcn_cvt_pk_fp8_f32(o0[0] * 16.f, o0[1] * 16.f, 0, false); w0 = __builtin_amdgcn_cvt_pk_fp8_f32(o0[2] * 16.f, o0[3] * 16.f, w0, true);
                    int w1 = __builtin_amdgcn_cvt_pk_fp8_f32(o1[0] * 16.f, o1[1] * 16.f, 0, false); w1 = __builtin_amdgcn_cvt_pk_fp8_f32(o1[2] * 16.f, o1[3] * 16.f, w1, true);
                    typedef int v2i_m __attribute__((ext_vector_type(2))); *(v2i_m*)(MG + row * 2048 + col) = (v2i_m){w0, w1}; } }
    }
};
struct EpiMergedB {
    static constexpr bool PERM = true, AFTER_DRAIN = false;
    const bf16_t* M1; const bf16_t* G; int ldg; bf16_t* MG;
    __device__ __forceinline__ void operator()(const f32x4 (&acc)[2][2][4][2], const Unit& u, int wr, int wc, int fr, int fq) const {
        const int row0 = u.pm * BM + wr * 64 + fr; const int col0 = u.pn * BM + wc * 32 + 8 * fq;
#pragma unroll
        for (int ai = 0; ai < 2; ++ai)
#pragma unroll
            for (int m = 0; m < 4; ++m) { const size_t row = (size_t)(row0 + ai * HALF + m * 16);
#pragma unroll
                for (int bj = 0; bj < 2; ++bj) { const int col = col0 + bj * HALF; const u32x4 g = *(const u32x4*)(G + row * ldg + col);
                    const u32x4 mw = *(const u32x4*)(M1 + row * 2048 + col);
                    const f32x4 m0 = {bf_lo(mw.x), bf_hi(mw.x), bf_lo(mw.y), bf_hi(mw.y)}, m1 = {bf_lo(mw.z), bf_hi(mw.z), bf_lo(mw.w), bf_hi(mw.w)};
                    const f32x4 a0 = acc[ai][bj][m][0], a1 = acc[ai][bj][m][1];
                    const f32x4 o0 = {m0[0] + a0[0] * bf_lo(g.x), m0[1] + a0[1] * bf_hi(g.x), m0[2] + a0[2] * bf_lo(g.y), m0[3] + a0[3] * bf_hi(g.y)};
                    const f32x4 o1 = {m1[0] + a1[0] * bf_lo(g.z), m1[1] + a1[1] * bf_hi(g.z), m1[2] + a1[2] * bf_lo(g.w), m1[3] + a1[3] * bf_hi(g.w)};
                    u32x4 w; w.x = cvt_pk_bf16(o0[0], o0[1]); w.y = cvt_pk_bf16(o0[2], o0[3]); w.z = cvt_pk_bf16(o1[0], o1[1]); w.w = cvt_pk_bf16(o1[2], o1[3]);
                    *(u32x4*)(MG + row * 2048 + col) = w; } }
    }
};
struct EpiH1 {
    static constexpr bool PERM = false, AFTER_DRAIN = false;
    const float* X; float* H1; const float* g1; int g1_stride; int tiles_per_batch; float wscale;
    __device__ __forceinline__ void operator()(const f32x4 (&acc)[2][2][4][2], const Unit& u, int wr, int wc, int fr, int fq) const {
        const int row0 = u.pm * BM + wr * 64 + fr; const int col0 = u.pn * BM + wc * 32 + 4 * fq; const float* gb = g1 + (size_t)(u.pm / tiles_per_batch) * g1_stride;
        f32x4 gv[2][2];
#pragma unroll
        for (int bj = 0; bj < 2; ++bj)
#pragma unroll
            for (int n = 0; n < 2; ++n) gv[bj][n] = *(const f32x4*)(gb + col0 + bj * HALF + n * 16);
#pragma unroll
        for (int ai = 0; ai < 2; ++ai)
#pragma unroll
            for (int m = 0; m < 4; ++m) { const size_t off = (size_t)(row0 + ai * HALF + m * 16) * 2048 + col0;
#pragma unroll
                for (int bj = 0; bj < 2; ++bj)
#pragma unroll
                    for (int n = 0; n < 2; ++n) { const f32x4 xv = *(const f32x4*)(X + off + bj * HALF + n * 16);
                        *(f32x4*)(H1 + off + bj * HALF + n * 16) = xv + gv[bj][n] * (acc[ai][bj][m][n] * wscale); } }
    }
};
struct EpiSwiGLU {
    static constexpr bool PERM = true, AFTER_DRAIN = false;
    unsigned char* Y; const float* bg; const float* bu; float wscale;
    __device__ __forceinline__ void operator()(const f32x4 (&acc)[2][2][4][2], const Unit& u, int wr, int wc, int fr, int fq) const {
        const int e = u.pn >> 4, pnl = u.pn & 15; const int row0 = u.pm * BM + wr * 64 + fr; const int col0 = pnl * HALF + wc * 32 + 8 * fq;
        f32x4 bgv[2], buv[2];
#pragma unroll
        for (int n = 0; n < 2; ++n) { bgv[n] = *(const f32x4*)(bg + (size_t)e * 2048 + col0 + 4 * n); buv[n] = *(const f32x4*)(bu + (size_t)e * 2048 + col0 + 4 * n); }
#pragma unroll
        for (int ai = 0; ai < 2; ++ai)
#pragma unroll
            for (int m = 0; m < 4; ++m) { unsigned char* rowp = Y + (size_t)(row0 + ai * HALF + m * 16) * 2048 + col0; f32x4 y[2];
#pragma unroll
                for (int n = 0; n < 2; ++n) { const f32x4 g4 = acc[ai][0][m][n] * wscale + bgv[n], u4 = acc[ai][1][m][n] * wscale + buv[n];
                    f32x4 gc, uc, ex;
#pragma unroll
                    for (int i = 0; i < 4; ++i) { gc[i] = fminf(g4[i], 7.0f); uc[i] = __builtin_amdgcn_fmed3f(u4[i], -7.0f, 7.0f); }
                    const f32x4 t = gc * (-1.702f * 1.4426950408889634f);
#pragma unroll
                    for (int i = 0; i < 4; ++i) ex[i] = __builtin_amdgcn_rcpf(1.0f + __builtin_amdgcn_exp2f(t[i]));
                    y[n] = (uc + 1.0f) * (gc * ex); }
                int w0 = __builtin_amdgcn_cvt_pk_fp8_f32(y[0][0], y[0][1], 0, false); w0 = __builtin_amdgcn_cvt_pk_fp8_f32(y[0][2], y[0][3], w0, true);
                int w1 = __builtin_amdgcn_cvt_pk_fp8_f32(y[1][0], y[1][1], 0, false); w1 = __builtin_amdgcn_cvt_pk_fp8_f32(y[1][2], y[1][3], w1, true);
                typedef int v2i_t __attribute__((ext_vector_type(2))); *(v2i_t*)rowp = (v2i_t){w0, w1}; }
    }
};
struct MoeOrder {
    const PG8_LAS int* tstart; int npn, lo, hi, rank, W; const int* tokof;
    __device__ __forceinline__ int arow(const Unit& u, int R) const { const int e = u.pn / npn, slot = (u.pm - tstart[e]) * 256 + R;
        return slot < tstart[40 + e] ? tokof[e * 8192 + slot] : 0; }
    __device__ __forceinline__ void init(const PG8_LAS int* ts, int npn_, int G, int c, const int* tk = nullptr) { tstart = ts; npn = npn_; tokof = tk; const int U = ts[32] * npn_; const int x = c % NXCD; rank = c / NXCD; W = G / NXCD;
        lo = (int)(((long)U * x) / NXCD); hi = (int)(((long)U * (x + 1)) / NXCD); }
    __device__ __forceinline__ bool next(int i, Unit& u) const {
        const int q = lo + rank + W * i; if (q >= hi) return false;
        const int lk = (int)(threadIdx.x & 31u);
        const int e = __builtin_popcountll(__ballot(tstart[lk] * npn <= q) & 0xffffffffull) - 1;
        const int ts = tstart[e], te = tstart[e + 1] - ts, qq = q - ts * npn;
        u.pm = ts + qq % te; u.pn = e * npn + qq / te; return true;
    }
    __device__ __forceinline__ void a_ready(const Unit&) const {}
    __device__ __forceinline__ void done(const Unit&) const {}
};
}
namespace att {
using bf16x8 = __attribute__((ext_vector_type(8))) short;
using s16x4  = __attribute__((ext_vector_type(4))) short;
using f32x16 = __attribute__((ext_vector_type(16))) float;
using u32x4  = __attribute__((ext_vector_type(4))) unsigned;
using f32x4v = __attribute__((ext_vector_type(4))) float;
typedef unsigned short bf16;
constexpr int   D = 128, NW = 8, QBLK = 32, KVBLK = 64;
constexpr float SCALE = 0.088388347648318440f;
constexpr float THR = 8.f;
constexpr size_t SHM_V = KVBLK * D * 2, SHM_K = KVBLK * D * 2, SHM_ATTN = 2 * SHM_V + 2 * SHM_K + NW * 64 * 4;
#define KSWZ(row, colB) ((row) * 256 + ((colB) ^ (((row) & 7) << 4)))
#define SBAR() __builtin_amdgcn_sched_barrier(0)
__device__ __forceinline__ int crow(int r, int hi) { return (r & 3) + 8 * (r >> 2) + 4 * hi; }
__device__ __forceinline__ unsigned cvtpk(float lo, float hi) { unsigned r; asm volatile("v_cvt_pk_bf16_f32 %0, %1, %2" : "=v"(r) : "v"(lo), "v"(hi)); return r; }

template <int MODE>
__device__ __forceinline__ void partialSM(f32x16& p0, f32x16& p1, float& m_reg, float& mn, float& alpha, float relb, float kk, bool valid, int side = 0) {
  constexpr float C = SCALE * 1.4426950408889634f;
  float base = 0.f;
  if (MODE == 0 && side != 0) {
    const float skk = side > 0 ? kk : -kk; base = -skk * relb;
#pragma unroll
    for (int r = 0; r < 16; ++r) { p0[r] = fmaf(skk, (float)((r & 3) + 8 * (r >> 2)), p0[r]); p1[r] = fmaf(skk, (float)((r & 3) + 8 * (r >> 2) + 32), p1[r]); }
  } else {
#pragma unroll
    for (int r = 0; r < 16; ++r) {
      const float d0 = relb - (float)((r & 3) + 8 * (r >> 2)), a0 = __builtin_fabsf(d0), a1 = __builtin_fabsf(d0 - 32.f);
      p0[r] = fmaf(a0, -kk, p0[r]); p1[r] = fmaf(a1, -kk, p1[r]);
      if (MODE == 1) { if (!(valid && a0 <= 64.f)) p0[r] = -INFINITY; if (!(valid && a1 <= 64.f)) p1[r] = -INFINITY; }
    }
  }
  float pmax = p0[0];
#pragma unroll
  for (int r = 1; r < 16; ++r) pmax = fmaxf(pmax, p0[r]);
#pragma unroll
  for (int r = 0; r < 16; ++r) pmax = fmaxf(pmax, p1[r]);
  { auto rr = __builtin_amdgcn_permlane32_swap(__float_as_uint(pmax), __float_as_uint(pmax), false, false);
    pmax = fmaxf(__uint_as_float(rr[0]), __uint_as_float(rr[1])); }
  pmax += base;
  if (__builtin_expect(__all(pmax - m_reg <= THR / SCALE), 1)) { mn = m_reg; alpha = 1.f; }
  else { mn = fmaxf(m_reg, pmax); alpha = __builtin_amdgcn_exp2f((m_reg - mn) * C); m_reg = mn; }
  const float mnC = (base - mn) * C;
#pragma unroll
  for (int r = 0; r < 16; ++r) p0[r] = fmaf(p0[r], C, mnC);
#pragma unroll
  for (int r = 0; r < 16; ++r) p1[r] = fmaf(p1[r], C, mnC);
#pragma unroll
  for (int r = 0; r < 16; ++r) p0[r] = __builtin_amdgcn_exp2f(p0[r]);
}
__device__ __forceinline__ void finishSM(f32x16& p0, f32x16& p1, float alpha, float& l_reg, bf16x8& pa0, bf16x8& pa1, bf16x8& pa2, bf16x8& pa3) {
#pragma unroll
  for (int r = 0; r < 16; ++r) p1[r] = __builtin_amdgcn_exp2f(p1[r]);
  float ps = 0;
#pragma unroll
  for (int r = 0; r < 16; ++r) ps += p0[r];
#pragma unroll
  for (int r = 0; r < 16; ++r) ps += p1[r];
  { auto rr = __builtin_amdgcn_permlane32_swap(__float_as_uint(ps), __float_as_uint(ps), false, false);
    ps = __uint_as_float(rr[0]) + __uint_as_float(rr[1]); }
  l_reg = l_reg * alpha + ps;
#define PK4(P, BASE, OUT) do { unsigned a0 = cvtpk(P[BASE + 0], P[BASE + 1]), a1 = cvtpk(P[BASE + 2], P[BASE + 3]);   \
    unsigned b0 = cvtpk(P[BASE + 4], P[BASE + 5]), b1 = cvtpk(P[BASE + 6], P[BASE + 7]);                              \
    auto r0 = __builtin_amdgcn_permlane32_swap(a0, b0, false, false); auto r1 = __builtin_amdgcn_permlane32_swap(a1, b1, false, false); \
    u32x4 w = {r0[0], r1[0], r0[1], r1[1]}; OUT = *reinterpret_cast<bf16x8*>(&w); } while (0)
  PK4(p0, 0, pa0); PK4(p0, 8, pa1); PK4(p1, 0, pa2); PK4(p1, 8, pa3);
#undef PK4
}
__device__ __forceinline__ void qkt(f32x16& p0, f32x16& p1, const bf16* Ks, const bf16x8* qr, int r32, int hi) {
  p0 = f32x16{}; p1 = f32x16{};
#pragma unroll
  for (int d0 = 0; d0 < 8; ++d0) { const int cb = (d0 * 16 + hi * 8) * 2;
    bf16x8 b0 = *reinterpret_cast<const bf16x8*>((const char*)Ks + KSWZ(r32, cb));
    bf16x8 b1 = *reinterpret_cast<const bf16x8*>((const char*)Ks + KSWZ(32 + r32, cb));
    p0 = __builtin_amdgcn_mfma_f32_32x32x16_bf16(b0, qr[d0], p0, 0, 0, 0);
    p1 = __builtin_amdgcn_mfma_f32_32x32x16_bf16(b1, qr[d0], p1, 0, 0, 0); }
}
__device__ __forceinline__ int v_st(int k, int c) { const int kk = (k & ~0xC) | ((k & 4) << 1) | ((k & 8) >> 1); return ((kk >> 3) * 4 + (c >> 5)) * 512 + ((kk & 7) * 32 + (c & 31)) * 2; }
__device__ __forceinline__ int v_rd_base(int lane) { return ((lane & 3) << 3) | (((lane >> 2) & 3) << 6) | (((lane >> 4) & 1) << 5) | (((lane >> 5) & 1) << 8); }
constexpr int v_rd_off(int d0, int ks, int half) { return d0 * 512 + ks * 4096 + half * 2048; }
template <int OFF> __device__ __forceinline__ s16x4 tr_read(int vb) {
  s16x4 r; asm volatile("ds_read_b64_tr_b16 %0, %1 offset:%2" : "=&v"(r) : "v"(vb), "i"(OFF) : "memory"); return r;
}
template <int D0> __device__ __forceinline__ void pv_one(f32x16& od, int vb, bf16x8 pa0, bf16x8 pa1, bf16x8 pa2, bf16x8 pa3) {
  const s16x4 l0 = tr_read<v_rd_off(D0, 0, 0)>(vb), h0 = tr_read<v_rd_off(D0, 0, 1)>(vb), l1 = tr_read<v_rd_off(D0, 1, 0)>(vb), h1 = tr_read<v_rd_off(D0, 1, 1)>(vb);
  const s16x4 l2 = tr_read<v_rd_off(D0, 2, 0)>(vb), h2 = tr_read<v_rd_off(D0, 2, 1)>(vb), l3 = tr_read<v_rd_off(D0, 3, 0)>(vb), h3 = tr_read<v_rd_off(D0, 3, 1)>(vb);
  asm volatile("s_waitcnt lgkmcnt(0)" ::: "memory"); SBAR();
#define PK(L, H) (bf16x8){L[0], L[1], L[2], L[3], H[0], H[1], H[2], H[3]}
  od = __builtin_amdgcn_mfma_f32_32x32x16_bf16(pa0, PK(l0, h0), od, 0, 0, 0);
  od = __builtin_amdgcn_mfma_f32_32x32x16_bf16(pa1, PK(l1, h1), od, 0, 0, 0);
  od = __builtin_amdgcn_mfma_f32_32x32x16_bf16(pa2, PK(l2, h2), od, 0, 0, 0);
  od = __builtin_amdgcn_mfma_f32_32x32x16_bf16(pa3, PK(l3, h3), od, 0, 0, 0);
#undef PK
}
__device__ __forceinline__ void pv_d0(f32x16* o, int vb, bf16x8 pa0, bf16x8 pa1, bf16x8 pa2, bf16x8 pa3) {
  pv_one<0>(o[0], vb, pa0, pa1, pa2, pa3); pv_one<1>(o[1], vb, pa0, pa1, pa2, pa3); pv_one<2>(o[2], vb, pa0, pa1, pa2, pa3); pv_one<3>(o[3], vb, pa0, pa1, pa2, pa3);
}

__device__ __forceinline__ const void* uni_ptr(const void* p) { const unsigned long long u = (unsigned long long)p;
  const unsigned lo = (unsigned)__builtin_amdgcn_readfirstlane((int)(unsigned)u), hi = (unsigned)__builtin_amdgcn_readfirstlane((int)(unsigned)(u >> 32)); return (const void*)(((unsigned long long)hi << 32) | lo); }
constexpr int PB_Q = 6, PB_ZONE = PB_Q * 1024, PB_TPITCH = 128, PB_TILE = 32 * PB_TPITCH, PB_WAVE = PB_ZONE + PB_TILE, PB_NIT = 96 * 1024;
#define PB_GAS __attribute__((address_space(1)))
#define PB_LAS __attribute__((address_space(3)))
struct Pb { int total, gw, NGW; const float* pg; long du, dd; PB_GAS unsigned char* wgu; PB_GAS unsigned char* wd; unsigned zone; };
__device__ __forceinline__ const char* pb_src(const Pb& pb, int it) {
  const int m = it >> 10, tp = it & 1023, e = m / 3, w = m % 3;
  return (const char*)pb.pg + pb.du * (long)(w == 1) + pb.dd * (long)(w == 2) + ((size_t)e * 2048 * 2048 + (size_t)((tp >> 6) * 128) * 2048 + (tp & 63) * 32) * 4;
}
__device__ __forceinline__ PB_GAS unsigned char* pb_dst(const Pb& pb, int it) {
  const int m = it >> 10, tp = it & 1023, e = m / 3, w = m % 3, k0 = (tp >> 6) * 128, n0 = (tp & 63) * 32;
  if (w == 2) return pb.wd + ((size_t)e * 2048 + n0) * 2048 + k0;
  return pb.wgu + ((size_t)e * 4096 + (size_t)(n0 >> 7) * 256 + (n0 & 127) + (w == 1 ? 128 : 0)) * 2048 + k0;
}
__device__ __forceinline__ int pb_issue(const Pb pb, int& c_issue, const char*& isrc, int lane) {
  asm volatile("s_waitcnt lgkmcnt(0)" ::: "memory");
  const int n = (pb.total - c_issue) < PB_Q ? (pb.total - c_issue) : PB_Q;
  if (n <= 0) return 0;
  const unsigned loff = (unsigned)(((lane >> 3) * 2048 + 4 * (lane & 7)) * 4);
  const unsigned z0 = (unsigned)__builtin_amdgcn_readfirstlane((int)pb.zone);
  unsigned keep; asm volatile("s_mov_b32 %0, m0" : "=s"(keep) :: "memory");
#pragma unroll
  for (int q = 0; q < PB_Q; ++q) { if (q < n) {
    if (((c_issue + q) & 15) == 0) isrc = (const char*)uni_ptr(pb_src(pb, pb.gw + ((c_issue + q) >> 4) * pb.NGW));
    asm volatile("s_mov_b32 m0, %2\n\ts_nop 0\n\tglobal_load_lds_dwordx4 %0, %1 sc1 nt" :: "v"(loff), "s"(isrc), "s"(z0 + q * 1024) : "memory");
    isrc += 65536; } }
  asm volatile("s_mov_b32 m0, %0" :: "s"(keep) : "memory");
  c_issue += n; return n;
}
__device__ __forceinline__ void pb_process(const Pb pb, int& c_proc, const int c_issue, char* lds_, int lane) {
  const int nn = lane & 31, a = lane >> 5;
  PB_LAS char* lds = (PB_LAS char*)lds_;
  PB_LAS char* tile = lds + pb.zone + PB_ZONE;
  const unsigned twr = (unsigned)(uintptr_t)(tile + nn * PB_TPITCH + 4 * a), nx = (unsigned)((nn & 7) << 4);
  const PB_LAS float* zrd = (const PB_LAS float*)(lds + pb.zone) + (4 * a) * 32 + nn;
  const int n = c_issue - c_proc;
#pragma unroll
  for (int q = 0; q < PB_Q; ++q) { if (q < n) {
    const int i = (c_proc + q) & 15;
    const PB_LAS float* z = zrd + q * 256;
    typedef float f2 __attribute__((ext_vector_type(2)));
    const f2 t01 = (f2){z[0], z[32]} * 64.f, t23 = (f2){z[64], z[96]} * 64.f;
    int w0 = __builtin_amdgcn_cvt_pk_fp8_f32(t01.x, t01.y, (int)__float_as_uint(t01.x), false); w0 = __builtin_amdgcn_cvt_pk_fp8_f32(t23.x, t23.y, w0, true);
    *(PB_LAS int*)(uintptr_t)((((unsigned)i << 3) ^ nx) + twr) = w0;
    if (i == 15) {
      PB_GAS unsigned char* dst = pb_dst(pb, pb.gw + ((c_proc + q) >> 4) * pb.NGW);
      const int lr = lane >> 3, l7 = lane & 7;
      const PB_LAS char* trd = tile + lr * PB_TPITCH + ((l7 ^ lr) << 4);
      const unsigned voff = (unsigned)(lr * 2048 + 16 * l7);
#pragma unroll
      for (int j = 0; j < 4; ++j) { const u32x4 o = *(const PB_LAS u32x4*)(trd + j * 8 * PB_TPITCH);
        __builtin_nontemporal_store(o, (PB_GAS u32x4*)(dst + (voff + (unsigned)j * 16384u))); }
    } } }
  c_proc = c_issue;
}
__device__ __forceinline__ int pb_step(const Pb pb, int& c_issue, int& c_proc, const char*& isrc, char* lds, int lane) {
  asm volatile("s_waitcnt vmcnt(4)" ::: "memory");
  pb_process(pb, c_proc, c_issue, lds, lane); return pb_issue(pb, c_issue, isrc, lane); }
__device__ __forceinline__ void pb_drain(const Pb pb, int& c_issue, int& c_proc, const char*& isrc, char* lds, int lane) {
#pragma unroll 1
  for (;;) { if (c_proc < c_issue) { asm volatile("s_waitcnt vmcnt(0)" ::: "memory"); pb_process(pb, c_proc, c_issue, lds, lane); }
    if (c_issue >= pb.total) break; (void)pb_issue(pb, c_issue, isrc, lane); }
  asm volatile("s_waitcnt vmcnt(0) lgkmcnt(0)" ::: "memory");
}

template <int D0> __device__ __forceinline__ void pv32_one(f32x16& od, int vb, bf16x8 pa0, bf16x8 pa1) {
  const s16x4 l0 = tr_read<v_rd_off(D0, 0, 0)>(vb), h0 = tr_read<v_rd_off(D0, 0, 1)>(vb), l1 = tr_read<v_rd_off(D0, 1, 0)>(vb), h1 = tr_read<v_rd_off(D0, 1, 1)>(vb);
  asm volatile("s_waitcnt lgkmcnt(0)" ::: "memory"); SBAR();
#define PK(L, H) (bf16x8){L[0], L[1], L[2], L[3], H[0], H[1], H[2], H[3]}
  od = __builtin_amdgcn_mfma_f32_32x32x16_bf16(pa0, PK(l0, h0), od, 0, 0, 0);
  od = __builtin_amdgcn_mfma_f32_32x32x16_bf16(pa1, PK(l1, h1), od, 0, 0, 0);
#undef PK
}
__device__ __forceinline__ void dilated_wave(const bf16* __restrict__ Qb, const bf16* __restrict__ Kb, const bf16* __restrict__ Vb, long ld, int j0, int L, float kk,
                                             bf16* __restrict__ Ob, long ldo, float* __restrict__ Lp, long ldl, char* ktile, char* vtile, float* scr) {
  constexpr float C = SCALE * 1.4426950408889634f;
  int lane = threadIdx.x & 63; asm volatile("" : "+v"(lane));
  const int r32 = lane & 31, hi = lane >> 5;
  bf16x8 qr[8];
  { const bf16* Qw = Qb + (long)(j0 + r32) * ld + hi * 8;
#pragma unroll
    for (int d0 = 0; d0 < 8; ++d0) qr[d0] = *reinterpret_cast<const bf16x8*>(Qw + d0 * 16); }
  float m_reg = -1e30f, l_reg = 0.f; f32x16 o[4] = {};
  const int vb0 = (int)(uintptr_t)vtile + v_rd_base(lane);
  const int sr = lane >> 4, scol = (lane & 15) * 8;
  bf16x8 kn[8], vn[8];
#define DW_LOAD(t_) do { const int kb_ = j0 - 64 + 32 * (t_); const int kbc_ = (kb_ >= 0 && kb_ < L) ? kb_ : j0;   \
    const bf16* Kw_ = Kb + (long)(kbc_ + sr) * ld + scol; const bf16* Vw_ = Vb + (long)(kbc_ + sr) * ld + scol; \
    _Pragma("unroll") for (int i_ = 0; i_ < 8; ++i_) { kn[i_] = *reinterpret_cast<const bf16x8*>(Kw_ + (long)(4 * i_) * ld); vn[i_] = *reinterpret_cast<const bf16x8*>(Vw_ + (long)(4 * i_) * ld); } } while (0)
  DW_LOAD(0);
#pragma unroll 1
  for (int t = 0; t < 5; ++t) {
    const int kb = j0 - 64 + 32 * t; const bool valid = kb >= 0 && kb < L;
#pragma unroll
    for (int i = 0; i < 8; ++i) { const int row = 4 * i + sr;
      *reinterpret_cast<bf16x8*>(ktile + row * 256 + ((scol * 2) ^ ((row & 7) << 4))) = kn[i];
      *reinterpret_cast<bf16x8*>(vtile + v_st(row, scol)) = vn[i]; }
    if (t + 1 < 5) DW_LOAD(t + 1);
    f32x16 p0 = {};
#pragma unroll
    for (int d0 = 0; d0 < 8; ++d0) { const int cbb = (d0 * 16 + hi * 8) * 2;
      const bf16x8 kf = *reinterpret_cast<const bf16x8*>(ktile + r32 * 256 + (cbb ^ ((r32 & 7) << 4)));
      p0 = __builtin_amdgcn_mfma_f32_32x32x16_bf16(kf, qr[d0], p0, 0, 0, 0); }
    const float relb = (float)(j0 + r32 - kb - 4 * hi);
#pragma unroll
    for (int r = 0; r < 16; ++r) { const float a = __builtin_fabsf(relb - (float)((r & 3) + 8 * (r >> 2))); p0[r] = fmaf(a, -kk, p0[r]); if (!(valid && a <= 64.f)) p0[r] = -INFINITY; }
    float pmax = p0[0];
#pragma unroll
    for (int r = 1; r < 16; ++r) pmax = fmaxf(pmax, p0[r]);
    { auto rr = __builtin_amdgcn_permlane32_swap(__float_as_uint(pmax), __float_as_uint(pmax), false, false); pmax = fmaxf(__uint_as_float(rr[0]), __uint_as_float(rr[1])); }
    const float mn = fmaxf(m_reg, pmax), alpha = __builtin_amdgcn_exp2f((m_reg - mn) * C), mnC = -mn * C; m_reg = mn;
    float ps = 0.f;
#pragma unroll
    for (int r = 0; r < 16; ++r) { p0[r] = __builtin_amdgcn_exp2f(fmaf(p0[r], C, mnC)); ps += p0[r]; }
    { auto rr = __builtin_amdgcn_permlane32_swap(__float_as_uint(ps), __float_as_uint(ps), false, false); ps = __uint_as_float(rr[0]) + __uint_as_float(rr[1]); }
    l_reg = l_reg * alpha + ps;
    if (__any(alpha < 1.f)) { if (hi == 0) scr[r32] = alpha; asm volatile("s_waitcnt lgkmcnt(0)" ::: "memory");
#pragma unroll
      for (int d = 0; d < 4; ++d)
#pragma unroll
        for (int r = 0; r < 16; ++r) o[d][r] *= scr[crow(r, hi)]; }
    bf16x8 pa0, pa1;
#define PK4(P, BASE, OUT) do { unsigned a0 = cvtpk(P[BASE + 0], P[BASE + 1]), a1 = cvtpk(P[BASE + 2], P[BASE + 3]);   \
    unsigned b0 = cvtpk(P[BASE + 4], P[BASE + 5]), b1 = cvtpk(P[BASE + 6], P[BASE + 7]);                              \
    auto r0 = __builtin_amdgcn_permlane32_swap(a0, b0, false, false); auto r1 = __builtin_amdgcn_permlane32_swap(a1, b1, false, false); \
    u32x4 w = {r0[0], r1[0], r0[1], r1[1]}; OUT = *reinterpret_cast<bf16x8*>(&w); } while (0)
    PK4(p0, 0, pa0); PK4(p0, 8, pa1);
#undef PK4
    SBAR();
    pv32_one<0>(o[0], vb0, pa0, pa1); pv32_one<1>(o[1], vb0, pa0, pa1); pv32_one<2>(o[2], vb0, pa0, pa1); pv32_one<3>(o[3], vb0, pa0, pa1);
  }
#undef DW_LOAD
  if (hi == 0) scr[32 + r32] = l_reg; asm volatile("s_waitcnt lgkmcnt(0)" ::: "memory");
  bf16* Ow = Ob + (long)(j0 + 4 * hi) * ldo + r32;
#pragma unroll
  for (int r = 0; r < 16; ++r) { const float rl = __builtin_amdgcn_rcpf(scr[32 + crow(r, hi)]); bf16* Or = Ow + (long)((r & 3) + 8 * (r >> 2)) * ldo;
#pragma unroll
    for (int d0 = 0; d0 < 4; ++d0) { const float y = o[d0][r] * rl; Or[d0 * 32] = (bf16)cvtpk(y, y); } }
  if (hi == 0) Lp[(long)(j0 + r32) * ldl] = m_reg * SCALE + __logf(l_reg);
}

template <int MODE>
__device__ __forceinline__ void attn_body(const bf16* __restrict__ Qb, long ldq, const bf16* __restrict__ Kh, const bf16* __restrict__ Vh, long ldk,
                                          int t0, int NT, int ntmax, int qpos0, float kk, bf16* __restrict__ Ob, long ldo, float* __restrict__ Lb, long ldl, char* lds, const Pb pb, int& pbi, int& pbp, const char*& pbs) {
  int tid = threadIdx.x; asm volatile("" : "+v"(tid));
  const int wid = tid >> 6, lane = tid & 63, r32 = lane & 31, hi = lane >> 5;
  bf16* V_lds = (bf16*)lds; bf16* K_lds = (bf16*)(lds + 2 * SHM_V);
  float* ws = (float*)(lds + 2 * SHM_V + 2 * SHM_K) + wid * 64; float* li_l = ws; float* al_l = ws + 32;
  float m_reg = -1e30f, l_reg = 0; f32x16 o[4] = {}; bf16x8 qr[8];
  const bf16* Qw = Qb + (long)(wid * QBLK + r32) * ldq + hi * 8;
#pragma unroll
  for (int d0 = 0; d0 < 8; ++d0) qr[d0] = *reinterpret_cast<const bf16x8*>(Qw + d0 * 16);
  const int sr = tid >> 4, sc = (tid & 15) * 8, vst0 = v_st(sr, sc), vst1 = v_st(32 + sr, sc);
  const int vb0 = (int)(uintptr_t)V_lds + v_rd_base(lane);
  const unsigned sob0 = 2u * (unsigned)(sr * (int)ldk + sc), sob1 = sob0 + 64u * (unsigned)ldk;
  const float qposf = (float)(qpos0 + wid * QBLK + r32 - 4 * hi);
  const int qlo = qpos0 + __builtin_amdgcn_readfirstlane(wid) * QBLK;
  struct { bf16x8 vs0, vs1, ks0, ks1; } sr_[1];
#define TCL(jt) ({ int _t = t0 + (jt); _t = _t < 0 ? 0 : (_t >= ntmax ? ntmax - 1 : _t); _t * KVBLK; })
#define TVALID(jt) ((t0 + (jt)) >= 0 && (t0 + (jt)) < ntmax)
#define RELB(jt) (qposf - (float)((t0 + (jt)) * KVBLK))
#define SIDE(jt) (qlo > (t0 + (jt)) * KVBLK + (KVBLK - 1) ? 1 : (qlo + (QBLK - 1) < (t0 + (jt)) * KVBLK ? -1 : 0))
#define SLOAD(i, jt) do { const long _k0 = (long)TCL(jt) * ldk; const bf16* _vp = (const bf16*)uni_ptr(Vh + _k0); const bf16* _kp = (const bf16*)uni_ptr(Kh + _k0); \
    asm volatile("s_nop 4\n\tglobal_load_dwordx4 %0, %4, %6\n\tglobal_load_dwordx4 %1, %5, %6\n\tglobal_load_dwordx4 %2, %4, %7\n\tglobal_load_dwordx4 %3, %5, %7" \
        : "=&v"(sr_[i].vs0), "=&v"(sr_[i].vs1), "=&v"(sr_[i].ks0), "=&v"(sr_[i].ks1) : "v"(sob0), "v"(sob1), "s"(_vp), "s"(_kp) : "memory"); } while (0)
#define SWAITN(i, n) asm volatile("s_waitcnt vmcnt(%4)" : "+v"(sr_[i].vs0), "+v"(sr_[i].vs1), "+v"(sr_[i].ks0), "+v"(sr_[i].ks1) : "i"(n) : "memory")
#define BSYNC() asm volatile("s_waitcnt lgkmcnt(0)\n\ts_barrier" ::: "memory")
#define SWRITE(b, i) do { *(bf16x8*)((char*)V_lds + (b) * SHM_V + vst0) = sr_[i].vs0;          \
    *(bf16x8*)((char*)V_lds + (b) * SHM_V + vst1) = sr_[i].vs1; const int kc = sc * 2;               \
    *(bf16x8*)((char*)K_lds + (b) * SHM_K + KSWZ(sr, kc)) = sr_[i].ks0;                       \
    *(bf16x8*)((char*)K_lds + (b) * SHM_K + KSWZ(32 + sr, kc)) = sr_[i].ks1; } while (0)
#define SWAIT() SWAITN(0, 0)
#define SWAITQ(n) asm volatile("s_cmp_eq_u32 %4, %5\n\ts_cbranch_scc1 .Lpbw%=\n\ts_waitcnt vmcnt(0)\n.Lpbw%=:\n\ts_waitcnt vmcnt(%5)" \
    : "+v"(sr_[0].vs0), "+v"(sr_[0].vs1), "+v"(sr_[0].ks0), "+v"(sr_[0].ks1) : "s"(n), "i"(PB_Q) : "memory", "scc")
#define RESC(a) do { if (__any((a) < 1.f)) { if (hi == 0) al_l[r32] = (a); asm volatile("s_waitcnt lgkmcnt(0)" ::: "memory"); \
    _Pragma("unroll") for (int d = 0; d < 4; ++d) _Pragma("unroll") for (int r = 0; r < 16; ++r) o[d][r] *= al_l[crow(r, hi)]; } } while (0)
  f32x16 pA0, pA1, pB0, pB1; float mnA, mnB, alA, alB; bf16x8 pa0, pa1, pa2, pa3; int nq = 0;
  constexpr int SE = 0, SO = 0;
  if constexpr (MODE == 1) {
    const int w2 = __builtin_amdgcn_readfirstlane(wid) >> 1;
    SLOAD(SE, 0); SWAIT(); SWRITE(0, SE); __syncthreads();
#pragma unroll 1
    for (int jt = 0; jt < NT; ++jt) {
      const int b = jt & 1;
      if (jt + 1 < NT) { SLOAD(SE, jt + 1); SBAR(); nq = pb_step(pb, pbi, pbp, pbs, lds, lane); SBAR(); }
      if (jt >= w2 && jt <= w2 + 2) {
        qkt(pA0, pA1, (bf16*)((char*)K_lds + b * SHM_K), qr, r32, hi); partialSM<MODE>(pA0, pA1, m_reg, mnA, alA, RELB(jt), kk, TVALID(jt));
        RESC(alA);
        finishSM(pA0, pA1, alA, l_reg, pa0, pa1, pa2, pa3); SBAR();
        pv_d0(o, vb0 + b * (int)SHM_V, pa0, pa1, pa2, pa3);
      }
      if (jt + 1 < NT) { SWAITQ(nq); SWRITE(b ^ 1, SE); BSYNC(); }
    }
  } else {
  SLOAD(SE, 0); SWAIT(); SWRITE(0, SE); __syncthreads();
  qkt(pA0, pA1, K_lds, qr, r32, hi); partialSM<MODE>(pA0, pA1, m_reg, mnA, alA, RELB(0), kk, TVALID(0), SIDE(0));
  SLOAD(SO, 1);
  SWAIT(); SWRITE(1, SO); __syncthreads();
  for (int j = 1; j + 1 < NT; j += 2) {
    SBAR(); qkt(pB0, pB1, (bf16*)((char*)K_lds + SHM_K), qr, r32, hi);
    finishSM(pA0, pA1, alA, l_reg, pa0, pa1, pa2, pa3); SBAR();
    SLOAD(SO, j + 1); SBAR();
    nq = pb_step(pb, pbi, pbp, pbs, lds, lane); SBAR();
    pv_d0(o, vb0, pa0, pa1, pa2, pa3); partialSM<MODE>(pB0, pB1, m_reg, mnB, alB, RELB(j), kk, TVALID(j), SIDE(j));
    BSYNC(); SWAITQ(nq); SWRITE(0, SE);
    RESC(alB); BSYNC();
    SBAR(); qkt(pA0, pA1, K_lds, qr, r32, hi);
    finishSM(pB0, pB1, alB, l_reg, pa0, pa1, pa2, pa3); SBAR();
    SLOAD(SE, j + 2); SBAR();
    nq = pb_step(pb, pbi, pbp, pbs, lds, lane); SBAR();
    pv_d0(o, vb0 + (int)SHM_V, pa0, pa1, pa2, pa3); partialSM<MODE>(pA0, pA1, m_reg, mnA, alA, RELB(j + 1), kk, TVALID(j + 1), SIDE(j + 1));
    BSYNC(); SWAITQ(nq); SWRITE(1, SO);
    RESC(alA); BSYNC();
  }
  SBAR(); qkt(pB0, pB1, (bf16*)((char*)K_lds + SHM_K), qr, r32, hi);
  finishSM(pA0, pA1, alA, l_reg, pa0, pa1, pa2, pa3); SBAR();
  pv_d0(o, vb0, pa0, pa1, pa2, pa3); partialSM<MODE>(pB0, pB1, m_reg, mnB, alB, RELB(NT - 1), kk, TVALID(NT - 1), SIDE(NT - 1));
  __syncthreads(); RESC(alB);
  finishSM(pB0, pB1, alB, l_reg, pa0, pa1, pa2, pa3); SBAR();
  pv_d0(o, vb0 + (int)SHM_V, pa0, pa1, pa2, pa3);
  }
  if (hi == 0) li_l[r32] = l_reg; asm volatile("s_waitcnt lgkmcnt(0)" ::: "memory");
  float rli[16];
#pragma unroll
  for (int r = 0; r < 16; ++r) rli[r] = __builtin_amdgcn_rcpf(li_l[crow(r, hi)]);
  int tide = tid; asm volatile("" : "+v"(tide));
  const int hie = (tide >> 5) & 1, r32e = tide & 31, wide = tide >> 6;
  bf16* Ow = Ob + (long)(wide * QBLK + 4 * hie) * ldo + r32e;
#pragma unroll
  for (int r = 0; r < 16; ++r) { bf16* Or = Ow + (long)((r & 3) + 8 * (r >> 2)) * ldo;
#pragma unroll
    for (int d0 = 0; d0 < 4; ++d0) { const float y = o[d0][r] * rli[r]; Or[d0 * 32] = (bf16)cvtpk(y, y); } }
  if (Lb != nullptr && hie == 0) Lb[(long)(wide * QBLK + r32e) * ldl] = m_reg * SCALE + __logf(l_reg);
  __syncthreads();
#undef TCL
#undef TVALID
#undef RELB
#undef SIDE
#undef SLOAD
#undef SWRITE
#undef SWAIT
#undef SWAITQ
#undef SWAITN
#undef BSYNC
#undef RESC
}

__device__ __forceinline__ int v_st256(int k, int c) { const int kk = (k & ~0xC) | ((k & 4) << 1) | ((k & 8) >> 1); return ((kk >> 3) * 8 + (c >> 5)) * 512 + ((kk & 7) * 32 + (c & 31)) * 2; }
constexpr int v_rd_off256(int d0, int ks, int half) { return d0 * 512 + ks * 8192 + half * 4096; }
template <int D0> __device__ __forceinline__ void pv32k_one(f32x16& od, int vb, bf16x8 pa0, bf16x8 pa1) {
  const s16x4 l0 = tr_read<v_rd_off256(D0, 0, 0)>(vb), h0 = tr_read<v_rd_off256(D0, 0, 1)>(vb), l1 = tr_read<v_rd_off256(D0, 1, 0)>(vb), h1 = tr_read<v_rd_off256(D0, 1, 1)>(vb);
  asm volatile("s_waitcnt lgkmcnt(0)" ::: "memory"); SBAR();
#define PK(L, H) (bf16x8){L[0], L[1], L[2], L[3], H[0], H[1], H[2], H[3]}
  od = __builtin_amdgcn_mfma_f32_32x32x16_bf16(pa0, PK(l0, h0), od, 0, 0, 0);
  od = __builtin_amdgcn_mfma_f32_32x32x16_bf16(pa1, PK(l1, h1), od, 0, 0, 0);
#undef PK
}
template <int NY> __device__ __forceinline__ int pb_step_n(const Pb pb, int& c_issue, int& c_proc, const char*& isrc, char* lds, int lane) {
  asm volatile("s_waitcnt vmcnt(%0)" :: "i"(NY) : "memory");
  pb_process(pb, c_proc, c_issue, lds, lane); return pb_issue(pb, c_issue, isrc, lane); }
constexpr int DK_V = 0, DK_K = 32768, DK_SCR = 65536;
__device__ __forceinline__ void diffk_body(const unsigned char* __restrict__ Qb, const unsigned char* __restrict__ Kh, const bf16* __restrict__ Vh, long ld, int qpos0, float kk_,
                                           bf16* __restrict__ Ob, char* lds, const Pb pb, int& pbi, int& pbp, const char*& pbs) {
  constexpr float C = SCALE * 1.4426950408889634f / 64.f, THRQ = THR / SCALE * 64.f;
  constexpr int NT = 4096 / KVBLK;
  const float kk = kk_ * 64.f;
  int tid = threadIdx.x; asm volatile("" : "+v"(tid));
  const int wid = tid >> 6, lane = tid & 63, r32 = lane & 31, hi = lane >> 5;
  const int rg = __builtin_amdgcn_readfirstlane(wid);
  float* ws = (float*)(lds + DK_SCR) + wid * 64; float* li_l = ws; float* al_l = ws + 32;
  float m_reg = -1e30f, l_reg = 0; f32x16 o[8] = {};
  typedef int v8i_q __attribute__((ext_vector_type(8)));
  v8i_q qB0, qB1;
  { const unsigned char* Qw = Qb + (long)(rg * 32 + r32) * 2048 + hi * 32;
    const u32x4 a = *reinterpret_cast<const u32x4*>(Qw), b = *reinterpret_cast<const u32x4*>(Qw + 16), c = *reinterpret_cast<const u32x4*>(Qw + 64), d = *reinterpret_cast<const u32x4*>(Qw + 80);
    qB0 = (v8i_q){(int)a.x, (int)a.y, (int)a.z, (int)a.w, (int)b.x, (int)b.y, (int)b.z, (int)b.w}; qB1 = (v8i_q){(int)c.x, (int)c.y, (int)c.z, (int)c.w, (int)d.x, (int)d.y, (int)d.z, (int)d.w}; }
#define DK_SOFFS() int t2_ = tid; asm volatile("" : "+v"(t2_)); const int sr = t2_ >> 4, sc = (t2_ & 15) * 8, l2_ = t2_ & 63, w2_ = t2_ >> 6; \
  const unsigned sob0 = 2u * (unsigned)(sr * (int)ld + sc), sob1 = sob0 + 64u * (unsigned)ld;        \
  const unsigned kof0 = (unsigned)((8 * w2_ + (l2_ >> 3)) * 2048) + (unsigned)((((l2_ & 7) ^ (l2_ >> 3)) & 7) << 4);
  const unsigned kdst = (unsigned)__builtin_amdgcn_readfirstlane((int)(unsigned)(uintptr_t)(lds + DK_K + wid * 1024));
  const int vb = (int)(uintptr_t)(lds + DK_V) + v_rd_base(lane);
  const float qposf = (float)(qpos0 + rg * 32 + r32 - 4 * hi);
  const int qlo = qpos0 + rg * 32;
  bf16x8 vs0, vs1, vs2, vs3; int nq = 0;
#define DK_KDMA(jt, b) do { const unsigned char* _kp = (const unsigned char*)uni_ptr(Kh + (long)(jt) * KVBLK * 2048); unsigned _keep; \
    asm volatile("s_nop 4\n\ts_mov_b32 %0, m0\n\ts_mov_b32 m0, %3\n\ts_nop 0\n\tglobal_load_lds_dwordx4 %1, %2\n\ts_mov_b32 m0, %0" \
        : "=&s"(_keep) : "v"(kof0), "s"(_kp), "s"(kdst + (b) * 8192u) : "memory"); } while (0)
#define DK_VLOAD(jt) do { const bf16* _vp = (const bf16*)uni_ptr(Vh + (long)(jt) * KVBLK * ld); \
    asm volatile("s_nop 4\n\tglobal_load_dwordx4 %0, %4, %6\n\tglobal_load_dwordx4 %1, %5, %6\n\tglobal_load_dwordx4 %2, %4, %6 offset:256\n\tglobal_load_dwordx4 %3, %5, %6 offset:256" \
        : "=&v"(vs0), "=&v"(vs1), "=&v"(vs2), "=&v"(vs3) : "v"(sob0), "v"(sob1), "s"(_vp) : "memory"); } while (0)
#define DK_VWAIT0() asm volatile("s_waitcnt vmcnt(0)" : "+v"(vs0), "+v"(vs1), "+v"(vs2), "+v"(vs3) :: "memory")
#define DK_VWAITQ(n) asm volatile("s_cmp_eq_u32 %4, %5\n\ts_cbranch_scc1 .Ldkw%=\n\ts_waitcnt vmcnt(0)\n.Ldkw%=:\n\ts_waitcnt vmcnt(%5)" \
    : "+v"(vs0), "+v"(vs1), "+v"(vs2), "+v"(vs3) : "s"(n), "i"(PB_Q) : "memory", "scc")
#define DK_VWRITE() do { int t3_ = tid; asm volatile("" : "+v"(t3_)); char* _v = lds + DK_V + v_st256(t3_ >> 4, (t3_ & 15) * 8); *(bf16x8*)(_v) = vs0; *(bf16x8*)(_v + 16384) = vs1; *(bf16x8*)(_v + 2048) = vs2; *(bf16x8*)(_v + 18432) = vs3; } while (0)
#define DK_BSYNC() asm volatile("s_waitcnt lgkmcnt(0)\n\ts_barrier" ::: "memory")
  { DK_SOFFS(); DK_KDMA(0, 0); DK_VLOAD(0); } DK_VWAIT0(); DK_VWRITE(); __syncthreads();
#pragma unroll 1
  for (int j = 0; j < NT; ++j) {
    const char* Kb = lds + DK_K + (j & 1) * 8192;
    if (j + 1 < NT) { { DK_SOFFS(); DK_KDMA(j + 1, (j + 1) & 1); DK_VLOAD(j + 1); } SBAR(); nq = pb_step_n<5>(pb, pbi, pbp, pbs, lds, lane); SBAR(); }
    else { SBAR(); nq = pb_step_n<0>(pb, pbi, pbp, pbs, lds, lane); SBAR(); }
#pragma unroll 1
    for (int kh = 0; kh < 2; ++kh) {
    if (kh == 1) { SBAR(); nq = pb_step_n<0>(pb, pbi, pbp, pbs, lds, lane); SBAR(); }
    f32x16 p;
    { const char* Kr = Kb + (kh * 32 + r32) * 128; const int sw = r32 & 7;
      const u32x4 a0 = *reinterpret_cast<const u32x4*>(Kr + (((2 * hi) ^ sw) << 4)), a1 = *reinterpret_cast<const u32x4*>(Kr + (((2 * hi + 1) ^ sw) << 4));
      const u32x4 a2 = *reinterpret_cast<const u32x4*>(Kr + (((4 + 2 * hi) ^ sw) << 4)), a3 = *reinterpret_cast<const u32x4*>(Kr + (((5 + 2 * hi) ^ sw) << 4));
      const v8i_q A0 = {(int)a0.x, (int)a0.y, (int)a0.z, (int)a0.w, (int)a1.x, (int)a1.y, (int)a1.z, (int)a1.w}, A1 = {(int)a2.x, (int)a2.y, (int)a2.z, (int)a2.w, (int)a3.x, (int)a3.y, (int)a3.z, (int)a3.w};
      const int one_ = 0x7f7f7f7f;
      asm volatile("s_nop 1\n\tv_mfma_scale_f32_32x32x64_f8f6f4 %0, %1, %2, 0, %3, %3 op_sel_hi:[0,0,0]" : "=&v"(p) : "v"(A0), "v"(qB0), "v"(one_));
      asm volatile("s_nop 15\n\ts_nop 3\n\tv_mfma_scale_f32_32x32x64_f8f6f4 %0, %1, %2, %0, %3, %3 op_sel_hi:[0,0,0]\n\ts_nop 15\n\ts_nop 7" : "+v"(p) : "v"(A1), "v"(qB1), "v"(one_)); }
    const float relb = qposf - (float)(j * KVBLK + 32 * kh);
    const int klo = j * KVBLK + 32 * kh;
    const int side = qlo > klo + 31 ? 1 : (qlo + 31 < klo ? -1 : 0);
    float base = 0.f;
    if (side != 0) { const float skk = side > 0 ? kk : -kk; base = -skk * relb;
#pragma unroll
      for (int r = 0; r < 16; ++r) p[r] = fmaf(skk, (float)((r & 3) + 8 * (r >> 2)), p[r]);
    } else {
#pragma unroll
      for (int r = 0; r < 16; ++r) p[r] = fmaf(__builtin_fabsf(relb - (float)((r & 3) + 8 * (r >> 2))), -kk, p[r]);
    }
    float pmax = p[0];
#pragma unroll
    for (int r = 1; r < 16; ++r) pmax = fmaxf(pmax, p[r]);
    { auto rr = __builtin_amdgcn_permlane32_swap(__float_as_uint(pmax), __float_as_uint(pmax), false, false); pmax = fmaxf(__uint_as_float(rr[0]), __uint_as_float(rr[1])); }
    pmax += base;
    float mn, alpha;
    if (__builtin_expect(__all(pmax - m_reg <= THRQ), 1)) { mn = m_reg; alpha = 1.f; }
    else { mn = fmaxf(m_reg, pmax); alpha = __builtin_amdgcn_exp2f((m_reg - mn) * C); m_reg = mn; }
    const float mnC = (base - mn) * C;
    float ps = 0.f;
#pragma unroll
    for (int r = 0; r < 16; ++r) { p[r] = __builtin_amdgcn_exp2f(fmaf(p[r], C, mnC)); ps += p[r]; }
    { auto rr = __builtin_amdgcn_permlane32_swap(__float_as_uint(ps), __float_as_uint(ps), false, false); ps = __uint_as_float(rr[0]) + __uint_as_float(rr[1]); }
    l_reg = l_reg * alpha + ps;
    if (__any(alpha < 1.f)) { if (hi == 0) al_l[r32] = alpha; asm volatile("s_waitcnt lgkmcnt(0)" ::: "memory");
#pragma unroll
      for (int d = 0; d < 8; ++d)
#pragma unroll
        for (int r = 0; r < 16; ++r) o[d][r] *= al_l[crow(r, hi)]; }
    bf16x8 pa0, pa1;
#define PK4(P, BASE, OUT) do { unsigned a0 = cvtpk(P[BASE + 0], P[BASE + 1]), a1 = cvtpk(P[BASE + 2], P[BASE + 3]);   \
    unsigned b0 = cvtpk(P[BASE + 4], P[BASE + 5]), b1 = cvtpk(P[BASE + 6], P[BASE + 7]);                              \
    auto r0 = __builtin_amdgcn_permlane32_swap(a0, b0, false, false); auto r1 = __builtin_amdgcn_permlane32_swap(a1, b1, false, false); \
    u32x4 w = {r0[0], r1[0], r0[1], r1[1]}; OUT = *reinterpret_cast<bf16x8*>(&w); } while (0)
    PK4(p, 0, pa0); PK4(p, 8, pa1);
#undef PK4
    SBAR();
    pv32k_one<0>(o[0], vb + kh * 16384, pa0, pa1); pv32k_one<1>(o[1], vb + kh * 16384, pa0, pa1); pv32k_one<2>(o[2], vb + kh * 16384, pa0, pa1); pv32k_one<3>(o[3], vb + kh * 16384, pa0, pa1);
    pv32k_one<4>(o[4], vb + kh * 16384, pa0, pa1); pv32k_one<5>(o[5], vb + kh * 16384, pa0, pa1); pv32k_one<6>(o[6], vb + kh * 16384, pa0, pa1); pv32k_one<7>(o[7], vb + kh * 16384, pa0, pa1);
    }
    if (j + 1 < NT) { DK_BSYNC(); DK_VWAITQ(nq); DK_VWRITE(); DK_BSYNC(); }
  }
  if (hi == 0) li_l[r32] = l_reg; asm volatile("s_waitcnt lgkmcnt(0)" ::: "memory");
  int tide = tid; asm volatile("" : "+v"(tide));
  const int hie = (tide >> 5) & 1, r32e = tide & 31;
  bf16* Ow = Ob + (long)(rg * 32 + 4 * hie) * 1024 + r32e;
#pragma unroll
  for (int r = 0; r < 16; ++r) { const float rl = __builtin_amdgcn_rcpf(li_l[crow(r, hie)]); bf16* Or = Ow + (long)((r & 3) + 8 * (r >> 2)) * 1024;
#pragma unroll
    for (int d0 = 0; d0 < 8; ++d0) { const float y = o[d0][r] * rl; Or[d0 * 32] = (bf16)cvtpk(y, y); } }
  __syncthreads();
#undef DK_KDMA
#undef DK_SOFFS
#undef DK_VLOAD
#undef DK_VWAIT0
#undef DK_VWAITQ
#undef DK_VWRITE
#undef DK_BSYNC
}
#undef KSWZ
#undef SBAR
}
constexpr int NWAVES = 8;
#ifndef MK_SPLIT
#define MK_SPLIT 0
#endif
constexpr int N_PHASES = 12;

constexpr int DM = 2048, BATCH = 2, SEQ = 4096, T = BATCH * SEQ;
constexpr int NQKV = 10240;
constexpr int C_QA = 0, C_KA = 1024, C_VA = 2048, C_QB = 3072, C_KB = 4096, C_VB = 5120, C_GA = 6144, C_GB = 8192;
constexpr unsigned long long LBMAP = 0x0ull;
constexpr unsigned long long LFMAP = 0x9876543210ull;
constexpr int NLB = 0, NLF = 10;
constexpr bool P6_F8 = true;
constexpr int NE = 32, TOPK = 4, TK = T * TOPK, TKPAD = TK + NE * 256;
constexpr float EPS = 1e-5f;
constexpr float LAMBDA_INIT = 0.2f;

constexpr size_t MiB = 1u << 20;
constexpr size_t WS_CTL = 0, CTL_ZERO_BYTES = 1 * MiB;
constexpr size_t WS_MOD = 1 * MiB;
constexpr size_t WS_RC = 1 * MiB + 512 * 1024;
constexpr size_t WS_TOPI = 2 * MiB;
constexpr size_t WS_TOPP = 2 * MiB + 256 * 1024;
constexpr size_t WS_POS = 2 * MiB + 512 * 1024;
constexpr size_t WS_TOKOF = 3 * MiB;
constexpr size_t WS_WINT = 4 * MiB;
constexpr size_t WS_WING = 4 * MiB;
constexpr size_t WS_U8Q = 770 * MiB;
constexpr size_t WS_WAT = 44 * MiB;
constexpr size_t WS_WBT = 48 * MiB;
constexpr size_t WS_WOT = 52 * MiB;
constexpr size_t WS_U = 64 * MiB;
constexpr size_t WS_QKV = 96 * MiB;
constexpr size_t WS_OA = 256 * MiB;
constexpr size_t WS_OB = 352 * MiB;
constexpr size_t WS_LSE = 416 * MiB;
constexpr size_t WS_YA = 418 * MiB;
constexpr size_t WS_YB = 434 * MiB;
constexpr size_t WS_M1 = 450 * MiB;
constexpr size_t WS_MG = 514 * MiB;
constexpr size_t WS_H1 = 546 * MiB;
constexpr size_t WS_XS = 610 * MiB;
constexpr size_t WS_QK8 = 610 * MiB;
constexpr size_t WS_YACT = 770 * MiB;
constexpr size_t WS_YSLOT = 930 * MiB;
constexpr size_t WS_WGU = 1090 * MiB;
constexpr size_t WS_WD = 1602 * MiB;
constexpr size_t WS_END = 1858 * MiB;
static_assert((long)WS_QK8 - (long)WS_QKV == pg8::EpiQKV::Q8_FROM_O, "EpiQKV::Q8_FROM_O");
constexpr int CW_TMO = 0, CW_CODE = 1;
constexpr int CW_BAR = 4096;
constexpr int CW_CNT = 8192;

constexpr int RING_OFF = 0, RING_BYTES = 131072;
constexpr int PB_OFF = 69632;
constexpr int LDSCTL_OFF = 159744, MISC_OFF = LDSCTL_OFF + 320;
constexpr int TST_OFF = LDSCTL_OFF + 1024;
constexpr int LDS_BYTES = 163840;

#define GAS __attribute__((address_space(1)))
#define LAS __attribute__((address_space(3)))
typedef unsigned short bf16;
typedef unsigned v4u __attribute__((ext_vector_type(4)));
typedef unsigned v2u __attribute__((ext_vector_type(2)));
typedef float f32x4 __attribute__((ext_vector_type(4)));
typedef float v2f __attribute__((ext_vector_type(2)));
typedef GAS unsigned gu32;
#define RLX_AGENT __ATOMIC_RELAXED, __HIP_MEMORY_SCOPE_AGENT
#define LDS_WAIT() asm volatile("s_waitcnt lgkmcnt(0)" ::: "memory")
#define VM_WAIT() asm volatile("s_waitcnt vmcnt(0)" ::: "memory")
__device__ __forceinline__ unsigned f2bf(float f) { unsigned u = __builtin_bit_cast(unsigned, f); return (u + 0x7fffu + ((u >> 16) & 1u)) >> 16; }
__device__ __forceinline__ unsigned pk2(float lo, float hi) { return f2bf(lo) | (f2bf(hi) << 16); }
__device__ __forceinline__ float bf2f(unsigned short h) { return __uint_as_float(((unsigned)h) << 16); }
__device__ __forceinline__ float wave_sum(float v) {
#pragma unroll
    for (int o = 1; o < 64; o <<= 1) v += __shfl_xor(v, o);
    return v;
}
__device__ __forceinline__ float wave_max(float v) {
#pragma unroll
    for (int o = 1; o < 64; o <<= 1) v = fmaxf(v, __shfl_xor(v, o));
    return v;
}
__device__ __forceinline__ float siluf(float x) { return x / (1.0f + __expf(-x)); }
#define XB_TMO      128
#define XB_XCNT(j)  (256  + 64 * (j))
#define XB_XSUB(j)  (1280 + 64 * (j))
#define XB_XGEN(j)  (2304 + 64 * (j))
#define XB_TOP      3328
#define XB_TOPGEN   3392
#define XCD_BAR_WORDS 3456
#define XB_SPIN_CAP (1u << 18)

__device__ __forceinline__ unsigned xb_ld(unsigned* p)              { return __hip_atomic_load(p, __ATOMIC_RELAXED, __HIP_MEMORY_SCOPE_AGENT); }
__device__ __forceinline__ unsigned xb_add(unsigned* p, unsigned v) { return __hip_atomic_fetch_add(p, v, __ATOMIC_RELAXED, __HIP_MEMORY_SCOPE_AGENT); }
__device__ __forceinline__ unsigned xb_xcc_id() { return (unsigned)__builtin_amdgcn_s_getreg((3 << 11) | 20) & 0xFu; }
#define XB_SPIN(cond, bar) do { unsigned _sp = 0; while (cond) { __builtin_amdgcn_s_sleep(1); \
    if ((++_sp & 255u) == 0u) { if (xb_ld(&(bar)[XB_TMO])) break; if (_sp > XB_SPIN_CAP) { atomicAdd(&(bar)[XB_TMO], 1u); break; } } } } while (0)

struct XcdBarrier {
    unsigned* bar; unsigned x;
    volatile LAS unsigned* st;
};

__device__ __forceinline__ XcdBarrier xcd_barrier_post(unsigned* bar, volatile LAS unsigned* st) {
    XcdBarrier b; b.bar = bar; b.x = xb_xcc_id(); b.st = st;
    if (threadIdx.x == 0) (void)xb_add(&bar[XB_XCNT(b.x)], 1u);
    return b;
}
__device__ __forceinline__ void xcd_barrier_complete(unsigned* bar, unsigned x, unsigned& nloc, unsigned& nx) {
    const unsigned G = gridDim.x * gridDim.y * gridDim.z;
    unsigned sum, cnt, mine, sp = 0u;
    for (;;) {
        sum = 0u; cnt = 0u; mine = 0u;
#pragma unroll
        for (unsigned j = 0; j < 16; ++j) { const unsigned c = xb_ld(&bar[XB_XCNT(j)]); sum += c; cnt += (c > 0u) ? 1u : 0u; mine = (j == x) ? c : mine; }
        if (sum == G) break;
        __builtin_amdgcn_s_sleep(1);
        if ((++sp & 255u) == 0u) { if (xb_ld(&bar[XB_TMO])) break; if (sp > XB_SPIN_CAP) { atomicAdd(&bar[XB_TMO], 1u); break; } }
    }
    nloc = mine > 0u ? mine : 1u; nx = cnt > 0u ? cnt : 1u;
}

__device__ __forceinline__ void xcd_barrier(const XcdBarrier& b) {
    asm volatile("s_waitcnt vmcnt(0)" ::: "memory");
    __syncthreads();
    if (threadIdx.x == 0) {
        unsigned* bar = b.bar;
        __builtin_amdgcn_s_waitcnt(0);
        unsigned nloc = b.st[0], nx = b.st[1];
        if (nloc == 0u) { xcd_barrier_complete(bar, b.x, nloc, nx); b.st[0] = nloc; b.st[1] = nx; }
        const unsigned old = xb_add(&bar[XB_XSUB(b.x)], 1u);
        const unsigned gen = old / nloc;
        if (old + 1u == (gen + 1u) * nloc) {
            __builtin_amdgcn_fence(__ATOMIC_RELEASE, "agent");
            asm volatile("s_waitcnt vmcnt(0)" ::: "memory");
            const unsigned og = xb_add(&bar[XB_TOP], 1u);
            const unsigned tg = og / nx;
            if (og + 1u == (tg + 1u) * nx) xb_add(&bar[XB_TOPGEN], 1u);
            else XB_SPIN(xb_ld(&bar[XB_TOPGEN]) == tg, bar);
            __builtin_amdgcn_fence(__ATOMIC_ACQUIRE, "agent");
            xb_add(&bar[XB_XGEN(b.x)], 1u);
            asm volatile("s_waitcnt vmcnt(0)" ::: "memory");
        } else {
            XB_SPIN(xb_ld(&bar[XB_XGEN(b.x)]) == gen, bar);
            __builtin_amdgcn_fence(__ATOMIC_ACQUIRE, "agent");
            asm volatile("s_waitcnt vmcnt(0)" ::: "memory");
        }
    }
    __syncthreads();
}
struct Args { const float* in[24]; float* out; unsigned char* ws; int ph_lo, ph_hi; };
enum { I_X = 0, I_C, I_WADA, I_BADA, I_N1G, I_WIN, I_LQ1, I_LK1, I_LQ2, I_LK2, I_SUBG, I_WOA, I_WOB, I_WO, I_N2G, I_WR, I_BR, I_WG, I_BG, I_WU, I_BU, I_WDN, I_BDN, I_FG };
struct Frame {
    LAS unsigned char* lds; char* ldsg;
    volatile LAS unsigned* MISC;
    gu32* ctl;
    int tid, lane, wave, vcu, G;
    unsigned char* ws;
};
#define WSP(T_, off) ((T_*)(F.ws + (off)))

constexpr float WSCALE = 64.0f;
__device__ __forceinline__ unsigned cvtpk_bf(float lo, float hi) { unsigned r; asm volatile("v_cvt_pk_bf16_f32 %0, %1, %2" : "=v"(r) : "v"(lo), "v"(hi)); return r; }
__device__ __forceinline__ void cvt_load(f32x4 (&v)[8], const float* __restrict__ W, int N, int k0, int n0, int lane) {
    const int lr = lane >> 3, lc = 4 * (lane & 7);
#pragma unroll
    for (int i = 0; i < 8; ++i) v[i] = __builtin_nontemporal_load((const f32x4*)(W + (size_t)(k0 + lr + 8 * i) * N + n0 + lc));
}
template <bool F8>
__device__ __forceinline__ void cvt_store(const f32x4 (&v)[8], int K, void* __restrict__ WT, int k0, long dst_row0, LAS float* scr, int lane) {
    const int lr = lane >> 3, lc = 4 * (lane & 7);
#pragma unroll
    for (int i = 0; i < 8; ++i) { LAS float* s = scr + (lr + 8 * i) * 33 + lc; s[0] = v[i].x; s[1] = v[i].y; s[2] = v[i].z; s[3] = v[i].w; }
    LDS_WAIT(); asm volatile("" ::: "memory");
    const int c = lane & 7;
#pragma unroll
    for (int j = 0; j < 4; ++j) { const int n = (lane >> 3) + 8 * j; const LAS float* s = scr + (8 * c) * 33 + n;
        if constexpr (F8) {
            int w0 = __builtin_amdgcn_cvt_pk_fp8_f32(s[0 * 33] * WSCALE, s[1 * 33] * WSCALE, 0, false); w0 = __builtin_amdgcn_cvt_pk_fp8_f32(s[2 * 33] * WSCALE, s[3 * 33] * WSCALE, w0, true);
            int w1 = __builtin_amdgcn_cvt_pk_fp8_f32(s[4 * 33] * WSCALE, s[5 * 33] * WSCALE, 0, false); w1 = __builtin_amdgcn_cvt_pk_fp8_f32(s[6 * 33] * WSCALE, s[7 * 33] * WSCALE, w1, true);
            *(v2u*)((unsigned char*)WT + (size_t)(dst_row0 + n) * K + k0 + 8 * c) = (v2u){(unsigned)w0, (unsigned)w1};
        } else {
            v4u o; o.x = cvtpk_bf(s[0 * 33], s[1 * 33]); o.y = cvtpk_bf(s[2 * 33], s[3 * 33]); o.z = cvtpk_bf(s[4 * 33], s[5 * 33]); o.w = cvtpk_bf(s[6 * 33], s[7 * 33]);
            *(v4u*)((bf16*)WT + (size_t)(dst_row0 + n) * K + k0 + 8 * c) = o; } }
    LDS_WAIT(); asm volatile("" ::: "memory");
}
__device__ __forceinline__ void cvt8_load(f32x4 (&v)[16], const float* __restrict__ W, int k0, int n0, int lane, int N = DM) {
    const float* p = W + (size_t)(k0 + (lane >> 3)) * N + n0 + 4 * (lane & 7);
#pragma unroll
    for (int i = 0; i < 16; ++i) v[i] = __builtin_nontemporal_load((const f32x4*)(p + (size_t)(8 * i) * N));
}
__device__ __forceinline__ void cvt8_store(const f32x4 (&v)[16], unsigned char* __restrict__ WT, int k0, long dst_row0, LAS float* scr, int lane) {
    const int lr = lane >> 3, lc = 4 * (lane & 7);
#pragma unroll
    for (int i = 0; i < 16; ++i) { LAS float* s = scr + (lr + 8 * i) * 33 + ((lc + 4 * (i >> 1)) & 31);
        s[0] = v[i].x; s[1] = v[i].y; s[2] = v[i].z; s[3] = v[i].w; }
    LDS_WAIT(); asm volatile("" ::: "memory");
    const int c = lane & 7;
#pragma unroll
    for (int j = 0; j < 4; ++j) { const int n = (lane >> 3) + 8 * j; const LAS float* s = scr + (16 * c) * 33 + ((n + 4 * c) & 31);
        v4u o;
#pragma unroll
        for (int h = 0; h < 4; ++h) { int w = __builtin_amdgcn_cvt_pk_fp8_f32(s[(4 * h + 0) * 33] * WSCALE, s[(4 * h + 1) * 33] * WSCALE, 0, false);
            w = __builtin_amdgcn_cvt_pk_fp8_f32(s[(4 * h + 2) * 33] * WSCALE, s[(4 * h + 3) * 33] * WSCALE, w, true); o[h] = (unsigned)w; }
        *(v4u*)(WT + (size_t)(dst_row0 + n) * DM + k0 + 16 * c) = o; }
    LDS_WAIT(); asm volatile("" ::: "memory");
}
__device__ __forceinline__ void p0_mod(Frame& F, const Args& A) {
    LAS float* red = (LAS float*)F.lds;
    LAS float* sc = red + 2048;
    if (F.vcu < 192) {
        for (int k = F.tid; k < DM; k += 512) { sc[2 * k] = siluf(A.in[I_C][k]); sc[2 * k + 1] = siluf(A.in[I_C][2048 + k]); }
    }
    __syncthreads();
    if (F.vcu < 192) {
        const int col = F.vcu * 64 + F.lane, k0 = F.wave * 256;
        const float* wp = A.in[I_WADA] + (size_t)k0 * 12288 + col; const LAS float* sp = sc + 2 * k0;
        float a0 = 0.f, a1 = 0.f;
#pragma unroll 16
        for (int k = 0; k < 256; ++k) { const float wv = __builtin_nontemporal_load(wp + (size_t)k * 12288); const v2f s2 = *(const LAS v2f*)(sp + 2 * k); a0 = fmaf(s2.x, wv, a0); a1 = fmaf(s2.y, wv, a1); }
        red[(F.wave * 2 + 0) * 64 + F.lane] = a0; red[(F.wave * 2 + 1) * 64 + F.lane] = a1;
    }
    __syncthreads();
    if (F.vcu < 192 && F.tid < 128) { const int b = F.tid >> 6, l = F.tid & 63; float s = 0.f;
#pragma unroll
        for (int w = 0; w < 8; ++w) s += red[(w * 2 + b) * 64 + l];
        const int col = F.vcu * 64 + l; WSP(float, WS_MOD)[b * 12288 + col] = s + A.in[I_BADA][col]; }
    __syncthreads();
}
__device__ __forceinline__ void p0_convert(Frame& F, const Args& A) {
    LAS float* scr = (LAS float*)(F.lds + F.wave * 16384);
    const int gw = F.vcu * NWAVES + F.wave, NGW = F.G * NWAVES;
    constexpr int I_IN = 32 * 320, I_A = 16 * 64, I_B = 16 * 64, I_O = P6_F8 ? 0 : 32 * 64, NSMALL = I_IN + I_A + I_B + I_O;
    f32x4 v0[8];
#pragma unroll 1
    for (int it = gw; it < NSMALL; it += NGW) { int r = it; const float* W; bf16* WT; int N, K, drow = 0;
        if (r < I_IN) { W = A.in[I_WIN]; WT = WSP(bf16, WS_WINT); N = NQKV; K = DM; const int g_ = (r % 320) >> 5; int pos_ = -1;
#pragma unroll
            for (int i_ = 0; i_ < NLB; ++i_) if ((int)((LBMAP >> (4 * i_)) & 15ull) == g_) pos_ = i_;
            if (pos_ < 0) continue; drow = pos_ * 1024 - g_ * 1024; }
        else if ((r -= I_IN) < I_A) { W = A.in[I_WOA]; WT = WSP(bf16, WS_WAT); N = DM; K = 1024; }
        else if ((r -= I_A) < I_B) { W = A.in[I_WOB]; WT = WSP(bf16, WS_WBT); N = DM; K = 1024; }
        else { r -= I_B; W = A.in[I_WO]; WT = WSP(bf16, WS_WOT); N = DM; K = DM; }
        const int nnb = N / 32, k0 = (r / nnb) * 64, n0 = (r % nnb) * 32;
        cvt_load(v0, W, N, k0, n0, F.lane); cvt_store<false>(v0, K, WT, k0, n0 + drow, scr, F.lane); }
    { __syncthreads(); LAS float* scr8 = (LAS float*)(F.lds + F.wave * 16896); f32x4 va[16];
      constexpr int NF8 = 16 * NLF * 32;
#pragma unroll 1
      for (int it = gw; it < NF8 + (P6_F8 ? 16 * 64 : 0); it += NGW) {
          if (it < NF8) { const int k0 = (it / (NLF * 32)) * 128, blk = it % (NLF * 32), pf = blk >> 5, g_ = (int)((LFMAP >> (4 * pf)) & 15ull);
              cvt8_load(va, A.in[I_WIN], k0, g_ * 1024 + (blk & 31) * 32, F.lane, NQKV); cvt8_store(va, WSP(unsigned char, WS_WING), k0, pf * 1024 + (blk & 31) * 32, scr8, F.lane); }
          else { const int j = it - NF8, k0 = (j >> 6) * 128, n0 = (j & 63) * 32;
              cvt8_load(va, A.in[I_WO], k0, n0, F.lane, DM); cvt8_store(va, WSP(unsigned char, WS_WOT), k0, n0, scr8, F.lane); } } }
}
__device__ __forceinline__ void p1_modulate(Frame& F, const Args& A) {
    const int gw = F.vcu * NWAVES + F.wave, NGW = F.G * NWAVES; const float* MOD = WSP(float, WS_MOD);
    if (F.vcu < 64 && F.wave == 0) { const int b = F.vcu >> 5, kq = F.vcu & 31, e = F.lane & 31, ks = F.lane >> 5; float s = 0.f;
#pragma unroll 8
        for (int i = 0; i < 32; ++i) { const int k = 64 * kq + 2 * i + ks; s = fmaf(MOD[b * 12288 + 3 * DM + k], A.in[I_WR][k * 32 + e], s); }
        s += __shfl_xor(s, 32); if (F.lane < 32) WSP(float, WS_RC)[(b * 32 + kq) * 32 + e] = s; }
    for (int m = gw; m < T; m += NGW) {
        const int b = m / SEQ; const float* xr = A.in[I_X] + (size_t)m * DM + 4 * F.lane; f32x4 v[8]; float s = 0.f;
#pragma unroll
        for (int j = 0; j < 8; ++j) { v[j] = *(const f32x4*)(xr + 256 * j); s += (v[j].x * v[j].x + v[j].y * v[j].y) + (v[j].z * v[j].z + v[j].w * v[j].w); }
        const float rstd = 1.0f / sqrtf(wave_sum(s) * (1.0f / DM) + EPS);
        bf16* ur = WSP(bf16, WS_U) + (size_t)m * DM + 4 * F.lane;
#pragma unroll
        for (int j = 0; j < 8; ++j) { const int k = 4 * F.lane + 256 * j;
            const f32x4 g = *(const f32x4*)(A.in[I_N1G] + k), sc = *(const f32x4*)(MOD + b * 12288 + 1 * DM + k), sh = *(const f32x4*)(MOD + b * 12288 + k);
            const f32x4 u = v[j] * rstd * g * (sc + 1.0f) + sh; if constexpr (NLB > 0) { v2u o; o.x = pk2(u.x, u.y); o.y = pk2(u.z, u.w); *(v2u*)(ur + 256 * j) = o; }
            int w8 = __builtin_amdgcn_cvt_pk_fp8_f32(u.x, u.y, 0, false); w8 = __builtin_amdgcn_cvt_pk_fp8_f32(u.z, u.w, w8, true); *(int*)(WSP(unsigned char, WS_U8Q) + (size_t)m * DM + 4 * F.lane + 256 * j) = w8; }
    }
}
__device__ __forceinline__ void p3_attention(Frame& F, const Args& A) {
    const bf16* QKV = WSP(bf16, WS_QKV);
    att::Pb pb; int pbi = 0, pbp = 0; const char* pbs = nullptr; pb.gw = F.vcu * NWAVES + F.wave; pb.NGW = F.G * NWAVES;
    pb.total = pb.gw < att::PB_NIT ? ((att::PB_NIT - pb.gw + pb.NGW - 1) / pb.NGW) * 16 : 0;
    pb.pg = A.in[I_WG]; pb.du = (const char*)A.in[I_WU] - (const char*)A.in[I_WG]; pb.dd = (const char*)A.in[I_WDN] - (const char*)A.in[I_WG];
    pb.wgu = (GAS unsigned char*)WSP(unsigned char, WS_WGU); pb.wd = (GAS unsigned char*)WSP(unsigned char, WS_WD); pb.zone = (unsigned)(PB_OFF + F.wave * att::PB_WAVE);
#pragma unroll 1
    for (int i = F.vcu; i < 256; i += F.G) {
        const int c2 = i >> 4, b = c2 >> 3, h = (c2 >> 1) & 3, c = c2 & 1, qb = i & 15;
        const size_t rowb = (size_t)b * SEQ;
        const unsigned char* Qb = WSP(unsigned char, WS_QK8) + (rowb + qb * 256) * 2048 + h * 256 + c * 128;
        const unsigned char* Kh = WSP(unsigned char, WS_QK8) + rowb * 2048 + 1024 + h * 256 + c * 128;
        const bf16* Vh = QKV + rowb * NQKV + C_VB + h * 256;
        bf16* Ob = WSP(bf16, WS_OB) + ((size_t)c * T + rowb + qb * 256) * 1024 + h * 256;
        const float slope = exp2f(-(float)(8 + h + 1) * (8.0f / 12.0f));
        att::diffk_body(Qb, Kh, Vh, NQKV, qb * 256, slope / att::SCALE, Ob, F.ldsg, pb, pbi, pbp, pbs);
    }
    att::pb_drain(pb, pbi, pbp, pbs, F.ldsg, F.lane);
    __syncthreads();
    {
        const int gw = F.vcu * NWAVES + F.wave, NGW = F.G * NWAVES;
        char* ktile = F.ldsg + F.wave * 16384; char* vtile = ktile + 8192; float* scr = (float*)(F.ldsg + 131072) + F.wave * 64;
#if defined(REP_DIL)
#pragma unroll 1
        for (int rep_ = 0; rep_ < 2; ++rep_)
#endif
#pragma unroll 1
        for (int tk = gw; tk < 3 * 2048; tk += NGW) {
            const int p = tk >> 11, r = tk & 2047, b = r >> 10, h = (r >> 7) & 7, blk = r & 127;
            const int dil = p == 0 ? 1 : (p == 1 ? 4 : 16), L = SEQ / dil, bpr = L / 32, res = blk / bpr, j0 = (blk % bpr) * 32;
            const size_t rowb = (size_t)b * SEQ + res;
            const bf16* Qb = QKV + rowb * NQKV + C_QA + h * 128; const bf16* Kb = QKV + rowb * NQKV + C_KA + h * 128; const bf16* Vb = QKV + rowb * NQKV + C_VA + h * 128;
            bf16* Ob = WSP(bf16, WS_OA) + ((size_t)p * T + rowb) * 1024 + h * 128; float* Lb = WSP(float, WS_LSE) + ((size_t)p * T + rowb) * 8 + h;
            const float slope = exp2f(-(float)(h + 1) * (8.0f / 12.0f)) * (float)dil;
            att::dilated_wave(Qb, Kb, Vb, (long)dil * NQKV, j0, L, slope / att::SCALE, Ob, (long)dil * 1024, Lb, (long)dil * 8, ktile, vtile, scr);
        }
    }
    __syncthreads();
}
__device__ __forceinline__ void p4_finalize(Frame& F, const Args& A) {
    const int gw = F.vcu * NWAVES + F.wave, NGW = F.G * NWAVES;
    float s1 = A.in[I_LQ1][F.lane] * A.in[I_LK1][F.lane] + A.in[I_LQ1][F.lane + 64] * A.in[I_LK1][F.lane + 64];
    float s2 = A.in[I_LQ2][F.lane] * A.in[I_LK2][F.lane] + A.in[I_LQ2][F.lane + 64] * A.in[I_LK2][F.lane + 64];
    s1 = wave_sum(s1); s2 = wave_sum(s2);
    const float lam = expf(s1) - expf(s2) + LAMBDA_INIT;
    const bf16* OA = WSP(bf16, WS_OA); const bf16* OB = WSP(bf16, WS_OB); const float* LS = WSP(float, WS_LSE);
    for (int m = gw; m < T; m += NGW) {
        { const int h = F.lane >> 3; const float l0 = LS[((size_t)0 * T + m) * 8 + h], l1 = LS[((size_t)1 * T + m) * 8 + h], l2 = LS[((size_t)2 * T + m) * 8 + h];
          const float mx = fmaxf(l0, fmaxf(l1, l2)); float w0 = __expf(l0 - mx), w1 = __expf(l1 - mx), w2 = __expf(l2 - mx); const float inv = 1.0f / (w0 + w1 + w2); w0 *= inv; w1 *= inv; w2 *= inv;
          const size_t o = (size_t)m * 1024 + 16 * F.lane; unsigned pk[8];
#pragma unroll
          for (int q = 0; q < 2; ++q) { const v4u a0 = *(const v4u*)(OA + o + 8 * q), a1 = *(const v4u*)(OA + (size_t)T * 1024 + o + 8 * q), a2 = *(const v4u*)(OA + (size_t)2 * T * 1024 + o + 8 * q);
#pragma unroll
              for (int e = 0; e < 4; ++e) { const float ylo = w0 * __uint_as_float(a0[e] << 16) + w1 * __uint_as_float(a1[e] << 16) + w2 * __uint_as_float(a2[e] << 16);
                  const float yhi = w0 * __uint_as_float(a0[e] & 0xffff0000u) + w1 * __uint_as_float(a1[e] & 0xffff0000u) + w2 * __uint_as_float(a2[e] & 0xffff0000u); pk[4 * q + e] = pk2(ylo, yhi); } }
          bf16* ya = WSP(bf16, WS_YA) + o; *(v4u*)ya = (v4u){pk[0], pk[1], pk[2], pk[3]}; *(v4u*)(ya + 8) = (v4u){pk[4], pk[5], pk[6], pk[7]}; }
#pragma unroll
        for (int h = 0; h < 4; ++h) { const size_t o = (size_t)m * 1024 + h * 256 + 4 * F.lane;
            const v2u b0 = *(const v2u*)(OB + o), b1 = *(const v2u*)(OB + (size_t)T * 1024 + o);
            const f32x4 v = (f32x4){__uint_as_float(b0.x << 16), __uint_as_float(b0.x & 0xffff0000u), __uint_as_float(b0.y << 16), __uint_as_float(b0.y & 0xffff0000u)}
                          - (f32x4){__uint_as_float(b1.x << 16), __uint_as_float(b1.x & 0xffff0000u), __uint_as_float(b1.y << 16), __uint_as_float(b1.y & 0xffff0000u)} * lam;
            const float ss = wave_sum((v.x * v.x + v.y * v.y) + (v.z * v.z + v.w * v.w)); const float rstd = 1.0f / sqrtf(ss * (1.0f / 256.0f) + EPS);
            const f32x4 g = *(const f32x4*)(A.in[I_SUBG] + 4 * F.lane); const f32x4 y = v * rstd * g * (1.0f - LAMBDA_INIT);
            v2u w; w.x = pk2(y.x, y.y); w.y = pk2(y.z, y.w); *(v2u*)(WSP(bf16, WS_YB) + o) = w; }
    }
}
typedef float f32x16r __attribute__((ext_vector_type(16)));
__device__ __forceinline__ void p7_router(Frame& F, const Args& A, bool commit = true) {
    LAS float* gainL = (LAS float*)F.lds;
    LAS float* shiftL = gainL + 2048;
    LAS float* part = shiftL + 2048;
    LAS float* ssp = part + 8 * 32 * 32;
    LAS float* logitL = ssp + 512;
    LAS float* rstdL = logitL + 32 * 33;
    LAS int* lcnt = (LAS int*)(rstdL + 32);
    LAS int* lbase = lcnt + 32;
    const float* H1 = WSP(float, WS_H1); const float* MODp = WSP(float, WS_MOD); const float* RC = WSP(float, WS_RC);
    for (int blk = F.vcu; blk < T / 32; blk += F.G) {
        const int t0 = blk * 32, bb = t0 / SEQ; const float* mod = MODp + bb * 12288;
        for (int k = F.tid; k < DM; k += 512) { gainL[k] = A.in[I_N2G][k] * (1.0f + mod[4 * DM + k]); shiftL[k] = mod[3 * DM + k]; }
        if (F.tid < 32) lcnt[F.tid] = 0;
        __syncthreads();
        {
            const int i = F.lane & 31, kk = F.lane >> 5, kb = F.wave * 256 + kk * 128;
            const float* hp = H1 + (size_t)(t0 + i) * DM + kb; const float* wp = A.in[I_WR] + (size_t)kb * 32 + i; const LAS float* gp = gainL + kb;
            f32x16r acc = {}; float ss = 0.f;
#pragma unroll 4
            for (int s0 = 0; s0 < 128; s0 += 4) {
                const f32x4 hv = *(const f32x4*)(hp + s0); const f32x4 g4 = *(const LAS f32x4*)(gp + s0);
                const float b0 = wp[(s0 + 0) * 32], b1 = wp[(s0 + 1) * 32], b2 = wp[(s0 + 2) * 32], b3 = wp[(s0 + 3) * 32];
                ss += (hv.x * hv.x + hv.y * hv.y) + (hv.z * hv.z + hv.w * hv.w);
                acc = __builtin_amdgcn_mfma_f32_32x32x2f32(hv.x * g4.x, b0, acc, 0, 0, 0);
                acc = __builtin_amdgcn_mfma_f32_32x32x2f32(hv.y * g4.y, b1, acc, 0, 0, 0);
                acc = __builtin_amdgcn_mfma_f32_32x32x2f32(hv.z * g4.z, b2, acc, 0, 0, 0);
                acc = __builtin_amdgcn_mfma_f32_32x32x2f32(hv.w * g4.w, b3, acc, 0, 0, 0);
            }
#pragma unroll
            for (int r = 0; r < 16; ++r) part[(F.wave * 32 + (r & 3) + 8 * (r >> 2) + 4 * kk) * 32 + i] = acc[r];
            ssp[F.wave * 64 + F.lane] = ss;
        }
        __syncthreads();
        { const int token = F.tid & 31, eg = F.tid >> 5; float s2 = 0.f;
#pragma unroll
          for (int w = 0; w < 8; ++w) s2 += ssp[w * 64 + token] + ssp[w * 64 + 32 + token];
          const float rstd = 1.0f / sqrtf(s2 * (1.0f / DM) + EPS);
#pragma unroll
          for (int q = 0; q < 2; ++q) { const int e = eg * 2 + q; float raw = 0.f;
#pragma unroll
              for (int w = 0; w < 8; ++w) raw += part[(w * 32 + token) * 32 + e];
              float rc = A.in[I_BR][e];
#pragma unroll 8
              for (int kq = 0; kq < 32; ++kq) rc += RC[(bb * 32 + kq) * 32 + e];
              logitL[token * 33 + e] = rstd * raw + rc; }
          if (eg == 0) rstdL[token] = rstd; }
        __syncthreads();
        int se[4] = {0, 0, 0, 0}, lp[4] = {0, 0, 0, 0}; float pv[4] = {0.f, 0.f, 0.f, 0.f};
        if (F.tid < 32) {
            float sv[4];
#pragma unroll
            for (int k = 0; k < 4; ++k) { float best = -INFINITY; int bi = 0;
                for (int e = 0; e < 32; ++e) { const float v = logitL[F.tid * 33 + e]; if (v > best) { best = v; bi = e; } }
                sv[k] = best; se[k] = bi; logitL[F.tid * 33 + bi] = -INFINITY; }
            float sum = 0.f;
#pragma unroll
            for (int k = 0; k < 4; ++k) { pv[k] = expf(sv[k] - sv[0]); sum += pv[k]; }
            const float inv = 1.0f / sum;
#pragma unroll
            for (int k = 0; k < 4; ++k) { pv[k] *= inv; lp[k] = __hip_atomic_fetch_add(lcnt + se[k], 1, __ATOMIC_RELAXED, __HIP_MEMORY_SCOPE_WORKGROUP); }
        }
        __syncthreads();
        if (F.tid < 32 && commit) lbase[F.tid] = (int)__hip_atomic_fetch_add((unsigned*)(F.ctl + CW_CNT + 64 * F.tid), (unsigned)lcnt[F.tid], RLX_AGENT);
        __syncthreads();
        if (F.tid < 32 && commit) { const int m = t0 + F.tid;
#pragma unroll
            for (int k = 0; k < 4; ++k) { const int pos = lbase[se[k]] + lp[k]; WSP(int, WS_TOPI)[m * 4 + k] = se[k]; WSP(float, WS_TOPP)[m * 4 + k] = pv[k]; WSP(int, WS_POS)[m * 4 + k] = pos;
                WSP(int, WS_TOKOF)[se[k] * 8192 + pos] = m; } }
        for (int i = 0; i < 4; ++i) { const int token = F.wave * 4 + i, m = t0 + token; const float rstd = rstdL[token];
            const float* hr = H1 + (size_t)m * DM + 4 * F.lane; unsigned char* ur = WSP(unsigned char, WS_U) + (size_t)m * DM + 4 * F.lane;
#pragma unroll
            for (int j = 0; j < 8; ++j) { const f32x4 h = *(const f32x4*)(hr + 256 * j), g = *(const LAS f32x4*)(gainL + 4 * F.lane + 256 * j), s = *(const LAS f32x4*)(shiftL + 4 * F.lane + 256 * j);
                const f32x4 u = h * rstd * g + s; int w8 = __builtin_amdgcn_cvt_pk_fp8_f32(u.x, u.y, 0, false); w8 = __builtin_amdgcn_cvt_pk_fp8_f32(u.z, u.w, w8, true); *(int*)(ur + 256 * j) = w8; } }
        __syncthreads();
    }
}
__device__ __forceinline__ void build_tile_table(Frame& F) {
    LAS int* ts = (LAS int*)(F.lds + TST_OFF);
    if (F.tid < 64) {
        const int e = F.tid & 31; const int c = (int)__hip_atomic_load((unsigned*)(F.ctl + CW_CNT + 64 * e), RLX_AGENT); const int tl = (c + 255) >> 8; int x = tl;
#pragma unroll
        for (int o = 1; o < 32; o <<= 1) { const int y = __shfl_up(x, o, 32); if (e >= o) x += y; }
        if (F.tid < 32) { ts[e] = x - tl; ts[40 + e] = c; if (e == 31) ts[32] = x; } }
    __syncthreads();
}
__device__ __forceinline__ void p11_final(Frame& F, const Args& A) {
    build_tile_table(F);
    const LAS int* ts = (const LAS int*)(F.lds + TST_OFF);
    const int gw = F.vcu * NWAVES + F.wave, NGW = F.G * NWAVES; const float* MODp = WSP(float, WS_MOD);
    for (int m = gw; m < T; m += NGW) {
        const int bb = m / SEQ; const bf16* yr[4]; float p[4];
#pragma unroll
        for (int k = 0; k < 4; ++k) { const int e = WSP(int, WS_TOPI)[m * 4 + k], pos = WSP(int, WS_POS)[m * 4 + k]; p[k] = WSP(float, WS_TOPP)[m * 4 + k];
            yr[k] = WSP(bf16, WS_YSLOT) + ((size_t)ts[e] * 256 + pos) * DM + 4 * F.lane; }
        const float* hr = WSP(float, WS_H1) + (size_t)m * DM + 4 * F.lane; f32x4 v[8]; float s = 0.f;
#pragma unroll
        for (int j = 0; j < 8; ++j) { f32x4 a = {0.f, 0.f, 0.f, 0.f};
#pragma unroll
            for (int k = 0; k < 4; ++k) { const v2u w = *(const v2u*)(yr[k] + 256 * j); const f32x4 y = {__uint_as_float(w.x << 16), __uint_as_float(w.x & 0xffff0000u), __uint_as_float(w.y << 16), __uint_as_float(w.y & 0xffff0000u)}; a += y * p[k]; }
            const f32x4 g2 = *(const f32x4*)(MODp + bb * 12288 + 5 * DM + 4 * F.lane + 256 * j);
            v[j] = *(const f32x4*)(hr + 256 * j) + g2 * a; s += (v[j].x * v[j].x + v[j].y * v[j].y) + (v[j].z * v[j].z + v[j].w * v[j].w); }
        const float rstd = 1.0f / sqrtf(wave_sum(s) * (1.0f / DM) + EPS);
        float* orow = A.out + (size_t)m * DM + 4 * F.lane;
#pragma unroll
        for (int j = 0; j < 8; ++j) { const f32x4 g = *(const f32x4*)(A.in[I_FG] + 4 * F.lane + 256 * j); *(f32x4*)(orow + 256 * j) = v[j] * rstd * g; }
    }
}

__global__ void __launch_bounds__(NWAVES * 64, 2) fwd(Args args) {
    extern __shared__ __attribute__((aligned(16))) unsigned char lds[];
    Frame F;
    F.lds = (LAS unsigned char*)lds; F.ldsg = (char*)lds;
    F.MISC = (volatile LAS unsigned*)(F.lds + MISC_OFF);
    F.tid = threadIdx.x; F.lane = F.tid & 63; F.wave = __builtin_amdgcn_readfirstlane(F.tid >> 6);
    F.G = gridDim.x; { const int bx = blockIdx.x; F.vcu = (F.G % 8 == 0) ? (bx % 8) * (F.G / 8) + bx / 8 : bx; }
    F.ws = args.ws; F.ctl = (gu32*)(args.ws + WS_CTL);
    for (int u = F.tid; u < (LDS_BYTES - LDSCTL_OFF) / 4; u += NWAVES * 64) ((LAS unsigned*)(F.lds + LDSCTL_OFF))[u] = 0u;
    __syncthreads();
#if MK_SPLIT
#define GRID_BAR() do { } while (0)
#else
    XcdBarrier bar = xcd_barrier_post((unsigned*)(F.ctl + CW_BAR), F.MISC + 8);
#define GRID_BAR() xcd_barrier(bar)
#endif
    const int lo = args.ph_lo, hi = args.ph_hi;
#define IN(k) (lo <= (k) && (k) < hi)
#define SEAM(k) do { if (IN(k) && IN((k) + 1)) GRID_BAR(); } while (0)
    const Args& A = args;
    constexpr bool AL = true, SP = true;

#ifndef REP_PHASE
#define REP_PHASE -1
#endif
#define REPN(k) ((REP_PHASE == (k)) ? 2 : 1)
    if (IN(0)) { for (int rep = 0; rep < REPN(0); ++rep) p0_mod(F, A); p0_convert(F, A); } SEAM(0);
    if (IN(1)) { for (int rep = 0; rep < REPN(1); ++rep) p1_modulate(F, A); } SEAM(1);
    if (IN(2)) {
        if constexpr (NLB > 0) { pg8::Gemm g{WSP(bf16, WS_U), WSP(bf16, WS_WINT), T, NLB * 1024, DM}; pg8::StaticOrder S; S.init(T, NLB * 1024, F.G, (int)blockIdx.x);
          pg8::EpiQKV E{WSP(bf16, WS_QKV), NQKV, LBMAP, 1.0f};
          pg8::gemm_phase<pg8::EpiQKV, pg8::StaticOrder, AL, SP>(F.lds + RING_OFF, g, S, E);
          VM_WAIT(); __syncthreads(); }
        { pg8::Gemm g{WSP(bf16, WS_U8Q), WSP(bf16, WS_WING), T, NLF * 1024, DM / 2}; pg8::StaticOrder S; S.init(T, NLF * 1024, F.G, (int)blockIdx.x);
          pg8::EpiQKV E{WSP(bf16, WS_QKV), NQKV, LFMAP, 1.0f / WSCALE};
          pg8::gemm_phase<pg8::EpiQKV, pg8::StaticOrder, AL, SP, true>(F.lds + RING_OFF, g, S, E); }
    } SEAM(2);
    if (IN(3)) { for (int rep = 0; rep < REPN(3); ++rep) p3_attention(F, A); } SEAM(3);
    if (IN(4)) { for (int rep = 0; rep < REPN(4); ++rep) p4_finalize(F, A); } SEAM(4);
    if (IN(5)) for (int rep = 0; rep < REPN(5); ++rep) {
        { pg8::Gemm g{WSP(bf16, WS_YA), WSP(bf16, WS_WAT), T, DM, 1024}; pg8::StaticOrder S; S.init(T, DM, F.G, (int)blockIdx.x);
          pg8::EpiM1 E{WSP(bf16, WS_M1), WSP(bf16, WS_QKV) + C_GA, NQKV};
          pg8::gemm_phase<pg8::EpiM1, pg8::StaticOrder, AL, SP>(F.lds + RING_OFF, g, S, E); }
        VM_WAIT(); __syncthreads();
        { pg8::Gemm g{WSP(bf16, WS_YB), WSP(bf16, WS_WBT), T, DM, 1024}; pg8::StaticOrder S; S.init(T, DM, F.G, (int)blockIdx.x);
          if constexpr (P6_F8) { pg8::EpiMerged E{WSP(bf16, WS_M1), WSP(bf16, WS_QKV) + C_GB, NQKV, WSP(unsigned char, WS_MG)};
            pg8::gemm_phase<pg8::EpiMerged, pg8::StaticOrder, AL, SP>(F.lds + RING_OFF, g, S, E); }
          else { pg8::EpiMergedB E{WSP(bf16, WS_M1), WSP(bf16, WS_QKV) + C_GB, NQKV, WSP(bf16, WS_MG)};
            pg8::gemm_phase<pg8::EpiMergedB, pg8::StaticOrder, AL, SP>(F.lds + RING_OFF, g, S, E); } }
    } SEAM(5);
    if (IN(6)) for (int rep = 0; rep < REPN(6); ++rep) {
        pg8::Gemm g{WSP(bf16, WS_MG), WSP(bf16, WS_WOT), T, DM, P6_F8 ? DM / 2 : DM}; pg8::StaticOrder S; S.init(T, DM, F.G, (int)blockIdx.x);
        pg8::EpiH1 E{A.in[I_X], WSP(float, WS_H1), WSP(float, WS_MOD) + 2 * DM, 12288, SEQ / 256, P6_F8 ? 1.0f / (16.0f * WSCALE) : 1.0f};
        pg8::gemm_phase<pg8::EpiH1, pg8::StaticOrder, AL, SP, P6_F8>(F.lds + RING_OFF, g, S, E);
    } SEAM(6);
    if (IN(7)) { for (int rep = 0; rep < REPN(7); ++rep) p7_router(F, A, rep == 0); } if (IN(7) && IN(9)) GRID_BAR();
    if (IN(9)) for (int rep = 0; rep < REPN(9); ++rep) {
        build_tile_table(F);
        pg8::Gemm g{WSP(bf16, WS_U), WSP(bf16, WS_WGU), TKPAD, NE * 4096, DM / 2}; pg8::MoeOrder S; S.init((const LAS int*)(F.lds + TST_OFF), 16, F.G, (int)blockIdx.x, WSP(int, WS_TOKOF));
        pg8::EpiSwiGLU E{WSP(unsigned char, WS_YACT), A.in[I_BG], A.in[I_BU], 1.0f / WSCALE};
        pg8::gemm_phase<pg8::EpiSwiGLU, pg8::MoeOrder, AL, SP, true, true>(F.lds + RING_OFF, g, S, E);
    } SEAM(9);
    if (IN(10)) for (int rep = 0; rep < REPN(10); ++rep) {
        build_tile_table(F);
        pg8::Gemm g{WSP(bf16, WS_YACT), WSP(bf16, WS_WD), TKPAD, NE * DM, DM / 2}; pg8::MoeOrder S; S.init((const LAS int*)(F.lds + TST_OFF), 8, F.G, (int)blockIdx.x);
        pg8::EpiBf16B E{WSP(bf16, WS_YSLOT), DM, A.in[I_BDN], 8, 1.0f / WSCALE};
        pg8::gemm_phase<pg8::EpiBf16B, pg8::MoeOrder, AL, SP, true>(F.lds + RING_OFF, g, S, E);
    } SEAM(10);
    if (IN(11)) { for (int rep = 0; rep < REPN(11); ++rep) p11_final(F, A); }
#undef IN
#undef SEAM
}
extern "C" void kernel_launch(void* const* d_in, const int* in_sizes, int n_in, void* d_out, int out_size, void* d_ws, size_t ws_size, hipStream_t stream) {
    static int grid = 0;
    if (grid == 0) {
        if (n_in != 24 || in_sizes[0] != T * DM || out_size != T * DM || ws_size < WS_END) { fprintf(stderr, "kernel_launch: shape mismatch (n_in %d, in0 %d, out %d, ws %zu < %zu); nothing launched\n", n_in, n_in > 0 ? in_sizes[0] : -1, out_size, ws_size, (size_t)WS_END); grid = -1; return; }
        int dev = 0, cus = 0, per_cu = 0;
        if (hipGetDevice(&dev) != hipSuccess || hipDeviceGetAttribute(&cus, hipDeviceAttributeMultiprocessorCount, dev) != hipSuccess) { grid = -1; return; }
        if (hipFuncSetAttribute((const void*)fwd, hipFuncAttributeMaxDynamicSharedMemorySize, LDS_BYTES) != hipSuccess) { fprintf(stderr, "kernel_launch: hipFuncSetAttribute failed\n"); grid = -1; return; }
        if (hipOccupancyMaxActiveBlocksPerMultiprocessor(&per_cu, (const void*)fwd, NWAVES * 64, LDS_BYTES) != hipSuccess || per_cu < 1)
            fprintf(stderr, "kernel_launch: note: occupancy query reports %d workgroups per CU\n", per_cu);
        (void)hipGetLastError();
        grid = cus;
    }
    if (grid < 0) return;
    if (hipMemsetAsync((char*)d_ws + WS_CTL, 0, CTL_ZERO_BYTES, stream) != hipSuccess) return;
    Args a; memset(&a, 0, sizeof(a));
    for (int i = 0; i < 24; ++i) a.in[i] = (const float*)d_in[i];
    a.out = (float*)d_out; a.ws = (unsigned char*)d_ws;
#if MK_SPLIT
    for (int ph = 0; ph < N_PHASES; ++ph) { a.ph_lo = ph; a.ph_hi = ph + 1; hipLaunchKernelGGL(fwd, dim3(grid), dim3(NWAVES * 64), LDS_BYTES, stream, a); }
#else
    a.ph_lo = 0; a.ph_hi = N_PHASES; hipLaunchKernelGGL(fwd, dim3(grid), dim3(NWAVES * 64), LDS_BYTES, stream, a);
#endif
    const hipError_t le = hipPeekAtLastError();
    if (le != hipSuccess) fprintf(stderr, "kernel_launch: launch failed: %s\n", hipGetErrorName(le));
}
```

```cpp
#include <hip/hip_runtime.h>
#include <cstdio>
#include <cstdint>
#include <cstring>
#include <cmath>
namespace pg8 {
#define PG8_LAS __attribute__((address_space(3)))
typedef unsigned short bf16_t;
typedef short bf16x8 __attribute__((ext_vector_type(8)));
typedef float f32x4 __attribute__((ext_vector_type(4)));
typedef unsigned u32x4 __attribute__((ext_vector_type(4)));
constexpr int BM = 256, BK = 64, HALF = 128, HTB = HALF * BK * 2  , STAGE_BYTES = 8 * HTB, NXCD = 8, WGM = 8;

__host__ __device__ __forceinline__ int lds_byte(int r, int c) { const int st = (r >> 4) * 2 + (c >> 5), rr = r & 15, cc = c & 31, ob = rr * 64 + cc * 2; return st * 1024 + (ob ^ (((ob >> 9) & 1) << 5)); }
__host__ __device__ __forceinline__ void stage_rc(int b, int& R, int& C) { const int st = b / 1024, sb = b % 1024, swz = sb ^ (((sb >> 9) & 1) << 5); R = (st >> 1) * 16 + swz / 64; C = (st & 1) * 32 + (swz % 64) / 2; }
__host__ __device__ __forceinline__ int perm32(int rho) { const int n = rho >> 4, i = rho & 15; return 8 * (i >> 2) + 4 * n + (i & 3); }

struct Unit { int pm, pn; };
struct Gemm { const bf16_t* A; const bf16_t* Bt; int M, N, K; };

struct StaticOrder {
    int nM, nN, nwg, G, c;
    __host__ __device__ void init(int M, int N, int G_, int c_) { nM = M / BM; nN = N / BM; nwg = nM * nN; G = G_; c = c_; }
    __host__ __device__ bool next(int i, Unit& u) const {
        const long L = (long)i * G + c; if (L >= nwg) return false;
        int wgid = (int)L; { const int q = nwg / NXCD, r = nwg % NXCD, xcd = wgid % NXCD, off = wgid / NXCD; wgid = (xcd < r ? xcd * (q + 1) : r * (q + 1) + (xcd - r) * q) + off; }
        const int nig = WGM * nN, gid = wgid / nig, fm = gid * WGM, gsz = (nM - fm) < WGM ? (nM - fm) : WGM;
        u.pm = fm + ((wgid % nig) % gsz); u.pn = (wgid % nig) / gsz; return true;
    }
    __device__ __forceinline__ void a_ready(const Unit&) const {}
    __device__ __forceinline__ void done(const Unit&) const {}
    __device__ __forceinline__ int arow(const Unit&, int R) const { return R; }
};

__device__ __forceinline__ unsigned cvt_pk_bf16(float lo, float hi) { unsigned r; asm volatile("v_cvt_pk_bf16_f32 %0, %1, %2" : "=v"(r) : "v"(lo), "v"(hi)); return r; }

typedef int v4i_t __attribute__((ext_vector_type(4)));
typedef int v8i_t __attribute__((ext_vector_type(8)));
template <class Epi, class Sched, bool ALIGN_EPI = false, bool SP2 = false, bool F8 = false, bool GATHER = false>
__device__ __forceinline__ void gemm_phase(PG8_LAS unsigned char* lds, const Gemm g, const Sched& S, const Epi& E) {
    int tid = threadIdx.x; asm volatile("" : "+v"(tid));
    const int wid = __builtin_amdgcn_readfirstlane(tid >> 6), lane = tid & 63, wr = wid >> 2, wc = wid & 3, fr = lane & 15, fq = lane >> 4;
    const int K = g.K, nt = K / BK;
    unsigned voffA[2], voffB[2];
#pragma unroll
    for (int i = 0; i < 2; ++i) { int R, C; stage_rc(tid * 16 + i * 8192, R, C); const int Rb = Epi::PERM ? ((R & ~31) + perm32(R & 31)) : R;
        voffA[i] = (unsigned)(R * K + C) * 2u; voffB[i] = (unsigned)(Rb * K + C) * 2u; }
    static_assert(!GATHER || SP2, "the gather form is written for the two-super-phase loop");
    unsigned vo[2][2], nvo[2][2];
#define PG8_SETVO(dst, u) do { _Pragma("unroll") for (int _h = 0; _h < 2; ++_h) _Pragma("unroll") for (int _i = 0; _i < 2; ++_i) { \
        if constexpr (GATHER) { int R_, C_; stage_rc(tid * 16 + _i * 8192, R_, C_); dst[_h][_i] = (unsigned)(S.arow(u, R_ + HALF * _h) * K + C_) * 2u; } \
        else dst[_h][_i] = voffA[_i] + (unsigned)_h * (unsigned)(HALF * K * 2); } } while (0)
    const size_t kstep = (size_t)(BK * 2);
    const size_t hstep = (size_t)HALF * K * 2;
    const size_t tstep = 2 * hstep;
    const unsigned ldsw = (unsigned)wid * 1024u;
    const int aoff = lds_byte(wr * 64 + fr, fq * 8), boff = lds_byte(wc * 32 + fr, fq * 8);
#define PG8_SA(b, h) (((b) * 2 + (h)) * HTB)
#define PG8_SB(b, h) ((4 + (b) * 2 + (h)) * HTB)
#define PG8_STAGE(bufoff, gbase, voff) do { _Pragma("unroll") for (int _i = 0; _i < 2; ++_i) \
        __builtin_amdgcn_global_load_lds((const unsigned*)((const char*)(gbase) + (voff)[_i]), (PG8_LAS unsigned*)(lds + (bufoff) + ldsw + _i * 8192), 16, 0, 0); } while (0)
#define PG8_LDA(dst, b, h) do { _Pragma("unroll") for (int m = 0; m < 4; ++m) _Pragma("unroll") for (int k = 0; k < 2; ++k) dst[m][k] = *(const PG8_LAS bf16x8*)(lds + PG8_SA(b, h) + aoff + m * 2048 + k * 1024); } while (0)
#define PG8_LDB(dst, b, h) do { _Pragma("unroll") for (int n = 0; n < 2; ++n) _Pragma("unroll") for (int k = 0; k < 2; ++k) dst[n][k] = *(const PG8_LAS bf16x8*)(lds + PG8_SB(b, h) + boff + n * 2048 + k * 1024); } while (0)
#define PG8_MMA(ai, bj, At, Bt) do { __builtin_amdgcn_s_setprio(1); _Pragma("unroll") for (int m = 0; m < 4; ++m) _Pragma("unroll") for (int n = 0; n < 2; ++n) { \
        if constexpr (F8) { const v8i_t _b = __builtin_shufflevector(__builtin_bit_cast(v4i_t, Bt[n][0]), __builtin_bit_cast(v4i_t, Bt[n][1]), 0, 1, 2, 3, 4, 5, 6, 7); \
            const v8i_t _a = __builtin_shufflevector(__builtin_bit_cast(v4i_t, At[m][0]), __builtin_bit_cast(v4i_t, At[m][1]), 0, 1, 2, 3, 4, 5, 6, 7); \
            asm volatile("v_mfma_scale_f32_16x16x128_f8f6f4 %0, %1, %2, %0, %3, %3 op_sel_hi:[0,0,0]" : "+v"(acc[ai][bj][m][n]) : "v"(_b), "v"(_a), "v"(f8scale)); } \
        else { _Pragma("unroll") for (int k = 0; k < 2; ++k) acc[ai][bj][m][n] = __builtin_amdgcn_mfma_f32_16x16x32_bf16(Bt[n][k], At[m][k], acc[ai][bj][m][n], 0, 0, 0); } } \
        __builtin_amdgcn_s_setprio(0); } while (0)
#define PG8_WAIT_V(n) asm volatile("s_waitcnt vmcnt(" #n ")" ::: "memory")
#define PG8_WAIT_L(n) asm volatile("s_waitcnt lgkmcnt(" #n ")" ::: "memory")
#define PG8_BAR __builtin_amdgcn_s_barrier()
#define PG8_SCHED __builtin_amdgcn_sched_barrier(0)
    Unit cur, nxt; int ui = 0;
    if (!S.next(0, cur)) return;
    const int f8scale = 0x7f7f7f7f;
    f32x4 acc[2][2][4][2];
#pragma unroll
    for (int a = 0; a < 2; ++a)
#pragma unroll
        for (int b = 0; b < 2; ++b)
#pragma unroll
            for (int m = 0; m < 4; ++m)
#pragma unroll
                for (int n = 0; n < 2; ++n) acc[a][b][m][n] = (f32x4){0.f, 0.f, 0.f, 0.f};
    bf16x8 At[4][2], B0[2][2], B1[2][2];
    const char* cA = (const char*)g.A + (GATHER ? (size_t)0 : (size_t)cur.pm * tstep); const char* cB = (const char*)g.Bt + (size_t)cur.pn * tstep;
    PG8_SETVO(vo, cur);
    S.a_ready(cur);
    if constexpr (SP2) {
        PG8_STAGE(PG8_SB(0, 0), cB, voffB); PG8_STAGE(PG8_SB(0, 1), cB + hstep, voffB); PG8_STAGE(PG8_SA(0, 0), cA, vo[0]); PG8_STAGE(PG8_SA(0, 1), cA, vo[1]);
        if (wr == 1) PG8_BAR;
        PG8_WAIT_V(2); PG8_BAR;
        PG8_STAGE(PG8_SB(1, 0), cB + kstep, voffB); PG8_STAGE(PG8_SA(1, 0), cA + kstep, vo[0]); PG8_STAGE(PG8_SB(1, 1), cB + hstep + kstep, voffB);
        PG8_WAIT_V(6); PG8_BAR;
    } else {
        PG8_STAGE(PG8_SB(0, 0), cB, voffB); PG8_STAGE(PG8_SA(0, 0), cA, vo[0]); PG8_STAGE(PG8_SB(0, 1), cB + hstep, voffB); PG8_STAGE(PG8_SA(0, 1), cA, vo[1]);
        if (wr == 1) PG8_BAR;
        PG8_WAIT_V(4); PG8_BAR;
        PG8_STAGE(PG8_SB(1, 0), cB + kstep, voffB); PG8_STAGE(PG8_SA(1, 0), cA + kstep, vo[0]); PG8_STAGE(PG8_SB(1, 1), cB + hstep + kstep, voffB);
        PG8_WAIT_V(6); PG8_BAR;
    }
    for (;;) {
        const bool has_next = S.next(ui + 1, nxt);
        const char* nA = (has_next && !GATHER) ? (const char*)g.A + (size_t)nxt.pm * tstep : cA; const char* nB = has_next ? (const char*)g.Bt + (size_t)nxt.pn * tstep : cB;
        if (has_next) { PG8_SETVO(nvo, nxt); } else {
#pragma unroll
            for (int _h = 0; _h < 2; ++_h)
#pragma unroll
                for (int _i = 0; _i < 2; ++_i) nvo[_h][_i] = vo[_h][_i]; }
        for (int t = 0; t < nt; t += 2) {
            const bool last = (t == nt - 2);
            const char* a1 = cA + (size_t)(t + 1) * kstep;
            const char* a2 = last ? nA : cA + (size_t)(t + 2) * kstep; const char* b2 = last ? nB : cB + (size_t)(t + 2) * kstep;
            const char* a3 = a2 + kstep; const char* b3 = b2 + kstep;
            unsigned s0[2], s1[2];
#pragma unroll
            for (int _i = 0; _i < 2; ++_i) { s0[_i] = last ? nvo[0][_i] : vo[0][_i]; s1[_i] = last ? nvo[1][_i] : vo[1][_i]; }
            if (last && has_next) S.a_ready(nxt);
            if constexpr (SP2) {
            PG8_LDB(B0, 0, 0); PG8_LDB(B1, 0, 1); PG8_SCHED; PG8_LDA(At, 0, 0); PG8_STAGE(PG8_SA(1, 1), a1, vo[1]);
            PG8_WAIT_V(8); PG8_WAIT_L(0); PG8_BAR; PG8_MMA(0, 0, At, B0); PG8_MMA(0, 1, At, B1); PG8_BAR; PG8_SCHED;
            PG8_LDA(At, 0, 1); PG8_STAGE(PG8_SB(0, 0), b2, voffB); PG8_STAGE(PG8_SB(0, 1), b2 + hstep, voffB); PG8_STAGE(PG8_SA(0, 0), a2, s0);
            PG8_WAIT_V(8); PG8_WAIT_L(0); PG8_BAR; PG8_MMA(1, 0, At, B0); PG8_MMA(1, 1, At, B1); PG8_BAR; PG8_SCHED;
            PG8_LDB(B0, 1, 0); PG8_LDB(B1, 1, 1); PG8_SCHED; PG8_LDA(At, 1, 0); PG8_STAGE(PG8_SA(0, 1), a2, s1);
            PG8_WAIT_V(8); PG8_WAIT_L(0); PG8_BAR; PG8_MMA(0, 0, At, B0); PG8_MMA(0, 1, At, B1); PG8_BAR; PG8_SCHED;
            PG8_LDA(At, 1, 1); PG8_STAGE(PG8_SB(1, 0), b3, voffB); PG8_STAGE(PG8_SB(1, 1), b3 + hstep, voffB); PG8_STAGE(PG8_SA(1, 0), a3, s0);
            PG8_WAIT_V(8); PG8_WAIT_L(0); PG8_BAR; PG8_MMA(1, 0, At, B0); PG8_MMA(1, 1, At, B1); PG8_BAR; PG8_SCHED;
            } else {
            PG8_LDB(B0, 0, 0); PG8_SCHED; PG8_LDA(At, 0, 0); PG8_STAGE(PG8_SA(1, 1), a1, vo[1]);
            PG8_WAIT_L(8); PG8_BAR; PG8_WAIT_L(0); PG8_MMA(0, 0, At, B0); PG8_BAR; PG8_SCHED;
            PG8_LDB(B1, 0, 1); PG8_STAGE(PG8_SB(0, 0), b2, voffB);
            PG8_BAR; PG8_WAIT_L(0); PG8_MMA(0, 1, At, B1); PG8_BAR;
            PG8_LDA(At, 0, 1); PG8_STAGE(PG8_SA(0, 0), a2, s0);
            PG8_BAR; PG8_WAIT_L(0); PG8_MMA(1, 0, At, B0); PG8_BAR; PG8_SCHED;
            PG8_STAGE(PG8_SB(0, 1), b2 + hstep, voffB);
            PG8_WAIT_V(6); PG8_BAR; PG8_MMA(1, 1, At, B1); PG8_BAR;
            PG8_LDB(B0, 1, 0); PG8_SCHED; PG8_LDA(At, 1, 0); PG8_STAGE(PG8_SA(0, 1), a2, s1);
            PG8_WAIT_L(8); PG8_BAR; PG8_WAIT_L(0); PG8_MMA(0, 0, At, B0); PG8_BAR; PG8_SCHED;
            PG8_LDB(B1, 1, 1); PG8_STAGE(PG8_SB(1, 0), b3, voffB);
            PG8_BAR; PG8_WAIT_L(0); PG8_MMA(0, 1, At, B1); PG8_BAR;
            PG8_LDA(At, 1, 1); PG8_STAGE(PG8_SA(1, 0), a3, s0);
            PG8_BAR; PG8_WAIT_L(0); PG8_MMA(1, 0, At, B0); PG8_BAR; PG8_SCHED;
            PG8_STAGE(PG8_SB(1, 1), b3 + hstep, voffB);
            PG8_WAIT_V(6); PG8_BAR; PG8_MMA(1, 1, At, B1); PG8_BAR;
            }
        }
        if constexpr (F8) asm volatile("s_nop 15\n\ts_nop 7" ::: "memory");
        if constexpr (ALIGN_EPI) { if (wr == 0) PG8_BAR; }
        if constexpr (!Epi::AFTER_DRAIN) { E(acc, cur, wr, wc, fr, fq); S.done(cur); }
        if (!has_next) break;
#pragma unroll
        for (int a = 0; a < 2; ++a)
#pragma unroll
            for (int b = 0; b < 2; ++b)
#pragma unroll
                for (int m = 0; m < 4; ++m)
#pragma unroll
                    for (int n = 0; n < 2; ++n) acc[a][b][m][n] = (f32x4){0.f, 0.f, 0.f, 0.f};
        cur = nxt; cA = nA; cB = nB; ++ui;
#pragma unroll
        for (int _h = 0; _h < 2; ++_h)
#pragma unroll
            for (int _i = 0; _i < 2; ++_i) vo[_h][_i] = nvo[_h][_i];
        if constexpr (ALIGN_EPI) { if (wr == 1) PG8_BAR; }
    }
    PG8_WAIT_V(0);
    if constexpr (!ALIGN_EPI) { if (wr == 0) PG8_BAR; }
    PG8_BAR;
    if constexpr (Epi::AFTER_DRAIN) { E.fused(acc, cur, wr, wc, fr, fq, lds, wid, lane); S.done(cur); }
#undef PG8_SA
#undef PG8_SETVO
#undef PG8_SB
#undef PG8_STAGE
#undef PG8_LDA
#undef PG8_LDB
#undef PG8_MMA
#undef PG8_WAIT_V
#undef PG8_WAIT_L
#undef PG8_BAR
#undef PG8_SCHED
}
}
namespace pg8 {
typedef float f32x2e __attribute__((ext_vector_type(2)));
__device__ __forceinline__ float bf_lo(unsigned w) { return __uint_as_float(w << 16); }
__device__ __forceinline__ float bf_hi(unsigned w) { return __uint_as_float(w & 0xffff0000u); }
__device__ __forceinline__ float sigmoidf_fast(float x) { return __builtin_amdgcn_rcpf(1.0f + __expf(-x)); }

struct EpiBf16B {
    static constexpr bool PERM = true, AFTER_DRAIN = false;
    bf16_t* O; int ldc; const float* bias; int ntile_mod; float scale;
    __device__ __forceinline__ void operator()(const f32x4 (&acc)[2][2][4][2], const Unit& u, int wr, int wc, int fr, int fq) const {
        const int row0 = u.pm * BM + wr * 64 + fr; const int colt = (u.pn % ntile_mod) * BM;
        const int col0 = colt + wc * 32 + 8 * fq, bcol0 = u.pn * BM + wc * 32 + 8 * fq;
        f32x4 bv[2][2];
#pragma unroll
        for (int bj = 0; bj < 2; ++bj)
#pragma unroll
            for (int n = 0; n < 2; ++n) bv[bj][n] = bias ? *(const f32x4*)(bias + bcol0 + bj * HALF + 4 * n) : (f32x4){0.f, 0.f, 0.f, 0.f};
#pragma unroll
        for (int ai = 0; ai < 2; ++ai)
#pragma unroll
            for (int m = 0; m < 4; ++m) { bf16_t* rowp = O + (size_t)(row0 + ai * HALF + m * 16) * ldc + col0;
#pragma unroll
                for (int bj = 0; bj < 2; ++bj) { const f32x4 v0 = acc[ai][bj][m][0] * scale + bv[bj][0], v1 = acc[ai][bj][m][1] * scale + bv[bj][1];
                    u32x4 w; w.x = cvt_pk_bf16(v0[0], v0[1]); w.y = cvt_pk_bf16(v0[2], v0[3]); w.z = cvt_pk_bf16(v1[0], v1[1]); w.w = cvt_pk_bf16(v1[2], v1[3]);
                    *(u32x4*)(rowp + bj * HALF) = w; } }
    }
};
struct EpiQKV {
    static constexpr bool PERM = true, AFTER_DRAIN = false;
    bf16_t* O; int ldc; unsigned long long gmap; float scale;
    static constexpr long Q8_FROM_O = (610L - 96L) * 1048576L;
    __device__ __forceinline__ void operator()(const f32x4 (&acc)[2][2][4][2], const Unit& u, int wr, int wc, int fr, int fq) const {
        const int og = (int)((gmap >> (4 * (u.pn >> 2))) & 15ull); const bool sg = og >= 6;
        const int row0 = u.pm * BM + wr * 64 + fr; const int col0 = (og * 4 + (u.pn & 3)) * BM + wc * 32 + 8 * fq;
#pragma unroll
        for (int ai = 0; ai < 2; ++ai)
#pragma unroll
            for (int m = 0; m < 4; ++m) { bf16_t* rowp = O + (size_t)(row0 + ai * HALF + m * 16) * ldc + col0;
#pragma unroll
                for (int bj = 0; bj < 2; ++bj) { f32x4 v0 = acc[ai][bj][m][0] * scale, v1 = acc[ai][bj][m][1] * scale;
                    if (og == 3 || og == 4) {
                        int w0 = __builtin_amdgcn_cvt_pk_fp8_f32(v0[0] * 8.f, v0[1] * 8.f, 0, false); w0 = __builtin_amdgcn_cvt_pk_fp8_f32(v0[2] * 8.f, v0[3] * 8.f, w0, true);
                        int w1 = __builtin_amdgcn_cvt_pk_fp8_f32(v1[0] * 8.f, v1[1] * 8.f, 0, false); w1 = __builtin_amdgcn_cvt_pk_fp8_f32(v1[2] * 8.f, v1[3] * 8.f, w1, true);
                        typedef int v2i_q __attribute__((ext_vector_type(2)));
                        *(v2i_q*)((unsigned char*)O + Q8_FROM_O + (size_t)(row0 + ai * HALF + m * 16) * 2048 + (og - 3) * 1024 + (u.pn & 3) * BM + wc * 32 + 8 * fq + bj * HALF) = (v2i_q){w0, w1};
                        continue; }
                    if (sg) {
#pragma unroll
                        for (int i = 0; i < 4; ++i) { v0[i] = sigmoidf_fast(v0[i]); v1[i] = sigmoidf_fast(v1[i]); } }
                    u32x4 w; w.x = cvt_pk_bf16(v0[0], v0[1]); w.y = cvt_pk_bf16(v0[2], v0[3]); w.z = cvt_pk_bf16(v1[0], v1[1]); w.w = cvt_pk_bf16(v1[2], v1[3]);
                    *(u32x4*)(rowp + bj * HALF) = w; } }
    }
};
struct EpiM1 {
    static constexpr bool PERM = true, AFTER_DRAIN = false;
    bf16_t* M1; const bf16_t* G; int ldg;
    __device__ __forceinline__ void operator()(const f32x4 (&acc)[2][2][4][2], const Unit& u, int wr, int wc, int fr, int fq) const {
        const int row0 = u.pm * BM + wr * 64 + fr; const int col0 = u.pn * BM + wc * 32 + 8 * fq;
#pragma unroll
        for (int ai = 0; ai < 2; ++ai)
#pragma unroll
            for (int m = 0; m < 4; ++m) { const size_t row = (size_t)(row0 + ai * HALF + m * 16);
#pragma unroll
                for (int bj = 0; bj < 2; ++bj) { const int col = col0 + bj * HALF; const u32x4 g = *(const u32x4*)(G + row * ldg + col);
                    const f32x4 a0 = acc[ai][bj][m][0], a1 = acc[ai][bj][m][1];
                    const f32x4 o0 = {a0[0] * bf_lo(g.x), a0[1] * bf_hi(g.x), a0[2] * bf_lo(g.y), a0[3] * bf_hi(g.y)};
                    const f32x4 o1 = {a1[0] * bf_lo(g.z), a1[1] * bf_hi(g.z), a1[2] * bf_lo(g.w), a1[3] * bf_hi(g.w)};
                    u32x4 w; w.x = cvt_pk_bf16(o0[0], o0[1]); w.y = cvt_pk_bf16(o0[2], o0[3]); w.z = cvt_pk_bf16(o1[0], o1[1]); w.w = cvt_pk_bf16(o1[2], o1[3]);
                    *(u32x4*)(M1 + row * 2048 + col) = w; } }
    }
};
struct EpiMerged {
    static constexpr bool PERM = true, AFTER_DRAIN = false;
    const bf16_t* M1; const bf16_t* G; int ldg; unsigned char* MG;
    __device__ __forceinline__ void operator()(const f32x4 (&acc)[2][2][4][2], const Unit& u, int wr, int wc, int fr, int fq) const {
        const int row0 = u.pm * BM + wr * 64 + fr; const int col0 = u.pn * BM + wc * 32 + 8 * fq;
#pragma unroll
        for (int ai = 0; ai < 2; ++ai)
#pragma unroll
            for (int m = 0; m < 4; ++m) { const size_t row = (size_t)(row0 + ai * HALF + m * 16);
#pragma unroll
                for (int bj = 0; bj < 2; ++bj) { const int col = col0 + bj * HALF; const u32x4 g = *(const u32x4*)(G + row * ldg + col);
                    const u32x4 mw = *(const u32x4*)(M1 + row * 2048 + col);
                    const f32x4 m0 = {bf_lo(mw.x), bf_hi(mw.x), bf_lo(mw.y), bf_hi(mw.y)}, m1 = {bf_lo(mw.z), bf_hi(mw.z), bf_lo(mw.w), bf_hi(mw.w)};
                    const f32x4 a0 = acc[ai][bj][m][0], a1 = acc[ai][bj][m][1];
                    const f32x4 o0 = {m0[0] + a0[0] * bf_lo(g.x), m0[1] + a0[1] * bf_hi(g.x), m0[2] + a0[2] * bf_lo(g.y), m0[3] + a0[3] * bf_hi(g.y)};
                    const f32x4 o1 = {m1[0] + a1[0] * bf_lo(g.z), m1[1] + a1[1] * bf_hi(g.z), m1[2] + a1[2] * bf_lo(g.w), m1[3] + a1[3] * bf_hi(g.w)};
                    int w0 = __builtin_amdgcn_cvt_pk_fp8_f32(o0[0] * 16.f, o0[1] * 16.f, 0, false); w0 = __builtin_amdgcn_cvt_pk_fp8_f32(o0[2] * 16.f, o0[3] * 16.f, w0, true);
                    int w1 = __builtin_amdgcn_cvt_pk_fp8_f32(o1[0] * 16.f, o1[1] * 16.f, 0, false); w1 = __builtin_amdgcn_cvt_pk_fp8_f32(o1[2] * 16.f, o1[3] * 16.f, w1, true);
                    typedef int v2i_m __attribute__((ext_vector_type(2))); *(v2i_m*)(MG + row * 2048 + col) = (v2i_m){w0, w1}; } }
    }
};
struct EpiMergedB {
    static constexpr bool PERM = true, AFTER_DRAIN = false;
    const bf16_t* M1; const bf16_t* G; int ldg; bf16_t* MG;
    __device__ __forceinline__ void operator()(const f32x4 (&acc)[2][2][4][2], const Unit& u, int wr, int wc, int fr, int fq) const {
        const int row0 = u.pm * BM + wr * 64 + fr; const int col0 = u.pn * BM + wc * 32 + 8 * fq;
#pragma unroll
        for (int ai = 0; ai < 2; ++ai)
#pragma unroll
            for (int m = 0; m < 4; ++m) { const size_t row = (size_t)(row0 + ai * HALF + m * 16);
#pragma unroll
                for (int bj = 0; bj < 2; ++bj) { const int col = col0 + bj * HALF; const u32x4 g = *(const u32x4*)(G + row * ldg + col);
                    const u32x4 mw = *(const u32x4*)(M1 + row * 2048 + col);
                    const f32x4 m0 = {bf_lo(mw.x), bf_hi(mw.x), bf_lo(mw.y), bf_hi(mw.y)}, m1 = {bf_lo(mw.z), bf_hi(mw.z), bf_lo(mw.w), bf_hi(mw.w)};
                    const f32x4 a0 = acc[ai][bj][m][0], a1 = acc[ai][bj][m][1];
                    const f32x4 o0 = {m0[0] + a0[0] * bf_lo(g.x), m0[1] + a0[1] * bf_hi(g.x), m0[2] + a0[2] * bf_lo(g.y), m0[3] + a0[3] * bf_hi(g.y)};
                    const f32x4 o1 = {m1[0] + a1[0] * bf_lo(g.z), m1[1] + a1[1] * bf_hi(g.z), m1[2] + a1[2] * bf_lo(g.w), m1[3] + a1[3] * bf_hi(g.w)};
                    u32x4 w; w.x = cvt_pk_bf16(o0[0], o0[1]); w.y = cvt_pk_bf16(o0[2], o0[3]); w.z = cvt_pk_bf16(o1[0], o1[1]); w.w = cvt_pk_bf16(o1[2], o1[3]);
                    *(u32x4*)(MG + row * 2048 + col) = w; } }
    }
};
struct EpiH1 {
    static constexpr bool PERM = false, AFTER_DRAIN = false;
    const float* X; float* H1; const float* g1; int g1_stride; int tiles_per_batch; float wscale;
    __device__ __forceinline__ void operator()(const f32x4 (&acc)[2][2][4][2], const Unit& u, int wr, int wc, int fr, int fq) const {
        const int row0 = u.pm * BM + wr * 64 + fr; const int col0 = u.pn * BM + wc * 32 + 4 * fq; const float* gb = g1 + (size_t)(u.pm / tiles_per_batch) * g1_stride;
        f32x4 gv[2][2];
#pragma unroll
        for (int bj = 0; bj < 2; ++bj)
#pragma unroll
            for (int n = 0; n < 2; ++n) gv[bj][n] = *(const f32x4*)(gb + col0 + bj * HALF + n * 16);
#pragma unroll
        for (int ai = 0; ai < 2; ++ai)
#pragma unroll
            for (int m = 0; m < 4; ++m) { const size_t off = (size_t)(row0 + ai * HALF + m * 16) * 2048 + col0;
#pragma unroll
                for (int bj = 0; bj < 2; ++bj)
#pragma unroll
                    for (int n = 0; n < 2; ++n) { const f32x4 xv = *(const f32x4*)(X + off + bj * HALF + n * 16);
                        *(f32x4*)(H1 + off + bj * HALF + n * 16) = xv + gv[bj][n] * (acc[ai][bj][m][n] * wscale); } }
    }
};
struct EpiSwiGLU {
    static constexpr bool PERM = true, AFTER_DRAIN = false;
    unsigned char* Y; const float* bg; const float* bu; float wscale;
    __device__ __forceinline__ void operator()(const f32x4 (&acc)[2][2][4][2], const Unit& u, int wr, int wc, int fr, int fq) const {
        const int e = u.pn >> 4, pnl = u.pn & 15; const int row0 = u.pm * BM + wr * 64 + fr; const int col0 = pnl * HALF + wc * 32 + 8 * fq;
        f32x4 bgv[2], buv[2];
#pragma unroll
        for (int n = 0; n < 2; ++n) { bgv[n] = *(const f32x4*)(bg + (size_t)e * 2048 + col0 + 4 * n); buv[n] = *(const f32x4*)(bu + (size_t)e * 2048 + col0 + 4 * n); }
#pragma unroll
        for (int ai = 0; ai < 2; ++ai)
#pragma unroll
            for (int m = 0; m < 4; ++m) { unsigned char* rowp = Y + (size_t)(row0 + ai * HALF + m * 16) * 2048 + col0; f32x4 y[2];
#pragma unroll
                for (int n = 0; n < 2; ++n) { const f32x4 g4 = acc[ai][0][m][n] * wscale + bgv[n], u4 = acc[ai][1][m][n] * wscale + buv[n];
                    f32x4 gc, uc, ex;
#pragma unroll
                    for (int i = 0; i < 4; ++i) { gc[i] = fminf(g4[i], 7.0f); uc[i] = __builtin_amdgcn_fmed3f(u4[i], -7.0f, 7.0f); }
                    const f32x4 t = gc * (-1.702f * 1.4426950408889634f);
#pragma unroll
                    for (int i = 0; i < 4; ++i) ex[i] = __builtin_amdgcn_rcpf(1.0f + __builtin_amdgcn_exp2f(t[i]));
                    y[n] = (uc + 1.0f) * (gc * ex); }
                int w0 = __builtin_amdgcn_cvt_pk_fp8_f32(y[0][0], y[0][1], 0, false); w0 = __builtin_amdgcn_cvt_pk_fp8_f32(y[0][2], y[0][3], w0, true);
                int w1 = __builtin_amdgcn_cvt_pk_fp8_f32(y[1][0], y[1][1], 0, false); w1 = __builtin_amdgcn_cvt_pk_fp8_f32(y[1][2], y[1][3], w1, true);
                typedef int v2i_t __attribute__((ext_vector_type(2))); *(v2i_t*)rowp = (v2i_t){w0, w1}; }
    }
};
struct MoeOrder {
    const PG8_LAS int* tstart; int npn, lo, hi, rank, W; const int* tokof;
    __device__ __forceinline__ int arow(const Unit& u, int R) const { const int e = u.pn / npn, slot = (u.pm - tstart[e]) * 256 + R;
        return slot < tstart[40 + e] ? tokof[e * 8192 + slot] : 0; }
    __device__ __forceinline__ void init(const PG8_LAS int* ts, int npn_, int G, int c, const int* tk = nullptr) { tstart = ts; npn = npn_; tokof = tk; const int U = ts[32] * npn_; const int x = c % NXCD; rank = c / NXCD; W = G / NXCD;
        lo = (int)(((long)U * x) / NXCD); hi = (int)(((long)U * (x + 1)) / NXCD); }
    __device__ __forceinline__ bool next(int i, Unit& u) const {
        const int q = lo + rank + W * i; if (q >= hi) return false;
        const int lk = (int)(threadIdx.x & 31u);
        const int e = __builtin_popcountll(__ballot(tstart[lk] * npn <= q) & 0xffffffffull) - 1;
        const int ts = tstart[e], te = tstart[e + 1] - ts, qq = q - ts * npn;
        u.pm = ts + qq % te; u.pn = e * npn + qq / te; return true;
    }
    __device__ __forceinline__ void a_ready(const Unit&) const {}
    __device__ __forceinline__ void done(const Unit&) const {}
};
}
namespace att {
using bf16x8 = __attribute__((ext_vector_type(8))) short;
using s16x4  = __attribute__((ext_vector_type(4))) short;
using f32x16 = __attribute__((ext_vector_type(16))) float;
using u32x4  = __attribute__((ext_vector_type(4))) unsigned;
using f32x4v = __attribute__((ext_vector_type(4))) float;
typedef unsigned short bf16;
constexpr int   D = 128, NW = 8, QBLK = 32, KVBLK = 64;
constexpr float SCALE = 0.088388347648318440f;
constexpr float THR = 8.f;
constexpr size_t SHM_V = KVBLK * D * 2, SHM_K = KVBLK * D * 2, SHM_ATTN = 2 * SHM_V + 2 * SHM_K + NW * 64 * 4;
#define KSWZ(row, colB) ((row) * 256 + ((colB) ^ (((row) & 7) << 4)))
#define SBAR() __builtin_amdgcn_sched_barrier(0)
__device__ __forceinline__ int crow(int r, int hi) { return (r & 3) + 8 * (r >> 2) + 4 * hi; }
__device__ __forceinline__ unsigned cvtpk(float lo, float hi) { unsigned r; asm volatile("v_cvt_pk_bf16_f32 %0, %1, %2" : "=v"(r) : "v"(lo), "v"(hi)); return r; }

template <int MODE>
__device__ __forceinline__ void partialSM(f32x16& p0, f32x16& p1, float& m_reg, float& mn, float& alpha, float relb, float kk, bool valid, int side = 0) {
  constexpr float C = SCALE * 1.4426950408889634f;
  float base = 0.f;
  if (MODE == 0 && side != 0) {
    const float skk = side > 0 ? kk : -kk; base = -skk * relb;
#pragma unroll
    for (int r = 0; r < 16; ++r) { p0[r] = fmaf(skk, (float)((r & 3) + 8 * (r >> 2)), p0[r]); p1[r] = fmaf(skk, (float)((r & 3) + 8 * (r >> 2) + 32), p1[r]); }
  } else {
#pragma unroll
    for (int r = 0; r < 16; ++r) {
      const float d0 = relb - (float)((r & 3) + 8 * (r >> 2)), a0 = __builtin_fabsf(d0), a1 = __builtin_fabsf(d0 - 32.f);
      p0[r] = fmaf(a0, -kk, p0[r]); p1[r] = fmaf(a1, -kk, p1[r]);
      if (MODE == 1) { if (!(valid && a0 <= 64.f)) p0[r] = -INFINITY; if (!(valid && a1 <= 64.f)) p1[r] = -INFINITY; }
    }
  }
  float pmax = p0[0];
#pragma unroll
  for (int r = 1; r < 16; ++r) pmax = fmaxf(pmax, p0[r]);
#pragma unroll
  for (int r = 0; r < 16; ++r) pmax = fmaxf(pmax, p1[r]);
  { auto rr = __builtin_amdgcn_permlane32_swap(__float_as_uint(pmax), __float_as_uint(pmax), false, false);
    pmax = fmaxf(__uint_as_float(rr[0]), __uint_as_float(rr[1])); }
  pmax += base;
  if (__builtin_expect(__all(pmax - m_reg <= THR / SCALE), 1)) { mn = m_reg; alpha = 1.f; }
  else { mn = fmaxf(m_reg, pmax); alpha = __builtin_amdgcn_exp2f((m_reg - mn) * C); m_reg = mn; }
  const float mnC = (base - mn) * C;
#pragma unroll
  for (int r = 0; r < 16; ++r) p0[r] = fmaf(p0[r], C, mnC);
#pragma unroll
  for (int r = 0; r < 16; ++r) p1[r] = fmaf(p1[r], C, mnC);
#pragma unroll
  for (int r = 0; r < 16; ++r) p0[r] = __builtin_amdgcn_exp2f(p0[r]);
}
__device__ __forceinline__ void finishSM(f32x16& p0, f32x16& p1, float alpha, float& l_reg, bf16x8& pa0, bf16x8& pa1, bf16x8& pa2, bf16x8& pa3) {
#pragma unroll
  for (int r = 0; r < 16; ++r) p1[r] = __builtin_amdgcn_exp2f(p1[r]);
  float ps = 0;
#pragma unroll
  for (int r = 0; r < 16; ++r) ps += p0[r];
#pragma unroll
  for (int r = 0; r < 16; ++r) ps += p1[r];
  { auto rr = __builtin_amdgcn_permlane32_swap(__float_as_uint(ps), __float_as_uint(ps), false, false);
    ps = __uint_as_float(rr[0]) + __uint_as_float(rr[1]); }
  l_reg = l_reg * alpha + ps;
#define PK4(P, BASE, OUT) do { unsigned a0 = cvtpk(P[BASE + 0], P[BASE + 1]), a1 = cvtpk(P[BASE + 2], P[BASE + 3]);   \
    unsigned b0 = cvtpk(P[BASE + 4], P[BASE + 5]), b1 = cvtpk(P[BASE + 6], P[BASE + 7]);                              \
    auto r0 = __builtin_amdgcn_permlane32_swap(a0, b0, false, false); auto r1 = __builtin_amdgcn_permlane32_swap(a1, b1, false, false); \
    u32x4 w = {r0[0], r1[0], r0[1], r1[1]}; OUT = *reinterpret_cast<bf16x8*>(&w); } while (0)
  PK4(p0, 0, pa0); PK4(p0, 8, pa1); PK4(p1, 0, pa2); PK4(p1, 8, pa3);
#undef PK4
}
__device__ __forceinline__ void qkt(f32x16& p0, f32x16& p1, const bf16* Ks, const bf16x8* qr, int r32, int hi) {
  p0 = f32x16{}; p1 = f32x16{};
#pragma unroll
  for (int d0 = 0; d0 < 8; ++d0) { const int cb = (d0 * 16 + hi * 8) * 2;
    bf16x8 b0 = *reinterpret_cast<const bf16x8*>((const char*)Ks + KSWZ(r32, cb));
    bf16x8 b1 = *reinterpret_cast<const bf16x8*>((const char*)Ks + KSWZ(32 + r32, cb));
    p0 = __builtin_amdgcn_mfma_f32_32x32x16_bf16(b0, qr[d0], p0, 0, 0, 0);
    p1 = __builtin_amdgcn_mfma_f32_32x32x16_bf16(b1, qr[d0], p1, 0, 0, 0); }
}
__device__ __forceinline__ int v_st(int k, int c) { const int kk = (k & ~0xC) | ((k & 4) << 1) | ((k & 8) >> 1); return ((kk >> 3) * 4 + (c >> 5)) * 512 + ((kk & 7) * 32 + (c & 31)) * 2; }
__device__ __forceinline__ int v_rd_base(int lane) { return ((lane & 3) << 3) | (((lane >> 2) & 3) << 6) | (((lane >> 4) & 1) << 5) | (((lane >> 5) & 1) << 8); }
constexpr int v_rd_off(int d0, int ks, int half) { return d0 * 512 + ks * 4096 + half * 2048; }
template <int OFF> __device__ __forceinline__ s16x4 tr_read(int vb) {
  s16x4 r; asm volatile("ds_read_b64_tr_b16 %0, %1 offset:%2" : "=&v"(r) : "v"(vb), "i"(OFF) : "memory"); return r;
}
template <int D0> __device__ __forceinline__ void pv_one(f32x16& od, int vb, bf16x8 pa0, bf16x8 pa1, bf16x8 pa2, bf16x8 pa3) {
  const s16x4 l0 = tr_read<v_rd_off(D0, 0, 0)>(vb), h0 = tr_read<v_rd_off(D0, 0, 1)>(vb), l1 = tr_read<v_rd_off(D0, 1, 0)>(vb), h1 = tr_read<v_rd_off(D0, 1, 1)>(vb);
  const s16x4 l2 = tr_read<v_rd_off(D0, 2, 0)>(vb), h2 = tr_read<v_rd_off(D0, 2, 1)>(vb), l3 = tr_read<v_rd_off(D0, 3, 0)>(vb), h3 = tr_read<v_rd_off(D0, 3, 1)>(vb);
  asm volatile("s_waitcnt lgkmcnt(0)" ::: "memory"); SBAR();
#define PK(L, H) (bf16x8){L[0], L[1], L[2], L[3], H[0], H[1], H[2], H[3]}
  od = __builtin_amdgcn_mfma_f32_32x32x16_bf16(pa0, PK(l0, h0), od, 0, 0, 0);
  od = __builtin_amdgcn_mfma_f32_32x32x16_bf16(pa1, PK(l1, h1), od, 0, 0, 0);
  od = __builtin_amdgcn_mfma_f32_32x32x16_bf16(pa2, PK(l2, h2), od, 0, 0, 0);
  od = __builtin_amdgcn_mfma_f32_32x32x16_bf16(pa3, PK(l3, h3), od, 0, 0, 0);
#undef PK
}
__device__ __forceinline__ void pv_d0(f32x16* o, int vb, bf16x8 pa0, bf16x8 pa1, bf16x8 pa2, bf16x8 pa3) {
  pv_one<0>(o[0], vb, pa0, pa1, pa2, pa3); pv_one<1>(o[1], vb, pa0, pa1, pa2, pa3); pv_one<2>(o[2], vb, pa0, pa1, pa2, pa3); pv_one<3>(o[3], vb, pa0, pa1, pa2, pa3);
}

__device__ __forceinline__ const void* uni_ptr(const void* p) { const unsigned long long u = (unsigned long long)p;
  const unsigned lo = (unsigned)__builtin_amdgcn_readfirstlane((int)(unsigned)u), hi = (unsigned)__builtin_amdgcn_readfirstlane((int)(unsigned)(u >> 32)); return (const void*)(((unsigned long long)hi << 32) | lo); }
constexpr int PB_Q = 6, PB_ZONE = PB_Q * 1024, PB_TPITCH = 128, PB_TILE = 32 * PB_TPITCH, PB_WAVE = PB_ZONE + PB_TILE, PB_NIT = 96 * 1024;
#define PB_GAS __attribute__((address_space(1)))
#define PB_LAS __attribute__((address_space(3)))
struct Pb { int total, gw, NGW; const float* pg; long du, dd; PB_GAS unsigned char* wgu; PB_GAS unsigned char* wd; unsigned zone; };
__device__ __forceinline__ const char* pb_src(const Pb& pb, int it) {
  const int m = it >> 10, tp = it & 1023, e = m / 3, w = m % 3;
  return (const char*)pb.pg + pb.du * (long)(w == 1) + pb.dd * (long)(w == 2) + ((size_t)e * 2048 * 2048 + (size_t)((tp >> 6) * 128) * 2048 + (tp & 63) * 32) * 4;
}
__device__ __forceinline__ PB_GAS unsigned char* pb_dst(const Pb& pb, int it) {
  const int m = it >> 10, tp = it & 1023, e = m / 3, w = m % 3, k0 = (tp >> 6) * 128, n0 = (tp & 63) * 32;
  if (w == 2) return pb.wd + ((size_t)e * 2048 + n0) * 2048 + k0;
  return pb.wgu + ((size_t)e * 4096 + (size_t)(n0 >> 7) * 256 + (n0 & 127) + (w == 1 ? 128 : 0)) * 2048 + k0;
}
__device__ __forceinline__ int pb_issue(const Pb pb, int& c_issue, const char*& isrc, int lane) {
  asm volatile("s_waitcnt lgkmcnt(0)" ::: "memory");
  const int n = (pb.total - c_issue) < PB_Q ? (pb.total - c_issue) : PB_Q;
  if (n <= 0) return 0;
  const unsigned loff = (unsigned)(((lane >> 3) * 2048 + 4 * (lane & 7)) * 4);
  const unsigned z0 = (unsigned)__builtin_amdgcn_readfirstlane((int)pb.zone);
  unsigned keep; asm volatile("s_mov_b32 %0, m0" : "=s"(keep) :: "memory");
#pragma unroll
  for (int q = 0; q < PB_Q; ++q) { if (q < n) {
    if (((c_issue + q) & 15) == 0) isrc = (const char*)uni_ptr(pb_src(pb, pb.gw + ((c_issue + q) >> 4) * pb.NGW));
    asm volatile("s_mov_b32 m0, %2\n\ts_nop 0\n\tglobal_load_lds_dwordx4 %0, %1 sc1 nt" :: "v"(loff), "s"(isrc), "s"(z0 + q * 1024) : "memory");
    isrc += 65536; } }
  asm volatile("s_mov_b32 m0, %0" :: "s"(keep) : "memory");
  c_issue += n; return n;
}
__device__ __forceinline__ void pb_process(const Pb pb, int& c_proc, const int c_issue, char* lds_, int lane) {
  const int nn = lane & 31, a = lane >> 5;
  PB_LAS char* lds = (PB_LAS char*)lds_;
  PB_LAS char* tile = lds + pb.zone + PB_ZONE;
  const unsigned twr = (unsigned)(uintptr_t)(tile + nn * PB_TPITCH + 4 * a), nx = (unsigned)((nn & 7) << 4);
  const PB_LAS float* zrd = (const PB_LAS float*)(lds + pb.zone) + (4 * a) * 32 + nn;
  const int n = c_issue - c_proc;
#pragma unroll
  for (int q = 0; q < PB_Q; ++q) { if (q < n) {
    const int i = (c_proc + q) & 15;
    const PB_LAS float* z = zrd + q * 256;
    typedef float f2 __attribute__((ext_vector_type(2)));
    const f2 t01 = (f2){z[0], z[32]} * 64.f, t23 = (f2){z[64], z[96]} * 64.f;
    int w0 = __builtin_amdgcn_cvt_pk_fp8_f32(t01.x, t01.y, (int)__float_as_uint(t01.x), false); w0 = __builtin_amdgcn_cvt_pk_fp8_f32(t23.x, t23.y, w0, true);
    *(PB_LAS int*)(uintptr_t)((((unsigned)i << 3) ^ nx) + twr) = w0;
    if (i == 15) {
      PB_GAS unsigned char* dst = pb_dst(pb, pb.gw + ((c_proc + q) >> 4) * pb.NGW);
      const int lr = lane >> 3, l7 = lane & 7;
      const PB_LAS char* trd = tile + lr * PB_TPITCH + ((l7 ^ lr) << 4);
      const unsigned voff = (unsigned)(lr * 2048 + 16 * l7);
#pragma unroll
      for (int j = 0; j < 4; ++j) { const u32x4 o = *(const PB_LAS u32x4*)(trd + j * 8 * PB_TPITCH);
        __builtin_nontemporal_store(o, (PB_GAS u32x4*)(dst + (voff + (unsigned)j * 16384u))); }
    } } }
  c_proc = c_issue;
}
__device__ __forceinline__ int pb_step(const Pb pb, int& c_issue, int& c_proc, const char*& isrc, char* lds, int lane) {
  asm volatile("s_waitcnt vmcnt(4)" ::: "memory");
  pb_process(pb, c_proc, c_issue, lds, lane); return pb_issue(pb, c_issue, isrc, lane); }
__device__ __forceinline__ void pb_drain(const Pb pb, int& c_issue, int& c_proc, const char*& isrc, char* lds, int lane) {
#pragma unroll 1
  for (;;) { if (c_proc < c_issue) { asm volatile("s_waitcnt vmcnt(0)" ::: "memory"); pb_process(pb, c_proc, c_issue, lds, lane); }
    if (c_issue >= pb.total) break; (void)pb_issue(pb, c_issue, isrc, lane); }
  asm volatile("s_waitcnt vmcnt(0) lgkmcnt(0)" ::: "memory");
}

template <int D0> __device__ __forceinline__ void pv32_one(f32x16& od, int vb, bf16x8 pa0, bf16x8 pa1) {
  const s16x4 l0 = tr_read<v_rd_off(D0, 0, 0)>(vb), h0 = tr_read<v_rd_off(D0, 0, 1)>(vb), l1 = tr_read<v_rd_off(D0, 1, 0)>(vb), h1 = tr_read<v_rd_off(D0, 1, 1)>(vb);
  asm volatile("s_waitcnt lgkmcnt(0)" ::: "memory"); SBAR();
#define PK(L, H) (bf16x8){L[0], L[1], L[2], L[3], H[0], H[1], H[2], H[3]}
  od = __builtin_amdgcn_mfma_f32_32x32x16_bf16(pa0, PK(l0, h0), od, 0, 0, 0);
  od = __builtin_amdgcn_mfma_f32_32x32x16_bf16(pa1, PK(l1, h1), od, 0, 0, 0);
#undef PK
}
__device__ __forceinline__ void dilated_wave(const bf16* __restrict__ Qb, const bf16* __restrict__ Kb, const bf16* __restrict__ Vb, long ld, int j0, int L, float kk,
                                             bf16* __restrict__ Ob, long ldo, float* __restrict__ Lp, long ldl, char* ktile, char* vtile, float* scr) {
  constexpr float C = SCALE * 1.4426950408889634f;
  int lane = threadIdx.x & 63; asm volatile("" : "+v"(lane));
  const int r32 = lane & 31, hi = lane >> 5;
  bf16x8 qr[8];
  { const bf16* Qw = Qb + (long)(j0 + r32) * ld + hi * 8;
#pragma unroll
    for (int d0 = 0; d0 < 8; ++d0) qr[d0] = *reinterpret_cast<const bf16x8*>(Qw + d0 * 16); }
  float m_reg = -1e30f, l_reg = 0.f; f32x16 o[4] = {};
  const int vb0 = (int)(uintptr_t)vtile + v_rd_base(lane);
  const int sr = lane >> 4, scol = (lane & 15) * 8;
  bf16x8 kn[8], vn[8];
#define DW_LOAD(t_) do { const int kb_ = j0 - 64 + 32 * (t_); const int kbc_ = (kb_ >= 0 && kb_ < L) ? kb_ : j0;   \
    const bf16* Kw_ = Kb + (long)(kbc_ + sr) * ld + scol; const bf16* Vw_ = Vb + (long)(kbc_ + sr) * ld + scol; \
    _Pragma("unroll") for (int i_ = 0; i_ < 8; ++i_) { kn[i_] = *reinterpret_cast<const bf16x8*>(Kw_ + (long)(4 * i_) * ld); vn[i_] = *reinterpret_cast<const bf16x8*>(Vw_ + (long)(4 * i_) * ld); } } while (0)
  DW_LOAD(0);
#pragma unroll 1
  for (int t = 0; t < 5; ++t) {
    const int kb = j0 - 64 + 32 * t; const bool valid = kb >= 0 && kb < L;
#pragma unroll
    for (int i = 0; i < 8; ++i) { const int row = 4 * i + sr;
      *reinterpret_cast<bf16x8*>(ktile + row * 256 + ((scol * 2) ^ ((row & 7) << 4))) = kn[i];
      *reinterpret_cast<bf16x8*>(vtile + v_st(row, scol)) = vn[i]; }
    if (t + 1 < 5) DW_LOAD(t + 1);
    f32x16 p0 = {};
#pragma unroll
    for (int d0 = 0; d0 < 8; ++d0) { const int cbb = (d0 * 16 + hi * 8) * 2;
      const bf16x8 kf = *reinterpret_cast<const bf16x8*>(ktile + r32 * 256 + (cbb ^ ((r32 & 7) << 4)));
      p0 = __builtin_amdgcn_mfma_f32_32x32x16_bf16(kf, qr[d0], p0, 0, 0, 0); }
    const float relb = (float)(j0 + r32 - kb - 4 * hi);
#pragma unroll
    for (int r = 0; r < 16; ++r) { const float a = __builtin_fabsf(relb - (float)((r & 3) + 8 * (r >> 2))); p0[r] = fmaf(a, -kk, p0[r]); if (!(valid && a <= 64.f)) p0[r] = -INFINITY; }
    float pmax = p0[0];
#pragma unroll
    for (int r = 1; r < 16; ++r) pmax = fmaxf(pmax, p0[r]);
    { auto rr = __builtin_amdgcn_permlane32_swap(__float_as_uint(pmax), __float_as_uint(pmax), false, false); pmax = fmaxf(__uint_as_float(rr[0]), __uint_as_float(rr[1])); }
    const float mn = fmaxf(m_reg, pmax), alpha = __builtin_amdgcn_exp2f((m_reg - mn) * C), mnC = -mn * C; m_reg = mn;
    float ps = 0.f;
#pragma unroll
    for (int r = 0; r < 16; ++r) { p0[r] = __builtin_amdgcn_exp2f(fmaf(p0[r], C, mnC)); ps += p0[r]; }
    { auto rr = __builtin_amdgcn_permlane32_swap(__float_as_uint(ps), __float_as_uint(ps), false, false); ps = __uint_as_float(rr[0]) + __uint_as_float(rr[1]); }
    l_reg = l_reg * alpha + ps;
    if (__any(alpha < 1.f)) { if (hi == 0) scr[r32] = alpha; asm volatile("s_waitcnt lgkmcnt(0)" ::: "memory");
#pragma unroll
      for (int d = 0; d < 4; ++d)
#pragma unroll
        for (int r = 0; r < 16; ++r) o[d][r] *= scr[crow(r, hi)]; }
    bf16x8 pa0, pa1;
#define PK4(P, BASE, OUT) do { unsigned a0 = cvtpk(P[BASE + 0], P[BASE + 1]), a1 = cvtpk(P[BASE + 2], P[BASE + 3]);   \
    unsigned b0 = cvtpk(P[BASE + 4], P[BASE + 5]), b1 = cvtpk(P[BASE + 6], P[BASE + 7]);                              \
    auto r0 = __builtin_amdgcn_permlane32_swap(a0, b0, false, false); auto r1 = __builtin_amdgcn_permlane32_swap(a1, b1, false, false); \
    u32x4 w = {r0[0], r1[0], r0[1], r1[1]}; OUT = *reinterpret_cast<bf16x8*>(&w); } while (0)
    PK4(p0, 0, pa0); PK4(p0, 8, pa1);
#undef PK4
    SBAR();
    pv32_one<0>(o[0], vb0, pa0, pa1); pv32_one<1>(o[1], vb0, pa0, pa1); pv32_one<2>(o[2], vb0, pa0, pa1); pv32_one<3>(o[3], vb0, pa0, pa1);
  }
#undef DW_LOAD
  if (hi == 0) scr[32 + r32] = l_reg; asm volatile("s_waitcnt lgkmcnt(0)" ::: "memory");
  bf16* Ow = Ob + (long)(j0 + 4 * hi) * ldo + r32;
#pragma unroll
  for (int r = 0; r < 16; ++r) { const float rl = __builtin_amdgcn_rcpf(scr[32 + crow(r, hi)]); bf16* Or = Ow + (long)((r & 3) + 8 * (r >> 2)) * ldo;
#pragma unroll
    for (int d0 = 0; d0 < 4; ++d0) { const float y = o[d0][r] * rl; Or[d0 * 32] = (bf16)cvtpk(y, y); } }
  if (hi == 0) Lp[(long)(j0 + r32) * ldl] = m_reg * SCALE + __logf(l_reg);
}

template <int MODE>
__device__ __forceinline__ void attn_body(const bf16* __restrict__ Qb, long ldq, const bf16* __restrict__ Kh, const bf16* __restrict__ Vh, long ldk,
                                          int t0, int NT, int ntmax, int qpos0, float kk, bf16* __restrict__ Ob, long ldo, float* __restrict__ Lb, long ldl, char* lds, const Pb pb, int& pbi, int& pbp, const char*& pbs) {
  int tid = threadIdx.x; asm volatile("" : "+v"(tid));
  const int wid = tid >> 6, lane = tid & 63, r32 = lane & 31, hi = lane >> 5;
  bf16* V_lds = (bf16*)lds; bf16* K_lds = (bf16*)(lds + 2 * SHM_V);
  float* ws = (float*)(lds + 2 * SHM_V + 2 * SHM_K) + wid * 64; float* li_l = ws; float* al_l = ws + 32;
  float m_reg = -1e30f, l_reg = 0; f32x16 o[4] = {}; bf16x8 qr[8];
  const bf16* Qw = Qb + (long)(wid * QBLK + r32) * ldq + hi * 8;
#pragma unroll
  for (int d0 = 0; d0 < 8; ++d0) qr[d0] = *reinterpret_cast<const bf16x8*>(Qw + d0 * 16);
  const int sr = tid >> 4, sc = (tid & 15) * 8, vst0 = v_st(sr, sc), vst1 = v_st(32 + sr, sc);
  const int vb0 = (int)(uintptr_t)V_lds + v_rd_base(lane);
  const unsigned sob0 = 2u * (unsigned)(sr * (int)ldk + sc), sob1 = sob0 + 64u * (unsigned)ldk;
  const float qposf = (float)(qpos0 + wid * QBLK + r32 - 4 * hi);
  const int qlo = qpos0 + __builtin_amdgcn_readfirstlane(wid) * QBLK;
  struct { bf16x8 vs0, vs1, ks0, ks1; } sr_[1];
#define TCL(jt) ({ int _t = t0 + (jt); _t = _t < 0 ? 0 : (_t >= ntmax ? ntmax - 1 : _t); _t * KVBLK; })
#define TVALID(jt) ((t0 + (jt)) >= 0 && (t0 + (jt)) < ntmax)
#define RELB(jt) (qposf - (float)((t0 + (jt)) * KVBLK))
#define SIDE(jt) (qlo > (t0 + (jt)) * KVBLK + (KVBLK - 1) ? 1 : (qlo + (QBLK - 1) < (t0 + (jt)) * KVBLK ? -1 : 0))
#define SLOAD(i, jt) do { const long _k0 = (long)TCL(jt) * ldk; const bf16* _vp = (const bf16*)uni_ptr(Vh + _k0); const bf16* _kp = (const bf16*)uni_ptr(Kh + _k0); \
    asm volatile("s_nop 4\n\tglobal_load_dwordx4 %0, %4, %6\n\tglobal_load_dwordx4 %1, %5, %6\n\tglobal_load_dwordx4 %2, %4, %7\n\tglobal_load_dwordx4 %3, %5, %7" \
        : "=&v"(sr_[i].vs0), "=&v"(sr_[i].vs1), "=&v"(sr_[i].ks0), "=&v"(sr_[i].ks1) : "v"(sob0), "v"(sob1), "s"(_vp), "s"(_kp) : "memory"); } while (0)
#define SWAITN(i, n) asm volatile("s_waitcnt vmcnt(%4)" : "+v"(sr_[i].vs0), "+v"(sr_[i].vs1), "+v"(sr_[i].ks0), "+v"(sr_[i].ks1) : "i"(n) : "memory")
#define BSYNC() asm volatile("s_waitcnt lgkmcnt(0)\n\ts_barrier" ::: "memory")
#define SWRITE(b, i) do { *(bf16x8*)((char*)V_lds + (b) * SHM_V + vst0) = sr_[i].vs0;          \
    *(bf16x8*)((char*)V_lds + (b) * SHM_V + vst1) = sr_[i].vs1; const int kc = sc * 2;               \
    *(bf16x8*)((char*)K_lds + (b) * SHM_K + KSWZ(sr, kc)) = sr_[i].ks0;                       \
    *(bf16x8*)((char*)K_lds + (b) * SHM_K + KSWZ(32 + sr, kc)) = sr_[i].ks1; } while (0)
#define SWAIT() SWAITN(0, 0)
#define SWAITQ(n) asm volatile("s_cmp_eq_u32 %4, %5\n\ts_cbranch_scc1 .Lpbw%=\n\ts_waitcnt vmcnt(0)\n.Lpbw%=:\n\ts_waitcnt vmcnt(%5)" \
    : "+v"(sr_[0].vs0), "+v"(sr_[0].vs1), "+v"(sr_[0].ks0), "+v"(sr_[0].ks1) : "s"(n), "i"(PB_Q) : "memory", "scc")
#define RESC(a) do { if (__any((a) < 1.f)) { if (hi == 0) al_l[r32] = (a); asm volatile("s_waitcnt lgkmcnt(0)" ::: "memory"); \
    _Pragma("unroll") for (int d = 0; d < 4; ++d) _Pragma("unroll") for (int r = 0; r < 16; ++r) o[d][r] *= al_l[crow(r, hi)]; } } while (0)
  f32x16 pA0, pA1, pB0, pB1; float mnA, mnB, alA, alB; bf16x8 pa0, pa1, pa2, pa3; int nq = 0;
  constexpr int SE = 0, SO = 0;
  if constexpr (MODE == 1) {
    const int w2 = __builtin_amdgcn_readfirstlane(wid) >> 1;
    SLOAD(SE, 0); SWAIT(); SWRITE(0, SE); __syncthreads();
#pragma unroll 1
    for (int jt = 0; jt < NT; ++jt) {
      const int b = jt & 1;
      if (jt + 1 < NT) { SLOAD(SE, jt + 1); SBAR(); nq = pb_step(pb, pbi, pbp, pbs, lds, lane); SBAR(); }
      if (jt >= w2 && jt <= w2 + 2) {
        qkt(pA0, pA1, (bf16*)((char*)K_lds + b * SHM_K), qr, r32, hi); partialSM<MODE>(pA0, pA1, m_reg, mnA, alA, RELB(jt), kk, TVALID(jt));
        RESC(alA);
        finishSM(pA0, pA1, alA, l_reg, pa0, pa1, pa2, pa3); SBAR();
        pv_d0(o, vb0 + b * (int)SHM_V, pa0, pa1, pa2, pa3);
      }
      if (jt + 1 < NT) { SWAITQ(nq); SWRITE(b ^ 1, SE); BSYNC(); }
    }
  } else {
  SLOAD(SE, 0); SWAIT(); SWRITE(0, SE); __syncthreads();
  qkt(pA0, pA1, K_lds, qr, r32, hi); partialSM<MODE>(pA0, pA1, m_reg, mnA, alA, RELB(0), kk, TVALID(0), SIDE(0));
  SLOAD(SO, 1);
  SWAIT(); SWRITE(1, SO); __syncthreads();
  for (int j = 1; j + 1 < NT; j += 2) {
    SBAR(); qkt(pB0, pB1, (bf16*)((char*)K_lds + SHM_K), qr, r32, hi);
    finishSM(pA0, pA1, alA, l_reg, pa0, pa1, pa2, pa3); SBAR();
    SLOAD(SO, j + 1); SBAR();
    nq = pb_step(pb, pbi, pbp, pbs, lds, lane); SBAR();
    pv_d0(o, vb0, pa0, pa1, pa2, pa3); partialSM<MODE>(pB0, pB1, m_reg, mnB, alB, RELB(j), kk, TVALID(j), SIDE(j));
    BSYNC(); SWAITQ(nq); SWRITE(0, SE);
    RESC(alB); BSYNC();
    SBAR(); qkt(pA0, pA1, K_lds, qr, r32, hi);
    finishSM(pB0, pB1, alB, l_reg, pa0, pa1, pa2, pa3); SBAR();
    SLOAD(SE, j + 2); SBAR();
    nq = pb_step(pb, pbi, pbp, pbs, lds, lane); SBAR();
    pv_d0(o, vb0 + (int)SHM_V, pa0, pa1, pa2, pa3); partialSM<MODE>(pA0, pA1, m_reg, mnA, alA, RELB(j + 1), kk, TVALID(j + 1), SIDE(j + 1));
    BSYNC(); SWAITQ(nq); SWRITE(1, SO);
    RESC(alA); BSYNC();
  }
  SBAR(); qkt(pB0, pB1, (bf16*)((char*)K_lds + SHM_K), qr, r32, hi);
  finishSM(pA0, pA1, alA, l_reg, pa0, pa1, pa2, pa3); SBAR();
  pv_d0(o, vb0, pa0, pa1, pa2, pa3); partialSM<MODE>(pB0, pB1, m_reg, mnB, alB, RELB(NT - 1), kk, TVALID(NT - 1), SIDE(NT - 1));
  __syncthreads(); RESC(alB);
  finishSM(pB0, pB1, alB, l_reg, pa0, pa1, pa2, pa3); SBAR();
  pv_d0(o, vb0 + (int)SHM_V, pa0, pa1, pa2, pa3);
  }
  if (hi == 0) li_l[r32] = l_reg; asm volatile("s_waitcnt lgkmcnt(0)" ::: "memory");
  float rli[16];
#pragma unroll
  for (int r = 0; r < 16; ++r) rli[r] = __builtin_amdgcn_rcpf(li_l[crow(r, hi)]);
  int tide = tid; asm volatile("" : "+v"(tide));
  const int hie = (tide >> 5) & 1, r32e = tide & 31, wide = tide >> 6;
  bf16* Ow = Ob + (long)(wide * QBLK + 4 * hie) * ldo + r32e;
#pragma unroll
  for (int r = 0; r < 16; ++r) { bf16* Or = Ow + (long)((r & 3) + 8 * (r >> 2)) * ldo;
#pragma unroll
    for (int d0 = 0; d0 < 4; ++d0) { const float y = o[d0][r] * rli[r]; Or[d0 * 32] = (bf16)cvtpk(y, y); } }
  if (Lb != nullptr && hie == 0) Lb[(long)(wide * QBLK + r32e) * ldl] = m_reg * SCALE + __logf(l_reg);
  __syncthreads();
#undef TCL
#undef TVALID
#undef RELB
#undef SIDE
#undef SLOAD
#undef SWRITE
#undef SWAIT
#undef SWAITQ
#undef SWAITN
#undef BSYNC
#undef RESC
}

__device__ __forceinline__ int v_st256(int k, int c) { const int kk = (k & ~0xC) | ((k & 4) << 1) | ((k & 8) >> 1); return ((kk >> 3) * 8 + (c >> 5)) * 512 + ((kk & 7) * 32 + (c & 31)) * 2; }
constexpr int v_rd_off256(int d0, int ks, int half) { return d0 * 512 + ks * 8192 + half * 4096; }
template <int D0> __device__ __forceinline__ void pv32k_one(f32x16& od, int vb, bf16x8 pa0, bf16x8 pa1) {
  const s16x4 l0 = tr_read<v_rd_off256(D0, 0, 0)>(vb), h0 = tr_read<v_rd_off256(D0, 0, 1)>(vb), l1 = tr_read<v_rd_off256(D0, 1, 0)>(vb), h1 = tr_read<v_rd_off256(D0, 1, 1)>(vb);
  asm volatile("s_waitcnt lgkmcnt(0)" ::: "memory"); SBAR();
#define PK(L, H) (bf16x8){L[0], L[1], L[2], L[3], H[0], H[1], H[2], H[3]}
  od = __builtin_amdgcn_mfma_f32_32x32x16_bf16(pa0, PK(l0, h0), od, 0, 0, 0);
  od = __builtin_amdgcn_mfma_f32_32x32x16_bf16(pa1, PK(l1, h1), od, 0, 0, 0);
#undef PK
}
template <int NY> __device__ __forceinline__ int pb_step_n(const Pb pb, int& c_issue, int& c_proc, const char*& isrc, char* lds, int lane) {
  asm volatile("s_waitcnt vmcnt(%0)" :: "i"(NY) : "memory");
  pb_process(pb, c_proc, c_issue, lds, lane); return pb_issue(pb, c_issue, isrc, lane); }
constexpr int DK_V = 0, DK_K = 32768, DK_SCR = 65536;
__device__ __forceinline__ void diffk_body(const unsigned char* __restrict__ Qb, const unsigned char* __restrict__ Kh, const bf16* __restrict__ Vh, long ld, int qpos0, float kk_,
                                           bf16* __restrict__ Ob, char* lds, const Pb pb, int& pbi, int& pbp, const char*& pbs) {
  constexpr float C = SCALE * 1.4426950408889634f / 64.f, THRQ = THR / SCALE * 64.f;
  constexpr int NT = 4096 / KVBLK;
  const float kk = kk_ * 64.f;
  int tid = threadIdx.x; asm volatile("" : "+v"(tid));
  const int wid = tid >> 6, lane = tid & 63, r32 = lane & 31, hi = lane >> 5;
  const int rg = __builtin_amdgcn_readfirstlane(wid);
  float* ws = (float*)(lds + DK_SCR) + wid * 64; float* li_l = ws; float* al_l = ws + 32;
  float m_reg = -1e30f, l_reg = 0; f32x16 o[8] = {};
  typedef int v8i_q __attribute__((ext_vector_type(8)));
  v8i_q qB0, qB1;
  { const unsigned char* Qw = Qb + (long)(rg * 32 + r32) * 2048 + hi * 32;
    const u32x4 a = *reinterpret_cast<const u32x4*>(Qw), b = *reinterpret_cast<const u32x4*>(Qw + 16), c = *reinterpret_cast<const u32x4*>(Qw + 64), d = *reinterpret_cast<const u32x4*>(Qw + 80);
    qB0 = (v8i_q){(int)a.x, (int)a.y, (int)a.z, (int)a.w, (int)b.x, (int)b.y, (int)b.z, (int)b.w}; qB1 = (v8i_q){(int)c.x, (int)c.y, (int)c.z, (int)c.w, (int)d.x, (int)d.y, (int)d.z, (int)d.w}; }
#define DK_SOFFS() int t2_ = tid; asm volatile("" : "+v"(t2_)); const int sr = t2_ >> 4, sc = (t2_ & 15) * 8, l2_ = t2_ & 63, w2_ = t2_ >> 6; \
  const unsigned sob0 = 2u * (unsigned)(sr * (int)ld + sc), sob1 = sob0 + 64u * (unsigned)ld;        \
  const unsigned kof0 = (unsigned)((8 * w2_ + (l2_ >> 3)) * 2048) + (unsigned)((((l2_ & 7) ^ (l2_ >> 3)) & 7) << 4);
  const unsigned kdst = (unsigned)__builtin_amdgcn_readfirstlane((int)(unsigned)(uintptr_t)(lds + DK_K + wid * 1024));
  const int vb = (int)(uintptr_t)(lds + DK_V) + v_rd_base(lane);
  const float qposf = (float)(qpos0 + rg * 32 + r32 - 4 * hi);
  const int qlo = qpos0 + rg * 32;
  bf16x8 vs0, vs1, vs2, vs3; int nq = 0;
#define DK_KDMA(jt, b) do { const unsigned char* _kp = (const unsigned char*)uni_ptr(Kh + (long)(jt) * KVBLK * 2048); unsigned _keep; \
    asm volatile("s_nop 4\n\ts_mov_b32 %0, m0\n\ts_mov_b32 m0, %3\n\ts_nop 0\n\tglobal_load_lds_dwordx4 %1, %2\n\ts_mov_b32 m0, %0" \
        : "=&s"(_keep) : "v"(kof0), "s"(_kp), "s"(kdst + (b) * 8192u) : "memory"); } while (0)
#define DK_VLOAD(jt) do { const bf16* _vp = (const bf16*)uni_ptr(Vh + (long)(jt) * KVBLK * ld); \
    asm volatile("s_nop 4\n\tglobal_load_dwordx4 %0, %4, %6\n\tglobal_load_dwordx4 %1, %5, %6\n\tglobal_load_dwordx4 %2, %4, %6 offset:256\n\tglobal_load_dwordx4 %3, %5, %6 offset:256" \
        : "=&v"(vs0), "=&v"(vs1), "=&v"(vs2), "=&v"(vs3) : "v"(sob0), "v"(sob1), "s"(_vp) : "memory"); } while (0)
#define DK_VWAIT0() asm volatile("s_waitcnt vmcnt(0)" : "+v"(vs0), "+v"(vs1), "+v"(vs2), "+v"(vs3) :: "memory")
#define DK_VWAITQ(n) asm volatile("s_cmp_eq_u32 %4, %5\n\ts_cbranch_scc1 .Ldkw%=\n\ts_waitcnt vmcnt(0)\n.Ldkw%=:\n\ts_waitcnt vmcnt(%5)" \
    : "+v"(vs0), "+v"(vs1), "+v"(vs2), "+v"(vs3) : "s"(n), "i"(PB_Q) : "memory", "scc")
#define DK_VWRITE() do { int t3_ = tid; asm volatile("" : "+v"(t3_)); char* _v = lds + DK_V + v_st256(t3_ >> 4, (t3_ & 15) * 8); *(bf16x8*)(_v) = vs0; *(bf16x8*)(_v + 16384) = vs1; *(bf16x8*)(_v + 2048) = vs2; *(bf16x8*)(_v + 18432) = vs3; } while (0)
#define DK_BSYNC() asm volatile("s_waitcnt lgkmcnt(0)\n\ts_barrier" ::: "memory")
  { DK_SOFFS(); DK_KDMA(0, 0); DK_VLOAD(0); } DK_VWAIT0(); DK_VWRITE(); __syncthreads();
#pragma unroll 1
  for (int j = 0; j < NT; ++j) {
    const char* Kb = lds + DK_K + (j & 1) * 8192;
    if (j + 1 < NT) { { DK_SOFFS(); DK_KDMA(j + 1, (j + 1) & 1); DK_VLOAD(j + 1); } SBAR(); nq = pb_step_n<5>(pb, pbi, pbp, pbs, lds, lane); SBAR(); }
    else { SBAR(); nq = pb_step_n<0>(pb, pbi, pbp, pbs, lds, lane); SBAR(); }
#pragma unroll
    for (int kh = 0; kh < 2; ++kh) {
    if (kh == 1) { SBAR(); nq = pb_step_n<0>(pb, pbi, pbp, pbs, lds, lane); SBAR(); }
    f32x16 p;
    { const char* Kr = Kb + (kh * 32 + r32) * 128; const int sw = r32 & 7;
      const u32x4 a0 = *reinterpret_cast<const u32x4*>(Kr + (((2 * hi) ^ sw) << 4)), a1 = *reinterpret_cast<const u32x4*>(Kr + (((2 * hi + 1) ^ sw) << 4));
      const u32x4 a2 = *reinterpret_cast<const u32x4*>(Kr + (((4 + 2 * hi) ^ sw) << 4)), a3 = *reinterpret_cast<const u32x4*>(Kr + (((5 + 2 * hi) ^ sw) << 4));
      const v8i_q A0 = {(int)a0.x, (int)a0.y, (int)a0.z, (int)a0.w, (int)a1.x, (int)a1.y, (int)a1.z, (int)a1.w}, A1 = {(int)a2.x, (int)a2.y, (int)a2.z, (int)a2.w, (int)a3.x, (int)a3.y, (int)a3.z, (int)a3.w};
      const int one_ = 0x7f7f7f7f;
      asm volatile("s_nop 1\n\tv_mfma_scale_f32_32x32x64_f8f6f4 %0, %1, %2, 0, %3, %3 op_sel_hi:[0,0,0]" : "=&v"(p) : "v"(A0), "v"(qB0), "v"(one_));
      asm volatile("s_nop 15\n\ts_nop 3\n\tv_mfma_scale_f32_32x32x64_f8f6f4 %0, %1, %2, %0, %3, %3 op_sel_hi:[0,0,0]\n\ts_nop 15\n\ts_nop 7" : "+v"(p) : "v"(A1), "v"(qB1), "v"(one_)); }
    const float relb = qposf - (float)(j * KVBLK + 32 * kh);
    const int klo = j * KVBLK + 32 * kh;
    const int side = qlo > klo + 31 ? 1 : (qlo + 31 < klo ? -1 : 0);
    float base = 0.f;
    if (side != 0) { const float skk = side > 0 ? kk : -kk; base = -skk * relb;
#pragma unroll
      for (int r = 0; r < 16; ++r) p[r] = fmaf(skk, (float)((r & 3) + 8 * (r >> 2)), p[r]);
    } else {
#pragma unroll
      for (int r = 0; r < 16; ++r) p[r] = fmaf(__builtin_fabsf(relb - (float)((r & 3) + 8 * (r >> 2))), -kk, p[r]);
    }
    float pmax = p[0];
#pragma unroll
    for (int r = 1; r < 16; ++r) pmax = fmaxf(pmax, p[r]);
    { auto rr = __builtin_amdgcn_permlane32_swap(__float_as_uint(pmax), __float_as_uint(pmax), false, false); pmax = fmaxf(__uint_as_float(rr[0]), __uint_as_float(rr[1])); }
    pmax += base;
    float mn, alpha;
    if (__builtin_expect(__all(pmax - m_reg <= THRQ), 1)) { mn = m_reg; alpha = 1.f; }
    else { mn = fmaxf(m_reg, pmax); alpha = __builtin_amdgcn_exp2f((m_reg - mn) * C); m_reg = mn; }
    const float mnC = (base - mn) * C;
    float ps = 0.f;
#pragma unroll
    for (int r = 0; r < 16; ++r) { p[r] = __builtin_amdgcn_exp2f(fmaf(p[r], C, mnC)); ps += p[r]; }
    { auto rr = __builtin_amdgcn_permlane32_swap(__float_as_uint(ps), __float_as_uint(ps), false, false); ps = __uint_as_float(rr[0]) + __uint_as_float(rr[1]); }
    l_reg = l_reg * alpha + ps;
    if (__any(alpha < 1.f)) { if (hi == 0) al_l[r32] = alpha; asm volatile("s_waitcnt lgkmcnt(0)" ::: "memory");
#pragma unroll
      for (int d = 0; d < 8; ++d)
#pragma unroll
        for (int r = 0; r < 16; ++r) o[d][r] *= al_l[crow(r, hi)]; }
    bf16x8 pa0, pa1;
#define PK4(P, BASE, OUT) do { unsigned a0 = cvtpk(P[BASE + 0], P[BASE + 1]), a1 = cvtpk(P[BASE + 2], P[BASE + 3]);   \
    unsigned b0 = cvtpk(P[BASE + 4], P[BASE + 5]), b1 = cvtpk(P[BASE + 6], P[BASE + 7]);                              \
    auto r0 = __builtin_amdgcn_permlane32_swap(a0, b0, false, false); auto r1 = __builtin_amdgcn_permlane32_swap(a1, b1, false, false); \
    u32x4 w = {r0[0], r1[0], r0[1], r1[1]}; OUT = *reinterpret_cast<bf16x8*>(&w); } while (0)
    PK4(p, 0, pa0); PK4(p, 8, pa1);
#undef PK4
    SBAR();
    pv32k_one<0>(o[0], vb + kh * 16384, pa0, pa1); pv32k_one<1>(o[1], vb + kh * 16384, pa0, pa1); pv32k_one<2>(o[2], vb + kh * 16384, pa0, pa1); pv32k_one<3>(o[3], vb + kh * 16384, pa0, pa1);
    pv32k_one<4>(o[4], vb + kh * 16384, pa0, pa1); pv32k_one<5>(o[5], vb + kh * 16384, pa0, pa1); pv32k_one<6>(o[6], vb + kh * 16384, pa0, pa1); pv32k_one<7>(o[7], vb + kh * 16384, pa0, pa1);
    }
    if (j + 1 < NT) { DK_BSYNC(); DK_VWAITQ(nq); DK_VWRITE(); DK_BSYNC(); }
  }
  if (hi == 0) li_l[r32] = l_reg; asm volatile("s_waitcnt lgkmcnt(0)" ::: "memory");
  int tide = tid; asm volatile("" : "+v"(tide));
  const int hie = (tide >> 5) & 1, r32e = tide & 31;
  bf16* Ow = Ob + (long)(rg * 32 + 4 * hie) * 1024 + r32e;
#pragma unroll
  for (int r = 0; r < 16; ++r) { const float rl = __builtin_amdgcn_rcpf(li_l[crow(r, hie)]); bf16* Or = Ow + (long)((r & 3) + 8 * (r >> 2)) * 1024;
#pragma unroll
    for (int d0 = 0; d0 < 8; ++d0) { const float y = o[d0][r] * rl; Or[d0 * 32] = (bf16)cvtpk(y, y); } }
  __syncthreads();
#undef DK_KDMA
#undef DK_SOFFS
#undef DK_VLOAD
#undef DK_VWAIT0
#undef DK_VWAITQ
#undef DK_VWRITE
#undef DK_BSYNC
}
#undef KSWZ
#undef SBAR
}
constexpr int NWAVES = 8;
#ifndef MK_SPLIT
#define MK_SPLIT 0
#endif
constexpr int N_PHASES = 12;

constexpr int DM = 2048, BATCH = 2, SEQ = 4096, T = BATCH * SEQ;
constexpr int NQKV = 10240;
constexpr int C_QA = 0, C_KA = 1024, C_VA = 2048, C_QB = 3072, C_KB = 4096, C_VB = 5120, C_GA = 6144, C_GB = 8192;
constexpr unsigned long long LBMAP = 0x0ull;
constexpr unsigned long long LFMAP = 0x9876543210ull;
constexpr int NLB = 0, NLF = 10;
constexpr bool P6_F8 = true;
constexpr int NE = 32, TOPK = 4, TK = T * TOPK, TKPAD = TK + NE * 256;
constexpr float EPS = 1e-5f;
constexpr float LAMBDA_INIT = 0.2f;

constexpr size_t MiB = 1u << 20;
constexpr size_t WS_CTL = 0, CTL_ZERO_BYTES = 1 * MiB;
constexpr size_t WS_MOD = 1 * MiB;
constexpr size_t WS_RC = 1 * MiB + 512 * 1024;
constexpr size_t WS_TOPI = 2 * MiB;
constexpr size_t WS_TOPP = 2 * MiB + 256 * 1024;
constexpr size_t WS_POS = 2 * MiB + 512 * 1024;
constexpr size_t WS_TOKOF = 3 * MiB;
constexpr size_t WS_WINT = 4 * MiB;
constexpr size_t WS_WING = 4 * MiB;
constexpr size_t WS_U8Q = 770 * MiB;
constexpr size_t WS_WAT = 44 * MiB;
constexpr size_t WS_WBT = 48 * MiB;
constexpr size_t WS_WOT = 52 * MiB;
constexpr size_t WS_U = 64 * MiB;
constexpr size_t WS_QKV = 96 * MiB;
constexpr size_t WS_OA = 256 * MiB;
constexpr size_t WS_OB = 352 * MiB;
constexpr size_t WS_LSE = 416 * MiB;
constexpr size_t WS_YA = 418 * MiB;
constexpr size_t WS_YB = 434 * MiB;
constexpr size_t WS_M1 = 450 * MiB;
constexpr size_t WS_MG = 514 * MiB;
constexpr size_t WS_H1 = 546 * MiB;
constexpr size_t WS_XS = 610 * MiB;
constexpr size_t WS_QK8 = 610 * MiB;
constexpr size_t WS_YACT = 770 * MiB;
constexpr size_t WS_YSLOT = 930 * MiB;
constexpr size_t WS_WGU = 1090 * MiB;
constexpr size_t WS_WD = 1602 * MiB;
constexpr size_t WS_END = 1858 * MiB;
static_assert((long)WS_QK8 - (long)WS_QKV == pg8::EpiQKV::Q8_FROM_O, "EpiQKV::Q8_FROM_O");
constexpr int CW_TMO = 0, CW_CODE = 1;
constexpr int CW_BAR = 4096;
constexpr int CW_CNT = 8192;

constexpr int RING_OFF = 0, RING_BYTES = 131072;
constexpr int PB_OFF = 69632;
constexpr int LDSCTL_OFF = 159744, MISC_OFF = LDSCTL_OFF + 320;
constexpr int TST_OFF = LDSCTL_OFF + 1024;
constexpr int LDS_BYTES = 163840;

#define GAS __attribute__((address_space(1)))
#define LAS __attribute__((address_space(3)))
typedef unsigned short bf16;
typedef unsigned v4u __attribute__((ext_vector_type(4)));
typedef unsigned v2u __attribute__((ext_vector_type(2)));
typedef float f32x4 __attribute__((ext_vector_type(4)));
typedef float v2f __attribute__((ext_vector_type(2)));
typedef GAS unsigned gu32;
#define RLX_AGENT __ATOMIC_RELAXED, __HIP_MEMORY_SCOPE_AGENT
#define LDS_WAIT() asm volatile("s_waitcnt lgkmcnt(0)" ::: "memory")
#define VM_WAIT() asm volatile("s_waitcnt vmcnt(0)" ::: "memory")
__device__ __forceinline__ unsigned f2bf(float f) { unsigned u = __builtin_bit_cast(unsigned, f); return (u + 0x7fffu + ((u >> 16) & 1u)) >> 16; }
__device__ __forceinline__ unsigned pk2(float lo, float hi) { return f2bf(lo) | (f2bf(hi) << 16); }
__device__ __forceinline__ float bf2f(unsigned short h) { return __uint_as_float(((unsigned)h) << 16); }
__device__ __forceinline__ float wave_sum(float v) {
#pragma unroll
    for (int o = 1; o < 64; o <<= 1) v += __shfl_xor(v, o);
    return v;
}
__device__ __forceinline__ float wave_max(float v) {
#pragma unroll
    for (int o = 1; o < 64; o <<= 1) v = fmaxf(v, __shfl_xor(v, o));
    return v;
}
__device__ __forceinline__ float siluf(float x) { return x / (1.0f + __expf(-x)); }
#define XB_TMO      128
#define XB_XCNT(j)  (256  + 64 * (j))
#define XB_XSUB(j)  (1280 + 64 * (j))
#define XB_XGEN(j)  (2304 + 64 * (j))
#define XB_TOP      3328
#define XB_TOPGEN   3392
#define XCD_BAR_WORDS 3456
#define XB_SPIN_CAP (1u << 18)

__device__ __forceinline__ unsigned xb_ld(unsigned* p)              { return __hip_atomic_load(p, __ATOMIC_RELAXED, __HIP_MEMORY_SCOPE_AGENT); }
__device__ __forceinline__ unsigned xb_add(unsigned* p, unsigned v) { return __hip_atomic_fetch_add(p, v, __ATOMIC_RELAXED, __HIP_MEMORY_SCOPE_AGENT); }
__device__ __forceinline__ unsigned xb_xcc_id() { return (unsigned)__builtin_amdgcn_s_getreg((3 << 11) | 20) & 0xFu; }
#define XB_SPIN(cond, bar) do { unsigned _sp = 0; while (cond) { __builtin_amdgcn_s_sleep(1); \
    if ((++_sp & 255u) == 0u) { if (xb_ld(&(bar)[XB_TMO])) break; if (_sp > XB_SPIN_CAP) { atomicAdd(&(bar)[XB_TMO], 1u); break; } } } } while (0)

struct XcdBarrier {
    unsigned* bar; unsigned x;
    volatile LAS unsigned* st;
};

__device__ __forceinline__ XcdBarrier xcd_barrier_post(unsigned* bar, volatile LAS unsigned* st) {
    XcdBarrier b; b.bar = bar; b.x = xb_xcc_id(); b.st = st;
    if (threadIdx.x == 0) (void)xb_add(&bar[XB_XCNT(b.x)], 1u);
    return b;
}
__device__ __forceinline__ void xcd_barrier_complete(unsigned* bar, unsigned x, unsigned& nloc, unsigned& nx) {
    const unsigned G = gridDim.x * gridDim.y * gridDim.z;
    unsigned sum, cnt, mine, sp = 0u;
    for (;;) {
        sum = 0u; cnt = 0u; mine = 0u;
#pragma unroll
        for (unsigned j = 0; j < 16; ++j) { const unsigned c = xb_ld(&bar[XB_XCNT(j)]); sum += c; cnt += (c > 0u) ? 1u : 0u; mine = (j == x) ? c : mine; }
        if (sum == G) break;
        __builtin_amdgcn_s_sleep(1);
        if ((++sp & 255u) == 0u) { if (xb_ld(&bar[XB_TMO])) break; if (sp > XB_SPIN_CAP) { atomicAdd(&bar[XB_TMO], 1u); break; } }
    }
    nloc = mine > 0u ? mine : 1u; nx = cnt > 0u ? cnt : 1u;
}

__device__ __forceinline__ void xcd_barrier(const XcdBarrier& b) {
    asm volatile("s_waitcnt vmcnt(0)" ::: "memory");
    __syncthreads();
    if (threadIdx.x == 0) {
        unsigned* bar = b.bar;
        __builtin_amdgcn_s_waitcnt(0);
        unsigned nloc = b.st[0], nx = b.st[1];
        if (nloc == 0u) { xcd_barrier_complete(bar, b.x, nloc, nx); b.st[0] = nloc; b.st[1] = nx; }
        const unsigned old = xb_add(&bar[XB_XSUB(b.x)], 1u);
        const unsigned gen = old / nloc;
        if (old + 1u == (gen + 1u) * nloc) {
            __builtin_amdgcn_fence(__ATOMIC_RELEASE, "agent");
            asm volatile("s_waitcnt vmcnt(0)" ::: "memory");
            const unsigned og = xb_add(&bar[XB_TOP], 1u);
            const unsigned tg = og / nx;
            if (og + 1u == (tg + 1u) * nx) xb_add(&bar[XB_TOPGEN], 1u);
            else XB_SPIN(xb_ld(&bar[XB_TOPGEN]) == tg, bar);
            __builtin_amdgcn_fence(__ATOMIC_ACQUIRE, "agent");
            xb_add(&bar[XB_XGEN(b.x)], 1u);
            asm volatile("s_waitcnt vmcnt(0)" ::: "memory");
        } else {
            XB_SPIN(xb_ld(&bar[XB_XGEN(b.x)]) == gen, bar);
            __builtin_amdgcn_fence(__ATOMIC_ACQUIRE, "agent");
            asm volatile("s_waitcnt vmcnt(0)" ::: "memory");
        }
    }
    __syncthreads();
}
struct Args { const float* in[24]; float* out; unsigned char* ws; int ph_lo, ph_hi; };
enum { I_X = 0, I_C, I_WADA, I_BADA, I_N1G, I_WIN, I_LQ1, I_LK1, I_LQ2, I_LK2, I_SUBG, I_WOA, I_WOB, I_WO, I_N2G, I_WR, I_BR, I_WG, I_BG, I_WU, I_BU, I_WDN, I_BDN, I_FG };
struct Frame {
    LAS unsigned char* lds; char* ldsg;
    volatile LAS unsigned* MISC;
    gu32* ctl;
    int tid, lane, wave, vcu, G;
    unsigned char* ws;
};
#define WSP(T_, off) ((T_*)(F.ws + (off)))

constexpr float WSCALE = 64.0f;
__device__ __forceinline__ unsigned cvtpk_bf(float lo, float hi) { unsigned r; asm volatile("v_cvt_pk_bf16_f32 %0, %1, %2" : "=v"(r) : "v"(lo), "v"(hi)); return r; }
__device__ __forceinline__ void cvt_load(f32x4 (&v)[8], const float* __restrict__ W, int N, int k0, int n0, int lane) {
    const int lr = lane >> 3, lc = 4 * (lane & 7);
#pragma unroll
    for (int i = 0; i < 8; ++i) v[i] = __builtin_nontemporal_load((const f32x4*)(W + (size_t)(k0 + lr + 8 * i) * N + n0 + lc));
}
template <bool F8>
__device__ __forceinline__ void cvt_store(const f32x4 (&v)[8], int K, void* __restrict__ WT, int k0, long dst_row0, LAS float* scr, int lane) {
    const int lr = lane >> 3, lc = 4 * (lane & 7);
#pragma unroll
    for (int i = 0; i < 8; ++i) { LAS float* s = scr + (lr + 8 * i) * 33 + lc; s[0] = v[i].x; s[1] = v[i].y; s[2] = v[i].z; s[3] = v[i].w; }
    LDS_WAIT(); asm volatile("" ::: "memory");
    const int c = lane & 7;
#pragma unroll
    for (int j = 0; j < 4; ++j) { const int n = (lane >> 3) + 8 * j; const LAS float* s = scr + (8 * c) * 33 + n;
        if constexpr (F8) {
            int w0 = __builtin_amdgcn_cvt_pk_fp8_f32(s[0 * 33] * WSCALE, s[1 * 33] * WSCALE, 0, false); w0 = __builtin_amdgcn_cvt_pk_fp8_f32(s[2 * 33] * WSCALE, s[3 * 33] * WSCALE, w0, true);
            int w1 = __builtin_amdgcn_cvt_pk_fp8_f32(s[4 * 33] * WSCALE, s[5 * 33] * WSCALE, 0, false); w1 = __builtin_amdgcn_cvt_pk_fp8_f32(s[6 * 33] * WSCALE, s[7 * 33] * WSCALE, w1, true);
            *(v2u*)((unsigned char*)WT + (size_t)(dst_row0 + n) * K + k0 + 8 * c) = (v2u){(unsigned)w0, (unsigned)w1};
        } else {
            v4u o; o.x = cvtpk_bf(s[0 * 33], s[1 * 33]); o.y = cvtpk_bf(s[2 * 33], s[3 * 33]); o.z = cvtpk_bf(s[4 * 33], s[5 * 33]); o.w = cvtpk_bf(s[6 * 33], s[7 * 33]);
            *(v4u*)((bf16*)WT + (size_t)(dst_row0 + n) * K + k0 + 8 * c) = o; } }
    LDS_WAIT(); asm volatile("" ::: "memory");
}
__device__ __forceinline__ void cvt8_load(f32x4 (&v)[16], const float* __restrict__ W, int k0, int n0, int lane, int N = DM) {
    const float* p = W + (size_t)(k0 + (lane >> 3)) * N + n0 + 4 * (lane & 7);
#pragma unroll
    for (int i = 0; i < 16; ++i) v[i] = __builtin_nontemporal_load((const f32x4*)(p + (size_t)(8 * i) * N));
}
__device__ __forceinline__ void cvt8_store(const f32x4 (&v)[16], unsigned char* __restrict__ WT, int k0, long dst_row0, LAS float* scr, int lane) {
    const int lr = lane >> 3, lc = 4 * (lane & 7);
#pragma unroll
    for (int i = 0; i < 16; ++i) { LAS float* s = scr + (lr + 8 * i) * 33 + ((lc + 4 * (i >> 1)) & 31);
        s[0] = v[i].x; s[1] = v[i].y; s[2] = v[i].z; s[3] = v[i].w; }
    LDS_WAIT(); asm volatile("" ::: "memory");
    const int c = lane & 7;
#pragma unroll
    for (int j = 0; j < 4; ++j) { const int n = (lane >> 3) + 8 * j; const LAS float* s = scr + (16 * c) * 33 + ((n + 4 * c) & 31);
        v4u o;
#pragma unroll
        for (int h = 0; h < 4; ++h) { int w = __builtin_amdgcn_cvt_pk_fp8_f32(s[(4 * h + 0) * 33] * WSCALE, s[(4 * h + 1) * 33] * WSCALE, 0, false);
            w = __builtin_amdgcn_cvt_pk_fp8_f32(s[(4 * h + 2) * 33] * WSCALE, s[(4 * h + 3) * 33] * WSCALE, w, true); o[h] = (unsigned)w; }
        *(v4u*)(WT + (size_t)(dst_row0 + n) * DM + k0 + 16 * c) = o; }
    LDS_WAIT(); asm volatile("" ::: "memory");
}
__device__ __forceinline__ void p0_mod(Frame& F, const Args& A) {
    LAS float* red = (LAS float*)F.lds;
    LAS float* sc = red + 2048;
    if (F.vcu < 192) {
        for (int k = F.tid; k < DM; k += 512) { sc[2 * k] = siluf(A.in[I_C][k]); sc[2 * k + 1] = siluf(A.in[I_C][2048 + k]); }
    }
    __syncthreads();
    if (F.vcu < 192) {
        const int col = F.vcu * 64 + F.lane, k0 = F.wave * 256;
        const float* wp = A.in[I_WADA] + (size_t)k0 * 12288 + col; const LAS float* sp = sc + 2 * k0;
        float a0 = 0.f, a1 = 0.f;
#pragma unroll 16
        for (int k = 0; k < 256; ++k) { const float wv = __builtin_nontemporal_load(wp + (size_t)k * 12288); const v2f s2 = *(const LAS v2f*)(sp + 2 * k); a0 = fmaf(s2.x, wv, a0); a1 = fmaf(s2.y, wv, a1); }
        red[(F.wave * 2 + 0) * 64 + F.lane] = a0; red[(F.wave * 2 + 1) * 64 + F.lane] = a1;
    }
    __syncthreads();
    if (F.vcu < 192 && F.tid < 128) { const int b = F.tid >> 6, l = F.tid & 63; float s = 0.f;
#pragma unroll
        for (int w = 0; w < 8; ++w) s += red[(w * 2 + b) * 64 + l];
        const int col = F.vcu * 64 + l; WSP(float, WS_MOD)[b * 12288 + col] = s + A.in[I_BADA][col]; }
    __syncthreads();
}
__device__ __forceinline__ void p0_convert(Frame& F, const Args& A) {
    LAS float* scr = (LAS float*)(F.lds + F.wave * 16384);
    const int gw = F.vcu * NWAVES + F.wave, NGW = F.G * NWAVES;
    constexpr int I_IN = 32 * 320, I_A = 16 * 64, I_B = 16 * 64, I_O = P6_F8 ? 0 : 32 * 64, NSMALL = I_IN + I_A + I_B + I_O;
    f32x4 v0[8];
#pragma unroll 1
    for (int it = gw; it < NSMALL; it += NGW) { int r = it; const float* W; bf16* WT; int N, K, drow = 0;
        if (r < I_IN) { W = A.in[I_WIN]; WT = WSP(bf16, WS_WINT); N = NQKV; K = DM; const int g_ = (r % 320) >> 5; int pos_ = -1;
#pragma unroll
            for (int i_ = 0; i_ < NLB; ++i_) if ((int)((LBMAP >> (4 * i_)) & 15ull) == g_) pos_ = i_;
            if (pos_ < 0) continue; drow = pos_ * 1024 - g_ * 1024; }
        else if ((r -= I_IN) < I_A) { W = A.in[I_WOA]; WT = WSP(bf16, WS_WAT); N = DM; K = 1024; }
        else if ((r -= I_A) < I_B) { W = A.in[I_WOB]; WT = WSP(bf16, WS_WBT); N = DM; K = 1024; }
        else { r -= I_B; W = A.in[I_WO]; WT = WSP(bf16, WS_WOT); N = DM; K = DM; }
        const int nnb = N / 32, k0 = (r / nnb) * 64, n0 = (r % nnb) * 32;
        cvt_load(v0, W, N, k0, n0, F.lane); cvt_store<false>(v0, K, WT, k0, n0 + drow, scr, F.lane); }
    { __syncthreads(); LAS float* scr8 = (LAS float*)(F.lds + F.wave * 16896); f32x4 va[16];
      constexpr int NF8 = 16 * NLF * 32;
#pragma unroll 1
      for (int it = gw; it < NF8 + (P6_F8 ? 16 * 64 : 0); it += NGW) {
          if (it < NF8) { const int k0 = (it / (NLF * 32)) * 128, blk = it % (NLF * 32), pf = blk >> 5, g_ = (int)((LFMAP >> (4 * pf)) & 15ull);
              cvt8_load(va, A.in[I_WIN], k0, g_ * 1024 + (blk & 31) * 32, F.lane, NQKV); cvt8_store(va, WSP(unsigned char, WS_WING), k0, pf * 1024 + (blk & 31) * 32, scr8, F.lane); }
          else { const int j = it - NF8, k0 = (j >> 6) * 128, n0 = (j & 63) * 32;
              cvt8_load(va, A.in[I_WO], k0, n0, F.lane, DM); cvt8_store(va, WSP(unsigned char, WS_WOT), k0, n0, scr8, F.lane); } } }
}
__device__ __forceinline__ void p1_modulate(Frame& F, const Args& A) {
    const int gw = F.vcu * NWAVES + F.wave, NGW = F.G * NWAVES; const float* MOD = WSP(float, WS_MOD);
    if (F.vcu < 64 && F.wave == 0) { const int b = F.vcu >> 5, kq = F.vcu & 31, e = F.lane & 31, ks = F.lane >> 5; float s = 0.f;
#pragma unroll 8
        for (int i = 0; i < 32; ++i) { const int k = 64 * kq + 2 * i + ks; s = fmaf(MOD[b * 12288 + 3 * DM + k], A.in[I_WR][k * 32 + e], s); }
        s += __shfl_xor(s, 32); if (F.lane < 32) WSP(float, WS_RC)[(b * 32 + kq) * 32 + e] = s; }
    for (int m = gw; m < T; m += NGW) {
        const int b = m / SEQ; const float* xr = A.in[I_X] + (size_t)m * DM + 4 * F.lane; f32x4 v[8]; float s = 0.f;
#pragma unroll
        for (int j = 0; j < 8; ++j) { v[j] = *(const f32x4*)(xr + 256 * j); s += (v[j].x * v[j].x + v[j].y * v[j].y) + (v[j].z * v[j].z + v[j].w * v[j].w); }
        const float rstd = 1.0f / sqrtf(wave_sum(s) * (1.0f / DM) + EPS);
        bf16* ur = WSP(bf16, WS_U) + (size_t)m * DM + 4 * F.lane;
#pragma unroll
        for (int j = 0; j < 8; ++j) { const int k = 4 * F.lane + 256 * j;
            const f32x4 g = *(const f32x4*)(A.in[I_N1G] + k), sc = *(const f32x4*)(MOD + b * 12288 + 1 * DM + k), sh = *(const f32x4*)(MOD + b * 12288 + k);
            const f32x4 u = v[j] * rstd * g * (sc + 1.0f) + sh; if constexpr (NLB > 0) { v2u o; o.x = pk2(u.x, u.y); o.y = pk2(u.z, u.w); *(v2u*)(ur + 256 * j) = o; }
            int w8 = __builtin_amdgcn_cvt_pk_fp8_f32(u.x, u.y, 0, false); w8 = __builtin_amdgcn_cvt_pk_fp8_f32(u.z, u.w, w8, true); *(int*)(WSP(unsigned char, WS_U8Q) + (size_t)m * DM + 4 * F.lane + 256 * j) = w8; }
    }
}
__device__ __forceinline__ void p3_attention(Frame& F, const Args& A) {
    const bf16* QKV = WSP(bf16, WS_QKV);
    att::Pb pb; int pbi = 0, pbp = 0; const char* pbs = nullptr; pb.gw = F.vcu * NWAVES + F.wave; pb.NGW = F.G * NWAVES;
    pb.total = pb.gw < att::PB_NIT ? ((att::PB_NIT - pb.gw + pb.NGW - 1) / pb.NGW) * 16 : 0;
    pb.pg = A.in[I_WG]; pb.du = (const char*)A.in[I_WU] - (const char*)A.in[I_WG]; pb.dd = (const char*)A.in[I_WDN] - (const char*)A.in[I_WG];
    pb.wgu = (GAS unsigned char*)WSP(unsigned char, WS_WGU); pb.wd = (GAS unsigned char*)WSP(unsigned char, WS_WD); pb.zone = (unsigned)(PB_OFF + F.wave * att::PB_WAVE);
#pragma unroll 1
    for (int i = F.vcu; i < 256; i += F.G) {
        const int c2 = i >> 4, b = c2 >> 3, h = (c2 >> 1) & 3, c = c2 & 1, qb = i & 15;
        const size_t rowb = (size_t)b * SEQ;
        const unsigned char* Qb = WSP(unsigned char, WS_QK8) + (rowb + qb * 256) * 2048 + h * 256 + c * 128;
        const unsigned char* Kh = WSP(unsigned char, WS_QK8) + rowb * 2048 + 1024 + h * 256 + c * 128;
        const bf16* Vh = QKV + rowb * NQKV + C_VB + h * 256;
        bf16* Ob = WSP(bf16, WS_OB) + ((size_t)c * T + rowb + qb * 256) * 1024 + h * 256;
        const float slope = exp2f(-(float)(8 + h + 1) * (8.0f / 12.0f));
        att::diffk_body(Qb, Kh, Vh, NQKV, qb * 256, slope / att::SCALE, Ob, F.ldsg, pb, pbi, pbp, pbs);
    }
    att::pb_drain(pb, pbi, pbp, pbs, F.ldsg, F.lane);
    __syncthreads();
    {
        const int gw = F.vcu * NWAVES + F.wave, NGW = F.G * NWAVES;
        char* ktile = F.ldsg + F.wave * 16384; char* vtile = ktile + 8192; float* scr = (float*)(F.ldsg + 131072) + F.wave * 64;
#if defined(REP_DIL)
#pragma unroll 1
        for (int rep_ = 0; rep_ < 2; ++rep_)
#endif
#pragma unroll 1
        for (int tk = gw; tk < 3 * 2048; tk += NGW) {
            const int p = tk >> 11, r = tk & 2047, b = r >> 10, h = (r >> 7) & 7, blk = r & 127;
            const int dil = p == 0 ? 1 : (p == 1 ? 4 : 16), L = SEQ / dil, bpr = L / 32, res = blk / bpr, j0 = (blk % bpr) * 32;
            const size_t rowb = (size_t)b * SEQ + res;
            const bf16* Qb = QKV + rowb * NQKV + C_QA + h * 128; const bf16* Kb = QKV + rowb * NQKV + C_KA + h * 128; const bf16* Vb = QKV + rowb * NQKV + C_VA + h * 128;
            bf16* Ob = WSP(bf16, WS_OA) + ((size_t)p * T + rowb) * 1024 + h * 128; float* Lb = WSP(float, WS_LSE) + ((size_t)p * T + rowb) * 8 + h;
            const float slope = exp2f(-(float)(h + 1) * (8.0f / 12.0f)) * (float)dil;
            att::dilated_wave(Qb, Kb, Vb, (long)dil * NQKV, j0, L, slope / att::SCALE, Ob, (long)dil * 1024, Lb, (long)dil * 8, ktile, vtile, scr);
        }
    }
    __syncthreads();
}
__device__ __forceinline__ void p4_finalize(Frame& F, const Args& A) {
    const int gw = F.vcu * NWAVES + F.wave, NGW = F.G * NWAVES;
    float s1 = A.in[I_LQ1][F.lane] * A.in[I_LK1][F.lane] + A.in[I_LQ1][F.lane + 64] * A.in[I_LK1][F.lane + 64];
    float s2 = A.in[I_LQ2][F.lane] * A.in[I_LK2][F.lane] + A.in[I_LQ2][F.lane + 64] * A.in[I_LK2][F.lane + 64];
    s1 = wave_sum(s1); s2 = wave_sum(s2);
    const float lam = expf(s1) - expf(s2) + LAMBDA_INIT;
    const bf16* OA = WSP(bf16, WS_OA); const bf16* OB = WSP(bf16, WS_OB); const float* LS = WSP(float, WS_LSE);
    for (int m = gw; m < T; m += NGW) {
        { const int h = F.lane >> 3; const float l0 = LS[((size_t)0 * T + m) * 8 + h], l1 = LS[((size_t)1 * T + m) * 8 + h], l2 = LS[((size_t)2 * T + m) * 8 + h];
          const float mx = fmaxf(l0, fmaxf(l1, l2)); float w0 = __expf(l0 - mx), w1 = __expf(l1 - mx), w2 = __expf(l2 - mx); const float inv = 1.0f / (w0 + w1 + w2); w0 *= inv; w1 *= inv; w2 *= inv;
          const size_t o = (size_t)m * 1024 + 16 * F.lane; unsigned pk[8];
#pragma unroll
          for (int q = 0; q < 2; ++q) { const v4u a0 = *(const v4u*)(OA + o + 8 * q), a1 = *(const v4u*)(OA + (size_t)T * 1024 + o + 8 * q), a2 = *(const v4u*)(OA + (size_t)2 * T * 1024 + o + 8 * q);
#pragma unroll
              for (int e = 0; e < 4; ++e) { const float ylo = w0 * __uint_as_float(a0[e] << 16) + w1 * __uint_as_float(a1[e] << 16) + w2 * __uint_as_float(a2[e] << 16);
                  const float yhi = w0 * __uint_as_float(a0[e] & 0xffff0000u) + w1 * __uint_as_float(a1[e] & 0xffff0000u) + w2 * __uint_as_float(a2[e] & 0xffff0000u); pk[4 * q + e] = pk2(ylo, yhi); } }
          bf16* ya = WSP(bf16, WS_YA) + o; *(v4u*)ya = (v4u){pk[0], pk[1], pk[2], pk[3]}; *(v4u*)(ya + 8) = (v4u){pk[4], pk[5], pk[6], pk[7]}; }
#pragma unroll
        for (int h = 0; h < 4; ++h) { const size_t o = (size_t)m * 1024 + h * 256 + 4 * F.lane;
            const v2u b0 = *(const v2u*)(OB + o), b1 = *(const v2u*)(OB + (size_t)T * 1024 + o);
            const f32x4 v = (f32x4){__uint_as_float(b0.x << 16), __uint_as_float(b0.x & 0xffff0000u), __uint_as_float(b0.y << 16), __uint_as_float(b0.y & 0xffff0000u)}
                          - (f32x4){__uint_as_float(b1.x << 16), __uint_as_float(b1.x & 0xffff0000u), __uint_as_float(b1.y << 16), __uint_as_float(b1.y & 0xffff0000u)} * lam;
            const float ss = wave_sum((v.x * v.x + v.y * v.y) + (v.z * v.z + v.w * v.w)); const float rstd = 1.0f / sqrtf(ss * (1.0f / 256.0f) + EPS);
            const f32x4 g = *(const f32x4*)(A.in[I_SUBG] + 4 * F.lane); const f32x4 y = v * rstd * g * (1.0f - LAMBDA_INIT);
            v2u w; w.x = pk2(y.x, y.y); w.y = pk2(y.z, y.w); *(v2u*)(WSP(bf16, WS_YB) + o) = w; }
    }
}
typedef float f32x16r __attribute__((ext_vector_type(16)));
__device__ __forceinline__ void p7_router(Frame& F, const Args& A, bool commit = true) {
    LAS float* gainL = (LAS float*)F.lds;
    LAS float* shiftL = gainL + 2048;
    LAS float* part = shiftL + 2048;
    LAS float* ssp = part + 8 * 32 * 32;
    LAS float* logitL = ssp + 512;
    LAS float* rstdL = logitL + 32 * 33;
    LAS int* lcnt = (LAS int*)(rstdL + 32);
    LAS int* lbase = lcnt + 32;
    const float* H1 = WSP(float, WS_H1); const float* MODp = WSP(float, WS_MOD); const float* RC = WSP(float, WS_RC);
    for (int blk = F.vcu; blk < T / 32; blk += F.G) {
        const int t0 = blk * 32, bb = t0 / SEQ; const float* mod = MODp + bb * 12288;
        for (int k = F.tid; k < DM; k += 512) { gainL[k] = A.in[I_N2G][k] * (1.0f + mod[4 * DM + k]); shiftL[k] = mod[3 * DM + k]; }
        if (F.tid < 32) lcnt[F.tid] = 0;
        __syncthreads();
        {
            const int i = F.lane & 31, kk = F.lane >> 5, kb = F.wave * 256 + kk * 128;
            const float* hp = H1 + (size_t)(t0 + i) * DM + kb; const float* wp = A.in[I_WR] + (size_t)kb * 32 + i; const LAS float* gp = gainL + kb;
            f32x16r acc = {}; float ss = 0.f;
#pragma unroll 4
            for (int s0 = 0; s0 < 128; s0 += 4) {
                const f32x4 hv = *(const f32x4*)(hp + s0); const f32x4 g4 = *(const LAS f32x4*)(gp + s0);
                const float b0 = wp[(s0 + 0) * 32], b1 = wp[(s0 + 1) * 32], b2 = wp[(s0 + 2) * 32], b3 = wp[(s0 + 3) * 32];
                ss += (hv.x * hv.x + hv.y * hv.y) + (hv.z * hv.z + hv.w * hv.w);
                acc = __builtin_amdgcn_mfma_f32_32x32x2f32(hv.x * g4.x, b0, acc, 0, 0, 0);
                acc = __builtin_amdgcn_mfma_f32_32x32x2f32(hv.y * g4.y, b1, acc, 0, 0, 0);
                acc = __builtin_amdgcn_mfma_f32_32x32x2f32(hv.z * g4.z, b2, acc, 0, 0, 0);
                acc = __builtin_amdgcn_mfma_f32_32x32x2f32(hv.w * g4.w, b3, acc, 0, 0, 0);
            }
#pragma unroll
            for (int r = 0; r < 16; ++r) part[(F.wave * 32 + (r & 3) + 8 * (r >> 2) + 4 * kk) * 32 + i] = acc[r];
            ssp[F.wave * 64 + F.lane] = ss;
        }
        __syncthreads();
        { const int token = F.tid & 31, eg = F.tid >> 5; float s2 = 0.f;
#pragma unroll
          for (int w = 0; w < 8; ++w) s2 += ssp[w * 64 + token] + ssp[w * 64 + 32 + token];
          const float rstd = 1.0f / sqrtf(s2 * (1.0f / DM) + EPS);
#pragma unroll
          for (int q = 0; q < 2; ++q) { const int e = eg * 2 + q; float raw = 0.f;
#pragma unroll
              for (int w = 0; w < 8; ++w) raw += part[(w * 32 + token) * 32 + e];
              float rc = A.in[I_BR][e];
#pragma unroll 8
              for (int kq = 0; kq < 32; ++kq) rc += RC[(bb * 32 + kq) * 32 + e];
              logitL[token * 33 + e] = rstd * raw + rc; }
          if (eg == 0) rstdL[token] = rstd; }
        __syncthreads();
        int se[4] = {0, 0, 0, 0}, lp[4] = {0, 0, 0, 0}; float pv[4] = {0.f, 0.f, 0.f, 0.f};
        if (F.tid < 32) {
            float sv[4];
#pragma unroll
            for (int k = 0; k < 4; ++k) { float best = -INFINITY; int bi = 0;
                for (int e = 0; e < 32; ++e) { const float v = logitL[F.tid * 33 + e]; if (v > best) { best = v; bi = e; } }
                sv[k] = best; se[k] = bi; logitL[F.tid * 33 + bi] = -INFINITY; }
            float sum = 0.f;
#pragma unroll
            for (int k = 0; k < 4; ++k) { pv[k] = expf(sv[k] - sv[0]); sum += pv[k]; }
            const float inv = 1.0f / sum;
#pragma unroll
            for (int k = 0; k < 4; ++k) { pv[k] *= inv; lp[k] = __hip_atomic_fetch_add(lcnt + se[k], 1, __ATOMIC_RELAXED, __HIP_MEMORY_SCOPE_WORKGROUP); }
        }
        __syncthreads();
        if (F.tid < 32 && commit) lbase[F.tid] = (int)__hip_atomic_fetch_add((unsigned*)(F.ctl + CW_CNT + 64 * F.tid), (unsigned)lcnt[F.tid], RLX_AGENT);
        __syncthreads();
        if (F.tid < 32 && commit) { const int m = t0 + F.tid;
#pragma unroll
            for (int k = 0; k < 4; ++k) { const int pos = lbase[se[k]] + lp[k]; WSP(int, WS_TOPI)[m * 4 + k] = se[k]; WSP(float, WS_TOPP)[m * 4 + k] = pv[k]; WSP(int, WS_POS)[m * 4 + k] = pos;
                WSP(int, WS_TOKOF)[se[k] * 8192 + pos] = m; } }
        for (int i = 0; i < 4; ++i) { const int token = F.wave * 4 + i, m = t0 + token; const float rstd = rstdL[token];
            const float* hr = H1 + (size_t)m * DM + 4 * F.lane; unsigned char* ur = WSP(unsigned char, WS_U) + (size_t)m * DM + 4 * F.lane;
#pragma unroll
            for (int j = 0; j < 8; ++j) { const f32x4 h = *(const f32x4*)(hr + 256 * j), g = *(const LAS f32x4*)(gainL + 4 * F.lane + 256 * j), s = *(const LAS f32x4*)(shiftL + 4 * F.lane + 256 * j);
                const f32x4 u = h * rstd * g + s; int w8 = __builtin_amdgcn_cvt_pk_fp8_f32(u.x, u.y, 0, false); w8 = __builtin_amdgcn_cvt_pk_fp8_f32(u.z, u.w, w8, true); *(int*)(ur + 256 * j) = w8; } }
        __syncthreads();
    }
}
__device__ __forceinline__ void build_tile_table(Frame& F) {
    LAS int* ts = (LAS int*)(F.lds + TST_OFF);
    if (F.tid < 64) {
        const int e = F.tid & 31; const int c = (int)__hip_atomic_load((unsigned*)(F.ctl + CW_CNT + 64 * e), RLX_AGENT); const int tl = (c + 255) >> 8; int x = tl;
#pragma unroll
        for (int o = 1; o < 32; o <<= 1) { const int y = __shfl_up(x, o, 32); if (e >= o) x += y; }
        if (F.tid < 32) { ts[e] = x - tl; ts[40 + e] = c; if (e == 31) ts[32] = x; } }
    __syncthreads();
}
__device__ __forceinline__ void p11_final(Frame& F, const Args& A) {
    build_tile_table(F);
    const LAS int* ts = (const LAS int*)(F.lds + TST_OFF);
    const int gw = F.vcu * NWAVES + F.wave, NGW = F.G * NWAVES; const float* MODp = WSP(float, WS_MOD);
    for (int m = gw; m < T; m += NGW) {
        const int bb = m / SEQ; const bf16* yr[4]; float p[4];
#pragma unroll
        for (int k = 0; k < 4; ++k) { const int e = WSP(int, WS_TOPI)[m * 4 + k], pos = WSP(int, WS_POS)[m * 4 + k]; p[k] = WSP(float, WS_TOPP)[m * 4 + k];
            yr[k] = WSP(bf16, WS_YSLOT) + ((size_t)ts[e] * 256 + pos) * DM + 4 * F.lane; }
        const float* hr = WSP(float, WS_H1) + (size_t)m * DM + 4 * F.lane; f32x4 v[8]; float s = 0.f;
#pragma unroll
        for (int j = 0; j < 8; ++j) { f32x4 a = {0.f, 0.f, 0.f, 0.f};
#pragma unroll
            for (int k = 0; k < 4; ++k) { const v2u w = *(const v2u*)(yr[k] + 256 * j); const f32x4 y = {__uint_as_float(w.x << 16), __uint_as_float(w.x & 0xffff0000u), __uint_as_float(w.y << 16), __uint_as_float(w.y & 0xffff0000u)}; a += y * p[k]; }
            const f32x4 g2 = *(const f32x4*)(MODp + bb * 12288 + 5 * DM + 4 * F.lane + 256 * j);
            v[j] = *(const f32x4*)(hr + 256 * j) + g2 * a; s += (v[j].x * v[j].x + v[j].y * v[j].y) + (v[j].z * v[j].z + v[j].w * v[j].w); }
        const float rstd = 1.0f / sqrtf(wave_sum(s) * (1.0f / DM) + EPS);
        float* orow = A.out + (size_t)m * DM + 4 * F.lane;
#pragma unroll
        for (int j = 0; j < 8; ++j) { const f32x4 g = *(const f32x4*)(A.in[I_FG] + 4 * F.lane + 256 * j); *(f32x4*)(orow + 256 * j) = v[j] * rstd * g; }
    }
}

__global__ void __launch_bounds__(NWAVES * 64, 2) fwd(Args args) {
    extern __shared__ __attribute__((aligned(16))) unsigned char lds[];
    Frame F;
    F.lds = (LAS unsigned char*)lds; F.ldsg = (char*)lds;
    F.MISC = (volatile LAS unsigned*)(F.lds + MISC_OFF);
    F.tid = threadIdx.x; F.lane = F.tid & 63; F.wave = __builtin_amdgcn_readfirstlane(F.tid >> 6);
    F.G = gridDim.x; { const int bx = blockIdx.x; F.vcu = (F.G % 8 == 0) ? (bx % 8) * (F.G / 8) + bx / 8 : bx; }
    F.ws = args.ws; F.ctl = (gu32*)(args.ws + WS_CTL);
    for (int u = F.tid; u < (LDS_BYTES - LDSCTL_OFF) / 4; u += NWAVES * 64) ((LAS unsigned*)(F.lds + LDSCTL_OFF))[u] = 0u;
    __syncthreads();
#if MK_SPLIT
#define GRID_BAR() do { } while (0)
#else
    XcdBarrier bar = xcd_barrier_post((unsigned*)(F.ctl + CW_BAR), F.MISC + 8);
#define GRID_BAR() xcd_barrier(bar)
#endif
    const int lo = args.ph_lo, hi = args.ph_hi;
#define IN(k) (lo <= (k) && (k) < hi)
#define SEAM(k) do { if (IN(k) && IN((k) + 1)) GRID_BAR(); } while (0)
    const Args& A = args;
    constexpr bool AL = true, SP = true;

#ifndef REP_PHASE
#define REP_PHASE -1
#endif
#define REPN(k) ((REP_PHASE == (k)) ? 2 : 1)
    if (IN(0)) { for (int rep = 0; rep < REPN(0); ++rep) p0_mod(F, A); p0_convert(F, A); } SEAM(0);
    if (IN(1)) { for (int rep = 0; rep < REPN(1); ++rep) p1_modulate(F, A); } SEAM(1);
    if (IN(2)) {
        if constexpr (NLB > 0) { pg8::Gemm g{WSP(bf16, WS_U), WSP(bf16, WS_WINT), T, NLB * 1024, DM}; pg8::StaticOrder S; S.init(T, NLB * 1024, F.G, (int)blockIdx.x);
          pg8::EpiQKV E{WSP(bf16, WS_QKV), NQKV, LBMAP, 1.0f};
          pg8::gemm_phase<pg8::EpiQKV, pg8::StaticOrder, AL, SP>(F.lds + RING_OFF, g, S, E);
          VM_WAIT(); __syncthreads(); }
        { pg8::Gemm g{WSP(bf16, WS_U8Q), WSP(bf16, WS_WING), T, NLF * 1024, DM / 2}; pg8::StaticOrder S; S.init(T, NLF * 1024, F.G, (int)blockIdx.x);
          pg8::EpiQKV E{WSP(bf16, WS_QKV), NQKV, LFMAP, 1.0f / WSCALE};
          pg8::gemm_phase<pg8::EpiQKV, pg8::StaticOrder, AL, SP, true>(F.lds + RING_OFF, g, S, E); }
    } SEAM(2);
    if (IN(3)) { for (int rep = 0; rep < REPN(3); ++rep) p3_attention(F, A); } SEAM(3);
    if (IN(4)) { for (int rep = 0; rep < REPN(4); ++rep) p4_finalize(F, A); } SEAM(4);
    if (IN(5)) for (int rep = 0; rep < REPN(5); ++rep) {
        { pg8::Gemm g{WSP(bf16, WS_YA), WSP(bf16, WS_WAT), T, DM, 1024}; pg8::StaticOrder S; S.init(T, DM, F.G, (int)blockIdx.x);
          pg8::EpiM1 E{WSP(bf16, WS_M1), WSP(bf16, WS_QKV) + C_GA, NQKV};
          pg8::gemm_phase<pg8::EpiM1, pg8::StaticOrder, AL, SP>(F.lds + RING_OFF, g, S, E); }
        VM_WAIT(); __syncthreads();
        { pg8::Gemm g{WSP(bf16, WS_YB), WSP(bf16, WS_WBT), T, DM, 1024}; pg8::StaticOrder S; S.init(T, DM, F.G, (int)blockIdx.x);
          if constexpr (P6_F8) { pg8::EpiMerged E{WSP(bf16, WS_M1), WSP(bf16, WS_QKV) + C_GB, NQKV, WSP(unsigned char, WS_MG)};
            pg8::gemm_phase<pg8::EpiMerged, pg8::StaticOrder, AL, SP>(F.lds + RING_OFF, g, S, E); }
          else { pg8::EpiMergedB E{WSP(bf16, WS_M1), WSP(bf16, WS_QKV) + C_GB, NQKV, WSP(bf16, WS_MG)};
            pg8::gemm_phase<pg8::EpiMergedB, pg8::StaticOrder, AL, SP>(F.lds + RING_OFF, g, S, E); } }
    } SEAM(5);
    if (IN(6)) for (int rep = 0; rep < REPN(6); ++rep) {
        pg8::Gemm g{WSP(bf16, WS_MG), WSP(bf16, WS_WOT), T, DM, P6_F8 ? DM / 2 : DM}; pg8::StaticOrder S; S.init(T, DM, F.G, (int)blockIdx.x);
        pg8::EpiH1 E{A.in[I_X], WSP(float, WS_H1), WSP(float, WS_MOD) + 2 * DM, 12288, SEQ / 256, P6_F8 ? 1.0f / (16.0f * WSCALE) : 1.0f};
        pg8::gemm_phase<pg8::EpiH1, pg8::StaticOrder, AL, SP, P6_F8>(F.lds + RING_OFF, g, S, E);
    } SEAM(6);
    if (IN(7)) { for (int rep = 0; rep < REPN(7); ++rep) p7_router(F, A, rep == 0); } if (IN(7) && IN(9)) GRID_BAR();
    if (IN(9)) for (int rep = 0; rep < REPN(9); ++rep) {
        build_tile_table(F);
        pg8::Gemm g{WSP(bf16, WS_U), WSP(bf16, WS_WGU), TKPAD, NE * 4096, DM / 2}; pg8::MoeOrder S; S.init((const LAS int*)(F.lds + TST_OFF), 16, F.G, (int)blockIdx.x, WSP(int, WS_TOKOF));
        pg8::EpiSwiGLU E{WSP(unsigned char, WS_YACT), A.in[I_BG], A.in[I_BU], 1.0f / WSCALE};
        pg8::gemm_phase<pg8::EpiSwiGLU, pg8::MoeOrder, AL, SP, true, true>(F.lds + RING_OFF, g, S, E);
    } SEAM(9);
    if (IN(10)) for (int rep = 0; rep < REPN(10); ++rep) {
        build_tile_table(F);
        pg8::Gemm g{WSP(bf16, WS_YACT), WSP(bf16, WS_WD), TKPAD, NE * DM, DM / 2}; pg8::MoeOrder S; S.init((const LAS int*)(F.lds + TST_OFF), 8, F.G, (int)blockIdx.x);
        pg8::EpiBf16B E{WSP(bf16, WS_YSLOT), DM, A.in[I_BDN], 8, 1.0f / WSCALE};
        pg8::gemm_phase<pg8::EpiBf16B, pg8::MoeOrder, AL, SP, true>(F.lds + RING_OFF, g, S, E);
    } SEAM(10);
    if (IN(11)) { for (int rep = 0; rep < REPN(11); ++rep) p11_final(F, A); }
#undef IN
#undef SEAM
}
extern "C" void kernel_launch(void* const* d_in, const int* in_sizes, int n_in, void* d_out, int out_size, void* d_ws, size_t ws_size, hipStream_t stream) {
    static int grid = 0;
    if (grid == 0) {
        if (n_in != 24 || in_sizes[0] != T * DM || out_size != T * DM || ws_size < WS_END) { fprintf(stderr, "kernel_launch: shape mismatch (n_in %d, in0 %d, out %d, ws %zu < %zu); nothing launched\n", n_in, n_in > 0 ? in_sizes[0] : -1, out_size, ws_size, (size_t)WS_END); grid = -1; return; }
        int dev = 0, cus = 0, per_cu = 0;
        if (hipGetDevice(&dev) != hipSuccess || hipDeviceGetAttribute(&cus, hipDeviceAttributeMultiprocessorCount, dev) != hipSuccess) { grid = -1; return; }
        if (hipFuncSetAttribute((const void*)fwd, hipFuncAttributeMaxDynamicSharedMemorySize, LDS_BYTES) != hipSuccess) { fprintf(stderr, "kernel_launch: hipFuncSetAttribute failed\n"); grid = -1; return; }
        if (hipOccupancyMaxActiveBlocksPerMultiprocessor(&per_cu, (const void*)fwd, NWAVES * 64, LDS_BYTES) != hipSuccess || per_cu < 1)
            fprintf(stderr, "kernel_launch: note: occupancy query reports %d workgroups per CU\n", per_cu);
        (void)hipGetLastError();
        grid = cus;
    }
    if (grid < 0) return;
    if (hipMemsetAsync((char*)d_ws + WS_CTL, 0, CTL_ZERO_BYTES, stream) != hipSuccess) return;
    Args a; memset(&a, 0, sizeof(a));
    for (int i = 0; i < 24; ++i) a.in[i] = (const float*)d_in[i];
    a.out = (float*)d_out; a.ws = (unsigned char*)d_ws;
#if MK_SPLIT
    for (int ph = 0; ph < N_PHASES; ++ph) { a.ph_lo = ph; a.ph_hi = ph + 1; hipLaunchKernelGGL(fwd, dim3(grid), dim3(NWAVES * 64), LDS_BYTES, stream, a); }
#else
    a.ph_lo = 0; a.ph_hi = N_PHASES; hipLaunchKernelGGL(fwd, dim3(grid), dim3(NWAVES * 64), LDS_BYTES, stream, a);
#endif
    const hipError_t le = hipPeekAtLastError();
    if (le != hipSuccess) fprintf(stderr, "kernel_launch: launch failed: %s\n", hipGetErrorName(le));
}
```
